# Optimizing an MI355X kernel written in HIP

```python
import jax, jax.numpy as jnp
from jax import lax
import numpy as np

D_MODEL = 1024
BATCH = 8
SEQ = 4096
DEPTH = 1

CHUNK = 64
Q_BLOCK = 128
EPS = 1e-6
NEG_INF = -1e30

MLA_HEADS = 8
MLA_NOPE_DIM = 64
MLA_ROPE_DIM = 32
MLA_V_DIM = 64
MLA_Q_RANK = 256
MLA_KV_RANK = 128
ROPE_THETA = 10000.0
MLA_WIDTH = MLA_HEADS * MLA_V_DIM

FOX_HEADS = 8
FOX_HEAD_DIM = 64
FOX_WIDTH = FOX_HEADS * FOX_HEAD_DIM
FORGET_BIAS_MEAN = 3.0

N_GROUPS = 4
EXPERTS_PER_GROUP = 8
N_EXPERTS = N_GROUPS * EXPERTS_PER_GROUP
TOP_K = 2
EXPERT_FF = 256

IN_SPLITS = [MLA_Q_RANK, MLA_KV_RANK, MLA_ROPE_DIM,
             FOX_WIDTH, FOX_WIDTH, FOX_WIDTH, FOX_HEADS,
             D_MODEL, D_MODEL]
D_IN = int(sum(IN_SPLITS))
SPLIT_IDX = [int(v) for v in np.cumsum(IN_SPLITS)[:-1]]

kernel_name = "hybrid_mla_fox_hmoe_block"


def rms_norm(x, g):
    xf = x.astype(jnp.float32)
    y = xf * lax.rsqrt(jnp.mean(xf * xf, axis=-1, keepdims=True) + EPS)
    return (y * g.astype(jnp.float32)).astype(x.dtype)


def rope(x, positions):
    d = x.shape[-1]
    half = d // 2
    inv_freq = ROPE_THETA ** (-jnp.arange(half, dtype=jnp.float32) / half)
    ang = positions.astype(jnp.float32)[:, :, None, None] * inv_freq
    cos, sin = jnp.cos(ang), jnp.sin(ang)
    xf = x.astype(jnp.float32)
    x1, x2 = xf[..., :half], xf[..., half:]
    out = jnp.concatenate([x1 * cos - x2 * sin, x2 * cos + x1 * sin], axis=-1)
    return out.astype(x.dtype)


def blocked_attention(q, k, v, scale, decay=None):
    S = q.shape[1]
    outs = []
    for i in range(S // Q_BLOCK):
        q0, q1 = i * Q_BLOCK, (i + 1) * Q_BLOCK
        logits = jnp.einsum('bqhd,bkhd->bhqk', q[:, q0:q1], k[:, :q1]).astype(jnp.float32) * scale
        q_pos = jnp.arange(q0, q1)[:, None]
        k_pos = jnp.arange(q1)[None, :]
        if decay is None:
            allowed = (k_pos // CHUNK) <= (q_pos // CHUNK)
        else:
            logits = logits + decay[:, :, q0:q1, None] - decay[:, :, None, :q1]
            allowed = k_pos <= q_pos
        logits = jnp.where(allowed, logits, NEG_INF)
        probs = jax.nn.softmax(logits, axis=-1).astype(v.dtype)
        outs.append(jnp.einsum('bhqk,bkhd->bqhd', probs, v[:, :q1]))
    return jnp.concatenate(outs, axis=1)


def hybrid_mixer(xn, positions, w_in, b_forget, g_cq, g_ckv, w_uq, w_uk, w_uv,
                 w_o_mla, w_o_fox, w_out):
    B, S, _ = xn.shape
    z = xn @ w_in
    c_q, c_kv, k_r, fq, fk, fv, f_logit, gate_a, gate_b = jnp.split(z, SPLIT_IDX, axis=-1)

    q = (rms_norm(c_q, g_cq) @ w_uq).reshape(B, S, MLA_HEADS, MLA_NOPE_DIM + MLA_ROPE_DIM)
    q = jnp.concatenate([q[..., :MLA_NOPE_DIM], rope(q[..., MLA_NOPE_DIM:], positions)], axis=-1)
    ckv = rms_norm(c_kv, g_ckv)
    k_nope = (ckv @ w_uk).reshape(B, S, MLA_HEADS, MLA_NOPE_DIM)
    v_a = (ckv @ w_uv).reshape(B, S, MLA_HEADS, MLA_V_DIM)
    k_rope = rope(k_r[:, :, None, :], positions)
    k_a = jnp.concatenate(
        [k_nope, jnp.broadcast_to(k_rope, (B, S, MLA_HEADS, MLA_ROPE_DIM))], axis=-1)
    o_a = blocked_attention(q, k_a, v_a, (MLA_NOPE_DIM + MLA_ROPE_DIM) ** -0.5)
    y_a = o_a.reshape(B, S, MLA_WIDTH) @ w_o_mla

    q_b = fq.reshape(B, S, FOX_HEADS, FOX_HEAD_DIM)
    k_b = fk.reshape(B, S, FOX_HEADS, FOX_HEAD_DIM)
    v_b = fv.reshape(B, S, FOX_HEADS, FOX_HEAD_DIM)
    log_f = jax.nn.log_sigmoid(f_logit.astype(jnp.float32) + b_forget.astype(jnp.float32))
    decay = jnp.transpose(jnp.cumsum(log_f, axis=1), (0, 2, 1))
    o_b = blocked_attention(q_b, k_b, v_b, FOX_HEAD_DIM ** -0.5, decay)
    y_b = o_b.reshape(B, S, FOX_WIDTH) @ w_o_fox

    mixed = jax.nn.sigmoid(gate_a) * y_a + jax.nn.sigmoid(gate_b) * y_b
    return mixed @ w_out


def hierarchical_moe(hn, w_group, b_group, w_router, b_router, w_e_gate, w_e_up, w_e_down):
    B, S, D = hn.shape
    t = hn.reshape(B * S, D)
    p_group = jax.nn.softmax((t @ w_group).astype(jnp.float32) + b_group.astype(jnp.float32), axis=-1)
    g_p, g_idx = lax.top_k(p_group, 1)
    exp_logits = ((t @ w_router).astype(jnp.float32) + b_router.astype(jnp.float32)
                  ).reshape(-1, N_GROUPS, EXPERTS_PER_GROUP)
    sel = jnp.take_along_axis(exp_logits, g_idx[:, :, None], axis=1)[:, 0]
    e_p, e_idx = lax.top_k(jax.nn.softmax(sel, axis=-1), TOP_K)
    e_p = e_p / jnp.sum(e_p, axis=-1, keepdims=True)
    weights = g_p * e_p
    expert_id = g_idx * EXPERTS_PER_GROUP + e_idx
    combine = jnp.sum(jax.nn.one_hot(expert_id, N_EXPERTS, dtype=jnp.float32)
                      * weights[..., None], axis=1)
    y = jnp.zeros((B * S, D), jnp.float32)
    for e in range(N_EXPERTS):
        a = jax.nn.silu(t @ w_e_gate[e]) * (t @ w_e_up[e])
        y = y + combine[:, e:e + 1] * (a @ w_e_down[e]).astype(jnp.float32)
    return y.reshape(B, S, D).astype(hn.dtype)


def setup_inputs(seed: int = 0) -> dict:
    key = jax.random.key(seed)
    ks = jax.random.split(key, 24)
    f32 = jnp.float32

    def w(k, shape, fan_in):
        return jax.random.normal(k, shape, f32) * (fan_in ** -0.5)

    def gain(k, n):
        return 1.0 + 0.02 * jax.random.normal(k, (n,), f32)

    x = jax.random.normal(ks[0], (BATCH, SEQ, D_MODEL), f32)
    offset = jax.random.randint(ks[1], (BATCH, 1), 0, 4096, dtype=jnp.int32)
    positions = offset + jnp.arange(SEQ, dtype=jnp.int32)[None, :]
    return {
        "x": x,
        "positions": positions,
        "g_mix": gain(ks[2], D_MODEL),
        "w_in": w(ks[3], (D_MODEL, D_IN), D_MODEL),
        "b_forget": FORGET_BIAS_MEAN + 0.5 * jax.random.normal(ks[4], (FOX_HEADS,), f32),
        "g_cq": gain(ks[5], MLA_Q_RANK),
        "g_ckv": gain(ks[6], MLA_KV_RANK),
        "w_uq": w(ks[7], (MLA_Q_RANK, MLA_HEADS * (MLA_NOPE_DIM + MLA_ROPE_DIM)), MLA_Q_RANK),
        "w_uk": w(ks[8], (MLA_KV_RANK, MLA_HEADS * MLA_NOPE_DIM), MLA_KV_RANK),
        "w_uv": w(ks[9], (MLA_KV_RANK, MLA_HEADS * MLA_V_DIM), MLA_KV_RANK),
        "w_o_mla": w(ks[10], (MLA_WIDTH, D_MODEL), MLA_WIDTH),
        "w_o_fox": w(ks[11], (FOX_WIDTH, D_MODEL), FOX_WIDTH),
        "w_out": w(ks[12], (D_MODEL, D_MODEL), D_MODEL),
        "g_ffn": gain(ks[13], D_MODEL),
        "w_group": w(ks[14], (D_MODEL, N_GROUPS), D_MODEL),
        "b_group": 0.01 * jax.random.normal(ks[15], (N_GROUPS,), f32),
        "w_router": w(ks[16], (D_MODEL, N_EXPERTS), D_MODEL),
        "b_router": 0.01 * jax.random.normal(ks[17], (N_EXPERTS,), f32),
        "w_e_gate": w(ks[18], (N_EXPERTS, D_MODEL, EXPERT_FF), D_MODEL),
        "w_e_up": w(ks[19], (N_EXPERTS, D_MODEL, EXPERT_FF), D_MODEL),
        "w_e_down": w(ks[20], (N_EXPERTS, EXPERT_FF, D_MODEL), EXPERT_FF),
        "g_final": gain(ks[21], D_MODEL),
    }


def reference(x, positions, g_mix, w_in, b_forget, g_cq, g_ckv, w_uq, w_uk, w_uv,
              w_o_mla, w_o_fox, w_out, g_ffn, w_group, b_group, w_router, b_router,
              w_e_gate, w_e_up, w_e_down, g_final):
    h = x
    for _ in range(DEPTH):
        h = h + hybrid_mixer(rms_norm(h, g_mix), positions, w_in, b_forget, g_cq, g_ckv,
                             w_uq, w_uk, w_uv, w_o_mla, w_o_fox, w_out)
        h = h + hierarchical_moe(rms_norm(h, g_ffn), w_group, b_group, w_router, b_router,
                                 w_e_gate, w_e_up, w_e_down)
    return rms_norm(h, g_final)
```

```cpp
#include <hip/hip_runtime.h>
#include <hip/hip_bf16.h>
#include <hip/hip_cooperative_groups.h>
#include <cstdio>
#include <cstdint>
#include <cmath>
namespace pg8 {
#define PG8_LAS __attribute__((address_space(3)))
typedef unsigned short bf16_t;
typedef short bf16x8 __attribute__((ext_vector_type(8)));
typedef float f32x4 __attribute__((ext_vector_type(4)));
typedef unsigned u32x4 __attribute__((ext_vector_type(4)));
constexpr int BM = 256, BK = 64, HALF = 128, HTB = HALF * BK * 2  , STAGE_BYTES = 8 * HTB, NXCD = 8, WGM = 8;

__host__ __device__ __forceinline__ int lds_byte(int r, int c) { const int st = (r >> 4) * 2 + (c >> 5), rr = r & 15, cc = c & 31, ob = rr * 64 + cc * 2; return st * 1024 + (ob ^ (((ob >> 9) & 1) << 5)); }
__host__ __device__ __forceinline__ void stage_rc(int b, int& R, int& C) { const int st = b / 1024, sb = b % 1024, swz = sb ^ (((sb >> 9) & 1) << 5); R = (st >> 1) * 16 + swz / 64; C = (st & 1) * 32 + (swz % 64) / 2; }
__host__ __device__ __forceinline__ int perm32(int rho) { const int n = rho >> 4, i = rho & 15; return 8 * (i >> 2) + 4 * n + (i & 3); }

struct Unit { int pm, pn; };
struct Gemm { const bf16_t* A; const bf16_t* Bt; int M, N, K; };

struct StaticOrder {
    int nM, nN, nwg, G, c;
    __host__ __device__ void init(int M, int N, int G_, int c_) { nM = M / BM; nN = N / BM; nwg = nM * nN; G = G_; c = c_; }
    __host__ __device__ bool next(int i, Unit& u) const {
        const long L = (long)i * G + c; if (L >= nwg) return false;
        int wgid = (int)L; { const int q = nwg / NXCD, r = nwg % NXCD, xcd = wgid % NXCD, off = wgid / NXCD; wgid = (xcd < r ? xcd * (q + 1) : r * (q + 1) + (xcd - r) * q) + off; }
        const int nig = WGM * nN, gid = wgid / nig, fm = gid * WGM, gsz = (nM - fm) < WGM ? (nM - fm) : WGM;
        u.pm = fm + ((wgid % nig) % gsz); u.pn = (wgid % nig) / gsz; return true;
    }
    __device__ __forceinline__ void a_ready(const Unit&) const {}
    __device__ __forceinline__ void done(const Unit&) const {}
};

__device__ __forceinline__ unsigned cvt_pk_bf16(float lo, float hi) { unsigned r; asm volatile("v_cvt_pk_bf16_f32 %0, %1, %2" : "=v"(r) : "v"(lo), "v"(hi)); return r; }
typedef float f32x2 __attribute__((ext_vector_type(2)));
template <class Epi, class Sched, bool ALIGN_EPI = false, bool SP2 = false>
__device__ __forceinline__ void gemm_phase(PG8_LAS unsigned char* lds, const Gemm g, const Sched& S, const Epi& E) {
    const int tid = threadIdx.x, wid = __builtin_amdgcn_readfirstlane(tid >> 6), lane = tid & 63, wr = wid >> 2, wc = wid & 3, fr = lane & 15, fq = lane >> 4;
    const int K = g.K; int nt = K / BK; asm volatile("" : "+s"(nt));
    unsigned voffA[2], voffB[2];
#pragma unroll
    for (int i = 0; i < 2; ++i) { int R, C; stage_rc(tid * 16 + i * 8192, R, C); const int Rb = Epi::PERM ? ((R & ~31) + perm32(R & 31)) : R;
        voffA[i] = (unsigned)(R * K + C) * 2u; voffB[i] = (unsigned)(Rb * K + C) * 2u; }
    const size_t kstep = (size_t)(BK * 2);
    const size_t hstep = (size_t)HALF * K * 2;
    const size_t tstep = 2 * hstep;
    const unsigned ldsw = (unsigned)wid * 1024u;
    const int aoff = lds_byte(wr * 64 + fr, fq * 8), boff = lds_byte(wc * 32 + fr, fq * 8);
#define PG8_SA(b, h) (((b) * 2 + (h)) * HTB)
#define PG8_SB(b, h) ((4 + (b) * 2 + (h)) * HTB)
#define PG8_STAGE(bufoff, gbase, voff) do { _Pragma("unroll") for (int _i = 0; _i < 2; ++_i) \
        __builtin_amdgcn_global_load_lds((const unsigned*)((const char*)(gbase) + (voff)[_i]), (PG8_LAS unsigned*)(lds + (bufoff) + ldsw + _i * 8192), 16, 0, 0); } while (0)
#define PG8_LDA(dst, b, h) do { _Pragma("unroll") for (int m = 0; m < 4; ++m) _Pragma("unroll") for (int k = 0; k < 2; ++k) dst[m][k] = *(const PG8_LAS bf16x8*)(lds + PG8_SA(b, h) + aoff + m * 2048 + k * 1024); } while (0)
#define PG8_LDB(dst, b, h) do { _Pragma("unroll") for (int n = 0; n < 2; ++n) _Pragma("unroll") for (int k = 0; k < 2; ++k) dst[n][k] = *(const PG8_LAS bf16x8*)(lds + PG8_SB(b, h) + boff + n * 2048 + k * 1024); } while (0)
#define PG8_MMA(ai, bj, At, Bt) do { __builtin_amdgcn_s_setprio(1); _Pragma("unroll") for (int m = 0; m < 4; ++m) _Pragma("unroll") for (int n = 0; n < 2; ++n) _Pragma("unroll") for (int k = 0; k < 2; ++k) \
        acc[ai][bj][m][n] = __builtin_amdgcn_mfma_f32_16x16x32_bf16(Bt[n][k], At[m][k], acc[ai][bj][m][n], 0, 0, 0); __builtin_amdgcn_s_setprio(0); } while (0)
#define PG8_WAIT_V(n) asm volatile("s_waitcnt vmcnt(" #n ")" ::: "memory")
#define PG8_WAIT_L(n) asm volatile("s_waitcnt lgkmcnt(" #n ")" ::: "memory")
#define PG8_BAR __builtin_amdgcn_s_barrier()
#define PG8_SCHED __builtin_amdgcn_sched_barrier(0)
    Unit cur, nxt; int ui = 0;
    if (!S.next(0, cur)) return;
    f32x4 acc[2][2][4][2];
#pragma unroll
    for (int a = 0; a < 2; ++a)
#pragma unroll
        for (int b = 0; b < 2; ++b)
#pragma unroll
            for (int m = 0; m < 4; ++m)
#pragma unroll
                for (int n = 0; n < 2; ++n) acc[a][b][m][n] = (f32x4){0.f, 0.f, 0.f, 0.f};
    bf16x8 At[4][2], B0[2][2], B1[2][2];
    const char* cA = (const char*)g.A + (size_t)cur.pm * tstep; const char* cB = (const char*)g.Bt + (size_t)cur.pn * tstep;
    S.a_ready(cur);
    if constexpr (SP2) {
        PG8_STAGE(PG8_SB(0, 0), cB, voffB); PG8_STAGE(PG8_SB(0, 1), cB + hstep, voffB); PG8_STAGE(PG8_SA(0, 0), cA, voffA); PG8_STAGE(PG8_SA(0, 1), cA + hstep, voffA);
        if (wr == 1) PG8_BAR;
        PG8_WAIT_V(2); PG8_BAR;
        PG8_STAGE(PG8_SB(1, 0), cB + kstep, voffB); PG8_STAGE(PG8_SA(1, 0), cA + kstep, voffA); PG8_STAGE(PG8_SB(1, 1), cB + hstep + kstep, voffB);
        PG8_WAIT_V(6); PG8_BAR;
    } else {
        PG8_STAGE(PG8_SB(0, 0), cB, voffB); PG8_STAGE(PG8_SA(0, 0), cA, voffA); PG8_STAGE(PG8_SB(0, 1), cB + hstep, voffB); PG8_STAGE(PG8_SA(0, 1), cA + hstep, voffA);
        if (wr == 1) PG8_BAR;
        PG8_WAIT_V(4); PG8_BAR;
        PG8_STAGE(PG8_SB(1, 0), cB + kstep, voffB); PG8_STAGE(PG8_SA(1, 0), cA + kstep, voffA); PG8_STAGE(PG8_SB(1, 1), cB + hstep + kstep, voffB);
        PG8_WAIT_V(6); PG8_BAR;
    }
    for (;;) {
        const bool has_next = S.next(ui + 1, nxt);
        const char* nA = has_next ? (const char*)g.A + (size_t)nxt.pm * tstep : cA; const char* nB = has_next ? (const char*)g.Bt + (size_t)nxt.pn * tstep : cB;
        for (int t = 0; t < nt; t += 2) {
            const bool last = (t == nt - 2);
            const char* a1 = cA + (size_t)(t + 1) * kstep;
            const char* a2 = last ? nA : cA + (size_t)(t + 2) * kstep; const char* b2 = last ? nB : cB + (size_t)(t + 2) * kstep;
            const char* a3 = a2 + kstep; const char* b3 = b2 + kstep;
            if (last && has_next) S.a_ready(nxt);
            if constexpr (SP2) {
            PG8_LDB(B0, 0, 0); PG8_LDB(B1, 0, 1); PG8_SCHED; PG8_LDA(At, 0, 0); PG8_STAGE(PG8_SA(1, 1), a1 + hstep, voffA);
            PG8_WAIT_V(8); PG8_WAIT_L(0); PG8_BAR; PG8_MMA(0, 0, At, B0); PG8_MMA(0, 1, At, B1); PG8_BAR; PG8_SCHED;
            PG8_LDA(At, 0, 1); PG8_STAGE(PG8_SB(0, 0), b2, voffB); PG8_STAGE(PG8_SB(0, 1), b2 + hstep, voffB); PG8_STAGE(PG8_SA(0, 0), a2, voffA);
            PG8_WAIT_V(8); PG8_WAIT_L(0); PG8_BAR; PG8_MMA(1, 0, At, B0); PG8_MMA(1, 1, At, B1); PG8_BAR; PG8_SCHED;
            PG8_LDB(B0, 1, 0); PG8_LDB(B1, 1, 1); PG8_SCHED; PG8_LDA(At, 1, 0); PG8_STAGE(PG8_SA(0, 1), a2 + hstep, voffA);
            PG8_WAIT_V(8); PG8_WAIT_L(0); PG8_BAR; PG8_MMA(0, 0, At, B0); PG8_MMA(0, 1, At, B1); PG8_BAR; PG8_SCHED;
            PG8_LDA(At, 1, 1); PG8_STAGE(PG8_SB(1, 0), b3, voffB); PG8_STAGE(PG8_SB(1, 1), b3 + hstep, voffB); PG8_STAGE(PG8_SA(1, 0), a3, voffA);
            PG8_WAIT_V(8); PG8_WAIT_L(0); PG8_BAR; PG8_MMA(1, 0, At, B0); PG8_MMA(1, 1, At, B1); PG8_BAR; PG8_SCHED;
            } else {
            PG8_LDB(B0, 0, 0); PG8_SCHED; PG8_LDA(At, 0, 0); PG8_STAGE(PG8_SA(1, 1), a1 + hstep, voffA);
            PG8_WAIT_L(8); PG8_BAR; PG8_WAIT_L(0); PG8_MMA(0, 0, At, B0); PG8_BAR; PG8_SCHED;
            PG8_LDB(B1, 0, 1); PG8_STAGE(PG8_SB(0, 0), b2, voffB);
            PG8_BAR; PG8_WAIT_L(0); PG8_MMA(0, 1, At, B1); PG8_BAR;
            PG8_LDA(At, 0, 1); PG8_STAGE(PG8_SA(0, 0), a2, voffA);
            PG8_BAR; PG8_WAIT_L(0); PG8_MMA(1, 0, At, B0); PG8_BAR; PG8_SCHED;
            PG8_STAGE(PG8_SB(0, 1), b2 + hstep, voffB);
            PG8_WAIT_V(6); PG8_BAR; PG8_MMA(1, 1, At, B1); PG8_BAR;
            PG8_LDB(B0, 1, 0); PG8_SCHED; PG8_LDA(At, 1, 0); PG8_STAGE(PG8_SA(0, 1), a2 + hstep, voffA);
            PG8_WAIT_L(8); PG8_BAR; PG8_WAIT_L(0); PG8_MMA(0, 0, At, B0); PG8_BAR; PG8_SCHED;
            PG8_LDB(B1, 1, 1); PG8_STAGE(PG8_SB(1, 0), b3, voffB);
            PG8_BAR; PG8_WAIT_L(0); PG8_MMA(0, 1, At, B1); PG8_BAR;
            PG8_LDA(At, 1, 1); PG8_STAGE(PG8_SA(1, 0), a3, voffA);
            PG8_BAR; PG8_WAIT_L(0); PG8_MMA(1, 0, At, B0); PG8_BAR; PG8_SCHED;
            PG8_STAGE(PG8_SB(1, 1), b3 + hstep, voffB);
            PG8_WAIT_V(6); PG8_BAR; PG8_MMA(1, 1, At, B1); PG8_BAR;
            }
        }
        if constexpr (ALIGN_EPI) { if (wr == 0) PG8_BAR; }
        if constexpr (!Epi::AFTER_DRAIN) { E(acc, cur, wr, wc, fr, fq); S.done(cur); }
        if (!has_next) break;
#pragma unroll
        for (int a = 0; a < 2; ++a)
#pragma unroll
            for (int b = 0; b < 2; ++b)
#pragma unroll
                for (int m = 0; m < 4; ++m)
#pragma unroll
                    for (int n = 0; n < 2; ++n) acc[a][b][m][n] = (f32x4){0.f, 0.f, 0.f, 0.f};
        cur = nxt; cA = nA; cB = nB; ++ui;
        if constexpr (ALIGN_EPI) { if (wr == 1) PG8_BAR; }
    }
    PG8_WAIT_V(0);
    if constexpr (!ALIGN_EPI) { if (wr == 0) PG8_BAR; }
    PG8_BAR;
    if constexpr (Epi::AFTER_DRAIN) { E.fused(acc, cur, wr, wc, fr, fq, lds, wid, lane); S.done(cur); }
#undef PG8_SA
#undef PG8_SB
#undef PG8_STAGE
#undef PG8_LDA
#undef PG8_LDB
#undef PG8_MMA
#undef PG8_WAIT_V
#undef PG8_WAIT_L
#undef PG8_BAR
#undef PG8_SCHED
}
}
namespace att {
typedef unsigned short bf16;
using bf16x8 = __attribute__((ext_vector_type(8))) short;
using s16x4 = __attribute__((ext_vector_type(4))) short;
using f32x16 = __attribute__((ext_vector_type(16))) float;
using u32x4 = __attribute__((ext_vector_type(4))) unsigned;
constexpr int SEQ = 4096, NW = 8, QB = 256, KVBLK = 64;
constexpr int KSLOT = 12288, VSLOT = 8192, NSLOT = 3;
constexpr int LDS_K = 0, LDS_V = NSLOT * KSLOT, LDS_WS = LDS_V + NSLOT * VSLOT, LDS_OST = LDS_WS + NW * 256, LDS_BYTES = LDS_OST + NW * 4096;
constexpr float THR = 8.0f;
#define ATT_LAS __attribute__((address_space(3)))
#define SBAR() __builtin_amdgcn_sched_barrier(0)
#define WAIT_BAR(N) asm volatile("s_waitcnt vmcnt(" #N ") lgkmcnt(0)\n\ts_barrier" ::: "memory")
__device__ __forceinline__ int crow(int r, int hi) { return (r & 3) + 8 * (r >> 2) + 4 * hi; }
__device__ __forceinline__ void glds16(const void* gsrc, unsigned lds_dst) { unsigned keep;
  asm volatile("s_mov_b32 %0, m0\n\ts_mov_b32 m0, %2\n\ts_nop 0\n\tglobal_load_lds_dwordx4 %1, off\n\ts_mov_b32 m0, %0" : "=&s"(keep) : "v"(gsrc), "s"(lds_dst) : "memory"); }
typedef float f32x2_t __attribute__((ext_vector_type(2))); typedef __bf16 bf16x2_t __attribute__((ext_vector_type(2)));
__device__ __forceinline__ unsigned cvtpk_s(float lo, float hi) { f32x2_t v = {lo, hi}; bf16x2_t b = __builtin_convertvector(v, bf16x2_t); return __builtin_bit_cast(unsigned, b); }
typedef ATT_LAS const char* lds_cptr;
#define MX3(a, b, c) __builtin_fmaxf(__builtin_fmaxf((a), (b)), (c))
__device__ __forceinline__ float rowmax(const f32x16& p0, const f32x16& p1) {
  float a = MX3(p0[0], p0[1], p1[0]), b = MX3(p0[2], p0[3], p1[1]); a = MX3(a, p1[2], p1[3]);
#pragma unroll
  for (int r = 4; r < 16; r += 4) { a = MX3(a, p0[r], p0[r + 1]); b = MX3(b, p0[r + 2], p0[r + 3]); a = MX3(a, p1[r], p1[r + 1]); b = MX3(b, p1[r + 2], p1[r + 3]); }
  float m = __builtin_fmaxf(a, b); auto rr = __builtin_amdgcn_permlane32_swap(__float_as_uint(m), __float_as_uint(m), false, false);
  return __builtin_fmaxf(__uint_as_float(rr[0]), __uint_as_float(rr[1])); }
__device__ __forceinline__ void cmask(f32x16& p0, f32x16& p1, int jb, int qrel, int hi) {
  const int kb = 64 * jb + 4 * hi;
#pragma unroll
  for (int r = 0; r < 16; ++r) { const int kv = kb + (r & 3) + 8 * (r >> 2); if (kv > qrel) p0[r] = -INFINITY; if (kv + 32 > qrel) p1[r] = -INFINITY; } }
template <int ND0> __device__ __forceinline__ void qkt(f32x16& p0, f32x16& p1, lds_cptr kp, const bf16x8* qr, const f32x16& negm) {
#pragma unroll
  for (int d0 = 0; d0 < ND0; ++d0) {
    const bf16x8 b0 = *(const ATT_LAS bf16x8*)(kp + d0 * 2048);
    const bf16x8 b1 = *(const ATT_LAS bf16x8*)(kp + d0 * 2048 + 512);
    if (d0 == 0) { p0 = __builtin_amdgcn_mfma_f32_32x32x16_bf16(b0, qr[0], negm, 0, 0, 0); p1 = __builtin_amdgcn_mfma_f32_32x32x16_bf16(b1, qr[0], negm, 0, 0, 0); }
    else { p0 = __builtin_amdgcn_mfma_f32_32x32x16_bf16(b0, qr[d0], p0, 0, 0, 0); p1 = __builtin_amdgcn_mfma_f32_32x32x16_bf16(b1, qr[d0], p1, 0, 0, 0); } }
}
__device__ __forceinline__ void pv(f32x16* o, int vb, bf16x8 pa0, bf16x8 pa1, bf16x8 pa2, bf16x8 pa3) {
#pragma unroll
  for (int d0 = 0; d0 < 2; ++d0) { s16x4 lo[4], hi[4];
#pragma unroll
    for (int ks = 0; ks < 4; ++ks) {
      asm volatile("ds_read_b64_tr_b16 %0,%1 offset:%c2" : "=&v"(lo[ks]) : "v"(vb), "i"(d0 * 4096 + ks * 1024) : "memory");
      asm volatile("ds_read_b64_tr_b16 %0,%1 offset:%c2" : "=&v"(hi[ks]) : "v"(vb), "i"(d0 * 4096 + ks * 1024 + 512) : "memory"); }
    asm volatile("s_waitcnt lgkmcnt(0)" ::: "memory"); SBAR();
#define PK(k) (bf16x8){lo[k][0], lo[k][1], lo[k][2], lo[k][3], hi[k][0], hi[k][1], hi[k][2], hi[k][3]}
    o[d0] = __builtin_amdgcn_mfma_f32_32x32x16_bf16(pa0, PK(0), o[d0], 0, 0, 0);
    o[d0] = __builtin_amdgcn_mfma_f32_32x32x16_bf16(pa1, PK(1), o[d0], 0, 0, 0);
    o[d0] = __builtin_amdgcn_mfma_f32_32x32x16_bf16(pa2, PK(2), o[d0], 0, 0, 0);
    o[d0] = __builtin_amdgcn_mfma_f32_32x32x16_bf16(pa3, PK(3), o[d0], 0, 0, 0);
#undef PK
  }
}
struct AttnT { const bf16* Q; const bf16* K; const bf16* KR; const bf16* V; bf16* O; const float* CS; };
template <int KIND> __device__ __forceinline__ void attn_unit(int b, int h, int qb, const AttnT& T, char* shm) {
  constexpr int ND0 = KIND == 0 ? 6 : 5, QP = KIND == 0 ? 768 : 640, HD = KIND == 0 ? 96 : 80;
  const int tid = threadIdx.x, lane = tid & 63, r32 = lane & 31, hi = lane >> 5; const int wid = __builtin_amdgcn_readfirstlane(tid >> 6);
  const long rowbase = (long)b * SEQ; const int q0 = qb * QB;
  const bf16* Qw = T.Q + (rowbase + q0 + wid * 32) * QP + h * HD;
  const unsigned lds0 = (unsigned)(uintptr_t)shm;
  const lds_cptr shm3 = (lds_cptr)shm;
  ATT_LAS float* wsf = (ATT_LAS float*)(shm3 + LDS_WS) + wid * 64;
  const bf16 *ksrcA, *ksrcB; long kstepA, kstepB; unsigned kdstB;
  const unsigned kdstA = lds0 + LDS_K + wid * 1024;
  if (KIND == 0) { ksrcA = T.K + (rowbase + lane) * 512 + h * 64 + wid * 8; ksrcB = T.KR + (rowbase + lane) * 32 + (wid & 3) * 8; kdstB = lds0 + LDS_K + (8 + (wid & 3)) * 1024; kstepA = 64 * 512; kstepB = 64 * 32; }
  else { ksrcA = T.K + (rowbase + lane) * 640 + h * 80 + wid * 8; ksrcB = T.K + (rowbase + lane) * 640 + h * 80 + (8 + (wid & 1)) * 8; kdstB = lds0 + LDS_K + (8 + (wid & 1)) * 1024; kstepA = 64 * 640; kstepB = 64 * 640; }
  const bf16* vsrc = T.V + (rowbase + 16 * (wid & 3) + (lane >> 2)) * 512 + h * 64 + (wid >> 2) * 32 + (lane & 3) * 8;
  const unsigned vdst = lds0 + LDS_V + wid * 1024;
#define DMA_T(t, s) do { glds16(ksrcA + (long)(t) * kstepA, (unsigned)__builtin_amdgcn_readfirstlane(kdstA + (s) * KSLOT)); \
                         glds16(ksrcB + (long)(t) * kstepB, (unsigned)__builtin_amdgcn_readfirstlane(kdstB + (s) * KSLOT)); \
                         glds16(vsrc + (long)(t) * (64 * 512), (unsigned)__builtin_amdgcn_readfirstlane(vdst + (s) * VSLOT)); } while (0)
  const int vb0 = (int)(lds0 + LDS_V) + ((lane >> 4) & 1) * 32 + (lane & 3) * 8 + (4 * hi + ((lane & 15) >> 2)) * 64;
  const lds_cptr kp0 = shm3 + LDS_K + hi * 1024 + r32 * 16;
  const int NT = (q0 + QB) / KVBLK;
  DMA_T(0, 0); DMA_T(1, 1);
  bf16x8 qr[ND0];
#pragma unroll
  for (int d0 = 0; d0 < ND0; ++d0) qr[d0] = *reinterpret_cast<const bf16x8*>(&Qw[(long)r32 * QP + d0 * 16 + hi * 8]);
  if (KIND == 0) {
    const float* cs = T.CS + (rowbase + q0 + wid * 32 + r32) * 32 + 16 * hi;
    typedef float f32x4_t __attribute__((ext_vector_type(4)));
    bf16x8 a = qr[4], c = qr[5];
#pragma unroll
    for (int j2 = 0; j2 < 4; ++j2) { const f32x4_t t4 = *(const f32x4_t*)(cs + 4 * j2);
#pragma unroll
      for (int e = 0; e < 2; ++e) { const int j = 2 * j2 + e; const float co = t4[2 * e], si = t4[2 * e + 1];
        const float x1 = __builtin_bit_cast(float, (unsigned)(unsigned short)a[j] << 16), x2 = __builtin_bit_cast(float, (unsigned)(unsigned short)c[j] << 16);
        const float o1 = x1 * co - x2 * si, o2 = x2 * co + x1 * si;
        qr[4][j] = (short)(cvtpk_s(o1, o1) & 0xffffu); qr[5][j] = (short)(cvtpk_s(o2, o2) & 0xffffu); } }
  }
  float mhat = 0.f, l_reg = 0.f; f32x16 o[2]; o[0] = f32x16{}; o[1] = f32x16{}; f32x16 negm = f32x16{};
  const int qrel = wid * 32 + r32;
  int s_cur = 0;
  for (int t = 0; t < NT; ++t) {
    if (t + 1 < NT) { WAIT_BAR(3); } else { WAIT_BAR(0); }
    if (t + 2 < NT) { const int s2 = (s_cur >= 1) ? s_cur - 1 : 2; DMA_T(t + 2, s2); }
    const int jb = t - 4 * qb;
    const bool vis = (KIND == 0) ? (t <= 4 * qb + (wid >> 1)) : ((jb < 0) || (64 * jb <= 32 * wid + 31));
    if (vis) {
      f32x16 p0, p1;
      qkt<ND0>(p0, p1, kp0 + s_cur * KSLOT, qr, negm);
      if (KIND == 1) { if (jb >= 0) cmask(p0, p1, jb, qrel, hi); }
      const float rm = rowmax(p0, p1);
      if (t == 0 || __any(rm > THR)) {
        const float dl = (t == 0) ? rm : __builtin_fmaxf(rm, 0.f);
        mhat += dl;
#pragma unroll
        for (int r = 0; r < 16; ++r) { p0[r] -= dl; p1[r] -= dl; negm[r] = -mhat; }
        const float f = __builtin_amdgcn_exp2f(-dl); l_reg *= f;
        if (t > 0) {
          if (hi == 0) wsf[r32] = f;
          asm volatile("s_waitcnt lgkmcnt(0)" ::: "memory");
#pragma unroll
          for (int d_ = 0; d_ < 2; ++d_)
#pragma unroll
            for (int r = 0; r < 16; ++r) o[d_][r] *= wsf[crow(r, hi)];
          asm volatile("s_waitcnt lgkmcnt(0)" ::: "memory");
        }
      }
      float sacc = 0.f;
#pragma unroll
      for (int r = 0; r < 16; ++r) { p0[r] = __builtin_amdgcn_exp2f(p0[r]); p1[r] = __builtin_amdgcn_exp2f(p1[r]); sacc += p0[r] + p1[r]; }
      l_reg += sacc;
      u32x4 pw0, pw1, pw2, pw3;
#define PKW(P, B) cvtpk_s(P[B], P[B + 1])
      pw0 = (u32x4){PKW(p0, 0), PKW(p0, 2), PKW(p0, 4), PKW(p0, 6)}; pw1 = (u32x4){PKW(p0, 8), PKW(p0, 10), PKW(p0, 12), PKW(p0, 14)};
      pw2 = (u32x4){PKW(p1, 0), PKW(p1, 2), PKW(p1, 4), PKW(p1, 6)}; pw3 = (u32x4){PKW(p1, 8), PKW(p1, 10), PKW(p1, 12), PKW(p1, 14)};
#undef PKW
      SBAR();
      pv(o, vb0 + s_cur * VSLOT, __builtin_bit_cast(bf16x8, pw0), __builtin_bit_cast(bf16x8, pw1), __builtin_bit_cast(bf16x8, pw2), __builtin_bit_cast(bf16x8, pw3));
    }
    s_cur = (s_cur == 2) ? 0 : s_cur + 1;
  }
  { auto rr = __builtin_amdgcn_permlane32_swap(__float_as_uint(l_reg), __float_as_uint(l_reg), false, false); l_reg = __uint_as_float(rr[0]) + __uint_as_float(rr[1]); }
  if (hi == 0) wsf[32 + r32] = l_reg;
  asm volatile("s_waitcnt lgkmcnt(0)" ::: "memory");
  float rli[16];
#pragma unroll
  for (int r = 0; r < 16; ++r) rli[r] = __builtin_amdgcn_rcpf(wsf[32 + crow(r, hi)]);
  bf16* Ow = T.O + (rowbase + q0 + wid * 32) * 512 + h * 64;
  { ATT_LAS bf16* stg = (ATT_LAS bf16*)(shm3 + LDS_OST) + wid * 2048;
#pragma unroll
    for (int r = 0; r < 16; ++r) { const int orow = crow(r, hi);
#pragma unroll
      for (int d0 = 0; d0 < 2; ++d0) { const float v = o[d0][r] * rli[r]; stg[orow * 64 + d0 * 32 + r32] = (bf16)(cvtpk_s(v, v) & 0xffffu); } }
    asm volatile("s_waitcnt lgkmcnt(0)" ::: "memory");
#pragma unroll
    for (int i = 0; i < 4; ++i) { const int row = i * 8 + (lane >> 3), ch = lane & 7; const u32x4 v = *(const ATT_LAS u32x4*)(stg + row * 64 + ch * 8); *(u32x4*)(Ow + (long)row * 512 + ch * 8) = v; } }
  asm volatile("s_waitcnt lgkmcnt(0)\n\ts_barrier" ::: "memory");
#undef DMA_T
}
#undef SBAR
#undef WAIT_BAR
#undef MX3
}
#ifndef MK_PER_PHASE
#define MK_PER_PHASE 1
#endif
constexpr int NWAVES = 8;
constexpr int BATCH = 8, SEQ = 4096, DM = 1024, M = BATCH * SEQ;
constexpr int NIN = 4096;
constexpr int NEXP = 32, XG_ROWS = 2 * M + NEXP * 256;
constexpr float EPS = 1e-6f, LOG2E = 1.4426950408889634f;
constexpr float C2F = 0.125f * LOG2E;
constexpr float C2M = 0.10206207261596577f * LOG2E;
constexpr int N_PHASES = 14;
constexpr size_t MiB = 1u << 20;
constexpr size_t WS_CTL = 0, CTL_ZERO_BYTES = 1 * MiB;
constexpr size_t WS_WIN = 1 * MiB, WS_WUQ = 9 * MiB, WS_WUKV = 9 * MiB + 512 * 1024, WS_WOA = 10 * MiB, WS_WOB = 11 * MiB, WS_WOUT = 12 * MiB, WS_WR = 14 * MiB, WS_WGU = 15 * MiB, WS_WDN = 47 * MiB;
constexpr size_t WS_CS = 63 * MiB, WS_LOGF = 67 * MiB, WS_EID = 68 * MiB, WS_SLOT = WS_EID + 256 * 1024, WS_WGT = WS_SLOT + 256 * 1024, WS_POS = WS_WGT + 256 * 1024, WS_WROW = 69 * MiB;
constexpr size_t WS_XN = 72 * MiB, WS_CQN = 72 * MiB, WS_CKVN = 88 * MiB, WS_VM = 96 * MiB, WS_KR = 128 * MiB;
constexpr size_t WS_Z0 = 136 * MiB, WS_Z1 = 152 * MiB, WS_QF = 184 * MiB, WS_KF = 224 * MiB, WS_VF = 264 * MiB, WS_OA = 296 * MiB, WS_OB = 328 * MiB, WS_MIX = 360 * MiB, WS_QM = 424 * MiB, WS_KM = 472 * MiB;
constexpr size_t WS_HN = 72 * MiB, WS_LG = 200 * MiB, WS_XG = 232 * MiB, WS_ACT = 376 * MiB, WS_YB = 72 * MiB, WS_END = 504 * MiB;
static_assert(WS_XG + (size_t)XG_ROWS * 2048 <= WS_ACT && WS_ACT + (size_t)XG_ROWS * 512 <= WS_END && WS_YB + (size_t)XG_ROWS * 2048 <= WS_XG, "moe map");
constexpr int CW_CNT = 64;
constexpr int CW_TPRE = 128;
constexpr int CW_BAR = 4096;
constexpr int RING_OFF = 0, RING_BYTES = 131072, LDSCTL_OFF = RING_BYTES, MISC_OFF = LDSCTL_OFF + 320, TP_OFF = LDSCTL_OFF + 1024, LDS_BYTES = 147456;

#define GAS __attribute__((address_space(1)))
#define LAS __attribute__((address_space(3)))
typedef unsigned short bf16;
typedef unsigned v4u __attribute__((ext_vector_type(4)));
typedef float f32x4 __attribute__((ext_vector_type(4)));
typedef short bf16x8 __attribute__((ext_vector_type(8)));
typedef GAS unsigned gu32;
typedef GAS unsigned long long gu64;
#define RLX_AGENT __ATOMIC_RELAXED, __HIP_MEMORY_SCOPE_AGENT
#define LDS_WAIT() asm volatile("s_waitcnt lgkmcnt(0)" ::: "memory")
#define VM_WAIT() asm volatile("s_waitcnt vmcnt(0)" ::: "memory")
__device__ __forceinline__ unsigned long long rt() { return __builtin_amdgcn_s_memrealtime(); }
__device__ __forceinline__ unsigned f2bf(float f) { unsigned u = __builtin_bit_cast(unsigned, f); return (u + 0x7fffu + ((u >> 16) & 1u)) >> 16; }
__device__ __forceinline__ unsigned pk2(float lo, float hi) { return f2bf(lo) | (f2bf(hi) << 16); }


#define XB_TMO      128
#define XB_XCNT(j)  (256  + 64 * (j))
#define XB_XSUB(j)  (1280 + 64 * (j))
#define XB_XGEN(j)  (2304 + 64 * (j))
#define XB_TOP      3328
#define XB_TOPGEN   3392
#define XCD_BAR_WORDS 3456
#define XB_SPIN_CAP (1u << 18)

__device__ __forceinline__ unsigned xb_ld(unsigned* p)              { return __hip_atomic_load(p, __ATOMIC_RELAXED, __HIP_MEMORY_SCOPE_AGENT); }
__device__ __forceinline__ unsigned xb_add(unsigned* p, unsigned v) { return __hip_atomic_fetch_add(p, v, __ATOMIC_RELAXED, __HIP_MEMORY_SCOPE_AGENT); }
__device__ __forceinline__ unsigned xb_xcc_id() { return (unsigned)__builtin_amdgcn_s_getreg((3 << 11) | 20) & 0xFu; }
#define XB_SPIN(cond, bar) do { unsigned _sp = 0; while (cond) { __builtin_amdgcn_s_sleep(1); \
    if ((++_sp & 255u) == 0u) { if (xb_ld(&(bar)[XB_TMO])) break; if (_sp > XB_SPIN_CAP) { atomicAdd(&(bar)[XB_TMO], 1u); break; } } } } while (0)

struct XcdBarrier {
    unsigned* bar; unsigned x;
    volatile LAS unsigned* st;
};

__device__ __forceinline__ XcdBarrier xcd_barrier_post(unsigned* bar, volatile LAS unsigned* st) {
    XcdBarrier b; b.bar = bar; b.x = xb_xcc_id(); b.st = st;
    if (threadIdx.x == 0) (void)xb_add(&bar[XB_XCNT(b.x)], 1u);
    return b;
}
__device__ __forceinline__ void xcd_barrier_complete(unsigned* bar, unsigned x, unsigned& nloc, unsigned& nx) {
    const unsigned G = gridDim.x * gridDim.y * gridDim.z;
    unsigned sum, cnt, mine, sp = 0u;
    for (;;) {
        sum = 0u; cnt = 0u; mine = 0u;
#pragma unroll
        for (unsigned j = 0; j < 16; ++j) { const unsigned c = xb_ld(&bar[XB_XCNT(j)]); sum += c; cnt += (c > 0u) ? 1u : 0u; mine = (j == x) ? c : mine; }
        if (sum == G) break;
        __builtin_amdgcn_s_sleep(1);
        if ((++sp & 255u) == 0u) { if (xb_ld(&bar[XB_TMO])) break; if (sp > XB_SPIN_CAP) { atomicAdd(&bar[XB_TMO], 1u); break; } }
    }
    nloc = mine > 0u ? mine : 1u; nx = cnt > 0u ? cnt : 1u;
}

__device__ __forceinline__ void xcd_barrier(const XcdBarrier& b) {
    asm volatile("s_waitcnt vmcnt(0)" ::: "memory");
    __syncthreads();
    if (threadIdx.x == 0) {
        unsigned* bar = b.bar;
        __builtin_amdgcn_s_waitcnt(0);
        unsigned nloc = b.st[0], nx = b.st[1];
        if (nloc == 0u) { xcd_barrier_complete(bar, b.x, nloc, nx); b.st[0] = nloc; b.st[1] = nx; }
        const unsigned old = xb_add(&bar[XB_XSUB(b.x)], 1u);
        const unsigned gen = old / nloc;
        if (old + 1u == (gen + 1u) * nloc) {
            __builtin_amdgcn_fence(__ATOMIC_RELEASE, "agent");
            asm volatile("s_waitcnt vmcnt(0)" ::: "memory");
            const unsigned og = xb_add(&bar[XB_TOP], 1u);
            const unsigned tg = og / nx;
            if (og + 1u == (tg + 1u) * nx) xb_add(&bar[XB_TOPGEN], 1u);
            else XB_SPIN(xb_ld(&bar[XB_TOPGEN]) == tg, bar);
            __builtin_amdgcn_fence(__ATOMIC_ACQUIRE, "agent");
            xb_add(&bar[XB_XGEN(b.x)], 1u);
            asm volatile("s_waitcnt vmcnt(0)" ::: "memory");
        } else {
            XB_SPIN(xb_ld(&bar[XB_XGEN(b.x)]) == gen, bar);
            __builtin_amdgcn_fence(__ATOMIC_ACQUIRE, "agent");
            asm volatile("s_waitcnt vmcnt(0)" ::: "memory");
        }
    }
    __syncthreads();
}


typedef unsigned v2u __attribute__((ext_vector_type(2)));
__device__ __forceinline__ float wave_sum(float v) {
#pragma unroll
    for (int o = 1; o < 64; o <<= 1) v += __shfl_xor(v, o);
    return v;
}
__device__ __forceinline__ float bf2f(unsigned short b) { return __builtin_bit_cast(float, (unsigned)b << 16); }
__device__ __forceinline__ float bflo(unsigned w) { return __builtin_bit_cast(float, w << 16); }
__device__ __forceinline__ float bfhi(unsigned w) { return __builtin_bit_cast(float, w & 0xffff0000u); }
__device__ __forceinline__ v4u pack8(f32x4 a, f32x4 b) { v4u w; w.x = pg8::cvt_pk_bf16(a[0], a[1]); w.y = pg8::cvt_pk_bf16(a[2], a[3]); w.z = pg8::cvt_pk_bf16(b[0], b[1]); w.w = pg8::cvt_pk_bf16(b[2], b[3]); return w; }
__device__ __forceinline__ float sigmoidf_(float x) { return __builtin_amdgcn_rcpf(1.0f + __builtin_amdgcn_exp2f(-x * LOG2E)); }

using pg8::Unit;
#define EPI_ROWS(...) int rb_ = u.pm * 256 + wr * 64 + fr; asm volatile("" : "+v"(rb_)); _Pragma("unroll") for (int ai = 0; ai < 2; ++ai) _Pragma("unroll") for (int m = 0; m < 4; ++m) { const size_t row = (size_t)(rb_ + ai * 128 + m * 16); \
        _Pragma("unroll") for (int bj = 0; bj < 2; ++bj) { const f32x4 v0 = acc[ai][bj][m][0], v1 = acc[ai][bj][m][1]; __VA_ARGS__ } }
struct EpiIn { static constexpr bool PERM = true, AFTER_DRAIN = false;
    bf16* Z0; float* Z1; bf16 *QF, *KF, *VF, *GA, *GB;
    __device__ __forceinline__ void operator()(const f32x4 (&acc)[2][2][4][2], const Unit& u, int wr, int wc, int fr, int fq) const {
        const int pn = u.pn;
        EPI_ROWS({ const int ct = bj * 128 + wc * 32 + 8 * fq;
            if (pn == 0) { *(v4u*)(Z0 + row * 256 + ct) = pack8(v0, v1); }
            else if (pn == 1) { float* p = Z1 + row * 256 + ct; *(f32x4*)p = v0; *(f32x4*)(p + 4) = v1; }
            else if (pn < 4) { const int c = (pn - 2) * 256 + ct; *(v4u*)(QF + row * 640 + (c >> 6) * 80 + (c & 63)) = pack8(v0 * C2F, v1 * C2F); }
            else if (pn < 6) { const int c = (pn - 4) * 256 + ct; *(v4u*)(KF + row * 640 + (c >> 6) * 80 + (c & 63)) = pack8(v0, v1); }
            else if (pn < 8) { const int c = (pn - 6) * 256 + ct; *(v4u*)(VF + row * 512 + c) = pack8(v0, v1); }
            else { bf16* G = pn < 12 ? GA : GB; const int c = ((pn - 8) & 3) * 256 + ct; f32x4 s0, s1;
                _Pragma("unroll") for (int e = 0; e < 4; ++e) { s0[e] = sigmoidf_(v0[e]); s1[e] = sigmoidf_(v1[e]); }
                *(v4u*)(G + row * 1024 + c) = pack8(s0, s1); } })
    }
};
struct EpiQup { static constexpr bool PERM = true, AFTER_DRAIN = false;
    bf16* QM;
    __device__ __forceinline__ void operator()(const f32x4 (&acc)[2][2][4][2], const Unit& u, int wr, int wc, int fr, int fq) const {
        EPI_ROWS({ const int ct = u.pn * 256 + bj * 128 + wc * 32 + 8 * fq; *(v4u*)(QM + row * 768 + ct) = pack8(v0 * C2M, v1 * C2M); })
    }
};
struct EpiKVup { static constexpr bool PERM = true, AFTER_DRAIN = false;
    bf16 *KM, *VM;
    __device__ __forceinline__ void operator()(const f32x4 (&acc)[2][2][4][2], const Unit& u, int wr, int wc, int fr, int fq) const {
        bf16* D = u.pn < 2 ? KM : VM; const int c0 = (u.pn & 1) * 256;
        EPI_ROWS({ const int ct = bj * 128 + wc * 32 + 8 * fq; *(v4u*)(D + row * 512 + c0 + ct) = pack8(v0, v1); })
    }
};
template <int SECOND> struct EpiGate { static constexpr bool PERM = true, AFTER_DRAIN = false;
    const bf16* G; bf16* MIX;
    __device__ __forceinline__ void operator()(const f32x4 (&acc)[2][2][4][2], const Unit& u, int wr, int wc, int fr, int fq) const {
        EPI_ROWS({ const size_t off = row * 1024 + u.pn * 256 + bj * 128 + wc * 32 + 8 * fq; const v4u g = *(const v4u*)(G + off);
            f32x4 r0 = {bflo(g.x) * v0[0], bfhi(g.x) * v0[1], bflo(g.y) * v0[2], bfhi(g.y) * v0[3]}, r1 = {bflo(g.z) * v1[0], bfhi(g.z) * v1[1], bflo(g.w) * v1[2], bfhi(g.w) * v1[3]};
            if (SECOND) { const v4u p = *(const v4u*)(MIX + off); r0 += (f32x4){bflo(p.x), bfhi(p.x), bflo(p.y), bfhi(p.y)}; r1 += (f32x4){bflo(p.z), bfhi(p.z), bflo(p.w), bfhi(p.w)}; }
            *(v4u*)(MIX + off) = pack8(r0, r1); })
    }
};
struct EpiRes { static constexpr bool PERM = false, AFTER_DRAIN = false;
    const float* X; float* H;
    __device__ __forceinline__ void operator()(const f32x4 (&acc)[2][2][4][2], const Unit& u, int wr, int wc, int fr, int fq) const {
        EPI_ROWS({ const size_t off = row * 1024 + u.pn * 256 + bj * 128 + wc * 32 + 4 * fq;
            *(f32x4*)(H + off) = *(const f32x4*)(X + off) + v0; *(f32x4*)(H + off + 16) = *(const f32x4*)(X + off + 16) + v1; })
    }
};
struct EpiLg { static constexpr bool PERM = true, AFTER_DRAIN = false;
    float* LG;
    __device__ __forceinline__ void operator()(const f32x4 (&acc)[2][2][4][2], const Unit& u, int wr, int wc, int fr, int fq) const {
        EPI_ROWS({ if (bj == 0) { float* p = LG + row * 128 + wc * 32 + 8 * fq; *(f32x4*)p = v0; *(f32x4*)(p + 4) = v1; } })
    }
};
struct EpiGU { static constexpr bool PERM = true, AFTER_DRAIN = false;
    bf16* ACT;
    __device__ __forceinline__ void operator()(const f32x4 (&acc)[2][2][4][2], const Unit& u, int wr, int wc, int fr, int fq) const {
        const int c0 = (u.pn & 1) * 128 + wc * 32 + 8 * fq; int rb_ = u.pm * 256 + wr * 64 + fr; asm volatile("" : "+v"(rb_));
#pragma unroll
        for (int ai = 0; ai < 2; ++ai)
#pragma unroll
            for (int m = 0; m < 4; ++m) { const size_t row = (size_t)(rb_ + ai * 128 + m * 16); f32x4 a0, a1;
#pragma unroll
                for (int e = 0; e < 4; ++e) { const float g0 = acc[ai][0][m][0][e], g1 = acc[ai][0][m][1][e]; a0[e] = g0 * sigmoidf_(g0) * acc[ai][1][m][0][e]; a1[e] = g1 * sigmoidf_(g1) * acc[ai][1][m][1][e]; }
                *(v4u*)(ACT + row * 256 + c0) = pack8(a0, a1); }
    }
};
struct EpiDown { static constexpr bool PERM = true, AFTER_DRAIN = false;
    bf16* YB; const float* WROW;
    __device__ __forceinline__ void operator()(const f32x4 (&acc)[2][2][4][2], const Unit& u, int wr, int wc, int fr, int fq) const {
        const int c0 = (u.pn & 3) * 256;
        EPI_ROWS({ const float w = WROW[row]; *(v4u*)(YB + row * 1024 + c0 + bj * 128 + wc * 32 + 8 * fq) = pack8(v0 * w, v1 * w); })
    }
};
struct ExpertOrder {
    const LAS unsigned* tpre; int NJ, G, c;
    __device__ __forceinline__ bool next(int i, Unit& u) const {
        const int total = (int)tpre[NEXP] * NJ; const long L = (long)i * G + c; if (L >= total) return false;
        const int T = (int)L / NJ, j = (int)L % NJ; int e = 0;
#pragma unroll 1
        for (int k = 1; k < NEXP; ++k) e += ((int)tpre[k] <= T) ? 1 : 0;
        u.pm = T; u.pn = e * NJ + j; return true;
    }
    __device__ __forceinline__ void a_ready(const Unit&) const {}
    __device__ __forceinline__ void done(const Unit&) const {}
};

__device__ __forceinline__ void tr_item(const float* colp, int N, int k0, bf16* dst  , int K, bool lo, LAS float* scr, int lane) {
#pragma unroll 8
    for (int i = 0; i < 32; ++i) { const int kk = 2 * i + (lane >> 5); float v = colp ? colp[(size_t)(k0 + kk) * N] : 0.f;
        if (lo) v = v - bf2f((unsigned short)f2bf(v));
        scr[kk * 33 + (lane & 31)] = v; }
    LDS_WAIT(); asm volatile("" ::: "memory");
    const int c = lane & 7;
#pragma unroll
    for (int j = 0; j < 4; ++j) { const int n = (lane >> 3) + 8 * j; const LAS float* s = scr + (8 * c) * 33 + n;
        v4u o; o.x = pk2(s[0 * 33], s[1 * 33]); o.y = pk2(s[2 * 33], s[3 * 33]); o.z = pk2(s[4 * 33], s[5 * 33]); o.w = pk2(s[6 * 33], s[7 * 33]);
        *(GAS v4u*)(dst + (size_t)n * K + 8 * c) = o; }
    LDS_WAIT(); asm volatile("" ::: "memory");
}
__device__ __forceinline__ double inv_freq_d(int i) {
    const int q = i >> 2, r = i & 3;
    const double a = q == 0 ? 1.0 : q == 1 ? 0.1 : q == 2 ? 0.01 : 0.001;
    const double b = r == 0 ? 1.0 : r == 1 ? 0.5623413251903491 : r == 2 ? 0.31622776601683794 : 0.1778279410038923;
    return a * b;
}

struct Args { const float* in[22]; float* out; unsigned char* ws; int ph_lo, ph_hi; };

__global__ void __launch_bounds__(NWAVES * 64, 2) mk_fwd(Args args) {
    extern __shared__ __attribute__((aligned(16))) unsigned char lds[];
    LAS unsigned char* const L = (LAS unsigned char*)lds;
    volatile LAS unsigned* const MISC = (volatile LAS unsigned*)(L + MISC_OFF);
    const int tid = threadIdx.x, lane = tid & 63, wave = __builtin_amdgcn_readfirstlane(tid >> 6);
    const int G = gridDim.x; const int bx = blockIdx.x; const int vcu = (G % 8 == 0) ? (bx % 8) * (G / 8) + bx / 8 : bx;
    const int gw = vcu * NWAVES + wave, NGW = G * NWAVES;
    unsigned char* const ws = args.ws;
    gu32* const ctl = (gu32*)(ws + WS_CTL);
    const float* x = args.in[0]; const int* positions = (const int*)args.in[1]; const float* g_mix = args.in[2]; const float* w_in = args.in[3]; const float* b_forget = args.in[4];
    const float* g_cq = args.in[5]; const float* g_ckv = args.in[6]; const float* w_uq = args.in[7]; const float* w_uk = args.in[8]; const float* w_uv = args.in[9];
    const float* w_o_mla = args.in[10]; const float* w_o_fox = args.in[11]; const float* w_out = args.in[12]; const float* g_ffn = args.in[13]; const float* w_group = args.in[14];
    const float* b_group = args.in[15]; const float* w_router = args.in[16]; const float* b_router = args.in[17]; const float* w_e_gate = args.in[18]; const float* w_e_up = args.in[19];
    const float* w_e_down = args.in[20]; const float* g_final = args.in[21];
    float* const out = args.out;
#define WIN ((bf16*)(ws + WS_WIN))
#define WUQ ((bf16*)(ws + WS_WUQ))
#define WUKV ((bf16*)(ws + WS_WUKV))
#define WOA ((bf16*)(ws + WS_WOA))
#define WOB ((bf16*)(ws + WS_WOB))
#define WOUT ((bf16*)(ws + WS_WOUT))
#define WR ((bf16*)(ws + WS_WR))
#define WGU ((bf16*)(ws + WS_WGU))
#define WDN ((bf16*)(ws + WS_WDN))
#define CS ((float*)(ws + WS_CS))
#define LOGF ((float*)(ws + WS_LOGF))
#define EID ((int*)(ws + WS_EID))
#define SLOT ((int*)(ws + WS_SLOT))
#define WGT ((float*)(ws + WS_WGT))
#define POS ((int*)(ws + WS_POS))
#define WROW ((float*)(ws + WS_WROW))
#define XN ((bf16*)(ws + WS_XN))
#define CQN ((bf16*)(ws + WS_CQN))
#define CKVN ((bf16*)(ws + WS_CKVN))
#define VM ((bf16*)(ws + WS_VM))
#define KR ((bf16*)(ws + WS_KR))
#define Z0 ((bf16*)(ws + WS_Z0))
#define Z1 ((float*)(ws + WS_Z1))
#define QF ((bf16*)(ws + WS_QF))
#define KF ((bf16*)(ws + WS_KF))
#define VF ((bf16*)(ws + WS_VF))
#define OA ((bf16*)(ws + WS_OA))
#define OB ((bf16*)(ws + WS_OB))
#define MIX ((bf16*)(ws + WS_MIX))
#define QM ((bf16*)(ws + WS_QM))
#define KM ((bf16*)(ws + WS_KM))
#define HN ((bf16*)(ws + WS_HN))
#define LG ((float*)(ws + WS_LG))
#define XG ((bf16*)(ws + WS_XG))
#define ACT ((bf16*)(ws + WS_ACT))
#define YB ((bf16*)(ws + WS_YB))
#define GA ((bf16*)out)
#define GB ((bf16*)out + (size_t)M * 1024)
#define H out

    for (int u = tid; u < (LDS_BYTES - LDSCTL_OFF) / 4; u += NWAVES * 64) ((LAS unsigned*)(L + LDSCTL_OFF))[u] = 0u;
    __syncthreads();
    XcdBarrier bar; bar.bar = (unsigned*)(ctl + CW_BAR); bar.x = 0; bar.st = nullptr;
    if (!MK_PER_PHASE) bar = xcd_barrier_post((unsigned*)(ctl + CW_BAR), MISC + 8);
    const int lo = args.ph_lo, hi = args.ph_hi;
#ifndef MK_ONLY
#define MK_ONLY -1
#endif
#define IN(k) ((MK_ONLY < 0 || MK_ONLY == (k)) && lo <= (k) && (k) < hi)
#define SEAM(k) do { if (IN(k) && IN((k) + 1)) { if ((k) == 0) { cooperative_groups::this_grid().sync(); } else { xcd_barrier(bar); } } } while (0)

    if (IN(0)) {
        LAS float* scr = (LAS float*)(L + RING_OFF + wave * 16384);
        constexpr int I0 = 128 * 16, I1 = 24 * 4, I2 = 32 * 2, I3 = 32 * 8, I4 = 32 * 8, I5 = 32 * 16, I6 = 8 * 16, I7 = NEXP * 16 * 16, I8 = NEXP * 32 * 4;
        constexpr int NITEMS = I0 + I1 + I2 + I3 + I4 + I5 + I6 + I7 + I8;
        const int l31 = lane & 31;
        for (int it = gw; it < NITEMS; it += NGW) {
            int r = it;
            if (r < I0) { const int nb = r % 128, kb = r / 128, n = nb * 32 + l31;
                int sc; if (n < 416) sc = n; else if (n < 424) sc = 1952 + (n - 416); else if (n < 512) sc = -1; else if (n < 2048) sc = n - 96; else sc = n - 88;
                tr_item(sc >= 0 ? w_in + sc : nullptr, 4008, kb * 64, WIN + (size_t)(nb * 32) * 1024 + kb * 64, 1024, false, scr, lane); continue; } r -= I0;
            if (r < I1) { const int nb = r % 24, kb = r / 24; tr_item(w_uq + nb * 32 + l31, 768, kb * 64, WUQ + (size_t)(nb * 32) * 256 + kb * 64, 256, false, scr, lane); continue; } r -= I1;
            if (r < I2) { const int nb = r % 32, kb = r / 32, n = nb * 32 + l31; tr_item(n < 512 ? w_uk + n : w_uv + (n - 512), 512, kb * 64, WUKV + (size_t)(nb * 32) * 128 + kb * 64, 128, false, scr, lane); continue; } r -= I2;
            if (r < I3) { const int nb = r % 32, kb = r / 32; tr_item(w_o_mla + nb * 32 + l31, 1024, kb * 64, WOA + (size_t)(nb * 32) * 512 + kb * 64, 512, false, scr, lane); continue; } r -= I3;
            if (r < I4) { const int nb = r % 32, kb = r / 32; tr_item(w_o_fox + nb * 32 + l31, 1024, kb * 64, WOB + (size_t)(nb * 32) * 512 + kb * 64, 512, false, scr, lane); continue; } r -= I4;
            if (r < I5) { const int nb = r % 32, kb = r / 32; tr_item(w_out + nb * 32 + l31, 1024, kb * 64, WOUT + (size_t)(nb * 32) * 1024 + kb * 64, 1024, false, scr, lane); continue; } r -= I5;
            if (r < I6) { const int nb = r % 8, kb = r / 8, n = nb * 32 + l31; const int j = n & 63; const bool islo = (n >= 64 && n < 128); const bool valid = (n < 128) && (j < 36);
                const float* cp = nullptr; int NN = 32; if (valid) { if (j < 4) { cp = w_group + j; NN = 4; } else { cp = w_router + (j - 4); NN = 32; } }
                { LAS float* sc2 = scr;
#pragma unroll 8
                  for (int i = 0; i < 32; ++i) { const int kk = 2 * i + (lane >> 5); float v = cp ? cp[(size_t)(kb * 64 + kk) * NN] : 0.f; if (islo) v = v - bf2f((unsigned short)f2bf(v)); sc2[kk * 33 + l31] = v; }
                  LDS_WAIT(); asm volatile("" ::: "memory");
                  const int c = lane & 7; bf16* dst = WR + (size_t)(nb * 32) * 1024 + kb * 64;
#pragma unroll
                  for (int jj = 0; jj < 4; ++jj) { const int nn = (lane >> 3) + 8 * jj; const LAS float* s = sc2 + (8 * c) * 33 + nn;
                      v4u o; o.x = pk2(s[0 * 33], s[1 * 33]); o.y = pk2(s[2 * 33], s[3 * 33]); o.z = pk2(s[4 * 33], s[5 * 33]); o.w = pk2(s[6 * 33], s[7 * 33]);
                      *(GAS v4u*)(dst + (size_t)nn * 1024 + 8 * c) = o; }
                  LDS_WAIT(); asm volatile("" ::: "memory"); }
                continue; } r -= I6;
            if (r < I7) { const int e = r / 256, q = r % 256, nb = q % 16, kb = q / 16, rr = nb * 32 + l31;
                const int j = rr >> 8, isup = (rr >> 7) & 1, cc = rr & 127; const float* src = (isup ? w_e_up : w_e_gate) + (size_t)e * 1024 * 256 + 128 * j + cc;
                tr_item(src, 256, kb * 64, WGU + ((size_t)e * 512 + nb * 32) * 1024 + kb * 64, 1024, false, scr, lane); continue; } r -= I7;
            { const int e = r / 128, q = r % 128, nb = q % 32, kb = q / 32; tr_item(w_e_down + (size_t)e * 256 * 1024 + nb * 32 + l31, 1024, kb * 64, WDN + ((size_t)e * 1024 + nb * 32) * 256 + kb * 64, 256, false, scr, lane); }
        }
        for (int m = gw; m < M; m += NGW) {
            const GAS f32x4* xr = (const GAS f32x4*)(x + (size_t)m * DM) + lane; f32x4 v[4]; float s2 = 0.f;
#pragma unroll
            for (int j = 0; j < 4; ++j) { v[j] = xr[64 * j]; s2 += (v[j].x * v[j].x + v[j].y * v[j].y) + (v[j].z * v[j].z + v[j].w * v[j].w); }
            const float rstd = 1.f / sqrtf(wave_sum(s2) * (1.f / DM) + EPS);
            GAS unsigned long long* o8 = (GAS unsigned long long*)(XN + (size_t)m * DM) + lane;
#pragma unroll
            for (int j = 0; j < 4; ++j) { const f32x4 g = *((const f32x4*)g_mix + lane + 64 * j);
                o8[64 * j] = (unsigned long long)pk2(v[j].x * rstd * g.x, v[j].y * rstd * g.y) | ((unsigned long long)pk2(v[j].z * rstd * g.z, v[j].w * rstd * g.w) << 32); }
        }
        for (int i = (vcu * NWAVES * 64 + tid); i < M * 16; i += G * NWAVES * 64) {
            const int m = i >> 4, f = i & 15; const double ang = (double)positions[m] * inv_freq_d(f); const double rev = ang * 0.15915494309189535; const float fr = (float)(rev - floor(rev));
            CS[2 * i] = __builtin_amdgcn_cosf(fr); CS[2 * i + 1] = __builtin_amdgcn_sinf(fr); }
    }
    SEAM(0);
    if (IN(1)) {
        pg8::Gemm g{XN, WIN, M, NIN, DM}; pg8::StaticOrder S; S.init(M, NIN, G, bx);
        EpiIn E{Z0, Z1, QF, KF, VF, GA, GB};
        pg8::gemm_phase<EpiIn, pg8::StaticOrder, true, true>(L + RING_OFF, g, S, E);
    }
    SEAM(1);
    if (IN(2)) {
        for (int m = gw; m < M; m += NGW) {
            { const v2u raw = *(const v2u*)(Z0 + (size_t)m * 256 + lane * 4); const float a0 = bflo(raw.x), a1 = bfhi(raw.x), a2 = bflo(raw.y), a3 = bfhi(raw.y);
              const float rstd = 1.f / sqrtf(wave_sum((a0 * a0 + a1 * a1) + (a2 * a2 + a3 * a3)) * (1.f / 256) + EPS); const f32x4 g = *((const f32x4*)g_cq + lane);
              v2u o; o.x = pk2(a0 * rstd * g.x, a1 * rstd * g.y); o.y = pk2(a2 * rstd * g.z, a3 * rstd * g.w); *(v2u*)(CQN + (size_t)m * 256 + lane * 4) = o; }
            const float* z = Z1 + (size_t)m * 256;
            { const float a0 = z[2 * lane], a1 = z[2 * lane + 1]; const float rstd = 1.f / sqrtf(wave_sum(a0 * a0 + a1 * a1) * (1.f / 128) + EPS);
              *(unsigned*)(CKVN + (size_t)m * 128 + 2 * lane) = pk2(a0 * rstd * g_ckv[2 * lane], a1 * rstd * g_ckv[2 * lane + 1]); }
            if (lane < 16) { const float x1 = z[128 + lane], x2 = z[144 + lane], c = CS[(size_t)m * 32 + 2 * lane], s = CS[(size_t)m * 32 + 2 * lane + 1];
              KR[(size_t)m * 32 + lane] = (bf16)f2bf(x1 * c - x2 * s); KR[(size_t)m * 32 + 16 + lane] = (bf16)f2bf(x2 * c + x1 * s); }
            else if (lane < 24) { const int j = lane - 16; const float xx = z[160 + j] + b_forget[j]; const float t = __expf(-fabsf(xx)); LOGF[(size_t)m * 8 + j] = fminf(xx, 0.f) - __logf(1.f + t); }
            else if (lane >= 32 && lane < 48) { const int hh = (lane - 32) >> 1, half = lane & 1; v4u o = {0u, 0u, 0u, 0u}; if (half == 0) { o.x = 0x3F803F80u; o.y = 0x00003F80u; }
              *(v4u*)(QF + (size_t)m * 640 + hh * 80 + 64 + half * 8) = o; }
            else if (lane >= 48) { const int hh = (lane - 48) >> 1, half = lane & 1; *(v4u*)(KF + (size_t)m * 640 + hh * 80 + 64 + half * 8) = (v4u){0u, 0u, 0u, 0u}; }
        }
    }
    SEAM(2);
    if (IN(3)) {
#ifndef NO_SCAN
        if (gw < 64) { const int b = gw >> 3, hh = gw & 7; const float* lf = LOGF + ((size_t)b * SEQ + 64 * lane) * 8 + hh; double s = 0.0;
#pragma unroll 8
            for (int i = 0; i < 64; ++i) s += (double)lf[i * 8];
            double incl = s;
#pragma unroll
            for (int o = 1; o < 64; o <<= 1) { const double t = __shfl_up(incl, o); if (lane >= o) incl += t; }
            double run = incl - s; bf16* kf = KF + ((size_t)b * SEQ + 64 * lane) * 640 + hh * 80 + 64;
#pragma unroll 4
            for (int i = 0; i < 64; ++i) { run += (double)lf[i * 8]; const float gneg = (float)(-run * 1.4426950408889634);
                const unsigned b0 = f2bf(gneg); const float r1 = gneg - bf2f((unsigned short)b0); const unsigned b1 = f2bf(r1); const float r2 = r1 - bf2f((unsigned short)b1); const unsigned b2 = f2bf(r2);
                *(unsigned*)(kf + (size_t)i * 640) = b0 | (b1 << 16); *(unsigned*)(kf + (size_t)i * 640 + 2) = b2; }
        }
#endif
#ifndef NO_QUP
        { pg8::Gemm g{CQN, WUQ, M, 768, 256}; pg8::StaticOrder S; S.init(M, 768, G, bx); EpiQup E{QM};
          pg8::gemm_phase<EpiQup, pg8::StaticOrder, true, true>(L + RING_OFF, g, S, E); }
#endif
#ifndef NO_KVUP
        { pg8::Gemm g{CKVN, WUKV, M, 1024, 128}; pg8::StaticOrder S; S.init(M, 1024, G, bx); EpiKVup E{KM, VM};
          pg8::gemm_phase<EpiKVup, pg8::StaticOrder, true, true>(L + RING_OFF, g, S, E); }
#endif
    }
    SEAM(3);
    if (IN(4)) {
        const att::AttnT TA{QM, KM, KR, VM, OA, CS}; const att::AttnT TB{QF, KF, KF, VF, OB, CS};
        for (int v = vcu; v < 256; v += G) { const int bh = v >> 2, sub = v & 3, b = bh >> 3, hh = bh & 7;
#pragma unroll 1
            for (int i = 0; i < 4; ++i) { const int qb = (i == 0) ? 15 - sub : (i == 1) ? 8 + sub : (i == 2) ? 7 - sub : sub;
                att::attn_unit<0>(b, hh, qb, TA, (char*)lds + RING_OFF);
                att::attn_unit<1>(b, hh, qb, TB, (char*)lds + RING_OFF); } }
    }
    SEAM(4);
    if (IN(5)) {
        { pg8::Gemm g{OA, WOA, M, 1024, 512}; pg8::StaticOrder S; S.init(M, 1024, G, bx); EpiGate<0> E{GA, MIX}; pg8::gemm_phase<EpiGate<0>, pg8::StaticOrder, true, true>(L + RING_OFF, g, S, E); }
        { pg8::Gemm g{OB, WOB, M, 1024, 512}; pg8::StaticOrder S; S.init(M, 1024, G, bx); EpiGate<1> E{GB, MIX}; pg8::gemm_phase<EpiGate<1>, pg8::StaticOrder, true, true>(L + RING_OFF, g, S, E); }
    }
    SEAM(5);
    if (IN(6)) {
        pg8::Gemm g{MIX, WOUT, M, 1024, 1024}; pg8::StaticOrder S; S.init(M, 1024, G, bx); EpiRes E{x, H}; pg8::gemm_phase<EpiRes, pg8::StaticOrder, true, true>(L + RING_OFF, g, S, E);
    }
    SEAM(6);
    if (IN(7)) {
        for (int m = gw; m < M; m += NGW) {
            const GAS f32x4* hr = (const GAS f32x4*)(H + (size_t)m * DM) + lane; f32x4 v[4]; float s2 = 0.f;
#pragma unroll
            for (int j = 0; j < 4; ++j) { v[j] = hr[64 * j]; s2 += (v[j].x * v[j].x + v[j].y * v[j].y) + (v[j].z * v[j].z + v[j].w * v[j].w); }
            const float rstd = 1.f / sqrtf(wave_sum(s2) * (1.f / DM) + EPS);
            GAS unsigned long long* oh = (GAS unsigned long long*)(HN + (size_t)m * DM) + lane; GAS unsigned long long* ol = (GAS unsigned long long*)(HN + (size_t)(M + m) * DM) + lane;
#pragma unroll
            for (int j = 0; j < 4; ++j) { const f32x4 g = *((const f32x4*)g_ffn + lane + 64 * j); const f32x4 y = {v[j].x * rstd * g.x, v[j].y * rstd * g.y, v[j].z * rstd * g.z, v[j].w * rstd * g.w};
                const unsigned h0 = f2bf(y.x), h1 = f2bf(y.y), h2 = f2bf(y.z), h3 = f2bf(y.w);
                oh[64 * j] = (unsigned long long)(h0 | (h1 << 16)) | ((unsigned long long)(h2 | (h3 << 16)) << 32);
                ol[64 * j] = (unsigned long long)pk2(y.x - bf2f((unsigned short)h0), y.y - bf2f((unsigned short)h1)) | ((unsigned long long)pk2(y.z - bf2f((unsigned short)h2), y.w - bf2f((unsigned short)h3)) << 32); }
        }
    }
    SEAM(7);
    if (IN(8)) {
        pg8::Gemm g{HN, WR, 2 * M, 256, 1024}; pg8::StaticOrder S; S.init(2 * M, 256, G, bx); EpiLg E{LG}; pg8::gemm_phase<EpiLg, pg8::StaticOrder, true, true>(L + RING_OFF, g, S, E);
    }
    SEAM(8);
    if (IN(9)) {
        for (int t = vcu * NWAVES * 64 + tid; t < M; t += G * NWAVES * 64) {
            float lg[36];
            const float* a = LG + (size_t)t * 128; const float* b2 = LG + (size_t)(M + t) * 128;
#pragma unroll
            for (int q = 0; q < 9; ++q) { const f32x4 p0 = *(const f32x4*)(a + 4 * q), p1 = *(const f32x4*)(a + 64 + 4 * q), p2 = *(const f32x4*)(b2 + 4 * q), p3 = *(const f32x4*)(b2 + 64 + 4 * q);
#pragma unroll
                for (int e = 0; e < 4; ++e) lg[4 * q + e] = (p0[e] + p1[e]) + (p2[e] + p3[e]); }
#pragma unroll
            for (int j = 0; j < 4; ++j) lg[j] += b_group[j];
#pragma unroll
            for (int j = 0; j < 32; ++j) lg[4 + j] += b_router[j];
            int gi = 0; float gm = lg[0];
#pragma unroll
            for (int j = 1; j < 4; ++j) if (lg[j] > gm) { gm = lg[j]; gi = j; }
            float gs = 0.f;
#pragma unroll
            for (int j = 0; j < 4; ++j) gs += __expf(lg[j] - gm);
            const float gp = 1.f / gs;
            float sel[8];
#pragma unroll
            for (int e = 0; e < 8; ++e) sel[e] = gi == 0 ? lg[4 + e] : gi == 1 ? lg[12 + e] : gi == 2 ? lg[20 + e] : lg[28 + e];
            int e0 = 0; float m0 = sel[0];
#pragma unroll
            for (int e = 1; e < 8; ++e) if (sel[e] > m0) { m0 = sel[e]; e0 = e; }
            int e1 = -1; float m1 = -INFINITY;
#pragma unroll
            for (int e = 0; e < 8; ++e) if (e != e0 && sel[e] > m1) { m1 = sel[e]; e1 = e; }
            const float r = __expf(m1 - m0); const float p0 = 1.f / (1.f + r), p1 = r / (1.f + r);
            const int x0 = gi * 8 + e0, x1 = gi * 8 + e1;
            const unsigned s0 = __hip_atomic_fetch_add(ctl + CW_CNT + x0, 1u, RLX_AGENT), s1 = __hip_atomic_fetch_add(ctl + CW_CNT + x1, 1u, RLX_AGENT);
            EID[2 * t] = x0; EID[2 * t + 1] = x1; SLOT[2 * t] = (int)s0; SLOT[2 * t + 1] = (int)s1; WGT[2 * t] = gp * p0; WGT[2 * t + 1] = gp * p1;
        }
    }
    SEAM(9);
    if (IN(10)) {
        LAS unsigned* tp = (LAS unsigned*)(L + TP_OFF);
        if (tid == 0) { unsigned acc = 0; for (int e = 0; e < NEXP; ++e) { tp[e] = acc; acc += (__hip_atomic_load(ctl + CW_CNT + e, RLX_AGENT) + 255u) >> 8; } tp[NEXP] = acc;
            if (bx == 0) for (int e = 0; e <= NEXP; ++e) __hip_atomic_store(ctl + CW_TPRE + e, tp[e], RLX_AGENT); }
        __syncthreads();
        for (int m = gw; m < M; m += NGW) {
            const int x0 = EID[2 * m], x1 = EID[2 * m + 1]; const int p0 = (int)tp[x0] * 256 + SLOT[2 * m], p1 = (int)tp[x1] * 256 + SLOT[2 * m + 1];
            if (lane == 0) { POS[2 * m] = p0; POS[2 * m + 1] = p1; WROW[p0] = WGT[2 * m]; WROW[p1] = WGT[2 * m + 1]; }
            const v4u a = *((const v4u*)(HN + (size_t)m * DM) + lane), b2 = *((const v4u*)(HN + (size_t)m * DM) + 64 + lane);
            *((v4u*)(XG + (size_t)p0 * DM) + lane) = a; *((v4u*)(XG + (size_t)p0 * DM) + 64 + lane) = b2;
            *((v4u*)(XG + (size_t)p1 * DM) + lane) = a; *((v4u*)(XG + (size_t)p1 * DM) + 64 + lane) = b2;
        }
        __syncthreads();
    }
    SEAM(10);
    if (IN(11)) {
        LAS unsigned* tp = (LAS unsigned*)(L + TP_OFF); if (tid <= NEXP) tp[tid] = __hip_atomic_load(ctl + CW_TPRE + tid, RLX_AGENT); __syncthreads();
        pg8::Gemm g{XG, WGU, XG_ROWS, NEXP * 512, 1024}; ExpertOrder S{tp, 2, G, bx}; EpiGU E{ACT};
        pg8::gemm_phase<EpiGU, ExpertOrder, true, true>(L + RING_OFF, g, S, E);
    }
    SEAM(11);
    if (IN(12)) {
        LAS unsigned* tp = (LAS unsigned*)(L + TP_OFF); if (tid <= NEXP) tp[tid] = __hip_atomic_load(ctl + CW_TPRE + tid, RLX_AGENT); __syncthreads();
        pg8::Gemm g{ACT, WDN, XG_ROWS, NEXP * 1024, 256}; ExpertOrder S{tp, 4, G, bx}; EpiDown E{YB, WROW};
        pg8::gemm_phase<EpiDown, ExpertOrder, true, true>(L + RING_OFF, g, S, E);
    }
    SEAM(12);
    if (IN(13)) {
        for (int m = gw; m < M; m += NGW) {
            const int p0 = POS[2 * m], p1 = POS[2 * m + 1];
            GAS f32x4* hr = (GAS f32x4*)(H + (size_t)m * DM) + lane; const v2u* y0 = (const v2u*)(YB + (size_t)p0 * DM) + lane; const v2u* y1 = (const v2u*)(YB + (size_t)p1 * DM) + lane;
            f32x4 v[4]; float s2 = 0.f;
#pragma unroll
            for (int j = 0; j < 4; ++j) { const v2u a = y0[64 * j], b2 = y1[64 * j]; v[j] = hr[64 * j];
                v[j].x += bflo(a.x) + bflo(b2.x); v[j].y += bfhi(a.x) + bfhi(b2.x); v[j].z += bflo(a.y) + bflo(b2.y); v[j].w += bfhi(a.y) + bfhi(b2.y);
                s2 += (v[j].x * v[j].x + v[j].y * v[j].y) + (v[j].z * v[j].z + v[j].w * v[j].w); }
            const float rstd = 1.f / sqrtf(wave_sum(s2) * (1.f / DM) + EPS);
#pragma unroll
            for (int j = 0; j < 4; ++j) { const f32x4 g = *((const f32x4*)g_final + lane + 64 * j); hr[64 * j] = (f32x4){v[j].x * rstd * g.x, v[j].y * rstd * g.y, v[j].z * rstd * g.z, v[j].w * rstd * g.w}; }
        }
    }
#undef IN
#undef SEAM
}

extern "C" void kernel_launch(void* const* d_in, const int* in_sizes, int n_in, void* d_out, int out_size, void* d_ws, size_t ws_size, hipStream_t stream) {
    static int grid = 0;
    if (grid == 0) {
        if (n_in != 22 || in_sizes[0] != M * DM || out_size != M * DM || ws_size < WS_END) { fprintf(stderr, "kernel_launch: unexpected shapes (n_in %d, in0 %d, out %d, ws %zu); nothing launched\n", n_in, n_in > 0 ? in_sizes[0] : -1, out_size, ws_size); grid = -1; return; }
        int dev = 0, cus = 0, per_cu = 0;
        if (hipGetDevice(&dev) != hipSuccess || hipDeviceGetAttribute(&cus, hipDeviceAttributeMultiprocessorCount, dev) != hipSuccess) { grid = -1; return; }
        if (hipFuncSetAttribute((const void*)mk_fwd, hipFuncAttributeMaxDynamicSharedMemorySize, LDS_BYTES) != hipSuccess) { fprintf(stderr, "kernel_launch: hipFuncSetAttribute failed\n"); grid = -1; return; }
        if (hipOccupancyMaxActiveBlocksPerMultiprocessor(&per_cu, (const void*)mk_fwd, NWAVES * 64, LDS_BYTES) != hipSuccess || per_cu < 1) { fprintf(stderr, "kernel_launch: occupancy query says %d blocks/CU\n", per_cu); per_cu = 1; }
        (void)hipGetLastError();
        grid = cus;
    }
    if (grid < 0) return;
    if (hipMemsetAsync((char*)d_ws + WS_CTL, 0, CTL_ZERO_BYTES, stream) != hipSuccess) { fprintf(stderr, "kernel_launch: memset failed\n"); return; }
    Args a{};
    for (int i = 0; i < 22; ++i) a.in[i] = (const float*)d_in[i];
    a.out = (float*)d_out; a.ws = (unsigned char*)d_ws;
#if MK_PER_PHASE
    for (int p = 0; p < N_PHASES; ++p) { a.ph_lo = p; a.ph_hi = p + 1; hipLaunchKernelGGL(mk_fwd, dim3(grid), dim3(NWAVES * 64), LDS_BYTES, stream, a); }
#else
    a.ph_lo = 0; a.ph_hi = N_PHASES;
    void* kargs[] = {&a};
    hipError_t e = hipLaunchCooperativeKernel((const void*)mk_fwd, dim3(grid), dim3(NWAVES * 64), kargs, LDS_BYTES, stream);
    if (e != hipSuccess) fprintf(stderr, "kernel_launch: cooperative launch failed: %s (grid %d)\n", hipGetErrorString(e), grid);
#endif
}
```

```cpp
#include <hip/hip_runtime.h>
#include <hip/hip_bf16.h>
#include <hip/hip_cooperative_groups.h>
#include <cstdio>
#include <cstdint>
#include <cmath>
namespace pg8 {
#define PG8_LAS __attribute__((address_space(3)))
typedef unsigned short bf16_t;
typedef short bf16x8 __attribute__((ext_vector_type(8)));
typedef float f32x4 __attribute__((ext_vector_type(4)));
typedef unsigned u32x4 __attribute__((ext_vector_type(4)));
constexpr int BM = 256, BK = 64, HALF = 128, HTB = HALF * BK * 2  , STAGE_BYTES = 8 * HTB, NXCD = 8, WGM = 8;

__host__ __device__ __forceinline__ int lds_byte(int r, int c) { const int st = (r >> 4) * 2 + (c >> 5), rr = r & 15, cc = c & 31, ob = rr * 64 + cc * 2; return st * 1024 + (ob ^ (((ob >> 9) & 1) << 5)); }
__host__ __device__ __forceinline__ void stage_rc(int b, int& R, int& C) { const int st = b / 1024, sb = b % 1024, swz = sb ^ (((sb >> 9) & 1) << 5); R = (st >> 1) * 16 + swz / 64; C = (st & 1) * 32 + (swz % 64) / 2; }
__host__ __device__ __forceinline__ int perm32(int rho) { const int n = rho >> 4, i = rho & 15; return 8 * (i >> 2) + 4 * n + (i & 3); }

struct Unit { int pm, pn; };
struct Gemm { const bf16_t* A; const bf16_t* Bt; int M, N, K; };

struct StaticOrder {
    int nM, nN, nwg, G, c;
    __host__ __device__ void init(int M, int N, int G_, int c_) { nM = M / BM; nN = N / BM; nwg = nM * nN; G = G_; c = c_; }
    __host__ __device__ bool next(int i, Unit& u) const {
        const long L = (long)i * G + c; if (L >= nwg) return false;
        int wgid = (int)L; { const int q = nwg / NXCD, r = nwg % NXCD, xcd = wgid % NXCD, off = wgid / NXCD; wgid = (xcd < r ? xcd * (q + 1) : r * (q + 1) + (xcd - r) * q) + off; }
        const int nig = WGM * nN, gid = wgid / nig, fm = gid * WGM, gsz = (nM - fm) < WGM ? (nM - fm) : WGM;
        u.pm = fm + ((wgid % nig) % gsz); u.pn = (wgid % nig) / gsz; return true;
    }
    __device__ __forceinline__ void a_ready(const Unit&) const {}
    __device__ __forceinline__ void done(const Unit&) const {}
};

__device__ __forceinline__ unsigned cvt_pk_bf16(float lo, float hi) { unsigned r; asm volatile("v_cvt_pk_bf16_f32 %0, %1, %2" : "=v"(r) : "v"(lo), "v"(hi)); return r; }
typedef float f32x2 __attribute__((ext_vector_type(2)));
template <class Epi, class Sched, bool ALIGN_EPI = false, bool SP2 = false>
__device__ __forceinline__ void gemm_phase(PG8_LAS unsigned char* lds, const Gemm g, const Sched& S, const Epi& E) {
    const int tid = threadIdx.x, wid = __builtin_amdgcn_readfirstlane(tid >> 6), lane = tid & 63, wr = wid >> 2, wc = wid & 3, fr = lane & 15, fq = lane >> 4;
    const int K = g.K; int nt = K / BK; asm volatile("" : "+s"(nt));
    unsigned voffA[2], voffB[2];
#pragma unroll
    for (int i = 0; i < 2; ++i) { int R, C; stage_rc(tid * 16 + i * 8192, R, C); const int Rb = Epi::PERM ? ((R & ~31) + perm32(R & 31)) : R;
        voffA[i] = (unsigned)(R * K + C) * 2u; voffB[i] = (unsigned)(Rb * K + C) * 2u; }
    const size_t kstep = (size_t)(BK * 2);
    const size_t hstep = (size_t)HALF * K * 2;
    const size_t tstep = 2 * hstep;
    const unsigned ldsw = (unsigned)wid * 1024u;
    const int aoff = lds_byte(wr * 64 + fr, fq * 8), boff = lds_byte(wc * 32 + fr, fq * 8);
#define PG8_SA(b, h) (((b) * 2 + (h)) * HTB)
#define PG8_SB(b, h) ((4 + (b) * 2 + (h)) * HTB)
#define PG8_STAGE(bufoff, gbase, voff) do { _Pragma("unroll") for (int _i = 0; _i < 2; ++_i) \
        __builtin_amdgcn_global_load_lds((const unsigned*)((const char*)(gbase) + (voff)[_i]), (PG8_LAS unsigned*)(lds + (bufoff) + ldsw + _i * 8192), 16, 0, 0); } while (0)
#define PG8_LDA(dst, b, h) do { _Pragma("unroll") for (int m = 0; m < 4; ++m) _Pragma("unroll") for (int k = 0; k < 2; ++k) dst[m][k] = *(const PG8_LAS bf16x8*)(lds + PG8_SA(b, h) + aoff + m * 2048 + k * 1024); } while (0)
#define PG8_LDB(dst, b, h) do { _Pragma("unroll") for (int n = 0; n < 2; ++n) _Pragma("unroll") for (int k = 0; k < 2; ++k) dst[n][k] = *(const PG8_LAS bf16x8*)(lds + PG8_SB(b, h) + boff + n * 2048 + k * 1024); } while (0)
#define PG8_MMA(ai, bj, At, Bt) do { __builtin_amdgcn_s_setprio(1); _Pragma("unroll") for (int m = 0; m < 4; ++m) _Pragma("unroll") for (int n = 0; n < 2; ++n) _Pragma("unroll") for (int k = 0; k < 2; ++k) \
        acc[ai][bj][m][n] = __builtin_amdgcn_mfma_f32_16x16x32_bf16(Bt[n][k], At[m][k], acc[ai][bj][m][n], 0, 0, 0); __builtin_amdgcn_s_setprio(0); } while (0)
#define PG8_WAIT_V(n) asm volatile("s_waitcnt vmcnt(" #n ")" ::: "memory")
#define PG8_WAIT_L(n) asm volatile("s_waitcnt lgkmcnt(" #n ")" ::: "memory")
#define PG8_BAR __builtin_amdgcn_s_barrier()
#define PG8_SCHED __builtin_amdgcn_sched_barrier(0)
    Unit cur, nxt; int ui = 0;
    if (!S.next(0, cur)) return;
    f32x4 acc[2][2][4][2];
#pragma unroll
    for (int a = 0; a < 2; ++a)
#pragma unroll
        for (int b = 0; b < 2; ++b)
#pragma unroll
            for (int m = 0; m < 4; ++m)
#pragma unroll
                for (int n = 0; n < 2; ++n) acc[a][b][m][n] = (f32x4){0.f, 0.f, 0.f, 0.f};
    bf16x8 At[4][2], B0[2][2], B1[2][2];
    const char* cA = (const char*)g.A + (size_t)cur.pm * tstep; const char* cB = (const char*)g.Bt + (size_t)cur.pn * tstep;
    S.a_ready(cur);
    if constexpr (SP2) {
        PG8_STAGE(PG8_SB(0, 0), cB, voffB); PG8_STAGE(PG8_SB(0, 1), cB + hstep, voffB); PG8_STAGE(PG8_SA(0, 0), cA, voffA); PG8_STAGE(PG8_SA(0, 1), cA + hstep, voffA);
        if (wr == 1) PG8_BAR;
        PG8_WAIT_V(2); PG8_BAR;
        PG8_STAGE(PG8_SB(1, 0), cB + kstep, voffB); PG8_STAGE(PG8_SA(1, 0), cA + kstep, voffA); PG8_STAGE(PG8_SB(1, 1), cB + hstep + kstep, voffB);
        PG8_WAIT_V(6); PG8_BAR;
    } else {
        PG8_STAGE(PG8_SB(0, 0), cB, voffB); PG8_STAGE(PG8_SA(0, 0), cA, voffA); PG8_STAGE(PG8_SB(0, 1), cB + hstep, voffB); PG8_STAGE(PG8_SA(0, 1), cA + hstep, voffA);
        if (wr == 1) PG8_BAR;
        PG8_WAIT_V(4); PG8_BAR;
        PG8_STAGE(PG8_SB(1, 0), cB + kstep, voffB); PG8_STAGE(PG8_SA(1, 0), cA + kstep, voffA); PG8_STAGE(PG8_SB(1, 1), cB + hstep + kstep, voffB);
        PG8_WAIT_V(6); PG8_BAR;
    }
    for (;;) {
        const bool has_next = S.next(ui + 1, nxt);
        const char* nA = has_next ? (const char*)g.A + (size_t)nxt.pm * tstep : cA; const char* nB = has_next ? (const char*)g.Bt + (size_t)nxt.pn * tstep : cB;
        for (int t = 0; t < nt; t += 2) {
            const bool last = (t == nt - 2);
            const char* a1 = cA + (size_t)(t + 1) * kstep;
            const char* a2 = last ? nA : cA + (size_t)(t + 2) * kstep; const char* b2 = last ? nB : cB + (size_t)(t + 2) * kstep;
            const char* a3 = a2 + kstep; const char* b3 = b2 + kstep;
            if (last && has_next) S.a_ready(nxt);
            if constexpr (SP2) {
            PG8_LDB(B0, 0, 0); PG8_LDB(B1, 0, 1); PG8_SCHED; PG8_LDA(At, 0, 0); PG8_STAGE(PG8_SA(1, 1), a1 + hstep, voffA);
            PG8_WAIT_V(8); PG8_WAIT_L(0); PG8_BAR; PG8_MMA(0, 0, At, B0); PG8_MMA(0, 1, At, B1); PG8_BAR; PG8_SCHED;
            PG8_LDA(At, 0, 1); PG8_STAGE(PG8_SB(0, 0), b2, voffB); PG8_STAGE(PG8_SB(0, 1), b2 + hstep, voffB); PG8_STAGE(PG8_SA(0, 0), a2, voffA);
            PG8_WAIT_V(8); PG8_WAIT_L(0); PG8_BAR; PG8_MMA(1, 0, At, B0); PG8_MMA(1, 1, At, B1); PG8_BAR; PG8_SCHED;
            PG8_LDB(B0, 1, 0); PG8_LDB(B1, 1, 1); PG8_SCHED; PG8_LDA(At, 1, 0); PG8_STAGE(PG8_SA(0, 1), a2 + hstep, voffA);
            PG8_WAIT_V(8); PG8_WAIT_L(0); PG8_BAR; PG8_MMA(0, 0, At, B0); PG8_MMA(0, 1, At, B1); PG8_BAR; PG8_SCHED;
            PG8_LDA(At, 1, 1); PG8_STAGE(PG8_SB(1, 0), b3, voffB); PG8_STAGE(PG8_SB(1, 1), b3 + hstep, voffB); PG8_STAGE(PG8_SA(1, 0), a3, voffA);
            PG8_WAIT_V(8); PG8_WAIT_L(0); PG8_BAR; PG8_MMA(1, 0, At, B0); PG8_MMA(1, 1, At, B1); PG8_BAR; PG8_SCHED;
            } else {
            PG8_LDB(B0, 0, 0); PG8_SCHED; PG8_LDA(At, 0, 0); PG8_STAGE(PG8_SA(1, 1), a1 + hstep, voffA);
            PG8_WAIT_L(8); PG8_BAR; PG8_WAIT_L(0); PG8_MMA(0, 0, At, B0); PG8_BAR; PG8_SCHED;
            PG8_LDB(B1, 0, 1); PG8_STAGE(PG8_SB(0, 0), b2, voffB);
            PG8_BAR; PG8_WAIT_L(0); PG8_MMA(0, 1, At, B1); PG8_BAR;
            PG8_LDA(At, 0, 1); PG8_STAGE(PG8_SA(0, 0), a2, voffA);
            PG8_BAR; PG8_WAIT_L(0); PG8_MMA(1, 0, At, B0); PG8_BAR; PG8_SCHED;
            PG8_STAGE(PG8_SB(0, 1), b2 + hstep, voffB);
            PG8_WAIT_V(6); PG8_BAR; PG8_MMA(1, 1, At, B1); PG8_BAR;
            PG8_LDB(B0, 1, 0); PG8_SCHED; PG8_LDA(At, 1, 0); PG8_STAGE(PG8_SA(0, 1), a2 + hstep, voffA);
            PG8_WAIT_L(8); PG8_BAR; PG8_WAIT_L(0); PG8_MMA(0, 0, At, B0); PG8_BAR; PG8_SCHED;
            PG8_LDB(B1, 1, 1); PG8_STAGE(PG8_SB(1, 0), b3, voffB);
            PG8_BAR; PG8_WAIT_L(0); PG8_MMA(0, 1, At, B1); PG8_BAR;
            PG8_LDA(At, 1, 1); PG8_STAGE(PG8_SA(1, 0), a3, voffA);
            PG8_BAR; PG8_WAIT_L(0); PG8_MMA(1, 0, At, B0); PG8_BAR; PG8_SCHED;
            PG8_STAGE(PG8_SB(1, 1), b3 + hstep, voffB);
            PG8_WAIT_V(6); PG8_BAR; PG8_MMA(1, 1, At, B1); PG8_BAR;
            }
        }
        if constexpr (ALIGN_EPI) { if (wr == 0) PG8_BAR; }
        if constexpr (!Epi::AFTER_DRAIN) { E(acc, cur, wr, wc, fr, fq); S.done(cur); }
        if (!has_next) break;
#pragma unroll
        for (int a = 0; a < 2; ++a)
#pragma unroll
            for (int b = 0; b < 2; ++b)
#pragma unroll
                for (int m = 0; m < 4; ++m)
#pragma unroll
                    for (int n = 0; n < 2; ++n) acc[a][b][m][n] = (f32x4){0.f, 0.f, 0.f, 0.f};
        cur = nxt; cA = nA; cB = nB; ++ui;
        if constexpr (ALIGN_EPI) { if (wr == 1) PG8_BAR; }
    }
    PG8_WAIT_V(0);
    if constexpr (!ALIGN_EPI) { if (wr == 0) PG8_BAR; }
    PG8_BAR;
    if constexpr (Epi::AFTER_DRAIN) { E.fused(acc, cur, wr, wc, fr, fq, lds, wid, lane); S.done(cur); }
#undef PG8_SA
#undef PG8_SB
#undef PG8_STAGE
#undef PG8_LDA
#undef PG8_LDB
#undef PG8_MMA
#undef PG8_WAIT_V
#undef PG8_WAIT_L
#undef PG8_BAR
#undef PG8_SCHED
}
}
namespace att {
typedef unsigned short bf16;
using bf16x8 = __attribute__((ext_vector_type(8))) short;
using s16x4 = __attribute__((ext_vector_type(4))) short;
using f32x16 = __attribute__((ext_vector_type(16))) float;
using u32x4 = __attribute__((ext_vector_type(4))) unsigned;
constexpr int SEQ = 4096, NW = 8, QB = 256, KVBLK = 64;
constexpr int KSLOT = 12288, VSLOT = 8192, NSLOT = 3;
constexpr int LDS_K = 0, LDS_V = NSLOT * KSLOT, LDS_WS = LDS_V + NSLOT * VSLOT, LDS_OST = LDS_WS + NW * 256, LDS_BYTES = LDS_OST + NW * 4096;
constexpr float THR = 8.0f;
#define ATT_LAS __attribute__((address_space(3)))
#define SBAR() __builtin_amdgcn_sched_barrier(0)
#define WAIT_BAR(N) asm volatile("s_waitcnt vmcnt(" #N ") lgkmcnt(0)\n\ts_barrier" ::: "memory")
__device__ __forceinline__ int crow(int r, int hi) { return (r & 3) + 8 * (r >> 2) + 4 * hi; }
__device__ __forceinline__ void glds16(const void* gsrc, unsigned lds_dst) { unsigned keep;
  asm volatile("s_mov_b32 %0, m0\n\ts_mov_b32 m0, %2\n\ts_nop 0\n\tglobal_load_lds_dwordx4 %1, off\n\ts_mov_b32 m0, %0" : "=&s"(keep) : "v"(gsrc), "s"(lds_dst) : "memory"); }
typedef float f32x2_t __attribute__((ext_vector_type(2))); typedef __bf16 bf16x2_t __attribute__((ext_vector_type(2)));
__device__ __forceinline__ unsigned cvtpk_s(float lo, float hi) { f32x2_t v = {lo, hi}; bf16x2_t b = __builtin_convertvector(v, bf16x2_t); return __builtin_bit_cast(unsigned, b); }
typedef ATT_LAS const char* lds_cptr;
#define MX3(a, b, c) __builtin_fmaxf(__builtin_fmaxf((a), (b)), (c))
__device__ __forceinline__ float rowmax(const f32x16& p0, const f32x16& p1) {
  float a = MX3(p0[0], p0[1], p1[0]), b = MX3(p0[2], p0[3], p1[1]); a = MX3(a, p1[2], p1[3]);
#pragma unroll
  for (int r = 4; r < 16; r += 4) { a = MX3(a, p0[r], p0[r + 1]); b = MX3(b, p0[r + 2], p0[r + 3]); a = MX3(a, p1[r], p1[r + 1]); b = MX3(b, p1[r + 2], p1[r + 3]); }
  float m = __builtin_fmaxf(a, b); auto rr = __builtin_amdgcn_permlane32_swap(__float_as_uint(m), __float_as_uint(m), false, false);
  return __builtin_fmaxf(__uint_as_float(rr[0]), __uint_as_float(rr[1])); }
__device__ __forceinline__ void cmask(f32x16& p0, f32x16& p1, int jb, int qrel, int hi) {
  const int kb = 64 * jb + 4 * hi;
#pragma unroll
  for (int r = 0; r < 16; ++r) { const int kv = kb + (r & 3) + 8 * (r >> 2); if (kv > qrel) p0[r] = -INFINITY; if (kv + 32 > qrel) p1[r] = -INFINITY; } }
template <int ND0> __device__ __forceinline__ void qkt(f32x16& p0, f32x16& p1, lds_cptr kp, const bf16x8* qr, const f32x16& negm) {
#pragma unroll
  for (int d0 = 0; d0 < ND0; ++d0) {
    const bf16x8 b0 = *(const ATT_LAS bf16x8*)(kp + d0 * 2048);
    const bf16x8 b1 = *(const ATT_LAS bf16x8*)(kp + d0 * 2048 + 512);
    if (d0 == 0) { p0 = __builtin_amdgcn_mfma_f32_32x32x16_bf16(b0, qr[0], negm, 0, 0, 0); p1 = __builtin_amdgcn_mfma_f32_32x32x16_bf16(b1, qr[0], negm, 0, 0, 0); }
    else { p0 = __builtin_amdgcn_mfma_f32_32x32x16_bf16(b0, qr[d0], p0, 0, 0, 0); p1 = __builtin_amdgcn_mfma_f32_32x32x16_bf16(b1, qr[d0], p1, 0, 0, 0); } }
}
__device__ __forceinline__ void pv(f32x16* o, int vb, bf16x8 pa0, bf16x8 pa1, bf16x8 pa2, bf16x8 pa3) {
#pragma unroll
  for (int d0 = 0; d0 < 2; ++d0) { s16x4 lo[4], hi[4];
#pragma unroll
    for (int ks = 0; ks < 4; ++ks) {
      asm volatile("ds_read_b64_tr_b16 %0,%1 offset:%c2" : "=&v"(lo[ks]) : "v"(vb), "i"(d0 * 4096 + ks * 1024) : "memory");
      asm volatile("ds_read_b64_tr_b16 %0,%1 offset:%c2" : "=&v"(hi[ks]) : "v"(vb), "i"(d0 * 4096 + ks * 1024 + 512) : "memory"); }
    asm volatile("s_waitcnt lgkmcnt(0)" ::: "memory"); SBAR();
#define PK(k) (bf16x8){lo[k][0], lo[k][1], lo[k][2], lo[k][3], hi[k][0], hi[k][1], hi[k][2], hi[k][3]}
    o[d0] = __builtin_amdgcn_mfma_f32_32x32x16_bf16(pa0, PK(0), o[d0], 0, 0, 0);
    o[d0] = __builtin_amdgcn_mfma_f32_32x32x16_bf16(pa1, PK(1), o[d0], 0, 0, 0);
    o[d0] = __builtin_amdgcn_mfma_f32_32x32x16_bf16(pa2, PK(2), o[d0], 0, 0, 0);
    o[d0] = __builtin_amdgcn_mfma_f32_32x32x16_bf16(pa3, PK(3), o[d0], 0, 0, 0);
#undef PK
  }
}
struct AttnT { const bf16* Q; const bf16* K; const bf16* KR; const bf16* V; bf16* O; const float* CS; };
template <int KIND> __device__ __forceinline__ void attn_unit(int b, int h, int qb, const AttnT& T, char* shm) {
  constexpr int ND0 = KIND == 0 ? 6 : 5, QP = KIND == 0 ? 768 : 640, HD = KIND == 0 ? 96 : 80;
  const int tid = threadIdx.x, lane = tid & 63, r32 = lane & 31, hi = lane >> 5; const int wid = __builtin_amdgcn_readfirstlane(tid >> 6);
  const long rowbase = (long)b * SEQ; const int q0 = qb * QB;
  const bf16* Qw = T.Q + (rowbase + q0 + wid * 32) * QP + h * HD;
  const unsigned lds0 = (unsigned)(uintptr_t)shm;
  const lds_cptr shm3 = (lds_cptr)shm;
  ATT_LAS float* wsf = (ATT_LAS float*)(shm3 + LDS_WS) + wid * 64;
  const bf16 *ksrcA, *ksrcB; long kstepA, kstepB; unsigned kdstB;
  const unsigned kdstA = lds0 + LDS_K + wid * 1024;
  if (KIND == 0) { ksrcA = T.K + (rowbase + lane) * 512 + h * 64 + wid * 8; ksrcB = T.KR + (rowbase + lane) * 32 + (wid & 3) * 8; kdstB = lds0 + LDS_K + (8 + (wid & 3)) * 1024; kstepA = 64 * 512; kstepB = 64 * 32; }
  else { ksrcA = T.K + (rowbase + lane) * 640 + h * 80 + wid * 8; ksrcB = T.K + (rowbase + lane) * 640 + h * 80 + (8 + (wid & 1)) * 8; kdstB = lds0 + LDS_K + (8 + (wid & 1)) * 1024; kstepA = 64 * 640; kstepB = 64 * 640; }
  const bf16* vsrc = T.V + (rowbase + 16 * (wid & 3) + (lane >> 2)) * 512 + h * 64 + (wid >> 2) * 32 + (lane & 3) * 8;
  const unsigned vdst = lds0 + LDS_V + wid * 1024;
#define DMA_T(t, s) do { glds16(ksrcA + (long)(t) * kstepA, (unsigned)__builtin_amdgcn_readfirstlane(kdstA + (s) * KSLOT)); \
                         glds16(ksrcB + (long)(t) * kstepB, (unsigned)__builtin_amdgcn_readfirstlane(kdstB + (s) * KSLOT)); \
                         glds16(vsrc + (long)(t) * (64 * 512), (unsigned)__builtin_amdgcn_readfirstlane(vdst + (s) * VSLOT)); } while (0)
  const int vb0 = (int)(lds0 + LDS_V) + ((lane >> 4) & 1) * 32 + (lane & 3) * 8 + (4 * hi + ((lane & 15) >> 2)) * 64;
  const lds_cptr kp0 = shm3 + LDS_K + hi * 1024 + r32 * 16;
  const int NT = (q0 + QB) / KVBLK;
  DMA_T(0, 0); DMA_T(1, 1);
  bf16x8 qr[ND0];
#pragma unroll
  for (int d0 = 0; d0 < ND0; ++d0) qr[d0] = *reinterpret_cast<const bf16x8*>(&Qw[(long)r32 * QP + d0 * 16 + hi * 8]);
  if (KIND == 0) {
    const float* cs = T.CS + (rowbase + q0 + wid * 32 + r32) * 32 + 16 * hi;
    typedef float f32x4_t __attribute__((ext_vector_type(4)));
    bf16x8 a = qr[4], c = qr[5];
#pragma unroll
    for (int j2 = 0; j2 < 4; ++j2) { const f32x4_t t4 = *(const f32x4_t*)(cs + 4 * j2);
#pragma unroll
      for (int e = 0; e < 2; ++e) { const int j = 2 * j2 + e; const float co = t4[2 * e], si = t4[2 * e + 1];
        const float x1 = __builtin_bit_cast(float, (unsigned)(unsigned short)a[j] << 16), x2 = __builtin_bit_cast(float, (unsigned)(unsigned short)c[j] << 16);
        const float o1 = x1 * co - x2 * si, o2 = x2 * co + x1 * si;
        qr[4][j] = (short)(cvtpk_s(o1, o1) & 0xffffu); qr[5][j] = (short)(cvtpk_s(o2, o2) & 0xffffu); } }
  }
  float mhat = 0.f, l_reg = 0.f; f32x16 o[2]; o[0] = f32x16{}; o[1] = f32x16{}; f32x16 negm = f32x16{};
  const int qrel = wid * 32 + r32;
  int s_cur = 0;
  for (int t = 0; t < NT; ++t) {
    if (t + 1 < NT) { WAIT_BAR(3); } else { WAIT_BAR(0); }
    if (t + 2 < NT) { const int s2 = (s_cur >= 1) ? s_cur - 1 : 2; DMA_T(t + 2, s2); }
    const int jb = t - 4 * qb;
    const bool vis = (KIND == 0) ? (t <= 4 * qb + (wid >> 1)) : ((jb < 0) || (64 * jb <= 32 * wid + 31));
    if (vis) {
      f32x16 p0, p1;
      qkt<ND0>(p0, p1, kp0 + s_cur * KSLOT, qr, negm);
      if (KIND == 1) { if (jb >= 0) cmask(p0, p1, jb, qrel, hi); }
      const float rm = rowmax(p0, p1);
      if (t == 0 || __any(rm > THR)) {
        const float dl = (t == 0) ? rm : __builtin_fmaxf(rm, 0.f);
        mhat += dl;
#pragma unroll
        for (int r = 0; r < 16; ++r) { p0[r] -= dl; p1[r] -= dl; negm[r] = -mhat; }
        const float f = __builtin_amdgcn_exp2f(-dl); l_reg *= f;
        if (t > 0) {
          if (hi == 0) wsf[r32] = f;
          asm volatile("s_waitcnt lgkmcnt(0)" ::: "memory");
#pragma unroll
          for (int d_ = 0; d_ < 2; ++d_)
#pragma unroll
            for (int r = 0; r < 16; ++r) o[d_][r] *= wsf[crow(r, hi)];
          asm volatile("s_waitcnt lgkmcnt(0)" ::: "memory");
        }
      }
      float sacc = 0.f;
#pragma unroll
      for (int r = 0; r < 16; ++r) { p0[r] = __builtin_amdgcn_exp2f(p0[r]); p1[r] = __builtin_amdgcn_exp2f(p1[r]); sacc += p0[r] + p1[r]; }
      l_reg += sacc;
      u32x4 pw0, pw1, pw2, pw3;
#define PKW(P, B) cvtpk_s(P[B], P[B + 1])
      pw0 = (u32x4){PKW(p0, 0), PKW(p0, 2), PKW(p0, 4), PKW(p0, 6)}; pw1 = (u32x4){PKW(p0, 8), PKW(p0, 10), PKW(p0, 12), PKW(p0, 14)};
      pw2 = (u32x4){PKW(p1, 0), PKW(p1, 2), PKW(p1, 4), PKW(p1, 6)}; pw3 = (u32x4){PKW(p1, 8), PKW(p1, 10), PKW(p1, 12), PKW(p1, 14)};
#undef PKW
      SBAR();
      pv(o, vb0 + s_cur * VSLOT, __builtin_bit_cast(bf16x8, pw0), __builtin_bit_cast(bf16x8, pw1), __builtin_bit_cast(bf16x8, pw2), __builtin_bit_cast(bf16x8, pw3));
    }
    s_cur = (s_cur == 2) ? 0 : s_cur + 1;
  }
  { auto rr = __builtin_amdgcn_permlane32_swap(__float_as_uint(l_reg), __float_as_uint(l_reg), false, false); l_reg = __uint_as_float(rr[0]) + __uint_as_float(rr[1]); }
  if (hi == 0) wsf[32 + r32] = l_reg;
  asm volatile("s_waitcnt lgkmcnt(0)" ::: "memory");
  float rli[16];
#pragma unroll
  for (int r = 0; r < 16; ++r) rli[r] = __builtin_amdgcn_rcpf(wsf[32 + crow(r, hi)]);
  bf16* Ow = T.O + (rowbase + q0 + wid * 32) * 512 + h * 64;
  { ATT_LAS bf16* stg = (ATT_LAS bf16*)(shm3 + LDS_OST) + wid * 2048;
#pragma unroll
    for (int r = 0; r < 16; ++r) { const int orow = crow(r, hi);
#pragma unroll
      for (int d0 = 0; d0 < 2; ++d0) { const float v = o[d0][r] * rli[r]; stg[orow * 64 + d0 * 32 + r32] = (bf16)(cvtpk_s(v, v) & 0xffffu); } }
    asm volatile("s_waitcnt lgkmcnt(0)" ::: "memory");
#pragma unroll
    for (int i = 0; i < 4; ++i) { const int row = i * 8 + (lane >> 3), ch = lane & 7; const u32x4 v = *(const ATT_LAS u32x4*)(stg + row * 64 + ch * 8); *(u32x4*)(Ow + (long)row * 512 + ch * 8) = v; } }
  asm volatile("s_waitcnt lgkmcnt(0)\n\ts_barrier" ::: "memory");
#undef DMA_T
}
#undef SBAR
#undef WAIT_BAR
#undef MX3
}
#ifndef MK_PER_PHASE
#define MK_PER_PHASE 0
#endif
constexpr int NWAVES = 8;
constexpr int BATCH = 8, SEQ = 4096, DM = 1024, M = BATCH * SEQ;
constexpr int NIN = 4096;
constexpr int NEXP = 32, XG_ROWS = 2 * M + NEXP * 256;
constexpr float EPS = 1e-6f, LOG2E = 1.4426950408889634f;
constexpr float C2F = 0.125f * LOG2E;
constexpr float C2M = 0.10206207261596577f * LOG2E;
constexpr int N_PHASES = 14;
constexpr size_t MiB = 1u << 20;
constexpr size_t WS_CTL = 0, CTL_ZERO_BYTES = 1 * MiB;
constexpr size_t WS_WIN = 1 * MiB, WS_WUQ = 9 * MiB, WS_WUKV = 9 * MiB + 512 * 1024, WS_WOA = 10 * MiB, WS_WOB = 11 * MiB, WS_WOUT = 12 * MiB, WS_WR = 14 * MiB, WS_WGU = 15 * MiB, WS_WDN = 47 * MiB;
constexpr size_t WS_CS = 63 * MiB, WS_LOGF = 67 * MiB, WS_EID = 68 * MiB, WS_SLOT = WS_EID + 256 * 1024, WS_WGT = WS_SLOT + 256 * 1024, WS_POS = WS_WGT + 256 * 1024, WS_WROW = 69 * MiB;
constexpr size_t WS_XN = 72 * MiB, WS_CQN = 72 * MiB, WS_CKVN = 88 * MiB, WS_VM = 96 * MiB, WS_KR = 128 * MiB;
constexpr size_t WS_Z0 = 136 * MiB, WS_Z1 = 152 * MiB, WS_QF = 184 * MiB, WS_KF = 224 * MiB, WS_VF = 264 * MiB, WS_OA = 296 * MiB, WS_OB = 328 * MiB, WS_MIX = 360 * MiB, WS_QM = 424 * MiB, WS_KM = 472 * MiB;
constexpr size_t WS_HN = 72 * MiB, WS_LG = 200 * MiB, WS_XG = 232 * MiB, WS_ACT = 376 * MiB, WS_YB = 72 * MiB, WS_END = 504 * MiB;
static_assert(WS_XG + (size_t)XG_ROWS * 2048 <= WS_ACT && WS_ACT + (size_t)XG_ROWS * 512 <= WS_END && WS_YB + (size_t)XG_ROWS * 2048 <= WS_XG, "moe map");
constexpr int CW_CNT = 64;
constexpr int CW_TPRE = 128;
constexpr int CW_BAR = 4096;
constexpr int RING_OFF = 0, RING_BYTES = 131072, LDSCTL_OFF = RING_BYTES, MISC_OFF = LDSCTL_OFF + 320, TP_OFF = LDSCTL_OFF + 1024, LDS_BYTES = 147456;

#define GAS __attribute__((address_space(1)))
#define LAS __attribute__((address_space(3)))
typedef unsigned short bf16;
typedef unsigned v4u __attribute__((ext_vector_type(4)));
typedef float f32x4 __attribute__((ext_vector_type(4)));
typedef short bf16x8 __attribute__((ext_vector_type(8)));
typedef GAS unsigned gu32;
typedef GAS unsigned long long gu64;
#define RLX_AGENT __ATOMIC_RELAXED, __HIP_MEMORY_SCOPE_AGENT
#define LDS_WAIT() asm volatile("s_waitcnt lgkmcnt(0)" ::: "memory")
#define VM_WAIT() asm volatile("s_waitcnt vmcnt(0)" ::: "memory")
__device__ __forceinline__ unsigned long long rt() { return __builtin_amdgcn_s_memrealtime(); }
__device__ __forceinline__ unsigned f2bf(float f) { unsigned u = __builtin_bit_cast(unsigned, f); return (u + 0x7fffu + ((u >> 16) & 1u)) >> 16; }
__device__ __forceinline__ unsigned pk2(float lo, float hi) { return f2bf(lo) | (f2bf(hi) << 16); }


#define XB_TMO      128
#define XB_XCNT(j)  (256  + 64 * (j))
#define XB_XSUB(j)  (1280 + 64 * (j))
#define XB_XGEN(j)  (2304 + 64 * (j))
#define XB_TOP      3328
#define XB_TOPGEN   3392
#define XCD_BAR_WORDS 3456
#define XB_SPIN_CAP (1u << 18)

__device__ __forceinline__ unsigned xb_ld(unsigned* p)              { return __hip_atomic_load(p, __ATOMIC_RELAXED, __HIP_MEMORY_SCOPE_AGENT); }
__device__ __forceinline__ unsigned xb_add(unsigned* p, unsigned v) { return __hip_atomic_fetch_add(p, v, __ATOMIC_RELAXED, __HIP_MEMORY_SCOPE_AGENT); }
__device__ __forceinline__ unsigned xb_xcc_id() { return (unsigned)__builtin_amdgcn_s_getreg((3 << 11) | 20) & 0xFu; }
#define XB_SPIN(cond, bar) do { unsigned _sp = 0; while (cond) { __builtin_amdgcn_s_sleep(1); \
    if ((++_sp & 255u) == 0u) { if (xb_ld(&(bar)[XB_TMO])) break; if (_sp > XB_SPIN_CAP) { atomicAdd(&(bar)[XB_TMO], 1u); break; } } } } while (0)

struct XcdBarrier {
    unsigned* bar; unsigned x;
    volatile LAS unsigned* st;
};

__device__ __forceinline__ XcdBarrier xcd_barrier_post(unsigned* bar, volatile LAS unsigned* st) {
    XcdBarrier b; b.bar = bar; b.x = xb_xcc_id(); b.st = st;
    if (threadIdx.x == 0) (void)xb_add(&bar[XB_XCNT(b.x)], 1u);
    return b;
}
__device__ __forceinline__ void xcd_barrier_complete(unsigned* bar, unsigned x, unsigned& nloc, unsigned& nx) {
    const unsigned G = gridDim.x * gridDim.y * gridDim.z;
    unsigned sum, cnt, mine, sp = 0u;
    for (;;) {
        sum = 0u; cnt = 0u; mine = 0u;
#pragma unroll
        for (unsigned j = 0; j < 16; ++j) { const unsigned c = xb_ld(&bar[XB_XCNT(j)]); sum += c; cnt += (c > 0u) ? 1u : 0u; mine = (j == x) ? c : mine; }
        if (sum == G) break;
        __builtin_amdgcn_s_sleep(1);
        if ((++sp & 255u) == 0u) { if (xb_ld(&bar[XB_TMO])) break; if (sp > XB_SPIN_CAP) { atomicAdd(&bar[XB_TMO], 1u); break; } }
    }
    nloc = mine > 0u ? mine : 1u; nx = cnt > 0u ? cnt : 1u;
}

__device__ __forceinline__ void xcd_barrier(const XcdBarrier& b) {
    asm volatile("s_waitcnt vmcnt(0)" ::: "memory");
    __syncthreads();
    if (threadIdx.x == 0) {
        unsigned* bar = b.bar;
        __builtin_amdgcn_s_waitcnt(0);
        unsigned nloc = b.st[0], nx = b.st[1];
        if (nloc == 0u) { xcd_barrier_complete(bar, b.x, nloc, nx); b.st[0] = nloc; b.st[1] = nx; }
        const unsigned old = xb_add(&bar[XB_XSUB(b.x)], 1u);
        const unsigned gen = old / nloc;
        if (old + 1u == (gen + 1u) * nloc) {
            __builtin_amdgcn_fence(__ATOMIC_RELEASE, "agent");
            asm volatile("s_waitcnt vmcnt(0)" ::: "memory");
            const unsigned og = xb_add(&bar[XB_TOP], 1u);
            const unsigned tg = og / nx;
            if (og + 1u == (tg + 1u) * nx) xb_add(&bar[XB_TOPGEN], 1u);
            else XB_SPIN(xb_ld(&bar[XB_TOPGEN]) == tg, bar);
            __builtin_amdgcn_fence(__ATOMIC_ACQUIRE, "agent");
            xb_add(&bar[XB_XGEN(b.x)], 1u);
            asm volatile("s_waitcnt vmcnt(0)" ::: "memory");
        } else {
            XB_SPIN(xb_ld(&bar[XB_XGEN(b.x)]) == gen, bar);
            __builtin_amdgcn_fence(__ATOMIC_ACQUIRE, "agent");
            asm volatile("s_waitcnt vmcnt(0)" ::: "memory");
        }
    }
    __syncthreads();
}


typedef unsigned v2u __attribute__((ext_vector_type(2)));
__device__ __forceinline__ float wave_sum(float v) {
#pragma unroll
    for (int o = 1; o < 64; o <<= 1) v += __shfl_xor(v, o);
    return v;
}
__device__ __forceinline__ float bf2f(unsigned short b) { return __builtin_bit_cast(float, (unsigned)b << 16); }
__device__ __forceinline__ float bflo(unsigned w) { return __builtin_bit_cast(float, w << 16); }
__device__ __forceinline__ float bfhi(unsigned w) { return __builtin_bit_cast(float, w & 0xffff0000u); }
__device__ __forceinline__ v4u pack8(f32x4 a, f32x4 b) { v4u w; w.x = pg8::cvt_pk_bf16(a[0], a[1]); w.y = pg8::cvt_pk_bf16(a[2], a[3]); w.z = pg8::cvt_pk_bf16(b[0], b[1]); w.w = pg8::cvt_pk_bf16(b[2], b[3]); return w; }
__device__ __forceinline__ float sigmoidf_(float x) { return __builtin_amdgcn_rcpf(1.0f + __builtin_amdgcn_exp2f(-x * LOG2E)); }

using pg8::Unit;
#define EPI_ROWS(...) int rb_ = u.pm * 256 + wr * 64 + fr; asm volatile("" : "+v"(rb_)); _Pragma("unroll") for (int ai = 0; ai < 2; ++ai) _Pragma("unroll") for (int m = 0; m < 4; ++m) { const size_t row = (size_t)(rb_ + ai * 128 + m * 16); \
        _Pragma("unroll") for (int bj = 0; bj < 2; ++bj) { const f32x4 v0 = acc[ai][bj][m][0], v1 = acc[ai][bj][m][1]; __VA_ARGS__ } }
struct EpiIn { static constexpr bool PERM = true, AFTER_DRAIN = false;
    bf16* Z0; float* Z1; bf16 *QF, *KF, *VF, *GA, *GB;
    __device__ __forceinline__ void operator()(const f32x4 (&acc)[2][2][4][2], const Unit& u, int wr, int wc, int fr, int fq) const {
        const int pn = u.pn;
        EPI_ROWS({ const int ct = bj * 128 + wc * 32 + 8 * fq;
            if (pn == 0) { *(v4u*)(Z0 + row * 256 + ct) = pack8(v0, v1); }
            else if (pn == 1) { float* p = Z1 + row * 256 + ct; *(f32x4*)p = v0; *(f32x4*)(p + 4) = v1; }
            else if (pn < 4) { const int c = (pn - 2) * 256 + ct; *(v4u*)(QF + row * 640 + (c >> 6) * 80 + (c & 63)) = pack8(v0 * C2F, v1 * C2F); }
            else if (pn < 6) { const int c = (pn - 4) * 256 + ct; *(v4u*)(KF + row * 640 + (c >> 6) * 80 + (c & 63)) = pack8(v0, v1); }
            else if (pn < 8) { const int c = (pn - 6) * 256 + ct; *(v4u*)(VF + row * 512 + c) = pack8(v0, v1); }
            else { bf16* G = pn < 12 ? GA : GB; const int c = ((pn - 8) & 3) * 256 + ct; f32x4 s0, s1;
                _Pragma("unroll") for (int e = 0; e < 4; ++e) { s0[e] = sigmoidf_(v0[e]); s1[e] = sigmoidf_(v1[e]); }
                *(v4u*)(G + row * 1024 + c) = pack8(s0, s1); } })
    }
};
struct EpiQup { static constexpr bool PERM = true, AFTER_DRAIN = false;
    bf16* QM;
    __device__ __forceinline__ void operator()(const f32x4 (&acc)[2][2][4][2], const Unit& u, int wr, int wc, int fr, int fq) const {
        EPI_ROWS({ const int ct = u.pn * 256 + bj * 128 + wc * 32 + 8 * fq; *(v4u*)(QM + row * 768 + ct) = pack8(v0 * C2M, v1 * C2M); })
    }
};
struct EpiKVup { static constexpr bool PERM = true, AFTER_DRAIN = false;
    bf16 *KM, *VM;
    __device__ __forceinline__ void operator()(const f32x4 (&acc)[2][2][4][2], const Unit& u, int wr, int wc, int fr, int fq) const {
        bf16* D = u.pn < 2 ? KM : VM; const int c0 = (u.pn & 1) * 256;
        EPI_ROWS({ const int ct = bj * 128 + wc * 32 + 8 * fq; *(v4u*)(D + row * 512 + c0 + ct) = pack8(v0, v1); })
    }
};
template <int SECOND> struct EpiGate { static constexpr bool PERM = true, AFTER_DRAIN = false;
    const bf16* G; bf16* MIX;
    __device__ __forceinline__ void operator()(const f32x4 (&acc)[2][2][4][2], const Unit& u, int wr, int wc, int fr, int fq) const {
        EPI_ROWS({ const size_t off = row * 1024 + u.pn * 256 + bj * 128 + wc * 32 + 8 * fq; const v4u g = *(const v4u*)(G + off);
            f32x4 r0 = {bflo(g.x) * v0[0], bfhi(g.x) * v0[1], bflo(g.y) * v0[2], bfhi(g.y) * v0[3]}, r1 = {bflo(g.z) * v1[0], bfhi(g.z) * v1[1], bflo(g.w) * v1[2], bfhi(g.w) * v1[3]};
            if (SECOND) { const v4u p = *(const v4u*)(MIX + off); r0 += (f32x4){bflo(p.x), bfhi(p.x), bflo(p.y), bfhi(p.y)}; r1 += (f32x4){bflo(p.z), bfhi(p.z), bflo(p.w), bfhi(p.w)}; }
            *(v4u*)(MIX + off) = pack8(r0, r1); })
    }
};
struct EpiRes { static constexpr bool PERM = false, AFTER_DRAIN = false;
    const float* X; float* H;
    __device__ __forceinline__ void operator()(const f32x4 (&acc)[2][2][4][2], const Unit& u, int wr, int wc, int fr, int fq) const {
        EPI_ROWS({ const size_t off = row * 1024 + u.pn * 256 + bj * 128 + wc * 32 + 4 * fq;
            *(f32x4*)(H + off) = *(const f32x4*)(X + off) + v0; *(f32x4*)(H + off + 16) = *(const f32x4*)(X + off + 16) + v1; })
    }
};
struct EpiLg { static constexpr bool PERM = true, AFTER_DRAIN = false;
    float* LG;
    __device__ __forceinline__ void operator()(const f32x4 (&acc)[2][2][4][2], const Unit& u, int wr, int wc, int fr, int fq) const {
        EPI_ROWS({ if (bj == 0) { float* p = LG + row * 128 + wc * 32 + 8 * fq; *(f32x4*)p = v0; *(f32x4*)(p + 4) = v1; } })
    }
};
struct EpiGU { static constexpr bool PERM = true, AFTER_DRAIN = false;
    bf16* ACT;
    __device__ __forceinline__ void operator()(const f32x4 (&acc)[2][2][4][2], const Unit& u, int wr, int wc, int fr, int fq) const {
        const int c0 = (u.pn & 1) * 128 + wc * 32 + 8 * fq; int rb_ = u.pm * 256 + wr * 64 + fr; asm volatile("" : "+v"(rb_));
#pragma unroll
        for (int ai = 0; ai < 2; ++ai)
#pragma unroll
            for (int m = 0; m < 4; ++m) { const size_t row = (size_t)(rb_ + ai * 128 + m * 16); f32x4 a0, a1;
#pragma unroll
                for (int e = 0; e < 4; ++e) { const float g0 = acc[ai][0][m][0][e], g1 = acc[ai][0][m][1][e]; a0[e] = g0 * sigmoidf_(g0) * acc[ai][1][m][0][e]; a1[e] = g1 * sigmoidf_(g1) * acc[ai][1][m][1][e]; }
                *(v4u*)(ACT + row * 256 + c0) = pack8(a0, a1); }
    }
};
struct EpiDown { static constexpr bool PERM = true, AFTER_DRAIN = false;
    bf16* YB; const float* WROW;
    __device__ __forceinline__ void operator()(const f32x4 (&acc)[2][2][4][2], const Unit& u, int wr, int wc, int fr, int fq) const {
        const int c0 = (u.pn & 3) * 256;
        EPI_ROWS({ const float w = WROW[row]; *(v4u*)(YB + row * 1024 + c0 + bj * 128 + wc * 32 + 8 * fq) = pack8(v0 * w, v1 * w); })
    }
};
struct ExpertOrder {
    const LAS unsigned* tpre; int NJ, G, c;
    __device__ __forceinline__ bool next(int i, Unit& u) const {
        const int total = (int)tpre[NEXP] * NJ; const long L = (long)i * G + c; if (L >= total) return false;
        const int T = (int)L / NJ, j = (int)L % NJ; int e = 0;
#pragma unroll 1
        for (int k = 1; k < NEXP; ++k) e += ((int)tpre[k] <= T) ? 1 : 0;
        u.pm = T; u.pn = e * NJ + j; return true;
    }
    __device__ __forceinline__ void a_ready(const Unit&) const {}
    __device__ __forceinline__ void done(const Unit&) const {}
};

__device__ __forceinline__ void tr_item(const float* colp, int N, int k0, bf16* dst  , int K, bool lo, LAS float* scr, int lane) {
#pragma unroll 8
    for (int i = 0; i < 32; ++i) { const int kk = 2 * i + (lane >> 5); float v = colp ? colp[(size_t)(k0 + kk) * N] : 0.f;
        if (lo) v = v - bf2f((unsigned short)f2bf(v));
        scr[kk * 33 + (lane & 31)] = v; }
    LDS_WAIT(); asm volatile("" ::: "memory");
    const int c = lane & 7;
#pragma unroll
    for (int j = 0; j < 4; ++j) { const int n = (lane >> 3) + 8 * j; const LAS float* s = scr + (8 * c) * 33 + n;
        v4u o; o.x = pk2(s[0 * 33], s[1 * 33]); o.y = pk2(s[2 * 33], s[3 * 33]); o.z = pk2(s[4 * 33], s[5 * 33]); o.w = pk2(s[6 * 33], s[7 * 33]);
        *(GAS v4u*)(dst + (size_t)n * K + 8 * c) = o; }
    LDS_WAIT(); asm volatile("" ::: "memory");
}
__device__ __forceinline__ double inv_freq_d(int i) {
    const int q = i >> 2, r = i & 3;
    const double a = q == 0 ? 1.0 : q == 1 ? 0.1 : q == 2 ? 0.01 : 0.001;
    const double b = r == 0 ? 1.0 : r == 1 ? 0.5623413251903491 : r == 2 ? 0.31622776601683794 : 0.1778279410038923;
    return a * b;
}

struct Args { const float* in[22]; float* out; unsigned char* ws; int ph_lo, ph_hi; };

__global__ void __launch_bounds__(NWAVES * 64, 2) mk_fwd(Args args) {
    extern __shared__ __attribute__((aligned(16))) unsigned char lds[];
    LAS unsigned char* const L = (LAS unsigned char*)lds;
    volatile LAS unsigned* const MISC = (volatile LAS unsigned*)(L + MISC_OFF);
    const int tid = threadIdx.x, lane = tid & 63, wave = __builtin_amdgcn_readfirstlane(tid >> 6);
    const int G = gridDim.x; const int bx = blockIdx.x; const int vcu = (G % 8 == 0) ? (bx % 8) * (G / 8) + bx / 8 : bx;
    const int gw = vcu * NWAVES + wave, NGW = G * NWAVES;
    unsigned char* const ws = args.ws;
    gu32* const ctl = (gu32*)(ws + WS_CTL);
    const float* x = args.in[0]; const int* positions = (const int*)args.in[1]; const float* g_mix = args.in[2]; const float* w_in = args.in[3]; const float* b_forget = args.in[4];
    const float* g_cq = args.in[5]; const float* g_ckv = args.in[6]; const float* w_uq = args.in[7]; const float* w_uk = args.in[8]; const float* w_uv = args.in[9];
    const float* w_o_mla = args.in[10]; const float* w_o_fox = args.in[11]; const float* w_out = args.in[12]; const float* g_ffn = args.in[13]; const float* w_group = args.in[14];
    const float* b_group = args.in[15]; const float* w_router = args.in[16]; const float* b_router = args.in[17]; const float* w_e_gate = args.in[18]; const float* w_e_up = args.in[19];
    const float* w_e_down = args.in[20]; const float* g_final = args.in[21];
    float* const out = args.out;
#define WIN ((bf16*)(ws + WS_WIN))
#define WUQ ((bf16*)(ws + WS_WUQ))
#define WUKV ((bf16*)(ws + WS_WUKV))
#define WOA ((bf16*)(ws + WS_WOA))
#define WOB ((bf16*)(ws + WS_WOB))
#define WOUT ((bf16*)(ws + WS_WOUT))
#define WR ((bf16*)(ws + WS_WR))
#define WGU ((bf16*)(ws + WS_WGU))
#define WDN ((bf16*)(ws + WS_WDN))
#define CS ((float*)(ws + WS_CS))
#define LOGF ((float*)(ws + WS_LOGF))
#define EID ((int*)(ws + WS_EID))
#define SLOT ((int*)(ws + WS_SLOT))
#define WGT ((float*)(ws + WS_WGT))
#define POS ((int*)(ws + WS_POS))
#define WROW ((float*)(ws + WS_WROW))
#define XN ((bf16*)(ws + WS_XN))
#define CQN ((bf16*)(ws + WS_CQN))
#define CKVN ((bf16*)(ws + WS_CKVN))
#define VM ((bf16*)(ws + WS_VM))
#define KR ((bf16*)(ws + WS_KR))
#define Z0 ((bf16*)(ws + WS_Z0))
#define Z1 ((float*)(ws + WS_Z1))
#define QF ((bf16*)(ws + WS_QF))
#define KF ((bf16*)(ws + WS_KF))
#define VF ((bf16*)(ws + WS_VF))
#define OA ((bf16*)(ws + WS_OA))
#define OB ((bf16*)(ws + WS_OB))
#define MIX ((bf16*)(ws + WS_MIX))
#define QM ((bf16*)(ws + WS_QM))
#define KM ((bf16*)(ws + WS_KM))
#define HN ((bf16*)(ws + WS_HN))
#define LG ((float*)(ws + WS_LG))
#define XG ((bf16*)(ws + WS_XG))
#define ACT ((bf16*)(ws + WS_ACT))
#define YB ((bf16*)(ws + WS_YB))
#define GA ((bf16*)out)
#define GB ((bf16*)out + (size_t)M * 1024)
#define H out

    for (int u = tid; u < (LDS_BYTES - LDSCTL_OFF) / 4; u += NWAVES * 64) ((LAS unsigned*)(L + LDSCTL_OFF))[u] = 0u;
    __syncthreads();
    XcdBarrier bar; bar.bar = (unsigned*)(ctl + CW_BAR); bar.x = 0; bar.st = nullptr;
    if (!MK_PER_PHASE) bar = xcd_barrier_post((unsigned*)(ctl + CW_BAR), MISC + 8);
    const int lo = args.ph_lo, hi = args.ph_hi;
#ifndef MK_ONLY
#define MK_ONLY -1
#endif
#define IN(k) ((MK_ONLY < 0 || MK_ONLY == (k)) && lo <= (k) && (k) < hi)
#define SEAM(k) do { if (IN(k) && IN((k) + 1)) { if ((k) == 0) { cooperative_groups::this_grid().sync(); } else { xcd_barrier(bar); } } } while (0)

    if (IN(0)) {
        LAS float* scr = (LAS float*)(L + RING_OFF + wave * 16384);
        constexpr int I0 = 128 * 16, I1 = 24 * 4, I2 = 32 * 2, I3 = 32 * 8, I4 = 32 * 8, I5 = 32 * 16, I6 = 8 * 16, I7 = NEXP * 16 * 16, I8 = NEXP * 32 * 4;
        constexpr int NITEMS = I0 + I1 + I2 + I3 + I4 + I5 + I6 + I7 + I8;
        const int l31 = lane & 31;
        for (int it = gw; it < NITEMS; it += NGW) {
            int r = it;
            if (r < I0) { const int nb = r % 128, kb = r / 128, n = nb * 32 + l31;
                int sc; if (n < 416) sc = n; else if (n < 424) sc = 1952 + (n - 416); else if (n < 512) sc = -1; else if (n < 2048) sc = n - 96; else sc = n - 88;
                tr_item(sc >= 0 ? w_in + sc : nullptr, 4008, kb * 64, WIN + (size_t)(nb * 32) * 1024 + kb * 64, 1024, false, scr, lane); continue; } r -= I0;
            if (r < I1) { const int nb = r % 24, kb = r / 24; tr_item(w_uq + nb * 32 + l31, 768, kb * 64, WUQ + (size_t)(nb * 32) * 256 + kb * 64, 256, false, scr, lane); continue; } r -= I1;
            if (r < I2) { const int nb = r % 32, kb = r / 32, n = nb * 32 + l31; tr_item(n < 512 ? w_uk + n : w_uv + (n - 512), 512, kb * 64, WUKV + (size_t)(nb * 32) * 128 + kb * 64, 128, false, scr, lane); continue; } r -= I2;
            if (r < I3) { const int nb = r % 32, kb = r / 32; tr_item(w_o_mla + nb * 32 + l31, 1024, kb * 64, WOA + (size_t)(nb * 32) * 512 + kb * 64, 512, false, scr, lane); continue; } r -= I3;
            if (r < I4) { const int nb = r % 32, kb = r / 32; tr_item(w_o_fox + nb * 32 + l31, 1024, kb * 64, WOB + (size_t)(nb * 32) * 512 + kb * 64, 512, false, scr, lane); continue; } r -= I4;
            if (r < I5) { const int nb = r % 32, kb = r / 32; tr_item(w_out + nb * 32 + l31, 1024, kb * 64, WOUT + (size_t)(nb * 32) * 1024 + kb * 64, 1024, false, scr, lane); continue; } r -= I5;
            if (r < I6) { const int nb = r % 8, kb = r / 8, n = nb * 32 + l31; const int j = n & 63; const bool islo = (n >= 64 && n < 128); const bool valid = (n < 128) && (j < 36);
                const float* cp = nullptr; int NN = 32; if (valid) { if (j < 4) { cp = w_group + j; NN = 4; } else { cp = w_router + (j - 4); NN = 32; } }
                { LAS float* sc2 = scr;
#pragma unroll 8
                  for (int i = 0; i < 32; ++i) { const int kk = 2 * i + (lane >> 5); float v = cp ? cp[(size_t)(kb * 64 + kk) * NN] : 0.f; if (islo) v = v - bf2f((unsigned short)f2bf(v)); sc2[kk * 33 + l31] = v; }
                  LDS_WAIT(); asm volatile("" ::: "memory");
                  const int c = lane & 7; bf16* dst = WR + (size_t)(nb * 32) * 1024 + kb * 64;
#pragma unroll
                  for (int jj = 0; jj < 4; ++jj) { const int nn = (lane >> 3) + 8 * jj; const LAS float* s = sc2 + (8 * c) * 33 + nn;
                      v4u o; o.x = pk2(s[0 * 33], s[1 * 33]); o.y = pk2(s[2 * 33], s[3 * 33]); o.z = pk2(s[4 * 33], s[5 * 33]); o.w = pk2(s[6 * 33], s[7 * 33]);
                      *(GAS v4u*)(dst + (size_t)nn * 1024 + 8 * c) = o; }
                  LDS_WAIT(); asm volatile("" ::: "memory"); }
                continue; } r -= I6;
            if (r < I7) { const int e = r / 256, q = r % 256, nb = q % 16, kb = q / 16, rr = nb * 32 + l31;
                const int j = rr >> 8, isup = (rr >> 7) & 1, cc = rr & 127; const float* src = (isup ? w_e_up : w_e_gate) + (size_t)e * 1024 * 256 + 128 * j + cc;
                tr_item(src, 256, kb * 64, WGU + ((size_t)e * 512 + nb * 32) * 1024 + kb * 64, 1024, false, scr, lane); continue; } r -= I7;
            { const int e = r / 128, q = r % 128, nb = q % 32, kb = q / 32; tr_item(w_e_down + (size_t)e * 256 * 1024 + nb * 32 + l31, 1024, kb * 64, WDN + ((size_t)e * 1024 + nb * 32) * 256 + kb * 64, 256, false, scr, lane); }
        }
        for (int m = gw; m < M; m += NGW) {
            const GAS f32x4* xr = (const GAS f32x4*)(x + (size_t)m * DM) + lane; f32x4 v[4]; float s2 = 0.f;
#pragma unroll
            for (int j = 0; j < 4; ++j) { v[j] = xr[64 * j]; s2 += (v[j].x * v[j].x + v[j].y * v[j].y) + (v[j].z * v[j].z + v[j].w * v[j].w); }
            const float rstd = 1.f / sqrtf(wave_sum(s2) * (1.f / DM) + EPS);
            GAS unsigned long long* o8 = (GAS unsigned long long*)(XN + (size_t)m * DM) + lane;
#pragma unroll
            for (int j = 0; j < 4; ++j) { const f32x4 g = *((const f32x4*)g_mix + lane + 64 * j);
                o8[64 * j] = (unsigned long long)pk2(v[j].x * rstd * g.x, v[j].y * rstd * g.y) | ((unsigned long long)pk2(v[j].z * rstd * g.z, v[j].w * rstd * g.w) << 32); }
        }
        for (int i = (vcu * NWAVES * 64 + tid); i < M * 16; i += G * NWAVES * 64) {
            const int m = i >> 4, f = i & 15; const double ang = (double)positions[m] * inv_freq_d(f); const double rev = ang * 0.15915494309189535; const float fr = (float)(rev - floor(rev));
            CS[2 * i] = __builtin_amdgcn_cosf(fr); CS[2 * i + 1] = __builtin_amdgcn_sinf(fr); }
    }
    SEAM(0);
    if (IN(1)) {
        pg8::Gemm g{XN, WIN, M, NIN, DM}; pg8::StaticOrder S; S.init(M, NIN, G, bx);
        EpiIn E{Z0, Z1, QF, KF, VF, GA, GB};
        pg8::gemm_phase<EpiIn, pg8::StaticOrder, true, true>(L + RING_OFF, g, S, E);
    }
    SEAM(1);
    if (IN(2)) {
        for (int m = gw; m < M; m += NGW) {
            { const v2u raw = *(const v2u*)(Z0 + (size_t)m * 256 + lane * 4); const float a0 = bflo(raw.x), a1 = bfhi(raw.x), a2 = bflo(raw.y), a3 = bfhi(raw.y);
              const float rstd = 1.f / sqrtf(wave_sum((a0 * a0 + a1 * a1) + (a2 * a2 + a3 * a3)) * (1.f / 256) + EPS); const f32x4 g = *((const f32x4*)g_cq + lane);
              v2u o; o.x = pk2(a0 * rstd * g.x, a1 * rstd * g.y); o.y = pk2(a2 * rstd * g.z, a3 * rstd * g.w); *(v2u*)(CQN + (size_t)m * 256 + lane * 4) = o; }
            const float* z = Z1 + (size_t)m * 256;
            { const float a0 = z[2 * lane], a1 = z[2 * lane + 1]; const float rstd = 1.f / sqrtf(wave_sum(a0 * a0 + a1 * a1) * (1.f / 128) + EPS);
              *(unsigned*)(CKVN + (size_t)m * 128 + 2 * lane) = pk2(a0 * rstd * g_ckv[2 * lane], a1 * rstd * g_ckv[2 * lane + 1]); }
            if (lane < 16) { const float x1 = z[128 + lane], x2 = z[144 + lane], c = CS[(size_t)m * 32 + 2 * lane], s = CS[(size_t)m * 32 + 2 * lane + 1];
              KR[(size_t)m * 32 + lane] = (bf16)f2bf(x1 * c - x2 * s); KR[(size_t)m * 32 + 16 + lane] = (bf16)f2bf(x2 * c + x1 * s); }
            else if (lane < 24) { const int j = lane - 16; const float xx = z[160 + j] + b_forget[j]; const float t = __expf(-fabsf(xx)); LOGF[(size_t)m * 8 + j] = fminf(xx, 0.f) - __logf(1.f + t); }
            else if (lane >= 32 && lane < 48) { const int hh = (lane - 32) >> 1, half = lane & 1; v4u o = {0u, 0u, 0u, 0u}; if (half == 0) { o.x = 0x3F803F80u; o.y = 0x00003F80u; }
              *(v4u*)(QF + (size_t)m * 640 + hh * 80 + 64 + half * 8) = o; }
            else if (lane >= 48) { const int hh = (lane - 48) >> 1, half = lane & 1; *(v4u*)(KF + (size_t)m * 640 + hh * 80 + 64 + half * 8) = (v4u){0u, 0u, 0u, 0u}; }
        }
    }
    SEAM(2);
    if (IN(3)) {
#ifndef NO_SCAN
        if (gw < 64) { const int b = gw >> 3, hh = gw & 7; const float* lf = LOGF + ((size_t)b * SEQ + 64 * lane) * 8 + hh; double s = 0.0;
#pragma unroll 8
            for (int i = 0; i < 64; ++i) s += (double)lf[i * 8];
            double incl = s;
#pragma unroll
            for (int o = 1; o < 64; o <<= 1) { const double t = __shfl_up(incl, o); if (lane >= o) incl += t; }
            double run = incl - s; bf16* kf = KF + ((size_t)b * SEQ + 64 * lane) * 640 + hh * 80 + 64;
#pragma unroll 4
            for (int i = 0; i < 64; ++i) { run += (double)lf[i * 8]; const float gneg = (float)(-run * 1.4426950408889634);
                const unsigned b0 = f2bf(gneg); const float r1 = gneg - bf2f((unsigned short)b0); const unsigned b1 = f2bf(r1); const float r2 = r1 - bf2f((unsigned short)b1); const unsigned b2 = f2bf(r2);
                *(unsigned*)(kf + (size_t)i * 640) = b0 | (b1 << 16); *(unsigned*)(kf + (size_t)i * 640 + 2) = b2; }
        }
#endif
#ifndef NO_QUP
        { pg8::Gemm g{CQN, WUQ, M, 768, 256}; pg8::StaticOrder S; S.init(M, 768, G, bx); EpiQup E{QM};
          pg8::gemm_phase<EpiQup, pg8::StaticOrder, true, true>(L + RING_OFF, g, S, E); }
#endif
#ifndef NO_KVUP
        { pg8::Gemm g{CKVN, WUKV, M, 1024, 128}; pg8::StaticOrder S; S.init(M, 1024, G, bx); EpiKVup E{KM, VM};
          pg8::gemm_phase<EpiKVup, pg8::StaticOrder, true, true>(L + RING_OFF, g, S, E); }
#endif
    }
    SEAM(3);
    if (IN(4)) {
        const att::AttnT TA{QM, KM, KR, VM, OA, CS}; const att::AttnT TB{QF, KF, KF, VF, OB, CS};
        for (int v = vcu; v < 256; v += G) { const int bh = v >> 2, sub = v & 3, b = bh >> 3, hh = bh & 7;
#pragma unroll 1
            for (int i = 0; i < 4; ++i) { const int qb = (i == 0) ? 15 - sub : (i == 1) ? 8 + sub : (i == 2) ? 7 - sub : sub;
                att::attn_unit<0>(b, hh, qb, TA, (char*)lds + RING_OFF);
                att::attn_unit<1>(b, hh, qb, TB, (char*)lds + RING_OFF); } }
    }
    SEAM(4);
    if (IN(5)) {
        { pg8::Gemm g{OA, WOA, M, 1024, 512}; pg8::StaticOrder S; S.init(M, 1024, G, bx); EpiGate<0> E{GA, MIX}; pg8::gemm_phase<EpiGate<0>, pg8::StaticOrder, true, true>(L + RING_OFF, g, S, E); }
        { pg8::Gemm g{OB, WOB, M, 1024, 512}; pg8::StaticOrder S; S.init(M, 1024, G, bx); EpiGate<1> E{GB, MIX}; pg8::gemm_phase<EpiGate<1>, pg8::StaticOrder, true, true>(L + RING_OFF, g, S, E); }
    }
    SEAM(5);
    if (IN(6)) {
        pg8::Gemm g{MIX, WOUT, M, 1024, 1024}; pg8::StaticOrder S; S.init(M, 1024, G, bx); EpiRes E{x, H}; pg8::gemm_phase<EpiRes, pg8::StaticOrder, true, true>(L + RING_OFF, g, S, E);
    }
    SEAM(6);
    if (IN(7)) {
        for (int m = gw; m < M; m += NGW) {
            const GAS f32x4* hr = (const GAS f32x4*)(H + (size_t)m * DM) + lane; f32x4 v[4]; float s2 = 0.f;
#pragma unroll
            for (int j = 0; j < 4; ++j) { v[j] = hr[64 * j]; s2 += (v[j].x * v[j].x + v[j].y * v[j].y) + (v[j].z * v[j].z + v[j].w * v[j].w); }
            const float rstd = 1.f / sqrtf(wave_sum(s2) * (1.f / DM) + EPS);
            GAS unsigned long long* oh = (GAS unsigned long long*)(HN + (size_t)m * DM) + lane; GAS unsigned long long* ol = (GAS unsigned long long*)(HN + (size_t)(M + m) * DM) + lane;
#pragma unroll
            for (int j = 0; j < 4; ++j) { const f32x4 g = *((const f32x4*)g_ffn + lane + 64 * j); const f32x4 y = {v[j].x * rstd * g.x, v[j].y * rstd * g.y, v[j].z * rstd * g.z, v[j].w * rstd * g.w};
                const unsigned h0 = f2bf(y.x), h1 = f2bf(y.y), h2 = f2bf(y.z), h3 = f2bf(y.w);
                oh[64 * j] = (unsigned long long)(h0 | (h1 << 16)) | ((unsigned long long)(h2 | (h3 << 16)) << 32);
                ol[64 * j] = (unsigned long long)pk2(y.x - bf2f((unsigned short)h0), y.y - bf2f((unsigned short)h1)) | ((unsigned long long)pk2(y.z - bf2f((unsigned short)h2), y.w - bf2f((unsigned short)h3)) << 32); }
        }
    }
    SEAM(7);
    if (IN(8)) {
        pg8::Gemm g{HN, WR, 2 * M, 256, 1024}; pg8::StaticOrder S; S.init(2 * M, 256, G, bx); EpiLg E{LG}; pg8::gemm_phase<EpiLg, pg8::StaticOrder, true, true>(L + RING_OFF, g, S, E);
    }
    SEAM(8);
    if (IN(9)) {
        for (int t = vcu * NWAVES * 64 + tid; t < M; t += G * NWAVES * 64) {
            float lg[36];
            const float* a = LG + (size_t)t * 128; const float* b2 = LG + (size_t)(M + t) * 128;
#pragma unroll
            for (int q = 0; q < 9; ++q) { const f32x4 p0 = *(const f32x4*)(a + 4 * q), p1 = *(const f32x4*)(a + 64 + 4 * q), p2 = *(const f32x4*)(b2 + 4 * q), p3 = *(const f32x4*)(b2 + 64 + 4 * q);
#pragma unroll
                for (int e = 0; e < 4; ++e) lg[4 * q + e] = (p0[e] + p1[e]) + (p2[e] + p3[e]); }
#pragma unroll
            for (int j = 0; j < 4; ++j) lg[j] += b_group[j];
#pragma unroll
            for (int j = 0; j < 32; ++j) lg[4 + j] += b_router[j];
            int gi = 0; float gm = lg[0];
#pragma unroll
            for (int j = 1; j < 4; ++j) if (lg[j] > gm) { gm = lg[j]; gi = j; }
            float gs = 0.f;
#pragma unroll
            for (int j = 0; j < 4; ++j) gs += __expf(lg[j] - gm);
            const float gp = 1.f / gs;
            float sel[8];
#pragma unroll
            for (int e = 0; e < 8; ++e) sel[e] = gi == 0 ? lg[4 + e] : gi == 1 ? lg[12 + e] : gi == 2 ? lg[20 + e] : lg[28 + e];
            int e0 = 0; float m0 = sel[0];
#pragma unroll
            for (int e = 1; e < 8; ++e) if (sel[e] > m0) { m0 = sel[e]; e0 = e; }
            int e1 = -1; float m1 = -INFINITY;
#pragma unroll
            for (int e = 0; e < 8; ++e) if (e != e0 && sel[e] > m1) { m1 = sel[e]; e1 = e; }
            const float r = __expf(m1 - m0); const float p0 = 1.f / (1.f + r), p1 = r / (1.f + r);
            const int x0 = gi * 8 + e0, x1 = gi * 8 + e1;
            const unsigned s0 = __hip_atomic_fetch_add(ctl + CW_CNT + x0, 1u, RLX_AGENT), s1 = __hip_atomic_fetch_add(ctl + CW_CNT + x1, 1u, RLX_AGENT);
            EID[2 * t] = x0; EID[2 * t + 1] = x1; SLOT[2 * t] = (int)s0; SLOT[2 * t + 1] = (int)s1; WGT[2 * t] = gp * p0; WGT[2 * t + 1] = gp * p1;
        }
    }
    SEAM(9);
    if (IN(10)) {
        LAS unsigned* tp = (LAS unsigned*)(L + TP_OFF);
        if (tid == 0) { unsigned acc = 0; for (int e = 0; e < NEXP; ++e) { tp[e] = acc; acc += (__hip_atomic_load(ctl + CW_CNT + e, RLX_AGENT) + 255u) >> 8; } tp[NEXP] = acc;
            if (bx == 0) for (int e = 0; e <= NEXP; ++e) __hip_atomic_store(ctl + CW_TPRE + e, tp[e], RLX_AGENT); }
        __syncthreads();
        for (int m = gw; m < M; m += NGW) {
            const int x0 = EID[2 * m], x1 = EID[2 * m + 1]; const int p0 = (int)tp[x0] * 256 + SLOT[2 * m], p1 = (int)tp[x1] * 256 + SLOT[2 * m + 1];
            if (lane == 0) { POS[2 * m] = p0; POS[2 * m + 1] = p1; WROW[p0] = WGT[2 * m]; WROW[p1] = WGT[2 * m + 1]; }
            const v4u a = *((const v4u*)(HN + (size_t)m * DM) + lane), b2 = *((const v4u*)(HN + (size_t)m * DM) + 64 + lane);
            *((v4u*)(XG + (size_t)p0 * DM) + lane) = a; *((v4u*)(XG + (size_t)p0 * DM) + 64 + lane) = b2;
            *((v4u*)(XG + (size_t)p1 * DM) + lane) = a; *((v4u*)(XG + (size_t)p1 * DM) + 64 + lane) = b2;
        }
        __syncthreads();
    }
    SEAM(10);
    if (IN(11)) {
        LAS unsigned* tp = (LAS unsigned*)(L + TP_OFF); if (tid <= NEXP) tp[tid] = __hip_atomic_load(ctl + CW_TPRE + tid, RLX_AGENT); __syncthreads();
        pg8::Gemm g{XG, WGU, XG_ROWS, NEXP * 512, 1024}; ExpertOrder S{tp, 2, G, bx}; EpiGU E{ACT};
        pg8::gemm_phase<EpiGU, ExpertOrder, true, true>(L + RING_OFF, g, S, E);
    }
    SEAM(11);
    if (IN(12)) {
        LAS unsigned* tp = (LAS unsigned*)(L + TP_OFF); if (tid <= NEXP) tp[tid] = __hip_atomic_load(ctl + CW_TPRE + tid, RLX_AGENT); __syncthreads();
        pg8::Gemm g{ACT, WDN, XG_ROWS, NEXP * 1024, 256}; ExpertOrder S{tp, 4, G, bx}; EpiDown E{YB, WROW};
        pg8::gemm_phase<EpiDown, ExpertOrder, true, true>(L + RING_OFF, g, S, E);
    }
    SEAM(12);
    if (IN(13)) {
        for (int m = gw; m < M; m += NGW) {
            const int p0 = POS[2 * m], p1 = POS[2 * m + 1];
            GAS f32x4* hr = (GAS f32x4*)(H + (size_t)m * DM) + lane; const v2u* y0 = (const v2u*)(YB + (size_t)p0 * DM) + lane; const v2u* y1 = (const v2u*)(YB + (size_t)p1 * DM) + lane;
            f32x4 v[4]; float s2 = 0.f;
#pragma unroll
            for (int j = 0; j < 4; ++j) { const v2u a = y0[64 * j], b2 = y1[64 * j]; v[j] = hr[64 * j];
                v[j].x += bflo(a.x) + bflo(b2.x); v[j].y += bfhi(a.x) + bfhi(b2.x); v[j].z += bflo(a.y) + bflo(b2.y); v[j].w += bfhi(a.y) + bfhi(b2.y);
                s2 += (v[j].x * v[j].x + v[j].y * v[j].y) + (v[j].z * v[j].z + v[j].w * v[j].w); }
            const float rstd = 1.f / sqrtf(wave_sum(s2) * (1.f / DM) + EPS);
#pragma unroll
            for (int j = 0; j < 4; ++j) { const f32x4 g = *((const f32x4*)g_final + lane + 64 * j); hr[64 * j] = (f32x4){v[j].x * rstd * g.x, v[j].y * rstd * g.y, v[j].z * rstd * g.z, v[j].w * rstd * g.w}; }
        }
    }
#undef IN
#undef SEAM
}

extern "C" void kernel_launch(void* const* d_in, const int* in_sizes, int n_in, void* d_out, int out_size, void* d_ws, size_t ws_size, hipStream_t stream) {
    static int grid = 0;
    if (grid == 0) {
        if (n_in != 22 || in_sizes[0] != M * DM || out_size != M * DM || ws_size < WS_END) { fprintf(stderr, "kernel_launch: unexpected shapes (n_in %d, in0 %d, out %d, ws %zu); nothing launched\n", n_in, n_in > 0 ? in_sizes[0] : -1, out_size, ws_size); grid = -1; return; }
        int dev = 0, cus = 0, per_cu = 0;
        if (hipGetDevice(&dev) != hipSuccess || hipDeviceGetAttribute(&cus, hipDeviceAttributeMultiprocessorCount, dev) != hipSuccess) { grid = -1; return; }
        if (hipFuncSetAttribute((const void*)mk_fwd, hipFuncAttributeMaxDynamicSharedMemorySize, LDS_BYTES) != hipSuccess) { fprintf(stderr, "kernel_launch: hipFuncSetAttribute failed\n"); grid = -1; return; }
        if (hipOccupancyMaxActiveBlocksPerMultiprocessor(&per_cu, (const void*)mk_fwd, NWAVES * 64, LDS_BYTES) != hipSuccess || per_cu < 1) { fprintf(stderr, "kernel_launch: occupancy query says %d blocks/CU\n", per_cu); per_cu = 1; }
        (void)hipGetLastError();
        grid = cus;
    }
    if (grid < 0) return;
    if (hipMemsetAsync((char*)d_ws + WS_CTL, 0, CTL_ZERO_BYTES, stream) != hipSuccess) { fprintf(stderr, "kernel_launch: memset failed\n"); return; }
    Args a{};
    for (int i = 0; i < 22; ++i) a.in[i] = (const float*)d_in[i];
    a.out = (float*)d_out; a.ws = (unsigned char*)d_ws;
#if MK_PER_PHASE
    for (int p = 0; p < N_PHASES; ++p) { a.ph_lo = p; a.ph_hi = p + 1; hipLaunchKernelGGL(mk_fwd, dim3(grid), dim3(NWAVES * 64), LDS_BYTES, stream, a); }
#else
    a.ph_lo = 0; a.ph_hi = N_PHASES;
    void* kargs[] = {&a};
    hipError_t e = hipLaunchCooperativeKernel((const void*)mk_fwd, dim3(grid), dim3(NWAVES * 64), kargs, LDS_BYTES, stream);
    if (e != hipSuccess) fprintf(stderr, "kernel_launch: cooperative launch failed: %s (grid %d)\n", hipGetErrorString(e), grid);
#endif
}
```

```cpp
#include <hip/hip_runtime.h>
#include <hip/hip_bf16.h>
#include <hip/hip_cooperative_groups.h>
#include <cstdio>
#include <cstdint>
#include <cmath>
namespace pg8 {
#define PG8_LAS __attribute__((address_space(3)))
typedef unsigned short bf16_t;
typedef short bf16x8 __attribute__((ext_vector_type(8)));
typedef float f32x4 __attribute__((ext_vector_type(4)));
typedef unsigned u32x4 __attribute__((ext_vector_type(4)));
constexpr int BM = 256, BK = 64, HALF = 128, HTB = HALF * BK * 2  , STAGE_BYTES = 8 * HTB, NXCD = 8, WGM = 8;

__host__ __device__ __forceinline__ int lds_byte(int r, int c) { const int st = (r >> 4) * 2 + (c >> 5), rr = r & 15, cc = c & 31, ob = rr * 64 + cc * 2; return st * 1024 + (ob ^ (((ob >> 9) & 1) << 5)); }
__host__ __device__ __forceinline__ void stage_rc(int b, int& R, int& C) { const int st = b / 1024, sb = b % 1024, swz = sb ^ (((sb >> 9) & 1) << 5); R = (st >> 1) * 16 + swz / 64; C = (st & 1) * 32 + (swz % 64) / 2; }
__host__ __device__ __forceinline__ int perm32(int rho) { const int n = rho >> 4, i = rho & 15; return 8 * (i >> 2) + 4 * n + (i & 3); }

struct Unit { int pm, pn; };
struct Gemm { const bf16_t* A; const bf16_t* Bt; int M, N, K; };

struct StaticOrder {
    int nM, nN, nwg, G, c;
    __host__ __device__ void init(int M, int N, int G_, int c_) { nM = M / BM; nN = N / BM; nwg = nM * nN; G = G_; c = c_; }
    __host__ __device__ bool next(int i, Unit& u) const {
        const long L = (long)i * G + c; if (L >= nwg) return false;
        int wgid = (int)L; { const int q = nwg / NXCD, r = nwg % NXCD, xcd = wgid % NXCD, off = wgid / NXCD; wgid = (xcd < r ? xcd * (q + 1) : r * (q + 1) + (xcd - r) * q) + off; }
        const int nig = WGM * nN, gid = wgid / nig, fm = gid * WGM, gsz = (nM - fm) < WGM ? (nM - fm) : WGM;
        u.pm = fm + ((wgid % nig) % gsz); u.pn = (wgid % nig) / gsz; return true;
    }
    __device__ __forceinline__ void a_ready(const Unit&) const {}
    __device__ __forceinline__ void done(const Unit&) const {}
};

__device__ __forceinline__ unsigned cvt_pk_bf16(float lo, float hi) { unsigned r; asm volatile("v_cvt_pk_bf16_f32 %0, %1, %2" : "=v"(r) : "v"(lo), "v"(hi)); return r; }
typedef float f32x2 __attribute__((ext_vector_type(2)));
template <class Epi, class Sched, bool ALIGN_EPI = false, bool SP2 = false>
__device__ __forceinline__ void gemm_phase(PG8_LAS unsigned char* lds, const Gemm g, const Sched& S, const Epi& E) {
    const int tid = threadIdx.x, wid = __builtin_amdgcn_readfirstlane(tid >> 6), lane = tid & 63, wr = wid >> 2, wc = wid & 3, fr = lane & 15, fq = lane >> 4;
    const int K = g.K; int nt = K / BK; asm volatile("" : "+s"(nt));
    unsigned voffA[2], voffB[2];
#pragma unroll
    for (int i = 0; i < 2; ++i) { int R, C; stage_rc(tid * 16 + i * 8192, R, C); const int Rb = Epi::PERM ? ((R & ~31) + perm32(R & 31)) : R;
        voffA[i] = (unsigned)(R * K + C) * 2u; voffB[i] = (unsigned)(Rb * K + C) * 2u; }
    const size_t kstep = (size_t)(BK * 2);
    const size_t hstep = (size_t)HALF * K * 2;
    const size_t tstep = 2 * hstep;
    const unsigned ldsw = (unsigned)wid * 1024u;
    const int aoff = lds_byte(wr * 64 + fr, fq * 8), boff = lds_byte(wc * 32 + fr, fq * 8);
#define PG8_SA(b, h) (((b) * 2 + (h)) * HTB)
#define PG8_SB(b, h) ((4 + (b) * 2 + (h)) * HTB)
#define PG8_STAGE(bufoff, gbase, voff) do { _Pragma("unroll") for (int _i = 0; _i < 2; ++_i) \
        __builtin_amdgcn_global_load_lds((const unsigned*)((const char*)(gbase) + (voff)[_i]), (PG8_LAS unsigned*)(lds + (bufoff) + ldsw + _i * 8192), 16, 0, 0); } while (0)
#define PG8_LDA(dst, b, h) do { _Pragma("unroll") for (int m = 0; m < 4; ++m) _Pragma("unroll") for (int k = 0; k < 2; ++k) dst[m][k] = *(const PG8_LAS bf16x8*)(lds + PG8_SA(b, h) + aoff + m * 2048 + k * 1024); } while (0)
#define PG8_LDB(dst, b, h) do { _Pragma("unroll") for (int n = 0; n < 2; ++n) _Pragma("unroll") for (int k = 0; k < 2; ++k) dst[n][k] = *(const PG8_LAS bf16x8*)(lds + PG8_SB(b, h) + boff + n * 2048 + k * 1024); } while (0)
#define PG8_MMA(ai, bj, At, Bt) do { __builtin_amdgcn_s_setprio(1); _Pragma("unroll") for (int m = 0; m < 4; ++m) _Pragma("unroll") for (int n = 0; n < 2; ++n) _Pragma("unroll") for (int k = 0; k < 2; ++k) \
        acc[ai][bj][m][n] = __builtin_amdgcn_mfma_f32_16x16x32_bf16(Bt[n][k], At[m][k], acc[ai][bj][m][n], 0, 0, 0); __builtin_amdgcn_s_setprio(0); } while (0)
#define PG8_WAIT_V(n) asm volatile("s_waitcnt vmcnt(" #n ")" ::: "memory")
#define PG8_WAIT_L(n) asm volatile("s_waitcnt lgkmcnt(" #n ")" ::: "memory")
#define PG8_BAR __builtin_amdgcn_s_barrier()
#define PG8_SCHED __builtin_amdgcn_sched_barrier(0)
    Unit cur, nxt; int ui = 0;
    if (!S.next(0, cur)) return;
    f32x4 acc[2][2][4][2];
#pragma unroll
    for (int a = 0; a < 2; ++a)
#pragma unroll
        for (int b = 0; b < 2; ++b)
#pragma unroll
            for (int m = 0; m < 4; ++m)
#pragma unroll
                for (int n = 0; n < 2; ++n) acc[a][b][m][n] = (f32x4){0.f, 0.f, 0.f, 0.f};
    bf16x8 At[4][2], B0[2][2], B1[2][2];
    const char* cA = (const char*)g.A + (size_t)cur.pm * tstep; const char* cB = (const char*)g.Bt + (size_t)cur.pn * tstep;
    S.a_ready(cur);
    if constexpr (SP2) {
        PG8_STAGE(PG8_SB(0, 0), cB, voffB); PG8_STAGE(PG8_SB(0, 1), cB + hstep, voffB); PG8_STAGE(PG8_SA(0, 0), cA, voffA); PG8_STAGE(PG8_SA(0, 1), cA + hstep, voffA);
        if (wr == 1) PG8_BAR;
        PG8_WAIT_V(2); PG8_BAR;
        PG8_STAGE(PG8_SB(1, 0), cB + kstep, voffB); PG8_STAGE(PG8_SA(1, 0), cA + kstep, voffA); PG8_STAGE(PG8_SB(1, 1), cB + hstep + kstep, voffB);
        PG8_WAIT_V(6); PG8_BAR;
    } else {
        PG8_STAGE(PG8_SB(0, 0), cB, voffB); PG8_STAGE(PG8_SA(0, 0), cA, voffA); PG8_STAGE(PG8_SB(0, 1), cB + hstep, voffB); PG8_STAGE(PG8_SA(0, 1), cA + hstep, voffA);
        if (wr == 1) PG8_BAR;
        PG8_WAIT_V(4); PG8_BAR;
        PG8_STAGE(PG8_SB(1, 0), cB + kstep, voffB); PG8_STAGE(PG8_SA(1, 0), cA + kstep, voffA); PG8_STAGE(PG8_SB(1, 1), cB + hstep + kstep, voffB);
        PG8_WAIT_V(6); PG8_BAR;
    }
    for (;;) {
        const bool has_next = S.next(ui + 1, nxt);
        const char* nA = has_next ? (const char*)g.A + (size_t)nxt.pm * tstep : cA; const char* nB = has_next ? (const char*)g.Bt + (size_t)nxt.pn * tstep : cB;
        for (int t = 0; t < nt; t += 2) {
            if constexpr (Epi::MID) { if (t == (nt >> 1)) E.mid(acc, cur, wr, wc, fr, fq); }
            const bool last = (t == nt - 2);
            const char* a1 = cA + (size_t)(t + 1) * kstep;
            const char* a2 = last ? nA : cA + (size_t)(t + 2) * kstep; const char* b2 = last ? nB : cB + (size_t)(t + 2) * kstep;
            const char* a3 = a2 + kstep; const char* b3 = b2 + kstep;
            if (last && has_next) S.a_ready(nxt);
            if constexpr (SP2) {
            PG8_LDB(B0, 0, 0); PG8_LDB(B1, 0, 1); PG8_SCHED; PG8_LDA(At, 0, 0); PG8_STAGE(PG8_SA(1, 1), a1 + hstep, voffA);
            PG8_WAIT_V(8); PG8_WAIT_L(0); PG8_BAR; PG8_MMA(0, 0, At, B0); PG8_MMA(0, 1, At, B1); PG8_BAR; PG8_SCHED;
            PG8_LDA(At, 0, 1); PG8_STAGE(PG8_SB(0, 0), b2, voffB); PG8_STAGE(PG8_SB(0, 1), b2 + hstep, voffB); PG8_STAGE(PG8_SA(0, 0), a2, voffA);
            PG8_WAIT_V(8); PG8_WAIT_L(0); PG8_BAR; PG8_MMA(1, 0, At, B0); PG8_MMA(1, 1, At, B1); PG8_BAR; PG8_SCHED;
            PG8_LDB(B0, 1, 0); PG8_LDB(B1, 1, 1); PG8_SCHED; PG8_LDA(At, 1, 0); PG8_STAGE(PG8_SA(0, 1), a2 + hstep, voffA);
            PG8_WAIT_V(8); PG8_WAIT_L(0); PG8_BAR; PG8_MMA(0, 0, At, B0); PG8_MMA(0, 1, At, B1); PG8_BAR; PG8_SCHED;
            PG8_LDA(At, 1, 1); PG8_STAGE(PG8_SB(1, 0), b3, voffB); PG8_STAGE(PG8_SB(1, 1), b3 + hstep, voffB); PG8_STAGE(PG8_SA(1, 0), a3, voffA);
            PG8_WAIT_V(8); PG8_WAIT_L(0); PG8_BAR; PG8_MMA(1, 0, At, B0); PG8_MMA(1, 1, At, B1); PG8_BAR; PG8_SCHED;
            } else {
            PG8_LDB(B0, 0, 0); PG8_SCHED; PG8_LDA(At, 0, 0); PG8_STAGE(PG8_SA(1, 1), a1 + hstep, voffA);
            PG8_WAIT_L(8); PG8_BAR; PG8_WAIT_L(0); PG8_MMA(0, 0, At, B0); PG8_BAR; PG8_SCHED;
            PG8_LDB(B1, 0, 1); PG8_STAGE(PG8_SB(0, 0), b2, voffB);
            PG8_BAR; PG8_WAIT_L(0); PG8_MMA(0, 1, At, B1); PG8_BAR;
            PG8_LDA(At, 0, 1); PG8_STAGE(PG8_SA(0, 0), a2, voffA);
            PG8_BAR; PG8_WAIT_L(0); PG8_MMA(1, 0, At, B0); PG8_BAR; PG8_SCHED;
            PG8_STAGE(PG8_SB(0, 1), b2 + hstep, voffB);
            PG8_WAIT_V(6); PG8_BAR; PG8_MMA(1, 1, At, B1); PG8_BAR;
            PG8_LDB(B0, 1, 0); PG8_SCHED; PG8_LDA(At, 1, 0); PG8_STAGE(PG8_SA(0, 1), a2 + hstep, voffA);
            PG8_WAIT_L(8); PG8_BAR; PG8_WAIT_L(0); PG8_MMA(0, 0, At, B0); PG8_BAR; PG8_SCHED;
            PG8_LDB(B1, 1, 1); PG8_STAGE(PG8_SB(1, 0), b3, voffB);
            PG8_BAR; PG8_WAIT_L(0); PG8_MMA(0, 1, At, B1); PG8_BAR;
            PG8_LDA(At, 1, 1); PG8_STAGE(PG8_SA(1, 0), a3, voffA);
            PG8_BAR; PG8_WAIT_L(0); PG8_MMA(1, 0, At, B0); PG8_BAR; PG8_SCHED;
            PG8_STAGE(PG8_SB(1, 1), b3 + hstep, voffB);
            PG8_WAIT_V(6); PG8_BAR; PG8_MMA(1, 1, At, B1); PG8_BAR;
            }
        }
        if constexpr (ALIGN_EPI) { if (wr == 0) PG8_BAR; }
        if constexpr (!Epi::AFTER_DRAIN) { E(acc, cur, wr, wc, fr, fq); S.done(cur); }
        if (!has_next) break;
#pragma unroll
        for (int a = 0; a < 2; ++a)
#pragma unroll
            for (int b = 0; b < 2; ++b)
#pragma unroll
                for (int m = 0; m < 4; ++m)
#pragma unroll
                    for (int n = 0; n < 2; ++n) acc[a][b][m][n] = (f32x4){0.f, 0.f, 0.f, 0.f};
        cur = nxt; cA = nA; cB = nB; ++ui;
        if constexpr (ALIGN_EPI) { if (wr == 1) PG8_BAR; }
    }
    PG8_WAIT_V(0);
    if constexpr (!ALIGN_EPI) { if (wr == 0) PG8_BAR; }
    PG8_BAR;
    if constexpr (Epi::AFTER_DRAIN) { E.fused(acc, cur, wr, wc, fr, fq, lds, wid, lane); S.done(cur); }
#undef PG8_SA
#undef PG8_SB
#undef PG8_STAGE
#undef PG8_LDA
#undef PG8_LDB
#undef PG8_MMA
#undef PG8_WAIT_V
#undef PG8_WAIT_L
#undef PG8_BAR
#undef PG8_SCHED
}
}
namespace att {
typedef unsigned short bf16;
using bf16x8 = __attribute__((ext_vector_type(8))) short;
using s16x4 = __attribute__((ext_vector_type(4))) short;
using f32x16 = __attribute__((ext_vector_type(16))) float;
using u32x4 = __attribute__((ext_vector_type(4))) unsigned;
constexpr int SEQ = 4096, NW = 8, QB = 256, KVBLK = 64;
constexpr int KSLOT = 12288, VSLOT = 8192, NSLOT = 3;
constexpr int LDS_K = 0, LDS_V = NSLOT * KSLOT, LDS_WS = LDS_V + NSLOT * VSLOT, LDS_OST = LDS_WS + NW * 256, LDS_BYTES = LDS_OST + NW * 4096;
constexpr float THR = 8.0f;
#define ATT_LAS __attribute__((address_space(3)))
#define SBAR() __builtin_amdgcn_sched_barrier(0)
#define WAIT_BAR(N) asm volatile("s_waitcnt vmcnt(" #N ") lgkmcnt(0)\n\ts_barrier" ::: "memory")
__device__ __forceinline__ int crow(int r, int hi) { return (r & 3) + 8 * (r >> 2) + 4 * hi; }
__device__ __forceinline__ void glds16(const void* gsrc, unsigned lds_dst) { unsigned keep;
  asm volatile("s_mov_b32 %0, m0\n\ts_mov_b32 m0, %2\n\ts_nop 0\n\tglobal_load_lds_dwordx4 %1, off\n\ts_mov_b32 m0, %0" : "=&s"(keep) : "v"(gsrc), "s"(lds_dst) : "memory"); }
typedef float f32x2_t __attribute__((ext_vector_type(2))); typedef __bf16 bf16x2_t __attribute__((ext_vector_type(2)));
__device__ __forceinline__ unsigned cvtpk_s(float lo, float hi) { f32x2_t v = {lo, hi}; bf16x2_t b = __builtin_convertvector(v, bf16x2_t); return __builtin_bit_cast(unsigned, b); }
typedef ATT_LAS const char* lds_cptr;
#define MX3(a, b, c) __builtin_fmaxf(__builtin_fmaxf((a), (b)), (c))
__device__ __forceinline__ float rowmax(const f32x16& p0, const f32x16& p1) {
  float a = MX3(p0[0], p0[1], p1[0]), b = MX3(p0[2], p0[3], p1[1]); a = MX3(a, p1[2], p1[3]);
#pragma unroll
  for (int r = 4; r < 16; r += 4) { a = MX3(a, p0[r], p0[r + 1]); b = MX3(b, p0[r + 2], p0[r + 3]); a = MX3(a, p1[r], p1[r + 1]); b = MX3(b, p1[r + 2], p1[r + 3]); }
  float m = __builtin_fmaxf(a, b); auto rr = __builtin_amdgcn_permlane32_swap(__float_as_uint(m), __float_as_uint(m), false, false);
  return __builtin_fmaxf(__uint_as_float(rr[0]), __uint_as_float(rr[1])); }
__device__ __forceinline__ void cmask(f32x16& p0, f32x16& p1, int jb, int qrel, int hi) {
  const int kb = 64 * jb + 4 * hi;
#pragma unroll
  for (int r = 0; r < 16; ++r) { const int kv = kb + (r & 3) + 8 * (r >> 2); if (kv > qrel) p0[r] = -INFINITY; if (kv + 32 > qrel) p1[r] = -INFINITY; } }
template <int ND0> __device__ __forceinline__ void qkt(f32x16& p0, f32x16& p1, lds_cptr kp, const bf16x8* qr, const f32x16& negm) {
#pragma unroll
  for (int d0 = 0; d0 < ND0; ++d0) {
    const bf16x8 b0 = *(const ATT_LAS bf16x8*)(kp + d0 * 2048);
    const bf16x8 b1 = *(const ATT_LAS bf16x8*)(kp + d0 * 2048 + 512);
    if (d0 == 0) { p0 = __builtin_amdgcn_mfma_f32_32x32x16_bf16(b0, qr[0], negm, 0, 0, 0); p1 = __builtin_amdgcn_mfma_f32_32x32x16_bf16(b1, qr[0], negm, 0, 0, 0); }
    else { p0 = __builtin_amdgcn_mfma_f32_32x32x16_bf16(b0, qr[d0], p0, 0, 0, 0); p1 = __builtin_amdgcn_mfma_f32_32x32x16_bf16(b1, qr[d0], p1, 0, 0, 0); } }
}
__device__ __forceinline__ void pv(f32x16* o, int vb, bf16x8 pa0, bf16x8 pa1, bf16x8 pa2, bf16x8 pa3) {
#pragma unroll
  for (int d0 = 0; d0 < 2; ++d0) { s16x4 lo[4], hi[4];
#pragma unroll
    for (int ks = 0; ks < 4; ++ks) {
      asm volatile("ds_read_b64_tr_b16 %0,%1 offset:%c2" : "=&v"(lo[ks]) : "v"(vb), "i"(d0 * 4096 + ks * 1024) : "memory");
      asm volatile("ds_read_b64_tr_b16 %0,%1 offset:%c2" : "=&v"(hi[ks]) : "v"(vb), "i"(d0 * 4096 + ks * 1024 + 512) : "memory"); }
    asm volatile("s_waitcnt lgkmcnt(0)" ::: "memory"); SBAR();
#define PK(k) (bf16x8){lo[k][0], lo[k][1], lo[k][2], lo[k][3], hi[k][0], hi[k][1], hi[k][2], hi[k][3]}
    o[d0] = __builtin_amdgcn_mfma_f32_32x32x16_bf16(pa0, PK(0), o[d0], 0, 0, 0);
    o[d0] = __builtin_amdgcn_mfma_f32_32x32x16_bf16(pa1, PK(1), o[d0], 0, 0, 0);
    o[d0] = __builtin_amdgcn_mfma_f32_32x32x16_bf16(pa2, PK(2), o[d0], 0, 0, 0);
    o[d0] = __builtin_amdgcn_mfma_f32_32x32x16_bf16(pa3, PK(3), o[d0], 0, 0, 0);
#undef PK
  }
}
struct AttnT { const bf16* Q; const bf16* K; const bf16* KR; const bf16* V; bf16* O; const float* CS; };
template <int KIND> __device__ __forceinline__ void attn_unit(int b, int h, int qb, const AttnT& T, char* shm) {
  constexpr int ND0 = KIND == 0 ? 6 : 5, QP = KIND == 0 ? 768 : 640, HD = KIND == 0 ? 96 : 80;
  const int tid = threadIdx.x, lane = tid & 63, r32 = lane & 31, hi = lane >> 5; const int wid = __builtin_amdgcn_readfirstlane(tid >> 6);
  const long rowbase = (long)b * SEQ; const int q0 = qb * QB;
  const bf16* Qw = T.Q + (rowbase + q0 + wid * 32) * QP + h * HD;
  const unsigned lds0 = (unsigned)(uintptr_t)shm;
  const lds_cptr shm3 = (lds_cptr)shm;
  ATT_LAS float* wsf = (ATT_LAS float*)(shm3 + LDS_WS) + wid * 64;
  const bf16 *ksrcA, *ksrcB; long kstepA, kstepB; unsigned kdstB;
  const unsigned kdstA = lds0 + LDS_K + wid * 1024;
  if (KIND == 0) { ksrcA = T.K + (rowbase + lane) * 512 + h * 64 + wid * 8; ksrcB = T.KR + (rowbase + lane) * 32 + (wid & 3) * 8; kdstB = lds0 + LDS_K + (8 + (wid & 3)) * 1024; kstepA = 64 * 512; kstepB = 64 * 32; }
  else { ksrcA = T.K + (rowbase + lane) * 640 + h * 80 + wid * 8; ksrcB = T.K + (rowbase + lane) * 640 + h * 80 + (8 + (wid & 1)) * 8; kdstB = lds0 + LDS_K + (8 + (wid & 1)) * 1024; kstepA = 64 * 640; kstepB = 64 * 640; }
  const bf16* vsrc = T.V + (rowbase + 16 * (wid & 3) + (lane >> 2)) * 512 + h * 64 + (wid >> 2) * 32 + (lane & 3) * 8;
  const unsigned vdst = lds0 + LDS_V + wid * 1024;
#define DMA_T(t, s) do { glds16(ksrcA + (long)(t) * kstepA, (unsigned)__builtin_amdgcn_readfirstlane(kdstA + (s) * KSLOT)); \
                         glds16(ksrcB + (long)(t) * kstepB, (unsigned)__builtin_amdgcn_readfirstlane(kdstB + (s) * KSLOT)); \
                         glds16(vsrc + (long)(t) * (64 * 512), (unsigned)__builtin_amdgcn_readfirstlane(vdst + (s) * VSLOT)); } while (0)
  const int vb0 = (int)(lds0 + LDS_V) + ((lane >> 4) & 1) * 32 + (lane & 3) * 8 + (4 * hi + ((lane & 15) >> 2)) * 64;
  const lds_cptr kp0 = shm3 + LDS_K + hi * 1024 + r32 * 16;
  const int NT = (q0 + QB) / KVBLK;
  DMA_T(0, 0); DMA_T(1, 1);
  bf16x8 qr[ND0];
#pragma unroll
  for (int d0 = 0; d0 < ND0; ++d0) qr[d0] = *reinterpret_cast<const bf16x8*>(&Qw[(long)r32 * QP + d0 * 16 + hi * 8]);
  if (KIND == 0) {
    const float* cs = T.CS + (rowbase + q0 + wid * 32 + r32) * 32 + 16 * hi;
    typedef float f32x4_t __attribute__((ext_vector_type(4)));
    bf16x8 a = qr[4], c = qr[5];
#pragma unroll
    for (int j2 = 0; j2 < 4; ++j2) { const f32x4_t t4 = *(const f32x4_t*)(cs + 4 * j2);
#pragma unroll
      for (int e = 0; e < 2; ++e) { const int j = 2 * j2 + e; const float co = t4[2 * e], si = t4[2 * e + 1];
        const float x1 = __builtin_bit_cast(float, (unsigned)(unsigned short)a[j] << 16), x2 = __builtin_bit_cast(float, (unsigned)(unsigned short)c[j] << 16);
        const float o1 = x1 * co - x2 * si, o2 = x2 * co + x1 * si;
        qr[4][j] = (short)(cvtpk_s(o1, o1) & 0xffffu); qr[5][j] = (short)(cvtpk_s(o2, o2) & 0xffffu); } }
  }
  float mhat = 0.f, l_reg = 0.f; f32x16 o[2]; o[0] = f32x16{}; o[1] = f32x16{}; f32x16 negm = f32x16{};
  const int qrel = wid * 32 + r32;
  int s_cur = 0;
  for (int t = 0; t < NT; ++t) {
    if (t + 1 < NT) { WAIT_BAR(3); } else { WAIT_BAR(0); }
    if (t + 2 < NT) { const int s2 = (s_cur >= 1) ? s_cur - 1 : 2; DMA_T(t + 2, s2); }
    const int jb = t - 4 * qb;
    const bool vis = (KIND == 0) ? (t <= 4 * qb + (wid >> 1)) : ((jb < 0) || (64 * jb <= 32 * wid + 31));
    if (vis) {
      f32x16 p0, p1;
      qkt<ND0>(p0, p1, kp0 + s_cur * KSLOT, qr, negm);
      if (KIND == 1) { if (jb >= 0) cmask(p0, p1, jb, qrel, hi); }
      const float rm = rowmax(p0, p1);
      if (t == 0 || __any(rm > THR)) {
        const float dl = (t == 0) ? rm : __builtin_fmaxf(rm, 0.f);
        mhat += dl;
#pragma unroll
        for (int r = 0; r < 16; ++r) { p0[r] -= dl; p1[r] -= dl; negm[r] = -mhat; }
        const float f = __builtin_amdgcn_exp2f(-dl); l_reg *= f;
        if (t > 0) {
          if (hi == 0) wsf[r32] = f;
          asm volatile("s_waitcnt lgkmcnt(0)" ::: "memory");
#pragma unroll
          for (int d_ = 0; d_ < 2; ++d_)
#pragma unroll
            for (int r = 0; r < 16; ++r) o[d_][r] *= wsf[crow(r, hi)];
          asm volatile("s_waitcnt lgkmcnt(0)" ::: "memory");
        }
      }
      float sacc = 0.f;
#pragma unroll
      for (int r = 0; r < 16; ++r) { p0[r] = __builtin_amdgcn_exp2f(p0[r]); p1[r] = __builtin_amdgcn_exp2f(p1[r]); sacc += p0[r] + p1[r]; }
      l_reg += sacc;
      u32x4 pw0, pw1, pw2, pw3;
#define PKW(P, B) cvtpk_s(P[B], P[B + 1])
      pw0 = (u32x4){PKW(p0, 0), PKW(p0, 2), PKW(p0, 4), PKW(p0, 6)}; pw1 = (u32x4){PKW(p0, 8), PKW(p0, 10), PKW(p0, 12), PKW(p0, 14)};
      pw2 = (u32x4){PKW(p1, 0), PKW(p1, 2), PKW(p1, 4), PKW(p1, 6)}; pw3 = (u32x4){PKW(p1, 8), PKW(p1, 10), PKW(p1, 12), PKW(p1, 14)};
#undef PKW
      SBAR();
      pv(o, vb0 + s_cur * VSLOT, __builtin_bit_cast(bf16x8, pw0), __builtin_bit_cast(bf16x8, pw1), __builtin_bit_cast(bf16x8, pw2), __builtin_bit_cast(bf16x8, pw3));
    }
    s_cur = (s_cur == 2) ? 0 : s_cur + 1;
  }
  { auto rr = __builtin_amdgcn_permlane32_swap(__float_as_uint(l_reg), __float_as_uint(l_reg), false, false); l_reg = __uint_as_float(rr[0]) + __uint_as_float(rr[1]); }
  if (hi == 0) wsf[32 + r32] = l_reg;
  asm volatile("s_waitcnt lgkmcnt(0)" ::: "memory");
  float rli[16];
#pragma unroll
  for (int r = 0; r < 16; ++r) rli[r] = __builtin_amdgcn_rcpf(wsf[32 + crow(r, hi)]);
  bf16* Ow = T.O + (rowbase + q0 + wid * 32) * 1024 + h * 64;
  { ATT_LAS bf16* stg = (ATT_LAS bf16*)(shm3 + LDS_OST) + wid * 2048;
#pragma unroll
    for (int r = 0; r < 16; ++r) { const int orow = crow(r, hi);
#pragma unroll
      for (int d0 = 0; d0 < 2; ++d0) { const float v = o[d0][r] * rli[r]; stg[orow * 64 + d0 * 32 + r32] = (bf16)(cvtpk_s(v, v) & 0xffffu); } }
    asm volatile("s_waitcnt lgkmcnt(0)" ::: "memory");
#pragma unroll
    for (int i = 0; i < 4; ++i) { const int row = i * 8 + (lane >> 3), ch = lane & 7; const u32x4 v = *(const ATT_LAS u32x4*)(stg + row * 64 + ch * 8); *(u32x4*)(Ow + (long)row * 1024 + ch * 8) = v; } }
  asm volatile("s_waitcnt lgkmcnt(0)\n\ts_barrier" ::: "memory");
#undef DMA_T
}
#undef SBAR
#undef WAIT_BAR
#undef MX3
}
#ifndef MK_PER_PHASE
#define MK_PER_PHASE 0
#endif
constexpr int NWAVES = 8;
constexpr int BATCH = 8, SEQ = 4096, DM = 1024, M = BATCH * SEQ;
constexpr int NIN = 4096;
constexpr int NEXP = 32, XG_ROWS = 2 * M + NEXP * 256;
constexpr float EPS = 1e-6f, LOG2E = 1.4426950408889634f;
constexpr float C2F = 0.125f * LOG2E;
constexpr float C2M = 0.10206207261596577f * LOG2E;
constexpr int N_PHASES = 14;
constexpr size_t MiB = 1u << 20;
constexpr size_t WS_CTL = 0, CTL_ZERO_BYTES = 1 * MiB;
constexpr size_t WS_WIN = 1 * MiB, WS_WUQ = 9 * MiB, WS_WUKV = 9 * MiB + 512 * 1024, WS_WOA = 10 * MiB, WS_WOB = 11 * MiB, WS_WOUT = 12 * MiB, WS_WR = 14 * MiB, WS_WGU = 15 * MiB, WS_WDN = 47 * MiB;
constexpr size_t WS_CS = 63 * MiB, WS_LOGF = 67 * MiB, WS_EID = 68 * MiB, WS_SLOT = WS_EID + 256 * 1024, WS_WGT = WS_SLOT + 256 * 1024, WS_POS = WS_WGT + 256 * 1024, WS_WROW = 69 * MiB;
constexpr size_t WS_XN = 72 * MiB, WS_CQN = 72 * MiB, WS_CKVN = 88 * MiB, WS_VM = 96 * MiB, WS_KR = 128 * MiB;
constexpr size_t WS_Z0 = 136 * MiB, WS_Z1 = 152 * MiB, WS_QF = 184 * MiB, WS_KF = 224 * MiB, WS_VF = 264 * MiB, WS_OA = 296 * MiB, WS_OB = 328 * MiB, WS_MIX = 360 * MiB, WS_QM = 424 * MiB, WS_KM = 472 * MiB;
constexpr size_t WS_HN = 72 * MiB, WS_LG = 200 * MiB, WS_XG = 232 * MiB, WS_ACT = 376 * MiB, WS_YB = 72 * MiB, WS_END = 504 * MiB;
static_assert(WS_XG + (size_t)XG_ROWS * 2048 <= WS_ACT && WS_ACT + (size_t)XG_ROWS * 512 <= WS_END && WS_YB + (size_t)XG_ROWS * 2048 <= WS_XG, "moe map");
constexpr int CW_CNT = 8192;
constexpr int CW_TPRE = 128;
constexpr int CW_BAR = 4096;
constexpr int RING_OFF = 0, RING_BYTES = 131072, LDSCTL_OFF = RING_BYTES, MISC_OFF = LDSCTL_OFF + 320, TP_OFF = LDSCTL_OFF + 1024, LDS_BYTES = 147456;

#define GAS __attribute__((address_space(1)))
#define LAS __attribute__((address_space(3)))
typedef unsigned short bf16;
typedef unsigned v4u __attribute__((ext_vector_type(4)));
typedef float f32x4 __attribute__((ext_vector_type(4)));
typedef short bf16x8 __attribute__((ext_vector_type(8)));
typedef GAS unsigned gu32;
typedef GAS unsigned long long gu64;
#define RLX_AGENT __ATOMIC_RELAXED, __HIP_MEMORY_SCOPE_AGENT
#define LDS_WAIT() asm volatile("s_waitcnt lgkmcnt(0)" ::: "memory")
#define VM_WAIT() asm volatile("s_waitcnt vmcnt(0)" ::: "memory")
__device__ __forceinline__ unsigned long long rt() { return __builtin_amdgcn_s_memrealtime(); }
__device__ __forceinline__ unsigned f2bf(float f) { unsigned u = __builtin_bit_cast(unsigned, f); return (u + 0x7fffu + ((u >> 16) & 1u)) >> 16; }
__device__ __forceinline__ unsigned pk2(float lo, float hi) { return f2bf(lo) | (f2bf(hi) << 16); }


#define XB_TMO      128
#define XB_XCNT(j)  (256  + 64 * (j))
#define XB_XSUB(j)  (1280 + 64 * (j))
#define XB_XGEN(j)  (2304 + 64 * (j))
#define XB_TOP      3328
#define XB_TOPGEN   3392
#define XCD_BAR_WORDS 3456
#define XB_SPIN_CAP (1u << 18)

__device__ __forceinline__ unsigned xb_ld(unsigned* p)              { return __hip_atomic_load(p, __ATOMIC_RELAXED, __HIP_MEMORY_SCOPE_AGENT); }
__device__ __forceinline__ unsigned xb_add(unsigned* p, unsigned v) { return __hip_atomic_fetch_add(p, v, __ATOMIC_RELAXED, __HIP_MEMORY_SCOPE_AGENT); }
__device__ __forceinline__ unsigned xb_xcc_id() { return (unsigned)__builtin_amdgcn_s_getreg((3 << 11) | 20) & 0xFu; }
#define XB_SPIN(cond, bar) do { unsigned _sp = 0; while (cond) { __builtin_amdgcn_s_sleep(1); \
    if ((++_sp & 255u) == 0u) { if (xb_ld(&(bar)[XB_TMO])) break; if (_sp > XB_SPIN_CAP) { atomicAdd(&(bar)[XB_TMO], 1u); break; } } } } while (0)

struct XcdBarrier {
    unsigned* bar; unsigned x;
    volatile LAS unsigned* st;
};

__device__ __forceinline__ XcdBarrier xcd_barrier_post(unsigned* bar, volatile LAS unsigned* st) {
    XcdBarrier b; b.bar = bar; b.x = xb_xcc_id(); b.st = st;
    if (threadIdx.x == 0) (void)xb_add(&bar[XB_XCNT(b.x)], 1u);
    return b;
}
__device__ __forceinline__ void xcd_barrier_complete(unsigned* bar, unsigned x, unsigned& nloc, unsigned& nx) {
    const unsigned G = gridDim.x * gridDim.y * gridDim.z;
    unsigned sum, cnt, mine, sp = 0u;
    for (;;) {
        sum = 0u; cnt = 0u; mine = 0u;
#pragma unroll
        for (unsigned j = 0; j < 16; ++j) { const unsigned c = xb_ld(&bar[XB_XCNT(j)]); sum += c; cnt += (c > 0u) ? 1u : 0u; mine = (j == x) ? c : mine; }
        if (sum == G) break;
        __builtin_amdgcn_s_sleep(1);
        if ((++sp & 255u) == 0u) { if (xb_ld(&bar[XB_TMO])) break; if (sp > XB_SPIN_CAP) { atomicAdd(&bar[XB_TMO], 1u); break; } }
    }
    nloc = mine > 0u ? mine : 1u; nx = cnt > 0u ? cnt : 1u;
}

__device__ __forceinline__ void xcd_barrier(const XcdBarrier& b) {
    asm volatile("s_waitcnt vmcnt(0)" ::: "memory");
    __syncthreads();
    if (threadIdx.x == 0) {
        unsigned* bar = b.bar;
        __builtin_amdgcn_s_waitcnt(0);
        unsigned nloc = b.st[0], nx = b.st[1];
        if (nloc == 0u) { xcd_barrier_complete(bar, b.x, nloc, nx); b.st[0] = nloc; b.st[1] = nx; }
        const unsigned old = xb_add(&bar[XB_XSUB(b.x)], 1u);
        const unsigned gen = old / nloc;
        if (old + 1u == (gen + 1u) * nloc) {
            __builtin_amdgcn_fence(__ATOMIC_RELEASE, "agent");
            asm volatile("s_waitcnt vmcnt(0)" ::: "memory");
            const unsigned og = xb_add(&bar[XB_TOP], 1u);
            const unsigned tg = og / nx;
            if (og + 1u == (tg + 1u) * nx) xb_add(&bar[XB_TOPGEN], 1u);
            else XB_SPIN(xb_ld(&bar[XB_TOPGEN]) == tg, bar);
            __builtin_amdgcn_fence(__ATOMIC_ACQUIRE, "agent");
            xb_add(&bar[XB_XGEN(b.x)], 1u);
            asm volatile("s_waitcnt vmcnt(0)" ::: "memory");
        } else {
            XB_SPIN(xb_ld(&bar[XB_XGEN(b.x)]) == gen, bar);
            __builtin_amdgcn_fence(__ATOMIC_ACQUIRE, "agent");
            asm volatile("s_waitcnt vmcnt(0)" ::: "memory");
        }
    }
    __syncthreads();
}


typedef unsigned v2u __attribute__((ext_vector_type(2)));
__device__ __forceinline__ float wave_sum(float v) {
#pragma unroll
    for (int o = 1; o < 64; o <<= 1) v += __shfl_xor(v, o);
    return v;
}
__device__ __forceinline__ float bf2f(unsigned short b) { return __builtin_bit_cast(float, (unsigned)b << 16); }
__device__ __forceinline__ float bflo(unsigned w) { return __builtin_bit_cast(float, w << 16); }
__device__ __forceinline__ float bfhi(unsigned w) { return __builtin_bit_cast(float, w & 0xffff0000u); }
__device__ __forceinline__ v4u pack8(f32x4 a, f32x4 b) { v4u w; w.x = pg8::cvt_pk_bf16(a[0], a[1]); w.y = pg8::cvt_pk_bf16(a[2], a[3]); w.z = pg8::cvt_pk_bf16(b[0], b[1]); w.w = pg8::cvt_pk_bf16(b[2], b[3]); return w; }
__device__ __forceinline__ float sigmoidf_(float x) { return __builtin_amdgcn_rcpf(1.0f + __builtin_amdgcn_exp2f(-x * LOG2E)); }

using pg8::Unit;
#define EPI_ROWS(...) int rb_ = u.pm * 256 + wr * 64 + fr; asm volatile("" : "+v"(rb_)); _Pragma("unroll") for (int ai = 0; ai < 2; ++ai) _Pragma("unroll") for (int m = 0; m < 4; ++m) { const size_t row = (size_t)(rb_ + ai * 128 + m * 16); \
        _Pragma("unroll") for (int bj = 0; bj < 2; ++bj) { const f32x4 v0 = acc[ai][bj][m][0], v1 = acc[ai][bj][m][1]; __VA_ARGS__ } }
struct EpiIn { static constexpr bool PERM = true, AFTER_DRAIN = false, MID = false;
    bf16* Z0; float* Z1; bf16 *QF, *KF, *VF, *GA, *GB;
    __device__ __forceinline__ void operator()(const f32x4 (&acc)[2][2][4][2], const Unit& u, int wr, int wc, int fr, int fq) const {
        const int pn = u.pn;
        EPI_ROWS({ const int ct = bj * 128 + wc * 32 + 8 * fq;
            if (pn == 0) { *(v4u*)(Z0 + row * 256 + ct) = pack8(v0, v1); }
            else if (pn == 1) { float* p = Z1 + row * 256 + ct; *(f32x4*)p = v0; *(f32x4*)(p + 4) = v1; }
            else if (pn < 4) { const int c = (pn - 2) * 256 + ct; *(v4u*)(QF + row * 640 + (c >> 6) * 80 + (c & 63)) = pack8(v0 * C2F, v1 * C2F); }
            else if (pn < 6) { const int c = (pn - 4) * 256 + ct; *(v4u*)(KF + row * 640 + (c >> 6) * 80 + (c & 63)) = pack8(v0, v1); }
            else if (pn < 8) { const int c = (pn - 6) * 256 + ct; *(v4u*)(VF + row * 512 + c) = pack8(v0, v1); }
            else { bf16* G = pn < 12 ? GA : GB; const int c = ((pn - 8) & 3) * 256 + ct; f32x4 s0, s1;
                _Pragma("unroll") for (int e = 0; e < 4; ++e) { s0[e] = sigmoidf_(v0[e]); s1[e] = sigmoidf_(v1[e]); }
                *(v4u*)(G + row * 1024 + c) = pack8(s0, s1); } })
    }
};
struct EpiQup { static constexpr bool PERM = true, AFTER_DRAIN = false, MID = false;
    bf16* QM;
    __device__ __forceinline__ void operator()(const f32x4 (&acc)[2][2][4][2], const Unit& u, int wr, int wc, int fr, int fq) const {
        EPI_ROWS({ const int ct = u.pn * 256 + bj * 128 + wc * 32 + 8 * fq; *(v4u*)(QM + row * 768 + ct) = pack8(v0 * C2M, v1 * C2M); })
    }
};
struct EpiKVup { static constexpr bool PERM = true, AFTER_DRAIN = false, MID = false;
    bf16 *KM, *VM;
    __device__ __forceinline__ void operator()(const f32x4 (&acc)[2][2][4][2], const Unit& u, int wr, int wc, int fr, int fq) const {
        bf16* D = u.pn < 2 ? KM : VM; const int c0 = (u.pn & 1) * 256;
        EPI_ROWS({ const int ct = bj * 128 + wc * 32 + 8 * fq; *(v4u*)(D + row * 512 + c0 + ct) = pack8(v0, v1); })
    }
};
struct EpiMix { static constexpr bool PERM = true, AFTER_DRAIN = false, MID = true;
    const bf16 *GA_, *GB_; bf16* MIX_;
    __device__ __forceinline__ void mid(f32x4 (&acc)[2][2][4][2], const Unit& u, int wr, int wc, int fr, int fq) const {
        int rb_ = u.pm * 256 + wr * 64 + fr; asm volatile("" : "+v"(rb_));
#pragma unroll
        for (int ai = 0; ai < 2; ++ai)
#pragma unroll
            for (int m = 0; m < 4; ++m) { const size_t row = (size_t)(rb_ + ai * 128 + m * 16);
#pragma unroll
                for (int bj = 0; bj < 2; ++bj) { const size_t off = row * 1024 + u.pn * 256 + bj * 128 + wc * 32 + 8 * fq; const v4u a = *(const v4u*)(GA_ + off), b = *(const v4u*)(GB_ + off);
                    const f32x4 r0 = {bflo(a.x) * __builtin_amdgcn_rcpf(bflo(b.x)), bfhi(a.x) * __builtin_amdgcn_rcpf(bfhi(b.x)), bflo(a.y) * __builtin_amdgcn_rcpf(bflo(b.y)), bfhi(a.y) * __builtin_amdgcn_rcpf(bfhi(b.y))};
                    const f32x4 r1 = {bflo(a.z) * __builtin_amdgcn_rcpf(bflo(b.z)), bfhi(a.z) * __builtin_amdgcn_rcpf(bfhi(b.z)), bflo(a.w) * __builtin_amdgcn_rcpf(bflo(b.w)), bfhi(a.w) * __builtin_amdgcn_rcpf(bfhi(b.w))};
                    acc[ai][bj][m][0] *= r0; acc[ai][bj][m][1] *= r1; }
                asm volatile("" ::: "memory"); }
    }
    __device__ __forceinline__ void operator()(const f32x4 (&acc)[2][2][4][2], const Unit& u, int wr, int wc, int fr, int fq) const {
        EPI_ROWS({ const size_t off = row * 1024 + u.pn * 256 + bj * 128 + wc * 32 + 8 * fq; const v4u g = *(const v4u*)(GB_ + off);
            const f32x4 r0 = {bflo(g.x) * v0[0], bfhi(g.x) * v0[1], bflo(g.y) * v0[2], bfhi(g.y) * v0[3]}; const f32x4 r1 = {bflo(g.z) * v1[0], bfhi(g.z) * v1[1], bflo(g.w) * v1[2], bfhi(g.w) * v1[3]};
            *(v4u*)(MIX_ + off) = pack8(r0, r1); })
    }
};
struct EpiRes { static constexpr bool PERM = false, AFTER_DRAIN = false, MID = false;
    const float* X; float* H;
    __device__ __forceinline__ void operator()(const f32x4 (&acc)[2][2][4][2], const Unit& u, int wr, int wc, int fr, int fq) const {
        EPI_ROWS({ const size_t off = row * 1024 + u.pn * 256 + bj * 128 + wc * 32 + 4 * fq;
            *(f32x4*)(H + off) = *(const f32x4*)(X + off) + v0; *(f32x4*)(H + off + 16) = *(const f32x4*)(X + off + 16) + v1; })
    }
};
struct EpiLg { static constexpr bool PERM = true, AFTER_DRAIN = false, MID = false;
    float* LG;
    __device__ __forceinline__ void operator()(const f32x4 (&acc)[2][2][4][2], const Unit& u, int wr, int wc, int fr, int fq) const {
        EPI_ROWS({ if (bj == 0) { float* p = LG + row * 128 + wc * 32 + 8 * fq; *(f32x4*)p = v0; *(f32x4*)(p + 4) = v1; } })
    }
};
struct EpiGU { static constexpr bool PERM = true, AFTER_DRAIN = false, MID = false;
    bf16* ACT;
    __device__ __forceinline__ void operator()(const f32x4 (&acc)[2][2][4][2], const Unit& u, int wr, int wc, int fr, int fq) const {
        const int c0 = (u.pn & 1) * 128 + wc * 32 + 8 * fq; int rb_ = u.pm * 256 + wr * 64 + fr; asm volatile("" : "+v"(rb_));
#pragma unroll
        for (int ai = 0; ai < 2; ++ai)
#pragma unroll
            for (int m = 0; m < 4; ++m) { const size_t row = (size_t)(rb_ + ai * 128 + m * 16); f32x4 a0, a1;
#pragma unroll
                for (int e = 0; e < 4; ++e) { const float g0 = acc[ai][0][m][0][e], g1 = acc[ai][0][m][1][e]; a0[e] = g0 * sigmoidf_(g0) * acc[ai][1][m][0][e]; a1[e] = g1 * sigmoidf_(g1) * acc[ai][1][m][1][e]; }
                *(v4u*)(ACT + row * 256 + c0) = pack8(a0, a1); }
    }
};
struct EpiDown { static constexpr bool PERM = true, AFTER_DRAIN = false, MID = false;
    bf16* YB; const float* WROW;
    __device__ __forceinline__ void operator()(const f32x4 (&acc)[2][2][4][2], const Unit& u, int wr, int wc, int fr, int fq) const {
        const int c0 = (u.pn & 3) * 256;
        EPI_ROWS({ const float w = WROW[row]; *(v4u*)(YB + row * 1024 + c0 + bj * 128 + wc * 32 + 8 * fq) = pack8(v0 * w, v1 * w); })
    }
};
struct ExpertOrder {
    const LAS unsigned* tpre; int NJ, G, c;
    __device__ __forceinline__ bool next(int i, Unit& u) const {
        const int total = (int)tpre[NEXP] * NJ; const long L = (long)i * G + c; if (L >= total) return false;
        const int T = (int)L / NJ, j = (int)L % NJ; int e = 0;
#pragma unroll 1
        for (int k = 1; k < NEXP; ++k) e += ((int)tpre[k] <= T) ? 1 : 0;
        u.pm = T; u.pn = e * NJ + j; return true;
    }
    __device__ __forceinline__ void a_ready(const Unit&) const {}
    __device__ __forceinline__ void done(const Unit&) const {}
};

__device__ __forceinline__ void tr_item(const float* colp, int N, int k0, bf16* dst  , int K, bool lo, LAS float* scr, int lane) {
#pragma unroll 8
    for (int i = 0; i < 32; ++i) { const int kk = 2 * i + (lane >> 5); float v = colp ? colp[(size_t)(k0 + kk) * N] : 0.f;
        if (lo) v = v - bf2f((unsigned short)f2bf(v));
        scr[kk * 33 + (lane & 31)] = v; }
    LDS_WAIT(); asm volatile("" ::: "memory");
    const int c = lane & 7;
#pragma unroll
    for (int j = 0; j < 4; ++j) { const int n = (lane >> 3) + 8 * j; const LAS float* s = scr + (8 * c) * 33 + n;
        v4u o; o.x = pk2(s[0 * 33], s[1 * 33]); o.y = pk2(s[2 * 33], s[3 * 33]); o.z = pk2(s[4 * 33], s[5 * 33]); o.w = pk2(s[6 * 33], s[7 * 33]);
        *(GAS v4u*)(dst + (size_t)n * K + 8 * c) = o; }
    LDS_WAIT(); asm volatile("" ::: "memory");
}
__device__ __forceinline__ void tr_item4(const float* cp4, int N, bf16* dst  , int K, LAS float* scr, int lane) {
    const int c = lane & 7, kr0 = lane >> 3; f32x4 v[8];
#pragma unroll
    for (int i = 0; i < 8; ++i) v[i] = cp4 ? *(const f32x4*)(cp4 + (size_t)(8 * i) * N) : (f32x4){0.f, 0.f, 0.f, 0.f};
#pragma unroll
    for (int i = 0; i < 8; ++i) { LAS float* s = scr + (kr0 + 8 * i) * 33 + 4 * c; s[0] = v[i].x; s[1] = v[i].y; s[2] = v[i].z; s[3] = v[i].w; }
    LDS_WAIT(); asm volatile("" ::: "memory");
#pragma unroll
    for (int j = 0; j < 4; ++j) { const int n = kr0 + 8 * j; const LAS float* s = scr + (8 * c) * 33 + n;
        v4u o; o.x = pk2(s[0 * 33], s[1 * 33]); o.y = pk2(s[2 * 33], s[3 * 33]); o.z = pk2(s[4 * 33], s[5 * 33]); o.w = pk2(s[6 * 33], s[7 * 33]);
        *(GAS v4u*)(dst + (size_t)n * K + 8 * c) = o; }
    LDS_WAIT(); asm volatile("" ::: "memory");
}
__device__ __forceinline__ double inv_freq_d(int i) {
    const int q = i >> 2, r = i & 3;
    const double a = q == 0 ? 1.0 : q == 1 ? 0.1 : q == 2 ? 0.01 : 0.001;
    const double b = r == 0 ? 1.0 : r == 1 ? 0.5623413251903491 : r == 2 ? 0.31622776601683794 : 0.1778279410038923;
    return a * b;
}

struct Args { const float* in[22]; float* out; unsigned char* ws; int ph_lo, ph_hi; };

__global__ void __launch_bounds__(NWAVES * 64, 2) mk_fwd(Args args) {
    extern __shared__ __attribute__((aligned(16))) unsigned char lds[];
    LAS unsigned char* const L = (LAS unsigned char*)lds;
    volatile LAS unsigned* const MISC = (volatile LAS unsigned*)(L + MISC_OFF);
    const int tid = threadIdx.x, lane = tid & 63, wave = __builtin_amdgcn_readfirstlane(tid >> 6);
    const int G = gridDim.x; const int bx = blockIdx.x; const int vcu = (G % 8 == 0) ? (bx % 8) * (G / 8) + bx / 8 : bx;
    const int gw = vcu * NWAVES + wave, NGW = G * NWAVES;
    unsigned char* const ws = args.ws;
    gu32* const ctl = (gu32*)(ws + WS_CTL);
    const float* x = args.in[0]; const int* positions = (const int*)args.in[1]; const float* g_mix = args.in[2]; const float* w_in = args.in[3]; const float* b_forget = args.in[4];
    const float* g_cq = args.in[5]; const float* g_ckv = args.in[6]; const float* w_uq = args.in[7]; const float* w_uk = args.in[8]; const float* w_uv = args.in[9];
    const float* w_o_mla = args.in[10]; const float* w_o_fox = args.in[11]; const float* w_out = args.in[12]; const float* g_ffn = args.in[13]; const float* w_group = args.in[14];
    const float* b_group = args.in[15]; const float* w_router = args.in[16]; const float* b_router = args.in[17]; const float* w_e_gate = args.in[18]; const float* w_e_up = args.in[19];
    const float* w_e_down = args.in[20]; const float* g_final = args.in[21];
    float* const out = args.out;
#define WIN ((bf16*)(ws + WS_WIN))
#define WUQ ((bf16*)(ws + WS_WUQ))
#define WUKV ((bf16*)(ws + WS_WUKV))
#define WOA ((bf16*)(ws + WS_WOA))
#define WOB ((bf16*)(ws + WS_WOB))
#define WOUT ((bf16*)(ws + WS_WOUT))
#define WR ((bf16*)(ws + WS_WR))
#define WGU ((bf16*)(ws + WS_WGU))
#define WDN ((bf16*)(ws + WS_WDN))
#define CS ((float*)(ws + WS_CS))
#define LOGF ((float*)(ws + WS_LOGF))
#define EID ((int*)(ws + WS_EID))
#define SLOT ((int*)(ws + WS_SLOT))
#define WGT ((float*)(ws + WS_WGT))
#define POS ((int*)(ws + WS_POS))
#define WROW ((float*)(ws + WS_WROW))
#define XN ((bf16*)(ws + WS_XN))
#define CQN ((bf16*)(ws + WS_CQN))
#define CKVN ((bf16*)(ws + WS_CKVN))
#define VM ((bf16*)(ws + WS_VM))
#define KR ((bf16*)(ws + WS_KR))
#define Z0 ((bf16*)(ws + WS_Z0))
#define Z1 ((float*)(ws + WS_Z1))
#define QF ((bf16*)(ws + WS_QF))
#define KF ((bf16*)(ws + WS_KF))
#define VF ((bf16*)(ws + WS_VF))
#define OA ((bf16*)(ws + WS_OA))
#define OB ((bf16*)(ws + WS_OB))
#define MIX ((bf16*)(ws + WS_MIX))
#define QM ((bf16*)(ws + WS_QM))
#define KM ((bf16*)(ws + WS_KM))
#define HN ((bf16*)(ws + WS_HN))
#define LG ((float*)(ws + WS_LG))
#define XG ((bf16*)(ws + WS_XG))
#define ACT ((bf16*)(ws + WS_ACT))
#define YB ((bf16*)(ws + WS_YB))
#define GA ((bf16*)out)
#define GB ((bf16*)out + (size_t)M * 1024)
#define H out

    for (int u = tid; u < (LDS_BYTES - LDSCTL_OFF) / 4; u += NWAVES * 64) ((LAS unsigned*)(L + LDSCTL_OFF))[u] = 0u;
    __syncthreads();
    XcdBarrier bar; bar.bar = (unsigned*)(ctl + CW_BAR); bar.x = 0; bar.st = nullptr;
    if (!MK_PER_PHASE) bar = xcd_barrier_post((unsigned*)(ctl + CW_BAR), MISC + 8);
    const int lo = args.ph_lo, hi = args.ph_hi;
#ifndef MK_REPEAT
#define MK_REPEAT -1
#endif
#ifndef MK_ONLY
#define MK_ONLY -1
#endif
#define IN(k) ((MK_ONLY < 0 || MK_ONLY == (k)) && lo <= (k) && (k) < hi)
#define SEAM(k) do { if (IN(k) && IN((k) + 1)) { if ((k) == 0) { cooperative_groups::this_grid().sync(); } else { xcd_barrier(bar); } } } while (0)

    if (IN(0)) for (int rep_ = 0; rep_ < ((MK_REPEAT == 0) ? 2 : 1); ++rep_) {
        LAS float* scr = (LAS float*)(L + RING_OFF + wave * 16384);
        constexpr int I0 = 128 * 16, I1 = 24 * 4, I2 = 32 * 2, I3 = 32 * 8, I4 = 32 * 8  , I5 = 32 * 16, I6 = 8 * 16, I7 = NEXP * 16 * 16, I8 = NEXP * 32 * 4;
        constexpr int NITEMS = I0 + I1 + I2 + I3 + I4 + I5 + I6 + I7 + I8;
        const int l31 = lane & 31, c4 = 4 * (lane & 7), kr0 = lane >> 3;
        for (int it = gw; it < NITEMS; it += NGW) {
            int r = it;
            if (r < I0) { const int nb = r % 128, kb = r / 128, n = nb * 32 + c4;
                int sc; if (n < 416) sc = n; else if (n < 424) sc = 1952 + (n - 416); else if (n < 512) sc = -1; else if (n < 2048) sc = n - 96; else sc = n - 88;
                tr_item4(sc >= 0 ? w_in + (size_t)(kb * 64 + kr0) * 4008 + sc : nullptr, 4008, WIN + (size_t)(nb * 32) * 1024 + kb * 64, 1024, scr, lane); continue; } r -= I0;
            if (r < I1) { const int nb = r % 24, kb = r / 24; tr_item4(w_uq + (size_t)(kb * 64 + kr0) * 768 + nb * 32 + c4, 768, WUQ + (size_t)(nb * 32) * 256 + kb * 64, 256, scr, lane); continue; } r -= I1;
            if (r < I2) { const int nb = r % 32, kb = r / 32, n = nb * 32 + c4; tr_item4((n < 512 ? w_uk + n : w_uv + (n - 512)) + (size_t)(kb * 64 + kr0) * 512, 512, WUKV + (size_t)(nb * 32) * 128 + kb * 64, 128, scr, lane); continue; } r -= I2;
            if (r < I3 + I4) { const int nb = r % 32, kb = r / 32;
                const float* src = (kb < 8 ? w_o_mla + (size_t)(kb * 64 + kr0) * 1024 : w_o_fox + (size_t)((kb - 8) * 64 + kr0) * 1024) + nb * 32 + c4;
                tr_item4(src, 1024, WOA + (size_t)(nb * 32) * 1024 + kb * 64, 1024, scr, lane); continue; } r -= I3 + I4;
            if (r < I5) { const int nb = r % 32, kb = r / 32; tr_item4(w_out + (size_t)(kb * 64 + kr0) * 1024 + nb * 32 + c4, 1024, WOUT + (size_t)(nb * 32) * 1024 + kb * 64, 1024, scr, lane); continue; } r -= I5;
            if (r < I6) { const int nb = r % 8, kb = r / 8, n = nb * 32 + l31; const int j = n & 63; const bool islo = (n >= 64 && n < 128); const bool valid = (n < 128) && (j < 36);
                const float* cp = nullptr; int NN = 32; if (valid) { if (j < 4) { cp = w_group + j; NN = 4; } else { cp = w_router + (j - 4); NN = 32; } }
                { LAS float* sc2 = scr;
#pragma unroll 8
                  for (int i = 0; i < 32; ++i) { const int kk = 2 * i + (lane >> 5); float v = cp ? cp[(size_t)(kb * 64 + kk) * NN] : 0.f; if (islo) v = v - bf2f((unsigned short)f2bf(v)); sc2[kk * 33 + l31] = v; }
                  LDS_WAIT(); asm volatile("" ::: "memory");
                  const int c = lane & 7; bf16* dst = WR + (size_t)(nb * 32) * 1024 + kb * 64;
#pragma unroll
                  for (int jj = 0; jj < 4; ++jj) { const int nn = (lane >> 3) + 8 * jj; const LAS float* s = sc2 + (8 * c) * 33 + nn;
                      v4u o; o.x = pk2(s[0 * 33], s[1 * 33]); o.y = pk2(s[2 * 33], s[3 * 33]); o.z = pk2(s[4 * 33], s[5 * 33]); o.w = pk2(s[6 * 33], s[7 * 33]);
                      *(GAS v4u*)(dst + (size_t)nn * 1024 + 8 * c) = o; }
                  LDS_WAIT(); asm volatile("" ::: "memory"); }
                continue; } r -= I6;
            if (r < I7) { const int e = r / 256, q = r % 256, nb = q % 16, kb = q / 16, rr = nb * 32 + c4;
                const int j = rr >> 8, isup = (rr >> 7) & 1, cc = rr & 127; const float* src = (isup ? w_e_up : w_e_gate) + (size_t)e * 1024 * 256 + (size_t)(kb * 64 + kr0) * 256 + 128 * j + cc;
                tr_item4(src, 256, WGU + ((size_t)e * 512 + nb * 32) * 1024 + kb * 64, 1024, scr, lane); continue; } r -= I7;
            { const int e = r / 128, q = r % 128, nb = q % 32, kb = q / 32; tr_item4(w_e_down + (size_t)e * 256 * 1024 + (size_t)(kb * 64 + kr0) * 1024 + nb * 32 + c4, 1024, WDN + ((size_t)e * 1024 + nb * 32) * 256 + kb * 64, 256, scr, lane); }
        }
        for (int m = 2 * gw; m < M; m += 2 * NGW) {
            const GAS f32x4* xr = (const GAS f32x4*)(x + (size_t)m * DM) + lane; f32x4 v[8]; float s2a = 0.f, s2b = 0.f;
#pragma unroll
            for (int j = 0; j < 8; ++j) v[j] = xr[64 * j];
#pragma unroll
            for (int j = 0; j < 4; ++j) { s2a += (v[j].x * v[j].x + v[j].y * v[j].y) + (v[j].z * v[j].z + v[j].w * v[j].w); s2b += (v[4 + j].x * v[4 + j].x + v[4 + j].y * v[4 + j].y) + (v[4 + j].z * v[4 + j].z + v[4 + j].w * v[4 + j].w); }
            const float ra = 1.f / sqrtf(wave_sum(s2a) * (1.f / DM) + EPS), rb = 1.f / sqrtf(wave_sum(s2b) * (1.f / DM) + EPS);
            GAS unsigned long long* o8 = (GAS unsigned long long*)(XN + (size_t)m * DM) + lane;
#pragma unroll
            for (int j = 0; j < 8; ++j) { const f32x4 g = *((const f32x4*)g_mix + lane + 64 * (j & 3)); const float rs = j < 4 ? ra : rb;
                o8[64 * j] = (unsigned long long)pk2(v[j].x * rs * g.x, v[j].y * rs * g.y) | ((unsigned long long)pk2(v[j].z * rs * g.z, v[j].w * rs * g.w) << 32); }
        }
        for (int i = (vcu * NWAVES * 64 + tid); i < M * 16; i += G * NWAVES * 64) {
            const int m = i >> 4, f = i & 15; const double ang = (double)positions[m] * inv_freq_d(f); const double rev = ang * 0.15915494309189535; const float fr = (float)(rev - floor(rev));
            CS[2 * i] = __builtin_amdgcn_cosf(fr); CS[2 * i + 1] = __builtin_amdgcn_sinf(fr); }
    }
    SEAM(0);
    if (IN(1)) for (int rep_ = 0; rep_ < ((MK_REPEAT == 1) ? 2 : 1); ++rep_) {
        pg8::Gemm g{XN, WIN, M, NIN, DM}; pg8::StaticOrder S; S.init(M, NIN, G, bx);
        EpiIn E{Z0, Z1, QF, KF, VF, GA, GB};
        pg8::gemm_phase<EpiIn, pg8::StaticOrder, true, true>(L + RING_OFF, g, S, E);
    }
    SEAM(1);
    if (IN(2)) for (int rep_ = 0; rep_ < ((MK_REPEAT == 2) ? 2 : 1); ++rep_) {
        float* const BSUM = (float*)(ws + WS_EID);
        LAS float* part = (LAS float*)(L + RING_OFF);
        for (int vb = vcu; vb < 256; vb += G) { float lfsum = 0.f;
        for (int i = 0; i < 16; ++i) { const int m = vb * 128 + wave * 16 + i;
            { const v2u raw = *(const v2u*)(Z0 + (size_t)m * 256 + lane * 4); const float a0 = bflo(raw.x), a1 = bfhi(raw.x), a2 = bflo(raw.y), a3 = bfhi(raw.y);
              const float rstd = 1.f / sqrtf(wave_sum((a0 * a0 + a1 * a1) + (a2 * a2 + a3 * a3)) * (1.f / 256) + EPS); const f32x4 g = *((const f32x4*)g_cq + lane);
              v2u o; o.x = pk2(a0 * rstd * g.x, a1 * rstd * g.y); o.y = pk2(a2 * rstd * g.z, a3 * rstd * g.w); *(v2u*)(CQN + (size_t)m * 256 + lane * 4) = o; }
            const float* z = Z1 + (size_t)m * 256;
            { const float a0 = z[2 * lane], a1 = z[2 * lane + 1]; const float rstd = 1.f / sqrtf(wave_sum(a0 * a0 + a1 * a1) * (1.f / 128) + EPS);
              *(unsigned*)(CKVN + (size_t)m * 128 + 2 * lane) = pk2(a0 * rstd * g_ckv[2 * lane], a1 * rstd * g_ckv[2 * lane + 1]); }
            if (lane < 16) { const float x1 = z[128 + lane], x2 = z[144 + lane], c = CS[(size_t)m * 32 + 2 * lane], s = CS[(size_t)m * 32 + 2 * lane + 1];
              KR[(size_t)m * 32 + lane] = (bf16)f2bf(x1 * c - x2 * s); KR[(size_t)m * 32 + 16 + lane] = (bf16)f2bf(x2 * c + x1 * s); }
            else if (lane < 24) { const int j = lane - 16; const float xx = z[160 + j] + b_forget[j]; const float t = __expf(-fabsf(xx)); const float lfv = fminf(xx, 0.f) - __logf(1.f + t); LOGF[(size_t)m * 8 + j] = lfv; lfsum += lfv; }
            else if (lane >= 32 && lane < 48) { const int hh = (lane - 32) >> 1, half = lane & 1; v4u o = {0u, 0u, 0u, 0u}; if (half == 0) { o.x = 0x3F803F80u; o.y = 0x00003F80u; }
              *(v4u*)(QF + (size_t)m * 640 + hh * 80 + 64 + half * 8) = o; }
            else if (lane >= 48) { const int hh = (lane - 48) >> 1, half = lane & 1; *(v4u*)(KF + (size_t)m * 640 + hh * 80 + 64 + half * 8) = (v4u){0u, 0u, 0u, 0u}; }
        }
        if (lane >= 16 && lane < 24) part[wave * 8 + (lane - 16)] = lfsum;
        __syncthreads();
        if (tid < 8) { float t = 0.f; for (int w = 0; w < 8; ++w) t += part[w * 8 + tid]; BSUM[vb * 8 + tid] = t; }
        __syncthreads();
        }
    }
    SEAM(2);
    if (IN(3)) for (int rep_ = 0; rep_ < ((MK_REPEAT == 3) ? 2 : 1); ++rep_) {
#ifndef NO_SCAN
        { const float* const BSUM = (const float*)(ws + WS_EID);
          for (int vb = vcu; vb < 256; vb += G) { const int b = vb >> 5, bi = vb & 31, hh = wave;
            double base = (lane < bi) ? (double)BSUM[(size_t)((b * 32 + lane) * 8 + hh)] : 0.0;
#pragma unroll
            for (int o = 1; o < 64; o <<= 1) base += __shfl_xor(base, o);
            const size_t t0 = (size_t)vb * 128 + 2 * lane; const float v0 = LOGF[t0 * 8 + hh], v1 = LOGF[(t0 + 1) * 8 + hh];
            const double sp = (double)v0 + (double)v1; double incl = sp;
#pragma unroll
            for (int o = 1; o < 64; o <<= 1) { const double t = __shfl_up(incl, o); if (lane >= o) incl += t; }
            const double run0 = base + (incl - sp) + (double)v0, run1 = run0 + (double)v1;
#pragma unroll
            for (int e = 0; e < 2; ++e) { const float gneg = (float)(-(e ? run1 : run0) * 1.4426950408889634);
                const unsigned b0 = f2bf(gneg); const float r1 = gneg - bf2f((unsigned short)b0); const unsigned b1 = f2bf(r1); const float r2 = r1 - bf2f((unsigned short)b1); const unsigned b2 = f2bf(r2);
                bf16* kf = KF + (t0 + e) * 640 + hh * 80 + 64; *(unsigned*)kf = b0 | (b1 << 16); *(unsigned*)(kf + 2) = b2; }
          } }
#endif
#ifndef NO_QUP
        { pg8::Gemm g{CQN, WUQ, M, 768, 256}; pg8::StaticOrder S; S.init(M, 768, G, bx); EpiQup E{QM};
          pg8::gemm_phase<EpiQup, pg8::StaticOrder, true, true>(L + RING_OFF, g, S, E); }
#endif
#ifndef NO_KVUP
        { pg8::Gemm g{CKVN, WUKV, M, 1024, 128}; pg8::StaticOrder S; S.init(M, 1024, G, bx); EpiKVup E{KM, VM};
          pg8::gemm_phase<EpiKVup, pg8::StaticOrder, true, true>(L + RING_OFF, g, S, E); }
#endif
    }
    SEAM(3);
    if (IN(4)) for (int rep_ = 0; rep_ < ((MK_REPEAT == 4) ? 2 : 1); ++rep_) {
        const att::AttnT TA{QM, KM, KR, VM, OA, CS}; const att::AttnT TB{QF, KF, KF, VF, OA + 512, CS};
        for (int v = vcu; v < 256; v += G) { const int bh = v >> 2, sub = v & 3, b = bh >> 3, hh = bh & 7;
#pragma unroll 1
            for (int i = 0; i < 4; ++i) { const int qb = (i == 0) ? 15 - sub : (i == 1) ? 8 + sub : (i == 2) ? 7 - sub : sub;
                att::attn_unit<0>(b, hh, qb, TA, (char*)lds + RING_OFF);
                att::attn_unit<1>(b, hh, qb, TB, (char*)lds + RING_OFF); } }
    }
    SEAM(4);
    if (IN(5)) for (int rep_ = 0; rep_ < ((MK_REPEAT == 5) ? 2 : 1); ++rep_) {
        pg8::Gemm g{OA, WOA, M, 1024, 1024}; pg8::StaticOrder S; S.init(M, 1024, G, bx); EpiMix E{GA, GB, MIX}; pg8::gemm_phase<EpiMix, pg8::StaticOrder, true, true>(L + RING_OFF, g, S, E);
    }
    SEAM(5);
    if (IN(6)) for (int rep_ = 0; rep_ < ((MK_REPEAT == 6) ? 2 : 1); ++rep_) {
        pg8::Gemm g{MIX, WOUT, M, 1024, 1024}; pg8::StaticOrder S; S.init(M, 1024, G, bx); EpiRes E{x, H}; pg8::gemm_phase<EpiRes, pg8::StaticOrder, true, true>(L + RING_OFF, g, S, E);
    }
    SEAM(6);
    if (IN(7)) for (int rep_ = 0; rep_ < ((MK_REPEAT == 7) ? 2 : 1); ++rep_) {
        for (int m = gw; m < M; m += NGW) {
            const GAS f32x4* hr = (const GAS f32x4*)(H + (size_t)m * DM) + lane; f32x4 v[4]; float s2 = 0.f;
#pragma unroll
            for (int j = 0; j < 4; ++j) { v[j] = hr[64 * j]; s2 += (v[j].x * v[j].x + v[j].y * v[j].y) + (v[j].z * v[j].z + v[j].w * v[j].w); }
            const float rstd = 1.f / sqrtf(wave_sum(s2) * (1.f / DM) + EPS);
            GAS unsigned long long* oh = (GAS unsigned long long*)(HN + (size_t)m * DM) + lane; GAS unsigned long long* ol = (GAS unsigned long long*)(HN + (size_t)(M + m) * DM) + lane;
#pragma unroll
            for (int j = 0; j < 4; ++j) { const f32x4 g = *((const f32x4*)g_ffn + lane + 64 * j); const f32x4 y = {v[j].x * rstd * g.x, v[j].y * rstd * g.y, v[j].z * rstd * g.z, v[j].w * rstd * g.w};
                const unsigned h0 = f2bf(y.x), h1 = f2bf(y.y), h2 = f2bf(y.z), h3 = f2bf(y.w);
                oh[64 * j] = (unsigned long long)(h0 | (h1 << 16)) | ((unsigned long long)(h2 | (h3 << 16)) << 32);
                ol[64 * j] = (unsigned long long)pk2(y.x - bf2f((unsigned short)h0), y.y - bf2f((unsigned short)h1)) | ((unsigned long long)pk2(y.z - bf2f((unsigned short)h2), y.w - bf2f((unsigned short)h3)) << 32); }
        }
    }
    SEAM(7);
    if (IN(8)) for (int rep_ = 0; rep_ < ((MK_REPEAT == 8) ? 2 : 1); ++rep_) {
        pg8::Gemm g{HN, WR, 2 * M, 256, 1024}; pg8::StaticOrder S; S.init(2 * M, 256, G, bx); EpiLg E{LG}; pg8::gemm_phase<EpiLg, pg8::StaticOrder, true, true>(L + RING_OFF, g, S, E);
    }
    SEAM(8);
    if (IN(9)) for (int rep_ = 0; rep_ < ((MK_REPEAT == 9) ? 2 : 1); ++rep_) {
        LAS unsigned* lc = (LAS unsigned*)(L + TP_OFF + 256);
        const int per = (M + G - 1) / G;
        for (int t0 = vcu * per; t0 < min(M, (vcu + 1) * per); t0 += NWAVES * 64) {
        if (tid < 64) lc[tid] = 0u;
        __syncthreads();
        const int t = t0 + tid; const bool act = (t < min(M, (vcu + 1) * per));
        int x0 = 0, x1 = 0; unsigned s0 = 0, s1 = 0; float w0 = 0.f, w1 = 0.f;
        if (act) {
            float lg[36];
            const float* a = LG + (size_t)t * 128; const float* b2 = LG + (size_t)(M + t) * 128;
#pragma unroll
            for (int q = 0; q < 9; ++q) { const f32x4 p0 = *(const f32x4*)(a + 4 * q), p1 = *(const f32x4*)(a + 64 + 4 * q), p2 = *(const f32x4*)(b2 + 4 * q), p3 = *(const f32x4*)(b2 + 64 + 4 * q);
#pragma unroll
                for (int e = 0; e < 4; ++e) lg[4 * q + e] = (p0[e] + p1[e]) + (p2[e] + p3[e]); }
#pragma unroll
            for (int j = 0; j < 4; ++j) lg[j] += b_group[j];
#pragma unroll
            for (int j = 0; j < 32; ++j) lg[4 + j] += b_router[j];
            int gi = 0; float gm = lg[0];
#pragma unroll
            for (int j = 1; j < 4; ++j) if (lg[j] > gm) { gm = lg[j]; gi = j; }
            float gs = 0.f;
#pragma unroll
            for (int j = 0; j < 4; ++j) gs += __expf(lg[j] - gm);
            const float gp = 1.f / gs;
            float sel[8];
#pragma unroll
            for (int e = 0; e < 8; ++e) sel[e] = gi == 0 ? lg[4 + e] : gi == 1 ? lg[12 + e] : gi == 2 ? lg[20 + e] : lg[28 + e];
            int e0 = 0; float m0 = sel[0];
#pragma unroll
            for (int e = 1; e < 8; ++e) if (sel[e] > m0) { m0 = sel[e]; e0 = e; }
            int e1 = -1; float m1 = -INFINITY;
#pragma unroll
            for (int e = 0; e < 8; ++e) if (e != e0 && sel[e] > m1) { m1 = sel[e]; e1 = e; }
            const float r = __expf(m1 - m0); w0 = gp / (1.f + r); w1 = gp * r / (1.f + r);
            x0 = gi * 8 + e0; x1 = gi * 8 + e1;
            s0 = __hip_atomic_fetch_add(lc + x0, 1u, __ATOMIC_RELAXED, __HIP_MEMORY_SCOPE_WORKGROUP); s1 = __hip_atomic_fetch_add(lc + x1, 1u, __ATOMIC_RELAXED, __HIP_MEMORY_SCOPE_WORKGROUP);
        }
        __syncthreads();
        if (tid < NEXP) { const unsigned c = lc[tid]; lc[32 + tid] = c ? __hip_atomic_fetch_add(ctl + CW_CNT + 64 * tid, c, RLX_AGENT) : 0u; }
        __syncthreads();
        if (act) { EID[2 * t] = x0; EID[2 * t + 1] = x1; SLOT[2 * t] = (int)(lc[32 + x0] + s0); SLOT[2 * t + 1] = (int)(lc[32 + x1] + s1); WGT[2 * t] = w0; WGT[2 * t + 1] = w1; }
        __syncthreads();
        }
    }
    SEAM(9);
    if (IN(10)) for (int rep_ = 0; rep_ < ((MK_REPEAT == 10) ? 2 : 1); ++rep_) {
        LAS unsigned* tp = (LAS unsigned*)(L + TP_OFF);
        if (tid == 0) { unsigned acc = 0; for (int e = 0; e < NEXP; ++e) { tp[e] = acc; acc += (__hip_atomic_load(ctl + CW_CNT + 64 * e, RLX_AGENT) + 255u) >> 8; } tp[NEXP] = acc;
            if (bx == 0) for (int e = 0; e <= NEXP; ++e) __hip_atomic_store(ctl + CW_TPRE + e, tp[e], RLX_AGENT); }
        __syncthreads();
        for (int m = gw; m < M; m += NGW) {
            const int x0 = EID[2 * m], x1 = EID[2 * m + 1]; const int p0 = (int)tp[x0] * 256 + SLOT[2 * m], p1 = (int)tp[x1] * 256 + SLOT[2 * m + 1];
            if (lane == 0) { POS[2 * m] = p0; POS[2 * m + 1] = p1; WROW[p0] = WGT[2 * m]; WROW[p1] = WGT[2 * m + 1]; }
            const v4u a = *((const v4u*)(HN + (size_t)m * DM) + lane), b2 = *((const v4u*)(HN + (size_t)m * DM) + 64 + lane);
            *((v4u*)(XG + (size_t)p0 * DM) + lane) = a; *((v4u*)(XG + (size_t)p0 * DM) + 64 + lane) = b2;
            *((v4u*)(XG + (size_t)p1 * DM) + lane) = a; *((v4u*)(XG + (size_t)p1 * DM) + 64 + lane) = b2;
        }
        __syncthreads();
    }
    SEAM(10);
    if (IN(11)) for (int rep_ = 0; rep_ < ((MK_REPEAT == 11) ? 2 : 1); ++rep_) {
        LAS unsigned* tp = (LAS unsigned*)(L + TP_OFF); if (tid <= NEXP) tp[tid] = __hip_atomic_load(ctl + CW_TPRE + tid, RLX_AGENT); __syncthreads();
        pg8::Gemm g{XG, WGU, XG_ROWS, NEXP * 512, 1024}; ExpertOrder S{tp, 2, G, bx}; EpiGU E{ACT};
        pg8::gemm_phase<EpiGU, ExpertOrder, true, true>(L + RING_OFF, g, S, E);
    }
    SEAM(11);
    if (IN(12)) for (int rep_ = 0; rep_ < ((MK_REPEAT == 12) ? 2 : 1); ++rep_) {
        LAS unsigned* tp = (LAS unsigned*)(L + TP_OFF); if (tid <= NEXP) tp[tid] = __hip_atomic_load(ctl + CW_TPRE + tid, RLX_AGENT); __syncthreads();
        pg8::Gemm g{ACT, WDN, XG_ROWS, NEXP * 1024, 256}; ExpertOrder S{tp, 4, G, bx}; EpiDown E{YB, WROW};
        pg8::gemm_phase<EpiDown, ExpertOrder, true, true>(L + RING_OFF, g, S, E);
    }
    SEAM(12);
    if (IN(13)) for (int rep_ = 0; rep_ < ((MK_REPEAT == 13) ? 2 : 1); ++rep_) {
        for (int m = gw; m < M; m += NGW) {
            const int p0 = POS[2 * m], p1 = POS[2 * m + 1];
            GAS f32x4* hr = (GAS f32x4*)(H + (size_t)m * DM) + lane; const v2u* y0 = (const v2u*)(YB + (size_t)p0 * DM) + lane; const v2u* y1 = (const v2u*)(YB + (size_t)p1 * DM) + lane;
            f32x4 v[4]; float s2 = 0.f;
#pragma unroll
            for (int j = 0; j < 4; ++j) { const v2u a = y0[64 * j], b2 = y1[64 * j]; v[j] = hr[64 * j];
                v[j].x += bflo(a.x) + bflo(b2.x); v[j].y += bfhi(a.x) + bfhi(b2.x); v[j].z += bflo(a.y) + bflo(b2.y); v[j].w += bfhi(a.y) + bfhi(b2.y);
                s2 += (v[j].x * v[j].x + v[j].y * v[j].y) + (v[j].z * v[j].z + v[j].w * v[j].w); }
            const float rstd = 1.f / sqrtf(wave_sum(s2) * (1.f / DM) + EPS);
#pragma unroll
            for (int j = 0; j < 4; ++j) { const f32x4 g = *((const f32x4*)g_final + lane + 64 * j); hr[64 * j] = (f32x4){v[j].x * rstd * g.x, v[j].y * rstd * g.y, v[j].z * rstd * g.z, v[j].w * rstd * g.w}; }
        }
    }
#undef IN
#undef SEAM
}

extern "C" void kernel_launch(void* const* d_in, const int* in_sizes, int n_in, void* d_out, int out_size, void* d_ws, size_t ws_size, hipStream_t stream) {
    static int grid = 0;
    if (grid == 0) {
        if (n_in != 22 || in_sizes[0] != M * DM || out_size != M * DM || ws_size < WS_END) { fprintf(stderr, "kernel_launch: unexpected shapes (n_in %d, in0 %d, out %d, ws %zu); nothing launched\n", n_in, n_in > 0 ? in_sizes[0] : -1, out_size, ws_size); grid = -1; return; }
        int dev = 0, cus = 0, per_cu = 0;
        if (hipGetDevice(&dev) != hipSuccess || hipDeviceGetAttribute(&cus, hipDeviceAttributeMultiprocessorCount, dev) != hipSuccess) { grid = -1; return; }
        if (hipFuncSetAttribute((const void*)mk_fwd, hipFuncAttributeMaxDynamicSharedMemorySize, LDS_BYTES) != hipSuccess) { fprintf(stderr, "kernel_launch: hipFuncSetAttribute failed\n"); grid = -1; return; }
        if (hipOccupancyMaxActiveBlocksPerMultiprocessor(&per_cu, (const void*)mk_fwd, NWAVES * 64, LDS_BYTES) != hipSuccess || per_cu < 1) { fprintf(stderr, "kernel_launch: occupancy query says %d blocks/CU\n", per_cu); per_cu = 1; }
        (void)hipGetLastError();
        grid = cus;
    }
    if (grid < 0) return;
    if (hipMemsetAsync((char*)d_ws + WS_CTL, 0, CTL_ZERO_BYTES, stream) != hipSuccess) { fprintf(stderr, "kernel_launch: memset failed\n"); return; }
    Args a{};
    for (int i = 0; i < 22; ++i) a.in[i] = (const float*)d_in[i];
    a.out = (float*)d_out; a.ws = (unsigned char*)d_ws;
#if MK_PER_PHASE
#ifndef MK_REPEAT_L
#define MK_REPEAT_L -1
#endif
    for (int p = 0; p < N_PHASES; ++p) { a.ph_lo = p; a.ph_hi = p + 1; hipLaunchKernelGGL(mk_fwd, dim3(grid), dim3(NWAVES * 64), LDS_BYTES, stream, a);
        if (p == MK_REPEAT_L) hipLaunchKernelGGL(mk_fwd, dim3(grid), dim3(NWAVES * 64), LDS_BYTES, stream, a); }
#else
#ifndef MK_PREFIX
#define MK_PREFIX -1
#endif
    void* kargs[] = {&a};
    if (MK_PREFIX >= 0) {
        a.ph_lo = 0; a.ph_hi = MK_PREFIX + 1;
        (void)hipLaunchCooperativeKernel((const void*)mk_fwd, dim3(grid), dim3(NWAVES * 64), kargs, LDS_BYTES, stream);
        (void)hipMemsetAsync((char*)d_ws + WS_CTL, 0, CTL_ZERO_BYTES, stream);
    }
    a.ph_lo = 0; a.ph_hi = N_PHASES;
    hipError_t e = hipLaunchCooperativeKernel((const void*)mk_fwd, dim3(grid), dim3(NWAVES * 64), kargs, LDS_BYTES, stream);
    if (e != hipSuccess) fprintf(stderr, "kernel_launch: cooperative launch failed: %s (grid %d)\n", hipGetErrorString(e), grid);
#endif
}
```

```cpp
#include <hip/hip_runtime.h>
#include <hip/hip_bf16.h>
#include <hip/hip_cooperative_groups.h>
#include <cstdio>
#include <cstdint>
#include <cmath>
namespace pg8 {
#define PG8_LAS __attribute__((address_space(3)))
typedef unsigned short bf16_t;
typedef short bf16x8 __attribute__((ext_vector_type(8)));
typedef float f32x4 __attribute__((ext_vector_type(4)));
typedef unsigned u32x4 __attribute__((ext_vector_type(4)));
constexpr int BM = 256, BK = 64, HALF = 128, HTB = HALF * BK * 2  , STAGE_BYTES = 8 * HTB, NXCD = 8, WGM = 8;

__host__ __device__ __forceinline__ int lds_byte(int r, int c) { const int st = (r >> 4) * 2 + (c >> 5), rr = r & 15, cc = c & 31, ob = rr * 64 + cc * 2; return st * 1024 + (ob ^ (((ob >> 9) & 1) << 5)); }
__host__ __device__ __forceinline__ void stage_rc(int b, int& R, int& C) { const int st = b / 1024, sb = b % 1024, swz = sb ^ (((sb >> 9) & 1) << 5); R = (st >> 1) * 16 + swz / 64; C = (st & 1) * 32 + (swz % 64) / 2; }
__host__ __device__ __forceinline__ int perm32(int rho) { const int n = rho >> 4, i = rho & 15; return 8 * (i >> 2) + 4 * n + (i & 3); }

struct Unit { int pm, pn; };
struct Gemm { const bf16_t* A; const bf16_t* Bt; int M, N, K; };

struct StaticOrder {
    int nM, nN, nwg, G, c;
    __host__ __device__ void init(int M, int N, int G_, int c_) { nM = M / BM; nN = N / BM; nwg = nM * nN; G = G_; c = c_; }
    __host__ __device__ bool next(int i, Unit& u) const {
        const long L = (long)i * G + c; if (L >= nwg) return false;
        int wgid = (int)L; { const int q = nwg / NXCD, r = nwg % NXCD, xcd = wgid % NXCD, off = wgid / NXCD; wgid = (xcd < r ? xcd * (q + 1) : r * (q + 1) + (xcd - r) * q) + off; }
        const int nig = WGM * nN, gid = wgid / nig, fm = gid * WGM, gsz = (nM - fm) < WGM ? (nM - fm) : WGM;
        u.pm = fm + ((wgid % nig) % gsz); u.pn = (wgid % nig) / gsz; return true;
    }
    __device__ __forceinline__ void a_ready(const Unit&) const {}
    __device__ __forceinline__ void done(const Unit&) const {}
};

__device__ __forceinline__ unsigned cvt_pk_bf16(float lo, float hi) { unsigned r; asm volatile("v_cvt_pk_bf16_f32 %0, %1, %2" : "=v"(r) : "v"(lo), "v"(hi)); return r; }
typedef float f32x2 __attribute__((ext_vector_type(2)));
template <class Epi, class Sched, bool ALIGN_EPI = false, bool SP2 = false>
__device__ __forceinline__ void gemm_phase(PG8_LAS unsigned char* lds, const Gemm g, const Sched& S, const Epi& E) {
    const int tid = threadIdx.x, wid = __builtin_amdgcn_readfirstlane(tid >> 6), lane = tid & 63, wr = wid >> 2, wc = wid & 3, fr = lane & 15, fq = lane >> 4;
    const int K = g.K; int nt = K / BK; asm volatile("" : "+s"(nt));
    unsigned voffA[2], voffB[2];
#pragma unroll
    for (int i = 0; i < 2; ++i) { int R, C; stage_rc(tid * 16 + i * 8192, R, C); const int Rb = Epi::PERM ? ((R & ~31) + perm32(R & 31)) : R;
        voffA[i] = (unsigned)(R * K + C) * 2u; voffB[i] = (unsigned)(Rb * K + C) * 2u; }
    const size_t kstep = (size_t)(BK * 2);
    const size_t hstep = (size_t)HALF * K * 2;
    const size_t tstep = 2 * hstep;
    const unsigned ldsw = (unsigned)wid * 1024u;
    const int aoff = lds_byte(wr * 64 + fr, fq * 8), boff = lds_byte(wc * 32 + fr, fq * 8);
#define PG8_SA(b, h) (((b) * 2 + (h)) * HTB)
#define PG8_SB(b, h) ((4 + (b) * 2 + (h)) * HTB)
#define PG8_STAGE(bufoff, gbase, voff) do { _Pragma("unroll") for (int _i = 0; _i < 2; ++_i) \
        __builtin_amdgcn_global_load_lds((const unsigned*)((const char*)(gbase) + (voff)[_i]), (PG8_LAS unsigned*)(lds + (bufoff) + ldsw + _i * 8192), 16, 0, 0); } while (0)
#define PG8_LDA(dst, b, h) do { _Pragma("unroll") for (int m = 0; m < 4; ++m) _Pragma("unroll") for (int k = 0; k < 2; ++k) dst[m][k] = *(const PG8_LAS bf16x8*)(lds + PG8_SA(b, h) + aoff + m * 2048 + k * 1024); } while (0)
#define PG8_LDB(dst, b, h) do { _Pragma("unroll") for (int n = 0; n < 2; ++n) _Pragma("unroll") for (int k = 0; k < 2; ++k) dst[n][k] = *(const PG8_LAS bf16x8*)(lds + PG8_SB(b, h) + boff + n * 2048 + k * 1024); } while (0)
#define PG8_MMA(ai, bj, At, Bt) do { __builtin_amdgcn_s_setprio(1); _Pragma("unroll") for (int m = 0; m < 4; ++m) _Pragma("unroll") for (int n = 0; n < 2; ++n) _Pragma("unroll") for (int k = 0; k < 2; ++k) \
        acc[ai][bj][m][n] = __builtin_amdgcn_mfma_f32_16x16x32_bf16(Bt[n][k], At[m][k], acc[ai][bj][m][n], 0, 0, 0); __builtin_amdgcn_s_setprio(0); } while (0)
#define PG8_WAIT_V(n) asm volatile("s_waitcnt vmcnt(" #n ")" ::: "memory")
#define PG8_WAIT_L(n) asm volatile("s_waitcnt lgkmcnt(" #n ")" ::: "memory")
#define PG8_BAR __builtin_amdgcn_s_barrier()
#define PG8_SCHED __builtin_amdgcn_sched_barrier(0)
    Unit cur, nxt; int ui = 0;
    if (!S.next(0, cur)) return;
    f32x4 acc[2][2][4][2];
#pragma unroll
    for (int a = 0; a < 2; ++a)
#pragma unroll
        for (int b = 0; b < 2; ++b)
#pragma unroll
            for (int m = 0; m < 4; ++m)
#pragma unroll
                for (int n = 0; n < 2; ++n) acc[a][b][m][n] = (f32x4){0.f, 0.f, 0.f, 0.f};
    bf16x8 At[4][2], B0[2][2], B1[2][2];
    const char* cA = (const char*)g.A + (size_t)cur.pm * tstep; const char* cB = (const char*)g.Bt + (size_t)cur.pn * tstep;
    S.a_ready(cur);
    if constexpr (SP2) {
        PG8_STAGE(PG8_SB(0, 0), cB, voffB); PG8_STAGE(PG8_SB(0, 1), cB + hstep, voffB); PG8_STAGE(PG8_SA(0, 0), cA, voffA); PG8_STAGE(PG8_SA(0, 1), cA + hstep, voffA);
        if (wr == 1) PG8_BAR;
        PG8_WAIT_V(2); PG8_BAR;
        PG8_STAGE(PG8_SB(1, 0), cB + kstep, voffB); PG8_STAGE(PG8_SA(1, 0), cA + kstep, voffA); PG8_STAGE(PG8_SB(1, 1), cB + hstep + kstep, voffB);
        PG8_WAIT_V(6); PG8_BAR;
    } else {
        PG8_STAGE(PG8_SB(0, 0), cB, voffB); PG8_STAGE(PG8_SA(0, 0), cA, voffA); PG8_STAGE(PG8_SB(0, 1), cB + hstep, voffB); PG8_STAGE(PG8_SA(0, 1), cA + hstep, voffA);
        if (wr == 1) PG8_BAR;
        PG8_WAIT_V(4); PG8_BAR;
        PG8_STAGE(PG8_SB(1, 0), cB + kstep, voffB); PG8_STAGE(PG8_SA(1, 0), cA + kstep, voffA); PG8_STAGE(PG8_SB(1, 1), cB + hstep + kstep, voffB);
        PG8_WAIT_V(6); PG8_BAR;
    }
    for (;;) {
        const bool has_next = S.next(ui + 1, nxt);
        const char* nA = has_next ? (const char*)g.A + (size_t)nxt.pm * tstep : cA; const char* nB = has_next ? (const char*)g.Bt + (size_t)nxt.pn * tstep : cB;
        for (int t = 0; t < nt; t += 2) {
            if constexpr (Epi::MID) { if (t == (nt >> 1)) E.mid(acc, cur, wr, wc, fr, fq); }
            const bool last = (t == nt - 2);
            const char* a1 = cA + (size_t)(t + 1) * kstep;
            const char* a2 = last ? nA : cA + (size_t)(t + 2) * kstep; const char* b2 = last ? nB : cB + (size_t)(t + 2) * kstep;
            const char* a3 = a2 + kstep; const char* b3 = b2 + kstep;
            if (last && has_next) S.a_ready(nxt);
            if constexpr (SP2) {
            PG8_LDB(B0, 0, 0); PG8_LDB(B1, 0, 1); PG8_SCHED; PG8_LDA(At, 0, 0); PG8_STAGE(PG8_SA(1, 1), a1 + hstep, voffA);
            PG8_WAIT_V(8); PG8_WAIT_L(0); PG8_BAR; PG8_MMA(0, 0, At, B0); PG8_MMA(0, 1, At, B1); PG8_BAR; PG8_SCHED;
            PG8_LDA(At, 0, 1); PG8_STAGE(PG8_SB(0, 0), b2, voffB); PG8_STAGE(PG8_SB(0, 1), b2 + hstep, voffB); PG8_STAGE(PG8_SA(0, 0), a2, voffA);
            PG8_WAIT_V(8); PG8_WAIT_L(0); PG8_BAR; PG8_MMA(1, 0, At, B0); PG8_MMA(1, 1, At, B1); PG8_BAR; PG8_SCHED;
            PG8_LDB(B0, 1, 0); PG8_LDB(B1, 1, 1); PG8_SCHED; PG8_LDA(At, 1, 0); PG8_STAGE(PG8_SA(0, 1), a2 + hstep, voffA);
            PG8_WAIT_V(8); PG8_WAIT_L(0); PG8_BAR; PG8_MMA(0, 0, At, B0); PG8_MMA(0, 1, At, B1); PG8_BAR; PG8_SCHED;
            PG8_LDA(At, 1, 1); PG8_STAGE(PG8_SB(1, 0), b3, voffB); PG8_STAGE(PG8_SB(1, 1), b3 + hstep, voffB); PG8_STAGE(PG8_SA(1, 0), a3, voffA);
            PG8_WAIT_V(8); PG8_WAIT_L(0); PG8_BAR; PG8_MMA(1, 0, At, B0); PG8_MMA(1, 1, At, B1); PG8_BAR; PG8_SCHED;
            } else {
            PG8_LDB(B0, 0, 0); PG8_SCHED; PG8_LDA(At, 0, 0); PG8_STAGE(PG8_SA(1, 1), a1 + hstep, voffA);
            PG8_WAIT_L(8); PG8_BAR; PG8_WAIT_L(0); PG8_MMA(0, 0, At, B0); PG8_BAR; PG8_SCHED;
            PG8_LDB(B1, 0, 1); PG8_STAGE(PG8_SB(0, 0), b2, voffB);
            PG8_BAR; PG8_WAIT_L(0); PG8_MMA(0, 1, At, B1); PG8_BAR;
            PG8_LDA(At, 0, 1); PG8_STAGE(PG8_SA(0, 0), a2, voffA);
            PG8_BAR; PG8_WAIT_L(0); PG8_MMA(1, 0, At, B0); PG8_BAR; PG8_SCHED;
            PG8_STAGE(PG8_SB(0, 1), b2 + hstep, voffB);
            PG8_WAIT_V(6); PG8_BAR; PG8_MMA(1, 1, At, B1); PG8_BAR;
            PG8_LDB(B0, 1, 0); PG8_SCHED; PG8_LDA(At, 1, 0); PG8_STAGE(PG8_SA(0, 1), a2 + hstep, voffA);
            PG8_WAIT_L(8); PG8_BAR; PG8_WAIT_L(0); PG8_MMA(0, 0, At, B0); PG8_BAR; PG8_SCHED;
            PG8_LDB(B1, 1, 1); PG8_STAGE(PG8_SB(1, 0), b3, voffB);
            PG8_BAR; PG8_WAIT_L(0); PG8_MMA(0, 1, At, B1); PG8_BAR;
            PG8_LDA(At, 1, 1); PG8_STAGE(PG8_SA(1, 0), a3, voffA);
            PG8_BAR; PG8_WAIT_L(0); PG8_MMA(1, 0, At, B0); PG8_BAR; PG8_SCHED;
            PG8_STAGE(PG8_SB(1, 1), b3 + hstep, voffB);
            PG8_WAIT_V(6); PG8_BAR; PG8_MMA(1, 1, At, B1); PG8_BAR;
            }
        }
        if constexpr (ALIGN_EPI) { if (wr == 0) PG8_BAR; }
        if constexpr (!Epi::AFTER_DRAIN) { E(acc, cur, wr, wc, fr, fq); S.done(cur); }
        if (!has_next) break;
#pragma unroll
        for (int a = 0; a < 2; ++a)
#pragma unroll
            for (int b = 0; b < 2; ++b)
#pragma unroll
                for (int m = 0; m < 4; ++m)
#pragma unroll
                    for (int n = 0; n < 2; ++n) acc[a][b][m][n] = (f32x4){0.f, 0.f, 0.f, 0.f};
        cur = nxt; cA = nA; cB = nB; ++ui;
        if constexpr (ALIGN_EPI) { if (wr == 1) PG8_BAR; }
    }
    PG8_WAIT_V(0);
    if constexpr (!ALIGN_EPI) { if (wr == 0) PG8_BAR; }
    PG8_BAR;
    if constexpr (Epi::AFTER_DRAIN) { E.fused(acc, cur, wr, wc, fr, fq, lds, wid, lane); S.done(cur); }
#undef PG8_SA
#undef PG8_SB
#undef PG8_STAGE
#undef PG8_LDA
#undef PG8_LDB
#undef PG8_MMA
#undef PG8_WAIT_V
#undef PG8_WAIT_L
#undef PG8_BAR
#undef PG8_SCHED
}
}
namespace att {
typedef unsigned short bf16;
using bf16x8 = __attribute__((ext_vector_type(8))) short;
using s16x4 = __attribute__((ext_vector_type(4))) short;
using f32x16 = __attribute__((ext_vector_type(16))) float;
using u32x4 = __attribute__((ext_vector_type(4))) unsigned;
constexpr int SEQ = 4096, NW = 8, QB = 256, KVBLK = 64;
constexpr int KSLOT = 12288, VSLOT = 8192, NKS = 4, NVS = 3;
constexpr int LDS_K = 0, LDS_V = NKS * KSLOT, LDS_WS = LDS_V + NVS * VSLOT, LDS_OST = LDS_WS + NW * 256, LDS_BYTES = LDS_OST + NW * 4096;
constexpr float THR = 8.0f;
#define ATT_LAS __attribute__((address_space(3)))
#define SBAR() __builtin_amdgcn_sched_barrier(0)
#define WAIT_BAR(N) asm volatile("s_waitcnt vmcnt(" #N ") lgkmcnt(0)\n\ts_barrier" ::: "memory")
__device__ __forceinline__ int crow(int r, int hi) { return (r & 3) + 8 * (r >> 2) + 4 * hi; }
__device__ __forceinline__ void glds16(const void* gsrc, unsigned lds_dst) { unsigned keep;
  asm volatile("s_mov_b32 %0, m0\n\ts_mov_b32 m0, %2\n\ts_nop 0\n\tglobal_load_lds_dwordx4 %1, off\n\ts_mov_b32 m0, %0" : "=&s"(keep) : "v"(gsrc), "s"(lds_dst) : "memory"); }
typedef float f32x2_t __attribute__((ext_vector_type(2))); typedef __bf16 bf16x2_t __attribute__((ext_vector_type(2)));
__device__ __forceinline__ unsigned cvtpk_s(float lo, float hi) { f32x2_t v = {lo, hi}; bf16x2_t b = __builtin_convertvector(v, bf16x2_t); return __builtin_bit_cast(unsigned, b); }
typedef ATT_LAS const char* lds_cptr;
#define MX3(a, b, c) __builtin_fmaxf(__builtin_fmaxf((a), (b)), (c))
__device__ __forceinline__ float rowmax(const f32x16& p0, const f32x16& p1) {
  float a = MX3(p0[0], p0[1], p1[0]), b = MX3(p0[2], p0[3], p1[1]); a = MX3(a, p1[2], p1[3]);
#pragma unroll
  for (int r = 4; r < 16; r += 4) { a = MX3(a, p0[r], p0[r + 1]); b = MX3(b, p0[r + 2], p0[r + 3]); a = MX3(a, p1[r], p1[r + 1]); b = MX3(b, p1[r + 2], p1[r + 3]); }
  float m = __builtin_fmaxf(a, b); auto rr = __builtin_amdgcn_permlane32_swap(__float_as_uint(m), __float_as_uint(m), false, false);
  return __builtin_fmaxf(__uint_as_float(rr[0]), __uint_as_float(rr[1])); }
__device__ __forceinline__ void cmask(f32x16& p0, f32x16& p1, int jb, int qrel, int hi) {
  const int kb = 64 * jb + 4 * hi;
#pragma unroll
  for (int r = 0; r < 16; ++r) { const int kv = kb + (r & 3) + 8 * (r >> 2); if (kv > qrel) p0[r] = -INFINITY; if (kv + 32 > qrel) p1[r] = -INFINITY; } }
template <int D0A, int D0B> __device__ __forceinline__ void kload(bf16x8* kf, lds_cptr kp) {
#pragma unroll
  for (int d0 = D0A; d0 < D0B; ++d0) { kf[2 * (d0 - D0A)] = *(const ATT_LAS bf16x8*)(kp + d0 * 2048); kf[2 * (d0 - D0A) + 1] = *(const ATT_LAS bf16x8*)(kp + d0 * 2048 + 512); }
}
template <int ND0, int NPRE> __device__ __forceinline__ void qkt(f32x16& p0, f32x16& p1, const bf16x8* kf, const bf16x8* kt, const bf16x8* qr, const f32x16& negm) {
#pragma unroll
  for (int d0 = 0; d0 < ND0; ++d0) { const bf16x8 b0 = d0 < NPRE ? kf[2 * d0] : kt[2 * (d0 - NPRE)], b1 = d0 < NPRE ? kf[2 * d0 + 1] : kt[2 * (d0 - NPRE) + 1];
    if (d0 == 0) { p0 = __builtin_amdgcn_mfma_f32_32x32x16_bf16(b0, qr[0], negm, 0, 0, 0); p1 = __builtin_amdgcn_mfma_f32_32x32x16_bf16(b1, qr[0], negm, 0, 0, 0); }
    else { p0 = __builtin_amdgcn_mfma_f32_32x32x16_bf16(b0, qr[d0], p0, 0, 0, 0); p1 = __builtin_amdgcn_mfma_f32_32x32x16_bf16(b1, qr[d0], p1, 0, 0, 0); } }
}
__device__ __forceinline__ void pv(f32x16* o, int vb, bf16x8 pa0, bf16x8 pa1, bf16x8 pa2, bf16x8 pa3) {
#pragma unroll
  for (int d0 = 0; d0 < 2; ++d0) { s16x4 lo[4], hi[4];
#pragma unroll
    for (int ks = 0; ks < 4; ++ks) {
      asm volatile("ds_read_b64_tr_b16 %0,%1 offset:%c2" : "=&v"(lo[ks]) : "v"(vb), "i"(d0 * 4096 + ks * 1024) : "memory");
      asm volatile("ds_read_b64_tr_b16 %0,%1 offset:%c2" : "=&v"(hi[ks]) : "v"(vb), "i"(d0 * 4096 + ks * 1024 + 512) : "memory"); }
    asm volatile("s_waitcnt lgkmcnt(0)" ::: "memory"); SBAR();
#define PK(k) (bf16x8){lo[k][0], lo[k][1], lo[k][2], lo[k][3], hi[k][0], hi[k][1], hi[k][2], hi[k][3]}
    o[d0] = __builtin_amdgcn_mfma_f32_32x32x16_bf16(pa0, PK(0), o[d0], 0, 0, 0);
    o[d0] = __builtin_amdgcn_mfma_f32_32x32x16_bf16(pa1, PK(1), o[d0], 0, 0, 0);
    o[d0] = __builtin_amdgcn_mfma_f32_32x32x16_bf16(pa2, PK(2), o[d0], 0, 0, 0);
    o[d0] = __builtin_amdgcn_mfma_f32_32x32x16_bf16(pa3, PK(3), o[d0], 0, 0, 0);
#undef PK
  }
}
struct AttnT { const bf16* Q; const bf16* K; const bf16* KR; const bf16* V; bf16* O; const float* CS; };
template <int KIND, int ABL = 0> __device__ __forceinline__ void attn_unit(int b, int h, int qb, const AttnT& T, char* shm) {
#ifndef ATT_NPRE0
#define ATT_NPRE0 2
#endif
#ifndef ATT_NPRE1
#define ATT_NPRE1 3
#endif
  constexpr int NPRE = KIND == 0 ? ATT_NPRE0 : ATT_NPRE1;
  constexpr int ND0 = KIND == 0 ? 6 : 5, QP = KIND == 0 ? 768 : 640, HD = KIND == 0 ? 96 : 80;
  const int tid = threadIdx.x, lane = tid & 63, r32 = lane & 31, hi = lane >> 5; const int wid = __builtin_amdgcn_readfirstlane(tid >> 6);
  const long rowbase = (long)b * SEQ; const int q0 = qb * QB;
  const bf16* Qw = T.Q + (rowbase + q0 + wid * 32) * QP + h * HD;
  const unsigned lds0 = (unsigned)(uintptr_t)shm;
  const lds_cptr shm3 = (lds_cptr)shm;
  ATT_LAS float* wsf = (ATT_LAS float*)(shm3 + LDS_WS) + wid * 64;
  const bf16 *ksrcA, *ksrcB; long kstepA, kstepB; unsigned kdstB;
  const unsigned kdstA = lds0 + LDS_K + wid * 1024;
  if (KIND == 0) { ksrcA = T.K + (rowbase + lane) * 512 + h * 64 + wid * 8; ksrcB = T.KR + (rowbase + lane) * 32 + (wid & 3) * 8; kdstB = lds0 + LDS_K + (8 + (wid & 3)) * 1024; kstepA = 64 * 512; kstepB = 64 * 32; }
  else { ksrcA = T.K + (rowbase + lane) * 640 + h * 80 + wid * 8; ksrcB = T.K + (rowbase + lane) * 640 + h * 80 + (8 + (wid & 1)) * 8; kdstB = lds0 + LDS_K + (8 + (wid & 1)) * 1024; kstepA = 64 * 640; kstepB = 64 * 640; }
  const bf16* vsrc = T.V + (rowbase + 16 * (wid & 3) + (lane >> 2)) * 512 + h * 64 + (wid >> 2) * 32 + (lane & 3) * 8;
  const unsigned vdst = lds0 + LDS_V + wid * 1024;
#define DMA_K(t, s) do { glds16(ksrcA + (long)(t) * kstepA, (unsigned)__builtin_amdgcn_readfirstlane(kdstA + (s) * KSLOT)); \
                         glds16(ksrcB + (long)(t) * kstepB, (unsigned)__builtin_amdgcn_readfirstlane(kdstB + (s) * KSLOT)); } while (0)
#define DMA_V(t, s) do { glds16(vsrc + (long)(t) * (64 * 512), (unsigned)__builtin_amdgcn_readfirstlane(vdst + (s) * VSLOT)); } while (0)
  const int vb0 = (int)(lds0 + LDS_V) + ((lane >> 4) & 1) * 32 + (lane & 3) * 8 + (4 * hi + ((lane & 15) >> 2)) * 64;
  const lds_cptr kp0 = shm3 + LDS_K + hi * 1024 + r32 * 16;
  const int NT = (q0 + QB) / KVBLK;
  DMA_K(0, 0); DMA_V(0, 0); DMA_K(1, 1); DMA_V(1, 1); DMA_K(2, 2);
  bf16x8 qr[ND0];
#pragma unroll
  for (int d0 = 0; d0 < ND0; ++d0) qr[d0] = *reinterpret_cast<const bf16x8*>(&Qw[(long)r32 * QP + d0 * 16 + hi * 8]);
  if (KIND == 0) {
    const float* cs = T.CS + (rowbase + q0 + wid * 32 + r32) * 32 + 16 * hi;
    typedef float f32x4_t __attribute__((ext_vector_type(4)));
    bf16x8 a = qr[4], c = qr[5];
#pragma unroll
    for (int j2 = 0; j2 < 4; ++j2) { const f32x4_t t4 = *(const f32x4_t*)(cs + 4 * j2);
#pragma unroll
      for (int e = 0; e < 2; ++e) { const int j = 2 * j2 + e; const float co = t4[2 * e], si = t4[2 * e + 1];
        const float x1 = __builtin_bit_cast(float, (unsigned)(unsigned short)a[j] << 16), x2 = __builtin_bit_cast(float, (unsigned)(unsigned short)c[j] << 16);
        const float o1 = x1 * co - x2 * si, o2 = x2 * co + x1 * si;
        qr[4][j] = (short)(cvtpk_s(o1, o1) & 0xffffu); qr[5][j] = (short)(cvtpk_s(o2, o2) & 0xffffu); } }
  }
  float mhat = 0.f, l_reg = 0.f; f32x16 o[2]; o[0] = f32x16{}; o[1] = f32x16{}; f32x16 negm = f32x16{};
  const int qrel = wid * 32 + r32;
  int ks_cur = 0, vs_cur = 0;
  bf16x8 kf[2 * NPRE];
  WAIT_BAR(6);
  kload<0, NPRE>(kf, kp0);
  u32x4 pw0, pw1, pw2, pw3;
  for (int t = 0; t < NT; ++t) {
    if (t + 2 < NT) { WAIT_BAR(3); } else if (t + 1 < NT) { WAIT_BAR(1); } else { WAIT_BAR(0); }
    const int ks1 = (ks_cur + 1) & 3, vs1 = (vs_cur == 2) ? 0 : vs_cur + 1, vs2 = (vs_cur == 0) ? 2 : vs_cur - 1;
    if (t + 2 < NT) { DMA_V(t + 2, vs2); }
    if (t + 3 < NT) { DMA_K(t + 3, ((ks_cur + 3) & 3)); }
    const int jb = t - 4 * qb;
    const bool vis = (KIND == 0) ? (t <= 4 * qb + (wid >> 1)) : ((jb < 0) || (64 * jb <= 32 * wid + 31));
    f32x16 p0, p1;
    if (vis) {
      bf16x8 kt[2 * (ND0 - NPRE)]; kload<NPRE, ND0>(kt, kp0 + ks_cur * KSLOT);
      if (ABL & 4) { p0 = negm; p1 = negm; asm volatile("" : "+v"(p0), "+v"(p1)); } else qkt<ND0, NPRE>(p0, p1, kf, kt, qr, negm);
    }
    if (t + 1 < NT) kload<0, NPRE>(kf, kp0 + ks1 * KSLOT);
    if (vis) {
      if (KIND == 1) { if (jb >= 0) cmask(p0, p1, jb, qrel, hi); }
      const float rm = rowmax(p0, p1);
      if (t == 0 || __any(rm > THR)) {
        const float dl = (t == 0) ? rm : __builtin_fmaxf(rm, 0.f);
        mhat += dl;
#pragma unroll
        for (int r = 0; r < 16; ++r) { p0[r] -= dl; p1[r] -= dl; negm[r] = -mhat; }
        const float f = __builtin_amdgcn_exp2f(-dl); l_reg *= f;
        if (t > 0) {
          if (hi == 0) wsf[r32] = f;
          asm volatile("s_waitcnt lgkmcnt(0)" ::: "memory");
#pragma unroll
          for (int d_ = 0; d_ < 2; ++d_)
#pragma unroll
            for (int r = 0; r < 16; ++r) o[d_][r] *= wsf[crow(r, hi)];
          asm volatile("s_waitcnt lgkmcnt(0)" ::: "memory");
        }
      }
      float sacc = 0.f;
#pragma unroll
      for (int r = 0; r < 16; ++r) { if (!(ABL & 2)) { p0[r] = __builtin_amdgcn_exp2f(p0[r]); p1[r] = __builtin_amdgcn_exp2f(p1[r]); } sacc += p0[r] + p1[r]; }
      l_reg += sacc;
#define PKW(P, B) cvtpk_s(P[B], P[B + 1])
      pw0 = (u32x4){PKW(p0, 0), PKW(p0, 2), PKW(p0, 4), PKW(p0, 6)}; pw1 = (u32x4){PKW(p0, 8), PKW(p0, 10), PKW(p0, 12), PKW(p0, 14)};
      pw2 = (u32x4){PKW(p1, 0), PKW(p1, 2), PKW(p1, 4), PKW(p1, 6)}; pw3 = (u32x4){PKW(p1, 8), PKW(p1, 10), PKW(p1, 12), PKW(p1, 14)};
#undef PKW
      SBAR();
      if (ABL & 1) { asm volatile("" :: "v"(pw0), "v"(pw1), "v"(pw2), "v"(pw3)); }
      else pv(o, vb0 + vs_cur * VSLOT, __builtin_bit_cast(bf16x8, pw0), __builtin_bit_cast(bf16x8, pw1), __builtin_bit_cast(bf16x8, pw2), __builtin_bit_cast(bf16x8, pw3));
    }
    ks_cur = ks1; vs_cur = vs1;
  }
  { auto rr = __builtin_amdgcn_permlane32_swap(__float_as_uint(l_reg), __float_as_uint(l_reg), false, false); l_reg = __uint_as_float(rr[0]) + __uint_as_float(rr[1]); }
  if (hi == 0) wsf[32 + r32] = l_reg;
  asm volatile("s_waitcnt lgkmcnt(0)" ::: "memory");
  float rli[16];
#pragma unroll
  for (int r = 0; r < 16; ++r) rli[r] = __builtin_amdgcn_rcpf(wsf[32 + crow(r, hi)]);
  bf16* Ow = T.O + (rowbase + q0 + wid * 32) * 1024 + h * 64;
  { ATT_LAS bf16* stg = (ATT_LAS bf16*)(shm3 + LDS_OST) + wid * 2048;
#pragma unroll
    for (int r = 0; r < 16; ++r) { const int orow = crow(r, hi);
#pragma unroll
      for (int d0 = 0; d0 < 2; ++d0) { const float v = o[d0][r] * rli[r]; stg[orow * 64 + d0 * 32 + r32] = (bf16)(cvtpk_s(v, v) & 0xffffu); } }
    asm volatile("s_waitcnt lgkmcnt(0)" ::: "memory");
#pragma unroll
    for (int i = 0; i < 4; ++i) { const int row = i * 8 + (lane >> 3), ch = lane & 7; const u32x4 v = *(const ATT_LAS u32x4*)(stg + row * 64 + ch * 8); *(u32x4*)(Ow + (long)row * 1024 + ch * 8) = v; } }
  asm volatile("s_waitcnt lgkmcnt(0)\n\ts_barrier" ::: "memory");
#undef DMA_K
#undef DMA_V
}
#undef SBAR
#undef WAIT_BAR
#undef MX3
}
#ifndef MK_PER_PHASE
#define MK_PER_PHASE 0
#endif
constexpr int NWAVES = 8;
constexpr int BATCH = 8, SEQ = 4096, DM = 1024, M = BATCH * SEQ;
constexpr int NIN = 4096;
constexpr int NEXP = 32, XG_ROWS = 2 * M + NEXP * 256;
constexpr float EPS = 1e-6f, LOG2E = 1.4426950408889634f;
constexpr float C2F = 0.125f * LOG2E;
constexpr float C2M = 0.10206207261596577f * LOG2E;
constexpr int N_PHASES = 14;
constexpr size_t MiB = 1u << 20;
constexpr size_t WS_CTL = 0, CTL_ZERO_BYTES = 1 * MiB;
constexpr size_t WS_WIN = 1 * MiB, WS_WUQ = 9 * MiB, WS_WUKV = 9 * MiB + 512 * 1024, WS_WOA = 10 * MiB, WS_WOB = 11 * MiB, WS_WOUT = 12 * MiB, WS_WR = 14 * MiB, WS_WGU = 15 * MiB, WS_WDN = 47 * MiB;
constexpr size_t WS_CS = 63 * MiB, WS_LOGF = 67 * MiB, WS_EID = 68 * MiB, WS_SLOT = WS_EID + 256 * 1024, WS_WGT = WS_SLOT + 256 * 1024, WS_POS = WS_WGT + 256 * 1024, WS_WROW = 69 * MiB;
constexpr size_t WS_XN = 72 * MiB, WS_CQN = 72 * MiB, WS_CKVN = 88 * MiB, WS_VM = 96 * MiB, WS_KR = 128 * MiB;
constexpr size_t WS_Z0 = 136 * MiB, WS_Z1 = 152 * MiB, WS_QF = 184 * MiB, WS_KF = 224 * MiB, WS_VF = 264 * MiB, WS_OA = 296 * MiB, WS_OB = 328 * MiB, WS_MIX = 360 * MiB, WS_QM = 424 * MiB, WS_KM = 472 * MiB;
constexpr size_t WS_HN = 72 * MiB, WS_LG = 200 * MiB, WS_XG = 232 * MiB, WS_ACT = 376 * MiB, WS_YB = 72 * MiB, WS_END = 504 * MiB;
static_assert(WS_XG + (size_t)XG_ROWS * 2048 <= WS_ACT && WS_ACT + (size_t)XG_ROWS * 512 <= WS_END && WS_YB + (size_t)XG_ROWS * 2048 <= WS_XG, "moe map");
constexpr int CW_CNT = 8192;
constexpr int CW_TPRE = 128;
constexpr int CW_BAR = 4096;
constexpr int RING_OFF = 0, RING_BYTES = 131072, LDSCTL_OFF = RING_BYTES, MISC_OFF = LDSCTL_OFF + 320, TP_OFF = LDSCTL_OFF + 1024, LDS_BYTES = 147456;

#define GAS __attribute__((address_space(1)))
#define LAS __attribute__((address_space(3)))
typedef unsigned short bf16;
typedef unsigned v4u __attribute__((ext_vector_type(4)));
typedef float f32x4 __attribute__((ext_vector_type(4)));
typedef short bf16x8 __attribute__((ext_vector_type(8)));
typedef GAS unsigned gu32;
typedef GAS unsigned long long gu64;
#define RLX_AGENT __ATOMIC_RELAXED, __HIP_MEMORY_SCOPE_AGENT
#define LDS_WAIT() asm volatile("s_waitcnt lgkmcnt(0)" ::: "memory")
#define VM_WAIT() asm volatile("s_waitcnt vmcnt(0)" ::: "memory")
__device__ __forceinline__ unsigned long long rt() { return __builtin_amdgcn_s_memrealtime(); }
__device__ __forceinline__ unsigned f2bf(float f) { unsigned u = __builtin_bit_cast(unsigned, f); return (u + 0x7fffu + ((u >> 16) & 1u)) >> 16; }
__device__ __forceinline__ unsigned pk2(float lo, float hi) { return f2bf(lo) | (f2bf(hi) << 16); }


#define XB_TMO      128
#define XB_XCNT(j)  (256  + 64 * (j))
#define XB_XSUB(j)  (1280 + 64 * (j))
#define XB_XGEN(j)  (2304 + 64 * (j))
#define XB_TOP      3328
#define XB_TOPGEN   3392
#define XCD_BAR_WORDS 3456
#define XB_SPIN_CAP (1u << 18)

__device__ __forceinline__ unsigned xb_ld(unsigned* p)              { return __hip_atomic_load(p, __ATOMIC_RELAXED, __HIP_MEMORY_SCOPE_AGENT); }
__device__ __forceinline__ unsigned xb_add(unsigned* p, unsigned v) { return __hip_atomic_fetch_add(p, v, __ATOMIC_RELAXED, __HIP_MEMORY_SCOPE_AGENT); }
__device__ __forceinline__ unsigned xb_xcc_id() { return (unsigned)__builtin_amdgcn_s_getreg((3 << 11) | 20) & 0xFu; }
#define XB_SPIN(cond, bar) do { unsigned _sp = 0; while (cond) { __builtin_amdgcn_s_sleep(1); \
    if ((++_sp & 255u) == 0u) { if (xb_ld(&(bar)[XB_TMO])) break; if (_sp > XB_SPIN_CAP) { atomicAdd(&(bar)[XB_TMO], 1u); break; } } } } while (0)

struct XcdBarrier {
    unsigned* bar; unsigned x;
    volatile LAS unsigned* st;
};

__device__ __forceinline__ XcdBarrier xcd_barrier_post(unsigned* bar, volatile LAS unsigned* st) {
    XcdBarrier b; b.bar = bar; b.x = xb_xcc_id(); b.st = st;
    if (threadIdx.x == 0) (void)xb_add(&bar[XB_XCNT(b.x)], 1u);
    return b;
}
__device__ __forceinline__ void xcd_barrier_complete(unsigned* bar, unsigned x, unsigned& nloc, unsigned& nx) {
    const unsigned G = gridDim.x * gridDim.y * gridDim.z;
    unsigned sum, cnt, mine, sp = 0u;
    for (;;) {
        sum = 0u; cnt = 0u; mine = 0u;
#pragma unroll
        for (unsigned j = 0; j < 16; ++j) { const unsigned c = xb_ld(&bar[XB_XCNT(j)]); sum += c; cnt += (c > 0u) ? 1u : 0u; mine = (j == x) ? c : mine; }
        if (sum == G) break;
        __builtin_amdgcn_s_sleep(1);
        if ((++sp & 255u) == 0u) { if (xb_ld(&bar[XB_TMO])) break; if (sp > XB_SPIN_CAP) { atomicAdd(&bar[XB_TMO], 1u); break; } }
    }
    nloc = mine > 0u ? mine : 1u; nx = cnt > 0u ? cnt : 1u;
}

__device__ __forceinline__ void xcd_barrier(const XcdBarrier& b) {
    asm volatile("s_waitcnt vmcnt(0)" ::: "memory");
    __syncthreads();
    if (threadIdx.x == 0) {
        unsigned* bar = b.bar;
        __builtin_amdgcn_s_waitcnt(0);
        unsigned nloc = b.st[0], nx = b.st[1];
        if (nloc == 0u) { xcd_barrier_complete(bar, b.x, nloc, nx); b.st[0] = nloc; b.st[1] = nx; }
        const unsigned old = xb_add(&bar[XB_XSUB(b.x)], 1u);
        const unsigned gen = old / nloc;
        if (old + 1u == (gen + 1u) * nloc) {
            __builtin_amdgcn_fence(__ATOMIC_RELEASE, "agent");
            asm volatile("s_waitcnt vmcnt(0)" ::: "memory");
            const unsigned og = xb_add(&bar[XB_TOP], 1u);
            const unsigned tg = og / nx;
            if (og + 1u == (tg + 1u) * nx) xb_add(&bar[XB_TOPGEN], 1u);
            else XB_SPIN(xb_ld(&bar[XB_TOPGEN]) == tg, bar);
            __builtin_amdgcn_fence(__ATOMIC_ACQUIRE, "agent");
            xb_add(&bar[XB_XGEN(b.x)], 1u);
            asm volatile("s_waitcnt vmcnt(0)" ::: "memory");
        } else {
            XB_SPIN(xb_ld(&bar[XB_XGEN(b.x)]) == gen, bar);
            __builtin_amdgcn_fence(__ATOMIC_ACQUIRE, "agent");
            asm volatile("s_waitcnt vmcnt(0)" ::: "memory");
        }
    }
    __syncthreads();
}


typedef unsigned v2u __attribute__((ext_vector_type(2)));
__device__ __forceinline__ float wave_sum(float v) {
#pragma unroll
    for (int o = 1; o < 64; o <<= 1) v += __shfl_xor(v, o);
    return v;
}
__device__ __forceinline__ float bf2f(unsigned short b) { return __builtin_bit_cast(float, (unsigned)b << 16); }
__device__ __forceinline__ float bflo(unsigned w) { return __builtin_bit_cast(float, w << 16); }
__device__ __forceinline__ float bfhi(unsigned w) { return __builtin_bit_cast(float, w & 0xffff0000u); }
__device__ __forceinline__ v4u pack8(f32x4 a, f32x4 b) { v4u w; w.x = pg8::cvt_pk_bf16(a[0], a[1]); w.y = pg8::cvt_pk_bf16(a[2], a[3]); w.z = pg8::cvt_pk_bf16(b[0], b[1]); w.w = pg8::cvt_pk_bf16(b[2], b[3]); return w; }
__device__ __forceinline__ float sigmoidf_(float x) { return __builtin_amdgcn_rcpf(1.0f + __builtin_amdgcn_exp2f(-x * LOG2E)); }

using pg8::Unit;
#define EPI_ROWS(...) int rb_ = u.pm * 256 + wr * 64 + fr; asm volatile("" : "+v"(rb_)); _Pragma("unroll") for (int ai = 0; ai < 2; ++ai) _Pragma("unroll") for (int m = 0; m < 4; ++m) { const size_t row = (size_t)(rb_ + ai * 128 + m * 16); \
        _Pragma("unroll") for (int bj = 0; bj < 2; ++bj) { const f32x4 v0 = acc[ai][bj][m][0], v1 = acc[ai][bj][m][1]; __VA_ARGS__ } }
struct EpiIn { static constexpr bool PERM = true, AFTER_DRAIN = false, MID = false;
    bf16* Z0; float* Z1; bf16 *QF, *KF, *VF, *GA, *GB;
    __device__ __forceinline__ void operator()(const f32x4 (&acc)[2][2][4][2], const Unit& u, int wr, int wc, int fr, int fq) const {
        const int pn = u.pn;
        EPI_ROWS({ const int ct = bj * 128 + wc * 32 + 8 * fq;
            if (pn == 0) { *(v4u*)(Z0 + row * 256 + ct) = pack8(v0, v1); }
            else if (pn == 1) { float* p = Z1 + row * 256 + ct; *(f32x4*)p = v0; *(f32x4*)(p + 4) = v1; }
            else if (pn < 4) { const int c = (pn - 2) * 256 + ct; *(v4u*)(QF + row * 640 + (c >> 6) * 80 + (c & 63)) = pack8(v0 * C2F, v1 * C2F); }
            else if (pn < 6) { const int c = (pn - 4) * 256 + ct; *(v4u*)(KF + row * 640 + (c >> 6) * 80 + (c & 63)) = pack8(v0, v1); }
            else if (pn < 8) { const int c = (pn - 6) * 256 + ct; *(v4u*)(VF + row * 512 + c) = pack8(v0, v1); }
            else { bf16* G = pn < 12 ? GA : GB; const int c = ((pn - 8) & 3) * 256 + ct; f32x4 s0, s1;
                _Pragma("unroll") for (int e = 0; e < 4; ++e) { s0[e] = sigmoidf_(v0[e]); s1[e] = sigmoidf_(v1[e]); }
                *(v4u*)(G + row * 1024 + c) = pack8(s0, s1); } })
    }
};
struct EpiQup { static constexpr bool PERM = true, AFTER_DRAIN = false, MID = false;
    bf16* QM;
    __device__ __forceinline__ void operator()(const f32x4 (&acc)[2][2][4][2], const Unit& u, int wr, int wc, int fr, int fq) const {
        EPI_ROWS({ const int ct = u.pn * 256 + bj * 128 + wc * 32 + 8 * fq; *(v4u*)(QM + row * 768 + ct) = pack8(v0 * C2M, v1 * C2M); })
    }
};
struct EpiKVup { static constexpr bool PERM = true, AFTER_DRAIN = false, MID = false;
    bf16 *KM, *VM;
    __device__ __forceinline__ void operator()(const f32x4 (&acc)[2][2][4][2], const Unit& u, int wr, int wc, int fr, int fq) const {
        bf16* D = u.pn < 2 ? KM : VM; const int c0 = (u.pn & 1) * 256;
        EPI_ROWS({ const int ct = bj * 128 + wc * 32 + 8 * fq; *(v4u*)(D + row * 512 + c0 + ct) = pack8(v0, v1); })
    }
};
struct EpiMix { static constexpr bool PERM = true, AFTER_DRAIN = false, MID = true;
    const bf16 *GA_, *GB_; bf16* MIX_;
    __device__ __forceinline__ void mid(f32x4 (&acc)[2][2][4][2], const Unit& u, int wr, int wc, int fr, int fq) const {
        int rb_ = u.pm * 256 + wr * 64 + fr; asm volatile("" : "+v"(rb_));
#pragma unroll
        for (int ai = 0; ai < 2; ++ai) { v4u ga[4][2], gb[4][2];
#pragma unroll
            for (int m = 0; m < 4; ++m)
#pragma unroll
                for (int bj = 0; bj < 2; ++bj) { const size_t off = (size_t)(rb_ + ai * 128 + m * 16) * 1024 + u.pn * 256 + bj * 128 + wc * 32 + 8 * fq; ga[m][bj] = *(const v4u*)(GA_ + off); gb[m][bj] = *(const v4u*)(GB_ + off); }
#pragma unroll
            for (int m = 0; m < 4; ++m)
#pragma unroll
                for (int bj = 0; bj < 2; ++bj) { const v4u a = ga[m][bj], b = gb[m][bj];
                    const f32x4 r0 = {bflo(a.x) * __builtin_amdgcn_rcpf(bflo(b.x)), bfhi(a.x) * __builtin_amdgcn_rcpf(bfhi(b.x)), bflo(a.y) * __builtin_amdgcn_rcpf(bflo(b.y)), bfhi(a.y) * __builtin_amdgcn_rcpf(bfhi(b.y))};
                    const f32x4 r1 = {bflo(a.z) * __builtin_amdgcn_rcpf(bflo(b.z)), bfhi(a.z) * __builtin_amdgcn_rcpf(bfhi(b.z)), bflo(a.w) * __builtin_amdgcn_rcpf(bflo(b.w)), bfhi(a.w) * __builtin_amdgcn_rcpf(bfhi(b.w))};
                    acc[ai][bj][m][0] *= r0; acc[ai][bj][m][1] *= r1; }
            asm volatile("" ::: "memory"); }
    }
    __device__ __forceinline__ void operator()(const f32x4 (&acc)[2][2][4][2], const Unit& u, int wr, int wc, int fr, int fq) const {
        EPI_ROWS({ const size_t off = row * 1024 + u.pn * 256 + bj * 128 + wc * 32 + 8 * fq; const v4u g = *(const v4u*)(GB_ + off);
            const f32x4 r0 = {bflo(g.x) * v0[0], bfhi(g.x) * v0[1], bflo(g.y) * v0[2], bfhi(g.y) * v0[3]}; const f32x4 r1 = {bflo(g.z) * v1[0], bfhi(g.z) * v1[1], bflo(g.w) * v1[2], bfhi(g.w) * v1[3]};
            *(v4u*)(MIX_ + off) = pack8(r0, r1); })
    }
};
struct EpiY { static constexpr bool PERM = true, AFTER_DRAIN = false, MID = false;
    bf16* Y_;
    __device__ __forceinline__ void operator()(const f32x4 (&acc)[2][2][4][2], const Unit& u, int wr, int wc, int fr, int fq) const {
        EPI_ROWS({ *(v4u*)(Y_ + row * 1024 + u.pn * 256 + bj * 128 + wc * 32 + 8 * fq) = pack8(v0, v1); })
    }
};
struct EpiLg { static constexpr bool PERM = true, AFTER_DRAIN = false, MID = false;
    float* LG;
    __device__ __forceinline__ void operator()(const f32x4 (&acc)[2][2][4][2], const Unit& u, int wr, int wc, int fr, int fq) const {
        EPI_ROWS({ if (bj == 0) { float* p = LG + row * 128 + wc * 32 + 8 * fq; *(f32x4*)p = v0; *(f32x4*)(p + 4) = v1; } })
    }
};
struct EpiGU { static constexpr bool PERM = true, AFTER_DRAIN = false, MID = false;
    bf16* ACT;
    __device__ __forceinline__ void operator()(const f32x4 (&acc)[2][2][4][2], const Unit& u, int wr, int wc, int fr, int fq) const {
        const int c0 = (u.pn & 1) * 128 + wc * 32 + 8 * fq; int rb_ = u.pm * 256 + wr * 64 + fr; asm volatile("" : "+v"(rb_));
#pragma unroll
        for (int ai = 0; ai < 2; ++ai)
#pragma unroll
            for (int m = 0; m < 4; ++m) { const size_t row = (size_t)(rb_ + ai * 128 + m * 16); f32x4 a0, a1;
#pragma unroll
                for (int e = 0; e < 4; ++e) { const float g0 = acc[ai][0][m][0][e], g1 = acc[ai][0][m][1][e]; a0[e] = g0 * sigmoidf_(g0) * acc[ai][1][m][0][e]; a1[e] = g1 * sigmoidf_(g1) * acc[ai][1][m][1][e]; }
                *(v4u*)(ACT + row * 256 + c0) = pack8(a0, a1); }
    }
};
struct EpiDown { static constexpr bool PERM = true, AFTER_DRAIN = false, MID = false;
    bf16* YB; const float* WROW;
    __device__ __forceinline__ void operator()(const f32x4 (&acc)[2][2][4][2], const Unit& u, int wr, int wc, int fr, int fq) const {
        const int c0 = (u.pn & 3) * 256;
        EPI_ROWS({ const float w = WROW[row]; *(v4u*)(YB + row * 1024 + c0 + bj * 128 + wc * 32 + 8 * fq) = pack8(v0 * w, v1 * w); })
    }
};
struct ExpertOrder {
    const LAS unsigned* tpre; int NJ, G, c;
    __device__ __forceinline__ bool next(int i, Unit& u) const {
        const int total = (int)tpre[NEXP] * NJ; const long L = (long)i * G + c; if (L >= total) return false;
        const int T = (int)L / NJ, j = (int)L % NJ; int e = 0;
#pragma unroll 1
        for (int k = 1; k < NEXP; ++k) e += ((int)tpre[k] <= T) ? 1 : 0;
        u.pm = T; u.pn = e * NJ + j; return true;
    }
    __device__ __forceinline__ void a_ready(const Unit&) const {}
    __device__ __forceinline__ void done(const Unit&) const {}
};

__device__ __forceinline__ void tr_item(const float* colp, int N, int k0, bf16* dst  , int K, bool lo, LAS float* scr, int lane) {
#pragma unroll 8
    for (int i = 0; i < 32; ++i) { const int kk = 2 * i + (lane >> 5); float v = colp ? colp[(size_t)(k0 + kk) * N] : 0.f;
        if (lo) v = v - bf2f((unsigned short)f2bf(v));
        scr[kk * 33 + (lane & 31)] = v; }
    LDS_WAIT(); asm volatile("" ::: "memory");
    const int c = lane & 7;
#pragma unroll
    for (int j = 0; j < 4; ++j) { const int n = (lane >> 3) + 8 * j; const LAS float* s = scr + (8 * c) * 33 + n;
        v4u o; o.x = pk2(s[0 * 33], s[1 * 33]); o.y = pk2(s[2 * 33], s[3 * 33]); o.z = pk2(s[4 * 33], s[5 * 33]); o.w = pk2(s[6 * 33], s[7 * 33]);
        *(GAS v4u*)(dst + (size_t)n * K + 8 * c) = o; }
    LDS_WAIT(); asm volatile("" ::: "memory");
}
__device__ __forceinline__ void tr_item4(const float* cp4, int N, bf16* dst  , int K, LAS float* scr, int lane) {
    const int c = lane & 7, kr0 = lane >> 3; f32x4 v[8];
#pragma unroll
    for (int i = 0; i < 8; ++i) v[i] = cp4 ? *(const f32x4*)(cp4 + (size_t)(8 * i) * N) : (f32x4){0.f, 0.f, 0.f, 0.f};
#pragma unroll
    for (int i = 0; i < 8; ++i) { LAS float* s = scr + (kr0 + 8 * i) * 33 + 4 * c; s[0] = v[i].x; s[1] = v[i].y; s[2] = v[i].z; s[3] = v[i].w; }
    LDS_WAIT(); asm volatile("" ::: "memory");
#pragma unroll
    for (int j = 0; j < 4; ++j) { const int n = kr0 + 8 * j; const LAS float* s = scr + (8 * c) * 33 + n;
        v4u o; o.x = pk2(s[0 * 33], s[1 * 33]); o.y = pk2(s[2 * 33], s[3 * 33]); o.z = pk2(s[4 * 33], s[5 * 33]); o.w = pk2(s[6 * 33], s[7 * 33]);
        *(GAS v4u*)(dst + (size_t)n * K + 8 * c) = o; }
    LDS_WAIT(); asm volatile("" ::: "memory");
}
__device__ __forceinline__ double inv_freq_d(int i) {
    const int q = i >> 2, r = i & 3;
    const double a = q == 0 ? 1.0 : q == 1 ? 0.1 : q == 2 ? 0.01 : 0.001;
    const double b = r == 0 ? 1.0 : r == 1 ? 0.5623413251903491 : r == 2 ? 0.31622776601683794 : 0.1778279410038923;
    return a * b;
}

struct Args { const float* in[22]; float* out; unsigned char* ws; int ph_lo, ph_hi; };

__global__ void __launch_bounds__(NWAVES * 64, 2) mk_fwd(Args args) {
    extern __shared__ __attribute__((aligned(16))) unsigned char lds[];
    LAS unsigned char* const L = (LAS unsigned char*)lds;
    volatile LAS unsigned* const MISC = (volatile LAS unsigned*)(L + MISC_OFF);
    const int tid = threadIdx.x, lane = tid & 63, wave = __builtin_amdgcn_readfirstlane(tid >> 6);
    const int G = gridDim.x; const int bx = blockIdx.x; const int vcu = (G % 8 == 0) ? (bx % 8) * (G / 8) + bx / 8 : bx;
    const int gw = vcu * NWAVES + wave, NGW = G * NWAVES;
    unsigned char* const ws = args.ws;
    gu32* const ctl = (gu32*)(ws + WS_CTL);
    const float* x = args.in[0]; const int* positions = (const int*)args.in[1]; const float* g_mix = args.in[2]; const float* w_in = args.in[3]; const float* b_forget = args.in[4];
    const float* g_cq = args.in[5]; const float* g_ckv = args.in[6]; const float* w_uq = args.in[7]; const float* w_uk = args.in[8]; const float* w_uv = args.in[9];
    const float* w_o_mla = args.in[10]; const float* w_o_fox = args.in[11]; const float* w_out = args.in[12]; const float* g_ffn = args.in[13]; const float* w_group = args.in[14];
    const float* b_group = args.in[15]; const float* w_router = args.in[16]; const float* b_router = args.in[17]; const float* w_e_gate = args.in[18]; const float* w_e_up = args.in[19];
    const float* w_e_down = args.in[20]; const float* g_final = args.in[21];
    float* const out = args.out;
#define WIN ((bf16*)(ws + WS_WIN))
#define WUQ ((bf16*)(ws + WS_WUQ))
#define WUKV ((bf16*)(ws + WS_WUKV))
#define WOA ((bf16*)(ws + WS_WOA))
#define WOB ((bf16*)(ws + WS_WOB))
#define WOUT ((bf16*)(ws + WS_WOUT))
#define WR ((bf16*)(ws + WS_WR))
#define WGU ((bf16*)(ws + WS_WGU))
#define WDN ((bf16*)(ws + WS_WDN))
#define CS ((float*)(ws + WS_CS))
#define LOGF ((float*)(ws + WS_LOGF))
#define EID ((int*)(ws + WS_EID))
#define SLOT ((int*)(ws + WS_SLOT))
#define WGT ((float*)(ws + WS_WGT))
#define POS ((int*)(ws + WS_POS))
#define WROW ((float*)(ws + WS_WROW))
#define XN ((bf16*)(ws + WS_XN))
#define CQN ((bf16*)(ws + WS_CQN))
#define CKVN ((bf16*)(ws + WS_CKVN))
#define VM ((bf16*)(ws + WS_VM))
#define KR ((bf16*)(ws + WS_KR))
#define Z0 ((bf16*)(ws + WS_Z0))
#define Z1 ((float*)(ws + WS_Z1))
#define QF ((bf16*)(ws + WS_QF))
#define KF ((bf16*)(ws + WS_KF))
#define VF ((bf16*)(ws + WS_VF))
#define OA ((bf16*)(ws + WS_OA))
#define OB ((bf16*)(ws + WS_OB))
#define MIX ((bf16*)(ws + WS_MIX))
#define QM ((bf16*)(ws + WS_QM))
#define KM ((bf16*)(ws + WS_KM))
#define HN ((bf16*)(ws + WS_HN))
#define LG ((float*)(ws + WS_LG))
#define XG ((bf16*)(ws + WS_XG))
#define ACT ((bf16*)(ws + WS_ACT))
#define YB ((bf16*)(ws + WS_YB))
#define GA ((bf16*)out)
#define GB ((bf16*)out + (size_t)M * 1024)
#define YM ((bf16*)(ws + WS_QM))

    for (int u = tid; u < (LDS_BYTES - LDSCTL_OFF) / 4; u += NWAVES * 64) ((LAS unsigned*)(L + LDSCTL_OFF))[u] = 0u;
    __syncthreads();
    XcdBarrier bar; bar.bar = (unsigned*)(ctl + CW_BAR); bar.x = 0; bar.st = nullptr;
    if (!MK_PER_PHASE) bar = xcd_barrier_post((unsigned*)(ctl + CW_BAR), MISC + 8);
    const int lo = args.ph_lo, hi = args.ph_hi;
#ifndef MK_REPEAT
#define MK_REPEAT -1
#endif
#ifndef MK_ONLY
#define MK_ONLY -1
#endif
#define IN(k) ((MK_ONLY < 0 || MK_ONLY == (k)) && lo <= (k) && (k) < hi)
#define SEAM(k) do { if (IN(k) && IN((k) + 1)) { if ((k) == 0) { cooperative_groups::this_grid().sync(); } else { xcd_barrier(bar); } } } while (0)

    if (IN(0)) for (int rep_ = 0; rep_ < ((MK_REPEAT == 0) ? 2 : 1); ++rep_) {
        LAS float* scr = (LAS float*)(L + RING_OFF + wave * 16384);
        constexpr int I0 = 128 * 16, I1 = 24 * 4, I2 = 32 * 2, I3 = 32 * 8, I4 = 32 * 8  , I5 = 32 * 16, I6 = 8 * 16, I7 = NEXP * 16 * 16, I8 = NEXP * 32 * 4;
        constexpr int NITEMS = I0 + I1 + I2 + I3 + I4 + I5 + I6 + I7 + I8;
        const int l31 = lane & 31, c4 = 4 * (lane & 7), kr0 = lane >> 3;
        for (int it = gw; it < NITEMS; it += NGW) {
            int r = it;
            if (r < I0) { const int nb = r % 128, kb = r / 128, n = nb * 32 + c4;
                int sc; if (n < 416) sc = n; else if (n < 424) sc = 1952 + (n - 416); else if (n < 512) sc = -1; else if (n < 2048) sc = n - 96; else sc = n - 88;
                tr_item4(sc >= 0 ? w_in + (size_t)(kb * 64 + kr0) * 4008 + sc : nullptr, 4008, WIN + (size_t)(nb * 32) * 1024 + kb * 64, 1024, scr, lane); continue; } r -= I0;
            if (r < I1) { const int nb = r % 24, kb = r / 24; tr_item4(w_uq + (size_t)(kb * 64 + kr0) * 768 + nb * 32 + c4, 768, WUQ + (size_t)(nb * 32) * 256 + kb * 64, 256, scr, lane); continue; } r -= I1;
            if (r < I2) { const int nb = r % 32, kb = r / 32, n = nb * 32 + c4; tr_item4((n < 512 ? w_uk + n : w_uv + (n - 512)) + (size_t)(kb * 64 + kr0) * 512, 512, WUKV + (size_t)(nb * 32) * 128 + kb * 64, 128, scr, lane); continue; } r -= I2;
            if (r < I3 + I4) { const int nb = r % 32, kb = r / 32;
                const float* src = (kb < 8 ? w_o_mla + (size_t)(kb * 64 + kr0) * 1024 : w_o_fox + (size_t)((kb - 8) * 64 + kr0) * 1024) + nb * 32 + c4;
                tr_item4(src, 1024, WOA + (size_t)(nb * 32) * 1024 + kb * 64, 1024, scr, lane); continue; } r -= I3 + I4;
            if (r < I5) { const int nb = r % 32, kb = r / 32; tr_item4(w_out + (size_t)(kb * 64 + kr0) * 1024 + nb * 32 + c4, 1024, WOUT + (size_t)(nb * 32) * 1024 + kb * 64, 1024, scr, lane); continue; } r -= I5;
            if (r < I6) { const int nb = r % 8, kb = r / 8, n = nb * 32 + l31; const int j = n & 63; const bool islo = (n >= 64 && n < 128); const bool valid = (n < 128) && (j < 36);
                const float* cp = nullptr; int NN = 32; if (valid) { if (j < 4) { cp = w_group + j; NN = 4; } else { cp = w_router + (j - 4); NN = 32; } }
                { LAS float* sc2 = scr;
#pragma unroll 8
                  for (int i = 0; i < 32; ++i) { const int kk = 2 * i + (lane >> 5); float v = cp ? cp[(size_t)(kb * 64 + kk) * NN] : 0.f; if (islo) v = v - bf2f((unsigned short)f2bf(v)); sc2[kk * 33 + l31] = v; }
                  LDS_WAIT(); asm volatile("" ::: "memory");
                  const int c = lane & 7; bf16* dst = WR + (size_t)(nb * 32) * 1024 + kb * 64;
#pragma unroll
                  for (int jj = 0; jj < 4; ++jj) { const int nn = (lane >> 3) + 8 * jj; const LAS float* s = sc2 + (8 * c) * 33 + nn;
                      v4u o; o.x = pk2(s[0 * 33], s[1 * 33]); o.y = pk2(s[2 * 33], s[3 * 33]); o.z = pk2(s[4 * 33], s[5 * 33]); o.w = pk2(s[6 * 33], s[7 * 33]);
                      *(GAS v4u*)(dst + (size_t)nn * 1024 + 8 * c) = o; }
                  LDS_WAIT(); asm volatile("" ::: "memory"); }
                continue; } r -= I6;
            if (r < I7) { const int e = r / 256, q = r % 256, nb = q % 16, kb = q / 16, rr = nb * 32 + c4;
                const int j = rr >> 8, isup = (rr >> 7) & 1, cc = rr & 127; const float* src = (isup ? w_e_up : w_e_gate) + (size_t)e * 1024 * 256 + (size_t)(kb * 64 + kr0) * 256 + 128 * j + cc;
                tr_item4(src, 256, WGU + ((size_t)e * 512 + nb * 32) * 1024 + kb * 64, 1024, scr, lane); continue; } r -= I7;
            { const int e = r / 128, q = r % 128, nb = q % 32, kb = q / 32; tr_item4(w_e_down + (size_t)e * 256 * 1024 + (size_t)(kb * 64 + kr0) * 1024 + nb * 32 + c4, 1024, WDN + ((size_t)e * 1024 + nb * 32) * 256 + kb * 64, 256, scr, lane); }
        }
        for (int m = 2 * gw; m < M; m += 2 * NGW) {
            const GAS f32x4* xr = (const GAS f32x4*)(x + (size_t)m * DM) + lane; f32x4 v[8]; float s2a = 0.f, s2b = 0.f;
#pragma unroll
            for (int j = 0; j < 8; ++j) v[j] = xr[64 * j];
#pragma unroll
            for (int j = 0; j < 4; ++j) { s2a += (v[j].x * v[j].x + v[j].y * v[j].y) + (v[j].z * v[j].z + v[j].w * v[j].w); s2b += (v[4 + j].x * v[4 + j].x + v[4 + j].y * v[4 + j].y) + (v[4 + j].z * v[4 + j].z + v[4 + j].w * v[4 + j].w); }
            const float ra = 1.f / sqrtf(wave_sum(s2a) * (1.f / DM) + EPS), rb = 1.f / sqrtf(wave_sum(s2b) * (1.f / DM) + EPS);
            GAS unsigned long long* o8 = (GAS unsigned long long*)(XN + (size_t)m * DM) + lane;
#pragma unroll
            for (int j = 0; j < 8; ++j) { const f32x4 g = *((const f32x4*)g_mix + lane + 64 * (j & 3)); const float rs = j < 4 ? ra : rb;
                o8[64 * j] = (unsigned long long)pk2(v[j].x * rs * g.x, v[j].y * rs * g.y) | ((unsigned long long)pk2(v[j].z * rs * g.z, v[j].w * rs * g.w) << 32); }
        }
        for (int i = (vcu * NWAVES * 64 + tid); i < M * 16; i += G * NWAVES * 64) {
            const int m = i >> 4, f = i & 15; const double ang = (double)positions[m] * inv_freq_d(f); const double rev = ang * 0.15915494309189535; const float fr = (float)(rev - floor(rev));
            CS[2 * i] = __builtin_amdgcn_cosf(fr); CS[2 * i + 1] = __builtin_amdgcn_sinf(fr); }
    }
    SEAM(0);
    if (IN(1)) for (int rep_ = 0; rep_ < ((MK_REPEAT == 1) ? 2 : 1); ++rep_) {
        pg8::Gemm g{XN, WIN, M, NIN, DM}; pg8::StaticOrder S; S.init(M, NIN, G, bx);
        EpiIn E{Z0, Z1, QF, KF, VF, GA, GB};
        pg8::gemm_phase<EpiIn, pg8::StaticOrder, true, true>(L + RING_OFF, g, S, E);
    }
    SEAM(1);
    if (IN(2)) for (int rep_ = 0; rep_ < ((MK_REPEAT == 2) ? 2 : 1); ++rep_) {
        float* const BSUM = (float*)(ws + WS_EID);
        LAS float* part = (LAS float*)(L + RING_OFF);
        for (int vb = vcu; vb < 256; vb += G) { float lfsum = 0.f; const int g4 = lane >> 4, l16 = lane & 15;
#pragma unroll 2
        for (int it = 0; it < 4; ++it) { const size_t m = (size_t)vb * 128 + wave * 16 + it * 4 + g4;
            const v4u ra = *(const v4u*)(Z0 + m * 256 + l16 * 16), rb = *(const v4u*)(Z0 + m * 256 + l16 * 16 + 8);
            const float* z = Z1 + m * 256;
            const f32x4 ka = *(const f32x4*)(z + l16 * 8), kb = *(const f32x4*)(z + l16 * 8 + 4);
            const float x1 = z[128 + l16], x2 = z[144 + l16], cc = CS[m * 32 + 2 * l16], sn = CS[m * 32 + 2 * l16 + 1];
            const float fl = z[160 + (l16 & 7)];
            float q[16] = {bflo(ra.x), bfhi(ra.x), bflo(ra.y), bfhi(ra.y), bflo(ra.z), bfhi(ra.z), bflo(ra.w), bfhi(ra.w), bflo(rb.x), bfhi(rb.x), bflo(rb.y), bfhi(rb.y), bflo(rb.z), bfhi(rb.z), bflo(rb.w), bfhi(rb.w)};
            float sq = 0.f, sk = (ka.x * ka.x + ka.y * ka.y) + (ka.z * ka.z + ka.w * ka.w) + (kb.x * kb.x + kb.y * kb.y) + (kb.z * kb.z + kb.w * kb.w);
#pragma unroll
            for (int e = 0; e < 16; ++e) sq += q[e] * q[e];
#pragma unroll
            for (int o = 1; o < 16; o <<= 1) { sq += __shfl_xor(sq, o); sk += __shfl_xor(sk, o); }
            const float rq = 1.f / sqrtf(sq * (1.f / 256) + EPS), rk = 1.f / sqrtf(sk * (1.f / 128) + EPS);
            { const f32x4 g0 = *((const f32x4*)g_cq + l16 * 4), g1 = *((const f32x4*)g_cq + l16 * 4 + 1), g2 = *((const f32x4*)g_cq + l16 * 4 + 2), g3 = *((const f32x4*)g_cq + l16 * 4 + 3);
              v4u o0, o1; o0.x = pk2(q[0] * rq * g0.x, q[1] * rq * g0.y); o0.y = pk2(q[2] * rq * g0.z, q[3] * rq * g0.w); o0.z = pk2(q[4] * rq * g1.x, q[5] * rq * g1.y); o0.w = pk2(q[6] * rq * g1.z, q[7] * rq * g1.w);
              o1.x = pk2(q[8] * rq * g2.x, q[9] * rq * g2.y); o1.y = pk2(q[10] * rq * g2.z, q[11] * rq * g2.w); o1.z = pk2(q[12] * rq * g3.x, q[13] * rq * g3.y); o1.w = pk2(q[14] * rq * g3.z, q[15] * rq * g3.w);
              *(v4u*)(CQN + m * 256 + l16 * 16) = o0; *(v4u*)(CQN + m * 256 + l16 * 16 + 8) = o1; }
            { const f32x4 g0 = *((const f32x4*)g_ckv + l16 * 2), g1 = *((const f32x4*)g_ckv + l16 * 2 + 1);
              v4u o; o.x = pk2(ka.x * rk * g0.x, ka.y * rk * g0.y); o.y = pk2(ka.z * rk * g0.z, ka.w * rk * g0.w); o.z = pk2(kb.x * rk * g1.x, kb.y * rk * g1.y); o.w = pk2(kb.z * rk * g1.z, kb.w * rk * g1.w);
              *(v4u*)(CKVN + m * 128 + l16 * 8) = o; }
            KR[m * 32 + l16] = (bf16)f2bf(x1 * cc - x2 * sn); KR[m * 32 + 16 + l16] = (bf16)f2bf(x2 * cc + x1 * sn);
            if (l16 < 8) { const float xx = fl + b_forget[l16]; const float t = __expf(-fabsf(xx)); const float lfv = fminf(xx, 0.f) - __logf(1.f + t); LOGF[m * 8 + l16] = lfv; lfsum += lfv; }
            { const int hh = l16 >> 1, half = l16 & 1; v4u o = {0u, 0u, 0u, 0u}; *(v4u*)(KF + m * 640 + hh * 80 + 64 + half * 8) = o;
              if (half == 0) { o.x = 0x3F803F80u; o.y = 0x00003F80u; } *(v4u*)(QF + m * 640 + hh * 80 + 64 + half * 8) = o; }
        }
        lfsum += __shfl_xor(lfsum, 16); lfsum += __shfl_xor(lfsum, 32);
        if (lane < 8) part[wave * 8 + lane] = lfsum;
        __syncthreads();
        if (tid < 8) { float t = 0.f; for (int w = 0; w < 8; ++w) t += part[w * 8 + tid]; BSUM[vb * 8 + tid] = t; }
        __syncthreads();
        }
    }
    SEAM(2);
    if (IN(3)) for (int rep_ = 0; rep_ < ((MK_REPEAT == 3) ? 2 : 1); ++rep_) {
#ifndef NO_SCAN
        { const float* const BSUM = (const float*)(ws + WS_EID);
          for (int vb = vcu; vb < 256; vb += G) { const int b = vb >> 5, bi = vb & 31, hh = wave;
            double base = (lane < bi) ? (double)BSUM[(size_t)((b * 32 + lane) * 8 + hh)] : 0.0;
#pragma unroll
            for (int o = 1; o < 64; o <<= 1) base += __shfl_xor(base, o);
            const size_t t0 = (size_t)vb * 128 + 2 * lane; const float v0 = LOGF[t0 * 8 + hh], v1 = LOGF[(t0 + 1) * 8 + hh];
            const double sp = (double)v0 + (double)v1; double incl = sp;
#pragma unroll
            for (int o = 1; o < 64; o <<= 1) { const double t = __shfl_up(incl, o); if (lane >= o) incl += t; }
            const double run0 = base + (incl - sp) + (double)v0, run1 = run0 + (double)v1;
#pragma unroll
            for (int e = 0; e < 2; ++e) { const float gneg = (float)(-(e ? run1 : run0) * 1.4426950408889634);
                const unsigned b0 = f2bf(gneg); const float r1 = gneg - bf2f((unsigned short)b0); const unsigned b1 = f2bf(r1); const float r2 = r1 - bf2f((unsigned short)b1); const unsigned b2 = f2bf(r2);
                bf16* kf = KF + (t0 + e) * 640 + hh * 80 + 64; *(unsigned*)kf = b0 | (b1 << 16); *(unsigned*)(kf + 2) = b2; }
          } }
#endif
#ifndef NO_QUP
        { pg8::Gemm g{CQN, WUQ, M, 768, 256}; pg8::StaticOrder S; S.init(M, 768, G, bx); EpiQup E{QM};
          pg8::gemm_phase<EpiQup, pg8::StaticOrder, true, true>(L + RING_OFF, g, S, E); }
#endif
#ifndef NO_KVUP
        { pg8::Gemm g{CKVN, WUKV, M, 1024, 128}; pg8::StaticOrder S; S.init(M, 1024, G, bx); EpiKVup E{KM, VM};
          pg8::gemm_phase<EpiKVup, pg8::StaticOrder, true, true>(L + RING_OFF, g, S, E); }
#endif
    }
    SEAM(3);
    if (IN(4)) for (int rep_ = 0; rep_ < ((MK_REPEAT == 4) ? 2 : 1); ++rep_) {
        const att::AttnT TA{QM, KM, KR, VM, OA, CS}; const att::AttnT TB{QF, KF, KF, VF, OA + 512, CS};
        for (int v = vcu; v < 256; v += G) { const int bh = v >> 2, sub = v & 3, b = bh >> 3, hh = bh & 7;
#pragma unroll 1
            for (int i = 0; i < 4; ++i) { const int qb = (i == 0) ? 15 - sub : (i == 1) ? 8 + sub : (i == 2) ? 7 - sub : sub;
                att::attn_unit<0>(b, hh, qb, TA, (char*)lds + RING_OFF);
                att::attn_unit<1>(b, hh, qb, TB, (char*)lds + RING_OFF); } }
    }
#ifndef MK_ATT_PROBE
#define MK_ATT_PROBE -1
#endif
    if (MK_ATT_PROBE >= 0 && IN(4)) {
        const att::AttnT TA{QM, KM, KR, VM, MIX, CS}; const att::AttnT TB{QF, KF, KF, VF, MIX + 512, CS};
        for (int v = vcu; v < 256; v += G) { const int bh = v >> 2, sub = v & 3, b = bh >> 3, hh = bh & 7;
#pragma unroll 1
            for (int i = 0; i < 4; ++i) { const int qb = (i == 0) ? 15 - sub : (i == 1) ? 8 + sub : (i == 2) ? 7 - sub : sub;
                att::attn_unit<0, (MK_ATT_PROBE < 0 ? 0 : MK_ATT_PROBE)>(b, hh, qb, TA, (char*)lds + RING_OFF);
                att::attn_unit<1, (MK_ATT_PROBE < 0 ? 0 : MK_ATT_PROBE)>(b, hh, qb, TB, (char*)lds + RING_OFF); } }
    }
    SEAM(4);
    if (IN(5)) for (int rep_ = 0; rep_ < ((MK_REPEAT == 5) ? 2 : 1); ++rep_) {
        pg8::Gemm g{OA, WOA, M, 1024, 1024}; pg8::StaticOrder S; S.init(M, 1024, G, bx); EpiMix E{GA, GB, MIX}; pg8::gemm_phase<EpiMix, pg8::StaticOrder, true, true>(L + RING_OFF, g, S, E);
    }
    SEAM(5);
    if (IN(6)) for (int rep_ = 0; rep_ < ((MK_REPEAT == 6) ? 2 : 1); ++rep_) {
        pg8::Gemm g{MIX, WOUT, M, 1024, 1024}; pg8::StaticOrder S; S.init(M, 1024, G, bx); EpiY E{YM}; pg8::gemm_phase<EpiY, pg8::StaticOrder, true, true>(L + RING_OFF, g, S, E);
    }
    SEAM(6);
    if (IN(7)) for (int rep_ = 0; rep_ < ((MK_REPEAT == 7) ? 2 : 1); ++rep_) {
        for (int m0 = 2 * gw; m0 < M; m0 += 2 * NGW) {
            f32x4 v[8]; v2u yv[8];
#pragma unroll
            for (int j = 0; j < 8; ++j) { const size_t m = (size_t)m0 + (j >> 2); v[j] = *((const GAS f32x4*)(x + m * DM) + lane + 64 * (j & 3)); yv[j] = *((const v2u*)(YM + m * DM) + lane + 64 * (j & 3)); }
            float s2[2] = {0.f, 0.f};
#pragma unroll
            for (int j = 0; j < 8; ++j) { v[j].x += bflo(yv[j].x); v[j].y += bfhi(yv[j].x); v[j].z += bflo(yv[j].y); v[j].w += bfhi(yv[j].y); s2[j >> 2] += (v[j].x * v[j].x + v[j].y * v[j].y) + (v[j].z * v[j].z + v[j].w * v[j].w); }
            const float rs[2] = {1.f / sqrtf(wave_sum(s2[0]) * (1.f / DM) + EPS), 1.f / sqrtf(wave_sum(s2[1]) * (1.f / DM) + EPS)};
#pragma unroll
            for (int j = 0; j < 8; ++j) { const size_t m = (size_t)m0 + (j >> 2); const float rstd = rs[j >> 2];
                GAS unsigned long long* oh = (GAS unsigned long long*)(HN + m * DM) + lane + 64 * (j & 3); GAS unsigned long long* ol = (GAS unsigned long long*)(HN + ((size_t)M + m) * DM) + lane + 64 * (j & 3);
                const f32x4 g = *((const f32x4*)g_ffn + lane + 64 * (j & 3)); const f32x4 y = {v[j].x * rstd * g.x, v[j].y * rstd * g.y, v[j].z * rstd * g.z, v[j].w * rstd * g.w};
                const unsigned h0 = f2bf(y.x), h1 = f2bf(y.y), h2 = f2bf(y.z), h3 = f2bf(y.w);
                *oh = (unsigned long long)(h0 | (h1 << 16)) | ((unsigned long long)(h2 | (h3 << 16)) << 32);
                *ol = (unsigned long long)pk2(y.x - bf2f((unsigned short)h0), y.y - bf2f((unsigned short)h1)) | ((unsigned long long)pk2(y.z - bf2f((unsigned short)h2), y.w - bf2f((unsigned short)h3)) << 32); }
        }
    }
    SEAM(7);
    if (IN(8)) for (int rep_ = 0; rep_ < ((MK_REPEAT == 8) ? 2 : 1); ++rep_) {
        pg8::Gemm g{HN, WR, 2 * M, 256, 1024}; pg8::StaticOrder S; S.init(2 * M, 256, G, bx); EpiLg E{LG}; pg8::gemm_phase<EpiLg, pg8::StaticOrder, true, true>(L + RING_OFF, g, S, E);
    }
    SEAM(8);
    if (IN(9)) for (int rep_ = 0; rep_ < ((MK_REPEAT == 9) ? 2 : 1); ++rep_) {
        LAS unsigned* lc = (LAS unsigned*)(L + TP_OFF + 256);
        const int per = (M + G - 1) / G;
        for (int t0 = vcu * per; t0 < min(M, (vcu + 1) * per); t0 += NWAVES * 64) {
        if (tid < 64) lc[tid] = 0u;
        __syncthreads();
        const int t = t0 + tid; const bool act = (t < min(M, (vcu + 1) * per));
        int x0 = 0, x1 = 0; unsigned s0 = 0, s1 = 0; float w0 = 0.f, w1 = 0.f;
        if (act) {
            float lg[36];
            const float* a = LG + (size_t)t * 128; const float* b2 = LG + (size_t)(M + t) * 128;
#pragma unroll
            for (int q = 0; q < 9; ++q) { const f32x4 p0 = *(const f32x4*)(a + 4 * q), p1 = *(const f32x4*)(a + 64 + 4 * q), p2 = *(const f32x4*)(b2 + 4 * q), p3 = *(const f32x4*)(b2 + 64 + 4 * q);
#pragma unroll
                for (int e = 0; e < 4; ++e) lg[4 * q + e] = (p0[e] + p1[e]) + (p2[e] + p3[e]); }
#pragma unroll
            for (int j = 0; j < 4; ++j) lg[j] += b_group[j];
#pragma unroll
            for (int j = 0; j < 32; ++j) lg[4 + j] += b_router[j];
            int gi = 0; float gm = lg[0];
#pragma unroll
            for (int j = 1; j < 4; ++j) if (lg[j] > gm) { gm = lg[j]; gi = j; }
            float gs = 0.f;
#pragma unroll
            for (int j = 0; j < 4; ++j) gs += __expf(lg[j] - gm);
            const float gp = 1.f / gs;
            float sel[8];
#pragma unroll
            for (int e = 0; e < 8; ++e) sel[e] = gi == 0 ? lg[4 + e] : gi == 1 ? lg[12 + e] : gi == 2 ? lg[20 + e] : lg[28 + e];
            int e0 = 0; float m0 = sel[0];
#pragma unroll
            for (int e = 1; e < 8; ++e) if (sel[e] > m0) { m0 = sel[e]; e0 = e; }
            int e1 = -1; float m1 = -INFINITY;
#pragma unroll
            for (int e = 0; e < 8; ++e) if (e != e0 && sel[e] > m1) { m1 = sel[e]; e1 = e; }
            const float r = __expf(m1 - m0); w0 = gp / (1.f + r); w1 = gp * r / (1.f + r);
            x0 = gi * 8 + e0; x1 = gi * 8 + e1;
            s0 = __hip_atomic_fetch_add(lc + x0, 1u, __ATOMIC_RELAXED, __HIP_MEMORY_SCOPE_WORKGROUP); s1 = __hip_atomic_fetch_add(lc + x1, 1u, __ATOMIC_RELAXED, __HIP_MEMORY_SCOPE_WORKGROUP);
        }
        __syncthreads();
        if (tid < NEXP) { const unsigned c = lc[tid]; lc[32 + tid] = c ? __hip_atomic_fetch_add(ctl + CW_CNT + 64 * tid, c, RLX_AGENT) : 0u; }
        __syncthreads();
        if (act) { EID[2 * t] = x0; EID[2 * t + 1] = x1; SLOT[2 * t] = (int)(lc[32 + x0] + s0); SLOT[2 * t + 1] = (int)(lc[32 + x1] + s1); WGT[2 * t] = w0; WGT[2 * t + 1] = w1; }
        __syncthreads();
        }
    }
    SEAM(9);
    if (IN(10)) for (int rep_ = 0; rep_ < ((MK_REPEAT == 10) ? 2 : 1); ++rep_) {
        LAS unsigned* tp = (LAS unsigned*)(L + TP_OFF);
        if (tid == 0) { unsigned acc = 0; for (int e = 0; e < NEXP; ++e) { tp[e] = acc; acc += (__hip_atomic_load(ctl + CW_CNT + 64 * e, RLX_AGENT) + 255u) >> 8; } tp[NEXP] = acc;
            if (bx == 0) for (int e = 0; e <= NEXP; ++e) __hip_atomic_store(ctl + CW_TPRE + e, tp[e], RLX_AGENT); }
        __syncthreads();
        for (int m = gw; m < M; m += NGW) {
            const int x0 = EID[2 * m], x1 = EID[2 * m + 1]; const int p0 = (int)tp[x0] * 256 + SLOT[2 * m], p1 = (int)tp[x1] * 256 + SLOT[2 * m + 1];
            if (lane == 0) { POS[2 * m] = p0; POS[2 * m + 1] = p1; WROW[p0] = WGT[2 * m]; WROW[p1] = WGT[2 * m + 1]; }
            const v4u a = *((const v4u*)(HN + (size_t)m * DM) + lane), b2 = *((const v4u*)(HN + (size_t)m * DM) + 64 + lane);
            *((v4u*)(XG + (size_t)p0 * DM) + lane) = a; *((v4u*)(XG + (size_t)p0 * DM) + 64 + lane) = b2;
            *((v4u*)(XG + (size_t)p1 * DM) + lane) = a; *((v4u*)(XG + (size_t)p1 * DM) + 64 + lane) = b2;
        }
        __syncthreads();
    }
    SEAM(10);
    if (IN(11)) for (int rep_ = 0; rep_ < ((MK_REPEAT == 11) ? 2 : 1); ++rep_) {
        LAS unsigned* tp = (LAS unsigned*)(L + TP_OFF); if (tid <= NEXP) tp[tid] = __hip_atomic_load(ctl + CW_TPRE + tid, RLX_AGENT); __syncthreads();
        pg8::Gemm g{XG, WGU, XG_ROWS, NEXP * 512, 1024}; ExpertOrder S{tp, 2, G, bx}; EpiGU E{ACT};
        pg8::gemm_phase<EpiGU, ExpertOrder, true, true>(L + RING_OFF, g, S, E);
    }
    SEAM(11);
    if (IN(12)) for (int rep_ = 0; rep_ < ((MK_REPEAT == 12) ? 2 : 1); ++rep_) {
        LAS unsigned* tp = (LAS unsigned*)(L + TP_OFF); if (tid <= NEXP) tp[tid] = __hip_atomic_load(ctl + CW_TPRE + tid, RLX_AGENT); __syncthreads();
        pg8::Gemm g{ACT, WDN, XG_ROWS, NEXP * 1024, 256}; ExpertOrder S{tp, 4, G, bx}; EpiDown E{YB, WROW};
        pg8::gemm_phase<EpiDown, ExpertOrder, true, true>(L + RING_OFF, g, S, E);
    }
    SEAM(12);
    if (IN(13)) for (int rep_ = 0; rep_ < ((MK_REPEAT == 13) ? 2 : 1); ++rep_) {
        for (int m = gw; m < M; m += NGW) {
            const int p0 = POS[2 * m], p1 = POS[2 * m + 1];
            const GAS f32x4* xr = (const GAS f32x4*)(x + (size_t)m * DM) + lane; const v2u* yr = (const v2u*)(YM + (size_t)m * DM) + lane;
            const v2u* y0 = (const v2u*)(YB + (size_t)p0 * DM) + lane; const v2u* y1 = (const v2u*)(YB + (size_t)p1 * DM) + lane;
            f32x4 v[4]; v2u ya[4], yb[4], yc[4]; float s2 = 0.f;
#pragma unroll
            for (int j = 0; j < 4; ++j) { v[j] = xr[64 * j]; ya[j] = yr[64 * j]; yb[j] = y0[64 * j]; yc[j] = y1[64 * j]; }
#pragma unroll
            for (int j = 0; j < 4; ++j) {
                v[j].x += bflo(ya[j].x) + (bflo(yb[j].x) + bflo(yc[j].x)); v[j].y += bfhi(ya[j].x) + (bfhi(yb[j].x) + bfhi(yc[j].x)); v[j].z += bflo(ya[j].y) + (bflo(yb[j].y) + bflo(yc[j].y)); v[j].w += bfhi(ya[j].y) + (bfhi(yb[j].y) + bfhi(yc[j].y));
                s2 += (v[j].x * v[j].x + v[j].y * v[j].y) + (v[j].z * v[j].z + v[j].w * v[j].w); }
            const float rstd = 1.f / sqrtf(wave_sum(s2) * (1.f / DM) + EPS);
            GAS f32x4* orow = (GAS f32x4*)(out + (size_t)m * DM) + lane;
#pragma unroll
            for (int j = 0; j < 4; ++j) { const f32x4 g = *((const f32x4*)g_final + lane + 64 * j); orow[64 * j] = (f32x4){v[j].x * rstd * g.x, v[j].y * rstd * g.y, v[j].z * rstd * g.z, v[j].w * rstd * g.w}; }
        }
    }
#undef IN
#undef SEAM
}

extern "C" void kernel_launch(void* const* d_in, const int* in_sizes, int n_in, void* d_out, int out_size, void* d_ws, size_t ws_size, hipStream_t stream) {
    static int grid = 0;
    if (grid == 0) {
        if (n_in != 22 || in_sizes[0] != M * DM || out_size != M * DM || ws_size < WS_END) { fprintf(stderr, "kernel_launch: unexpected shapes (n_in %d, in0 %d, out %d, ws %zu); nothing launched\n", n_in, n_in > 0 ? in_sizes[0] : -1, out_size, ws_size); grid = -1; return; }
        int dev = 0, cus = 0, per_cu = 0;
        if (hipGetDevice(&dev) != hipSuccess || hipDeviceGetAttribute(&cus, hipDeviceAttributeMultiprocessorCount, dev) != hipSuccess) { grid = -1; return; }
        if (hipFuncSetAttribute((const void*)mk_fwd, hipFuncAttributeMaxDynamicSharedMemorySize, LDS_BYTES) != hipSuccess) { fprintf(stderr, "kernel_launch: hipFuncSetAttribute failed\n"); grid = -1; return; }
        if (hipOccupancyMaxActiveBlocksPerMultiprocessor(&per_cu, (const void*)mk_fwd, NWAVES * 64, LDS_BYTES) != hipSuccess || per_cu < 1) { fprintf(stderr, "kernel_launch: occupancy query says %d blocks/CU\n", per_cu); per_cu = 1; }
        (void)hipGetLastError();
        grid = cus;
    }
    if (grid < 0) return;
    if (hipMemsetAsync((char*)d_ws + WS_CTL, 0, CTL_ZERO_BYTES, stream) != hipSuccess) { fprintf(stderr, "kernel_launch: memset failed\n"); return; }
    Args a{};
    for (int i = 0; i < 22; ++i) a.in[i] = (const float*)d_in[i];
    a.out = (float*)d_out; a.ws = (unsigned char*)d_ws;
#if MK_PER_PHASE
#ifndef MK_REPEAT_L
#define MK_REPEAT_L -1
#endif
    for (int p = 0; p < N_PHASES; ++p) { a.ph_lo = p; a.ph_hi = p + 1; hipLaunchKernelGGL(mk_fwd, dim3(grid), dim3(NWAVES * 64), LDS_BYTES, stream, a);
        if (p == MK_REPEAT_L) hipLaunchKernelGGL(mk_fwd, dim3(grid), dim3(NWAVES * 64), LDS_BYTES, stream, a); }
#else
#ifndef MK_PREFIX
#define MK_PREFIX -1
#endif
    void* kargs[] = {&a};
    if (MK_PREFIX >= 0) {
        a.ph_lo = 0; a.ph_hi = MK_PREFIX + 1;
        (void)hipLaunchCooperativeKernel((const void*)mk_fwd, dim3(grid), dim3(NWAVES * 64), kargs, LDS_BYTES, stream);
        (void)hipMemsetAsync((char*)d_ws + WS_CTL, 0, CTL_ZERO_BYTES, stream);
    }
    a.ph_lo = 0; a.ph_hi = N_PHASES;
    hipError_t e = hipLaunchCooperativeKernel((const void*)mk_fwd, dim3(grid), dim3(NWAVES * 64), kargs, LDS_BYTES, stream);
    if (e != hipSuccess) fprintf(stderr, "kernel_launch: cooperative launch failed: %s (grid %d)\n", hipGetErrorString(e), grid);
#endif
}
```

```cpp
#include <hip/hip_runtime.h>
#include <hip/hip_bf16.h>
#include <hip/hip_cooperative_groups.h>
#include <cstdio>
#include <cstdint>
#include <cmath>
namespace pg8 {
#define PG8_LAS __attribute__((address_space(3)))
typedef unsigned short bf16_t;
typedef short bf16x8 __attribute__((ext_vector_type(8)));
typedef float f32x4 __attribute__((ext_vector_type(4)));
typedef unsigned u32x4 __attribute__((ext_vector_type(4)));
constexpr int BM = 256, BK = 64, HALF = 128, HTB = HALF * BK * 2  , STAGE_BYTES = 8 * HTB, NXCD = 8, WGM = 8;

__host__ __device__ __forceinline__ int lds_byte(int r, int c) { const int st = (r >> 4) * 2 + (c >> 5), rr = r & 15, cc = c & 31, ob = rr * 64 + cc * 2; return st * 1024 + (ob ^ (((ob >> 9) & 1) << 5)); }
__host__ __device__ __forceinline__ void stage_rc(int b, int& R, int& C) { const int st = b / 1024, sb = b % 1024, swz = sb ^ (((sb >> 9) & 1) << 5); R = (st >> 1) * 16 + swz / 64; C = (st & 1) * 32 + (swz % 64) / 2; }
__host__ __device__ __forceinline__ int perm32(int rho) { const int n = rho >> 4, i = rho & 15; return 8 * (i >> 2) + 4 * n + (i & 3); }

struct Unit { int pm, pn; };
struct Gemm { const bf16_t* A; const bf16_t* Bt; int M, N, K; };

struct StaticOrder {
    int nM, nN, nwg, G, c;
    __host__ __device__ void init(int M, int N, int G_, int c_) { nM = M / BM; nN = N / BM; nwg = nM * nN; G = G_; c = c_; }
    __host__ __device__ bool next(int i, Unit& u) const {
        const long L = (long)i * G + c; if (L >= nwg) return false;
        int wgid = (int)L; { const int q = nwg / NXCD, r = nwg % NXCD, xcd = wgid % NXCD, off = wgid / NXCD; wgid = (xcd < r ? xcd * (q + 1) : r * (q + 1) + (xcd - r) * q) + off; }
        const int nig = WGM * nN, gid = wgid / nig, fm = gid * WGM, gsz = (nM - fm) < WGM ? (nM - fm) : WGM;
        u.pm = fm + ((wgid % nig) % gsz); u.pn = (wgid % nig) / gsz; return true;
    }
    __device__ __forceinline__ void a_ready(const Unit&) const {}
    __device__ __forceinline__ void done(const Unit&) const {}
};

__device__ __forceinline__ unsigned cvt_pk_bf16(float lo, float hi) { unsigned r; asm volatile("v_cvt_pk_bf16_f32 %0, %1, %2" : "=v"(r) : "v"(lo), "v"(hi)); return r; }
typedef float f32x2 __attribute__((ext_vector_type(2)));
template <class Epi, class Sched, bool ALIGN_EPI = false, bool SP2 = false>
__device__ __forceinline__ void gemm_phase(PG8_LAS unsigned char* lds, const Gemm g, const Sched& S, const Epi& E) {
    const int tid = threadIdx.x, wid = __builtin_amdgcn_readfirstlane(tid >> 6), lane = tid & 63, wr = wid >> 2, wc = wid & 3, fr = lane & 15, fq = lane >> 4;
    const int K = g.K; int nt = K / BK; asm volatile("" : "+s"(nt));
    unsigned voffA[2], voffB[2];
#pragma unroll
    for (int i = 0; i < 2; ++i) { int R, C; stage_rc(tid * 16 + i * 8192, R, C); const int Rb = Epi::PERM ? ((R & ~31) + perm32(R & 31)) : R;
        voffA[i] = (unsigned)(R * K + C) * 2u; voffB[i] = (unsigned)(Rb * K + C) * 2u; }
    const size_t kstep = (size_t)(BK * 2);
    const size_t hstep = (size_t)HALF * K * 2;
    const size_t tstep = 2 * hstep;
    const unsigned ldsw = (unsigned)wid * 1024u;
    const int aoff = lds_byte(wr * 64 + fr, fq * 8), boff = lds_byte(wc * 32 + fr, fq * 8);
#define PG8_SA(b, h) (((b) * 2 + (h)) * HTB)
#define PG8_SB(b, h) ((4 + (b) * 2 + (h)) * HTB)
#define PG8_STAGE(bufoff, gbase, voff) do { _Pragma("unroll") for (int _i = 0; _i < 2; ++_i) \
        __builtin_amdgcn_global_load_lds((const unsigned*)((const char*)(gbase) + (voff)[_i]), (PG8_LAS unsigned*)(lds + (bufoff) + ldsw + _i * 8192), 16, 0, 0); } while (0)
#define PG8_LDA(dst, b, h) do { _Pragma("unroll") for (int m = 0; m < 4; ++m) _Pragma("unroll") for (int k = 0; k < 2; ++k) dst[m][k] = *(const PG8_LAS bf16x8*)(lds + PG8_SA(b, h) + aoff + m * 2048 + k * 1024); } while (0)
#define PG8_LDB(dst, b, h) do { _Pragma("unroll") for (int n = 0; n < 2; ++n) _Pragma("unroll") for (int k = 0; k < 2; ++k) dst[n][k] = *(const PG8_LAS bf16x8*)(lds + PG8_SB(b, h) + boff + n * 2048 + k * 1024); } while (0)
#define PG8_MMA(ai, bj, At, Bt) do { __builtin_amdgcn_s_setprio(1); _Pragma("unroll") for (int m = 0; m < 4; ++m) _Pragma("unroll") for (int n = 0; n < 2; ++n) _Pragma("unroll") for (int k = 0; k < 2; ++k) \
        acc[ai][bj][m][n] = __builtin_amdgcn_mfma_f32_16x16x32_bf16(Bt[n][k], At[m][k], acc[ai][bj][m][n], 0, 0, 0); __builtin_amdgcn_s_setprio(0); } while (0)
#define PG8_WAIT_V(n) asm volatile("s_waitcnt vmcnt(" #n ")" ::: "memory")
#define PG8_WAIT_L(n) asm volatile("s_waitcnt lgkmcnt(" #n ")" ::: "memory")
#define PG8_BAR __builtin_amdgcn_s_barrier()
#define PG8_SCHED __builtin_amdgcn_sched_barrier(0)
    Unit cur, nxt; int ui = 0;
    if (!S.next(0, cur)) return;
    f32x4 acc[2][2][4][2];
#pragma unroll
    for (int a = 0; a < 2; ++a)
#pragma unroll
        for (int b = 0; b < 2; ++b)
#pragma unroll
            for (int m = 0; m < 4; ++m)
#pragma unroll
                for (int n = 0; n < 2; ++n) acc[a][b][m][n] = (f32x4){0.f, 0.f, 0.f, 0.f};
    bf16x8 At[4][2], B0[2][2], B1[2][2];
    const char* cA = (const char*)g.A + (size_t)cur.pm * tstep; const char* cB = (const char*)g.Bt + (size_t)cur.pn * tstep;
    S.a_ready(cur);
    if constexpr (SP2) {
        PG8_STAGE(PG8_SB(0, 0), cB, voffB); PG8_STAGE(PG8_SB(0, 1), cB + hstep, voffB); PG8_STAGE(PG8_SA(0, 0), cA, voffA); PG8_STAGE(PG8_SA(0, 1), cA + hstep, voffA);
        if (wr == 1) PG8_BAR;
        PG8_WAIT_V(2); PG8_BAR;
        PG8_STAGE(PG8_SB(1, 0), cB + kstep, voffB); PG8_STAGE(PG8_SA(1, 0), cA + kstep, voffA); PG8_STAGE(PG8_SB(1, 1), cB + hstep + kstep, voffB);
        PG8_WAIT_V(6); PG8_BAR;
    } else {
        PG8_STAGE(PG8_SB(0, 0), cB, voffB); PG8_STAGE(PG8_SA(0, 0), cA, voffA); PG8_STAGE(PG8_SB(0, 1), cB + hstep, voffB); PG8_STAGE(PG8_SA(0, 1), cA + hstep, voffA);
        if (wr == 1) PG8_BAR;
        PG8_WAIT_V(4); PG8_BAR;
        PG8_STAGE(PG8_SB(1, 0), cB + kstep, voffB); PG8_STAGE(PG8_SA(1, 0), cA + kstep, voffA); PG8_STAGE(PG8_SB(1, 1), cB + hstep + kstep, voffB);
        PG8_WAIT_V(6); PG8_BAR;
    }
    for (;;) {
        const bool has_next = S.next(ui + 1, nxt);
        const char* nA = has_next ? (const char*)g.A + (size_t)nxt.pm * tstep : cA; const char* nB = has_next ? (const char*)g.Bt + (size_t)nxt.pn * tstep : cB;
        for (int t = 0; t < nt; t += 2) {
            if constexpr (Epi::MID) { if (t == (nt >> 1)) E.mid(acc, cur, wr, wc, fr, fq); }
            const bool last = (t == nt - 2);
            const char* a1 = cA + (size_t)(t + 1) * kstep;
            const char* a2 = last ? nA : cA + (size_t)(t + 2) * kstep; const char* b2 = last ? nB : cB + (size_t)(t + 2) * kstep;
            const char* a3 = a2 + kstep; const char* b3 = b2 + kstep;
            if (last && has_next) S.a_ready(nxt);
            if constexpr (SP2) {
            PG8_LDB(B0, 0, 0); PG8_LDB(B1, 0, 1); PG8_SCHED; PG8_LDA(At, 0, 0); PG8_STAGE(PG8_SA(1, 1), a1 + hstep, voffA);
            PG8_WAIT_V(8); PG8_WAIT_L(0); PG8_BAR; PG8_MMA(0, 0, At, B0); PG8_MMA(0, 1, At, B1); PG8_BAR; PG8_SCHED;
            PG8_LDA(At, 0, 1); PG8_STAGE(PG8_SB(0, 0), b2, voffB); PG8_STAGE(PG8_SB(0, 1), b2 + hstep, voffB); PG8_STAGE(PG8_SA(0, 0), a2, voffA);
            PG8_WAIT_V(8); PG8_WAIT_L(0); PG8_BAR; PG8_MMA(1, 0, At, B0); PG8_MMA(1, 1, At, B1); PG8_BAR; PG8_SCHED;
            PG8_LDB(B0, 1, 0); PG8_LDB(B1, 1, 1); PG8_SCHED; PG8_LDA(At, 1, 0); PG8_STAGE(PG8_SA(0, 1), a2 + hstep, voffA);
            PG8_WAIT_V(8); PG8_WAIT_L(0); PG8_BAR; PG8_MMA(0, 0, At, B0); PG8_MMA(0, 1, At, B1); PG8_BAR; PG8_SCHED;
            PG8_LDA(At, 1, 1); PG8_STAGE(PG8_SB(1, 0), b3, voffB); PG8_STAGE(PG8_SB(1, 1), b3 + hstep, voffB); PG8_STAGE(PG8_SA(1, 0), a3, voffA);
            PG8_WAIT_V(8); PG8_WAIT_L(0); PG8_BAR; PG8_MMA(1, 0, At, B0); PG8_MMA(1, 1, At, B1); PG8_BAR; PG8_SCHED;
            } else {
            PG8_LDB(B0, 0, 0); PG8_SCHED; PG8_LDA(At, 0, 0); PG8_STAGE(PG8_SA(1, 1), a1 + hstep, voffA);
            PG8_WAIT_L(8); PG8_BAR; PG8_WAIT_L(0); PG8_MMA(0, 0, At, B0); PG8_BAR; PG8_SCHED;
            PG8_LDB(B1, 0, 1); PG8_STAGE(PG8_SB(0, 0), b2, voffB);
            PG8_BAR; PG8_WAIT_L(0); PG8_MMA(0, 1, At, B1); PG8_BAR;
            PG8_LDA(At, 0, 1); PG8_STAGE(PG8_SA(0, 0), a2, voffA);
            PG8_BAR; PG8_WAIT_L(0); PG8_MMA(1, 0, At, B0); PG8_BAR; PG8_SCHED;
            PG8_STAGE(PG8_SB(0, 1), b2 + hstep, voffB);
            PG8_WAIT_V(6); PG8_BAR; PG8_MMA(1, 1, At, B1); PG8_BAR;
            PG8_LDB(B0, 1, 0); PG8_SCHED; PG8_LDA(At, 1, 0); PG8_STAGE(PG8_SA(0, 1), a2 + hstep, voffA);
            PG8_WAIT_L(8); PG8_BAR; PG8_WAIT_L(0); PG8_MMA(0, 0, At, B0); PG8_BAR; PG8_SCHED;
            PG8_LDB(B1, 1, 1); PG8_STAGE(PG8_SB(1, 0), b3, voffB);
            PG8_BAR; PG8_WAIT_L(0); PG8_MMA(0, 1, At, B1); PG8_BAR;
            PG8_LDA(At, 1, 1); PG8_STAGE(PG8_SA(1, 0), a3, voffA);
            PG8_BAR; PG8_WAIT_L(0); PG8_MMA(1, 0, At, B0); PG8_BAR; PG8_SCHED;
            PG8_STAGE(PG8_SB(1, 1), b3 + hstep, voffB);
            PG8_WAIT_V(6); PG8_BAR; PG8_MMA(1, 1, At, B1); PG8_BAR;
            }
        }
        if constexpr (ALIGN_EPI) { if (wr == 0) PG8_BAR; }
        if constexpr (!Epi::AFTER_DRAIN) { E(acc, cur, wr, wc, fr, fq); S.done(cur); }
        if (!has_next) break;
#pragma unroll
        for (int a = 0; a < 2; ++a)
#pragma unroll
            for (int b = 0; b < 2; ++b)
#pragma unroll
                for (int m = 0; m < 4; ++m)
#pragma unroll
                    for (int n = 0; n < 2; ++n) acc[a][b][m][n] = (f32x4){0.f, 0.f, 0.f, 0.f};
        cur = nxt; cA = nA; cB = nB; ++ui;
        if constexpr (ALIGN_EPI) { if (wr == 1) PG8_BAR; }
    }
    PG8_WAIT_V(0);
    if constexpr (!ALIGN_EPI) { if (wr == 0) PG8_BAR; }
    PG8_BAR;
    if constexpr (Epi::AFTER_DRAIN) { E.fused(acc, cur, wr, wc, fr, fq, lds, wid, lane); S.done(cur); }
#undef PG8_SA
#undef PG8_SB
#undef PG8_STAGE
#undef PG8_LDA
#undef PG8_LDB
#undef PG8_MMA
#undef PG8_WAIT_V
#undef PG8_WAIT_L
#undef PG8_BAR
#undef PG8_SCHED
}
}
namespace att {
typedef unsigned short bf16;
using bf16x8 = __attribute__((ext_vector_type(8))) short;
using s16x4 = __attribute__((ext_vector_type(4))) short;
using f32x16 = __attribute__((ext_vector_type(16))) float;
using u32x4 = __attribute__((ext_vector_type(4))) unsigned;
constexpr int SEQ = 4096, NW = 8, QB = 256, KVBLK = 64;
constexpr int KSLOT = 12288, VSLOT = 8192, NKS = 4, NVS = 4;
constexpr int LDS_K = 0, LDS_V = NKS * KSLOT, LDS_WS = LDS_V + NVS * VSLOT, LDS_OST = LDS_WS + NW * 256, LDS_BYTES = LDS_OST + NW * 4096;
constexpr float THR = 8.0f;
#define ATT_LAS __attribute__((address_space(3)))
#define SBAR() __builtin_amdgcn_sched_barrier(0)
#define WAIT_BAR(N) asm volatile("s_waitcnt vmcnt(" #N ") lgkmcnt(0)\n\ts_barrier" ::: "memory")
__device__ __forceinline__ int crow(int r, int hi) { return (r & 3) + 8 * (r >> 2) + 4 * hi; }
__device__ __forceinline__ void glds16(const void* gsrc, unsigned lds_dst) { unsigned keep;
  asm volatile("s_mov_b32 %0, m0\n\ts_mov_b32 m0, %2\n\ts_nop 0\n\tglobal_load_lds_dwordx4 %1, off\n\ts_mov_b32 m0, %0" : "=&s"(keep) : "v"(gsrc), "s"(lds_dst) : "memory"); }
typedef float f32x2_t __attribute__((ext_vector_type(2))); typedef __bf16 bf16x2_t __attribute__((ext_vector_type(2)));
__device__ __forceinline__ unsigned cvtpk_s(float lo, float hi) { f32x2_t v = {lo, hi}; bf16x2_t b = __builtin_convertvector(v, bf16x2_t); return __builtin_bit_cast(unsigned, b); }
typedef ATT_LAS const char* lds_cptr;
#define MX3(a, b, c) __builtin_fmaxf(__builtin_fmaxf((a), (b)), (c))
__device__ __forceinline__ float rowmax(const f32x16& p0, const f32x16& p1) {
  float a = MX3(p0[0], p0[1], p1[0]), b = MX3(p0[2], p0[3], p1[1]); a = MX3(a, p1[2], p1[3]);
#pragma unroll
  for (int r = 4; r < 16; r += 4) { a = MX3(a, p0[r], p0[r + 1]); b = MX3(b, p0[r + 2], p0[r + 3]); a = MX3(a, p1[r], p1[r + 1]); b = MX3(b, p1[r + 2], p1[r + 3]); }
  float m = __builtin_fmaxf(a, b); auto rr = __builtin_amdgcn_permlane32_swap(__float_as_uint(m), __float_as_uint(m), false, false);
  return __builtin_fmaxf(__uint_as_float(rr[0]), __uint_as_float(rr[1])); }
__device__ __forceinline__ void cmask(f32x16& p0, f32x16& p1, int jb, int qrel, int hi) {
  const int kb = 64 * jb + 4 * hi;
#pragma unroll
  for (int r = 0; r < 16; ++r) { const int kv = kb + (r & 3) + 8 * (r >> 2); if (kv > qrel) p0[r] = -INFINITY; if (kv + 32 > qrel) p1[r] = -INFINITY; } }
template <int D0A, int D0B> __device__ __forceinline__ void kload(bf16x8* kf, lds_cptr kp) {
#pragma unroll
  for (int d0 = D0A; d0 < D0B; ++d0) { kf[2 * (d0 - D0A)] = *(const ATT_LAS bf16x8*)(kp + d0 * 2048); kf[2 * (d0 - D0A) + 1] = *(const ATT_LAS bf16x8*)(kp + d0 * 2048 + 512); }
}
template <int ND0, int NPRE> __device__ __forceinline__ void qkt(f32x16& p0, f32x16& p1, const bf16x8* kf, const bf16x8* kt, const bf16x8* qr, const f32x16& negm) {
#pragma unroll
  for (int d0 = 0; d0 < ND0; ++d0) { const bf16x8 b0 = d0 < NPRE ? kf[2 * d0] : kt[2 * (d0 - NPRE)], b1 = d0 < NPRE ? kf[2 * d0 + 1] : kt[2 * (d0 - NPRE) + 1];
    if (d0 == 0) { p0 = __builtin_amdgcn_mfma_f32_32x32x16_bf16(b0, qr[0], negm, 0, 0, 0); p1 = __builtin_amdgcn_mfma_f32_32x32x16_bf16(b1, qr[0], negm, 0, 0, 0); }
    else { p0 = __builtin_amdgcn_mfma_f32_32x32x16_bf16(b0, qr[d0], p0, 0, 0, 0); p1 = __builtin_amdgcn_mfma_f32_32x32x16_bf16(b1, qr[d0], p1, 0, 0, 0); } }
}
__device__ __forceinline__ void pv(f32x16* o, int vb, bf16x8 pa0, bf16x8 pa1, bf16x8 pa2, bf16x8 pa3) {
#pragma unroll
  for (int d0 = 0; d0 < 2; ++d0) { s16x4 lo[4], hi[4];
#pragma unroll
    for (int ks = 0; ks < 4; ++ks) {
      asm volatile("ds_read_b64_tr_b16 %0,%1 offset:%c2" : "=&v"(lo[ks]) : "v"(vb), "i"(d0 * 4096 + ks * 1024) : "memory");
      asm volatile("ds_read_b64_tr_b16 %0,%1 offset:%c2" : "=&v"(hi[ks]) : "v"(vb), "i"(d0 * 4096 + ks * 1024 + 512) : "memory"); }
    asm volatile("s_waitcnt lgkmcnt(0)" ::: "memory"); SBAR();
#define PK(k) (bf16x8){lo[k][0], lo[k][1], lo[k][2], lo[k][3], hi[k][0], hi[k][1], hi[k][2], hi[k][3]}
    o[d0] = __builtin_amdgcn_mfma_f32_32x32x16_bf16(pa0, PK(0), o[d0], 0, 0, 0);
    o[d0] = __builtin_amdgcn_mfma_f32_32x32x16_bf16(pa1, PK(1), o[d0], 0, 0, 0);
    o[d0] = __builtin_amdgcn_mfma_f32_32x32x16_bf16(pa2, PK(2), o[d0], 0, 0, 0);
    o[d0] = __builtin_amdgcn_mfma_f32_32x32x16_bf16(pa3, PK(3), o[d0], 0, 0, 0);
#undef PK
  }
}
struct AttnT { const bf16* Q; const bf16* K; const bf16* KR; const bf16* V; bf16* O; const float* CS; const float* GB; const unsigned* QKM; };
template <int KIND, int ABL = 0> __device__ __forceinline__ void attn_unit(int b, int h, int qb, const AttnT& T, char* shm) {
#ifndef ATT_NPRE0
#define ATT_NPRE0 2
#endif
#ifndef ATT_NPRE1
#define ATT_NPRE1 3
#endif
  constexpr int NPRE = KIND == 0 ? ATT_NPRE0 : ATT_NPRE1;
  constexpr int ND0 = KIND == 0 ? 6 : 5, QP = KIND == 0 ? 768 : 640, HD = KIND == 0 ? 96 : 80;
  const int tid = threadIdx.x, lane = tid & 63, r32 = lane & 31, hi = lane >> 5; const int wid = __builtin_amdgcn_readfirstlane(tid >> 6);
  const long rowbase = (long)b * SEQ; const int q0 = qb * QB;
  const bf16* Qw = T.Q + (rowbase + q0 + wid * 32) * QP + h * HD;
  const unsigned lds0 = (unsigned)(uintptr_t)shm;
  const lds_cptr shm3 = (lds_cptr)shm;
  ATT_LAS float* wsf = (ATT_LAS float*)(shm3 + LDS_WS) + wid * 64;
  const bf16 *ksrcA, *ksrcB; long kstepA, kstepB; unsigned kdstB;
  const unsigned kdstA = lds0 + LDS_K + wid * 1024;
  if (KIND == 0) { ksrcA = T.K + (rowbase + lane) * 512 + h * 64 + wid * 8; ksrcB = T.KR + (rowbase + lane) * 32 + (wid & 3) * 8; kdstB = lds0 + LDS_K + (8 + (wid & 3)) * 1024; kstepA = 64 * 512; kstepB = 64 * 32; }
  else { ksrcA = T.K + (rowbase + lane) * 640 + h * 80 + wid * 8; ksrcB = T.K + (rowbase + lane) * 640 + h * 80 + (8 + (wid & 1)) * 8; kdstB = lds0 + LDS_K + (8 + (wid & 1)) * 1024; kstepA = 64 * 640; kstepB = 64 * 640; }
  const bf16* vsrc = T.V + (rowbase + 16 * (wid & 3) + (lane >> 2)) * 512 + h * 64 + (wid >> 2) * 32 + (lane & 3) * 8;
  const unsigned vdst = lds0 + LDS_V + wid * 1024;
#define DMA_K(t, s) do { glds16(ksrcA + (long)(t) * kstepA, (unsigned)__builtin_amdgcn_readfirstlane(kdstA + (s) * KSLOT)); \
                         glds16(ksrcB + (long)(t) * kstepB, (unsigned)__builtin_amdgcn_readfirstlane(kdstB + (s) * KSLOT)); } while (0)
#define DMA_V(t, s) do { glds16(vsrc + (long)(t) * (64 * 512), (unsigned)__builtin_amdgcn_readfirstlane(vdst + (s) * VSLOT)); } while (0)
  const int vb0 = (int)(lds0 + LDS_V) + ((lane >> 4) & 1) * 32 + (lane & 3) * 8 + (4 * hi + ((lane & 15) >> 2)) * 64;
  const lds_cptr kp0 = shm3 + LDS_K + hi * 1024 + r32 * 16;
  const int NT = (q0 + QB) / KVBLK;
  int tb = 0;
  if (KIND == 1) {
    const float qmax = __uint_as_float(T.QKM[2 * (b * 8 + h)]), kmax = __uint_as_float(T.QKM[2 * (b * 8 + h) + 1]);
    const float qk2 = 2.02f * qmax * kmax, gq0 = T.GB[(rowbase + q0) * 8 + h];
    const float ge = (lane < 4 * qb) ? T.GB[(rowbase + 64 * lane + 63) * 8 + h] : 3.0e38f;
    const unsigned long long bal = __ballot(qk2 + ge - gq0 >= -40.f);
    tb = __builtin_amdgcn_readfirstlane((int)__builtin_ctzll(bal));
  }
  DMA_K(tb, 0); DMA_V(tb, 0); DMA_K(tb + 1, 1); DMA_V(tb + 1, 1); DMA_K(tb + 2, 2);
  bf16x8 qr[ND0];
#pragma unroll
  for (int d0 = 0; d0 < ND0; ++d0) qr[d0] = *reinterpret_cast<const bf16x8*>(&Qw[(long)r32 * QP + d0 * 16 + hi * 8]);
  if (KIND == 0) {
    const float* cs = T.CS + (rowbase + q0 + wid * 32 + r32) * 32 + 16 * hi;
    typedef float f32x4_t __attribute__((ext_vector_type(4)));
    bf16x8 a = qr[4], c = qr[5];
#pragma unroll
    for (int j2 = 0; j2 < 4; ++j2) { const f32x4_t t4 = *(const f32x4_t*)(cs + 4 * j2);
#pragma unroll
      for (int e = 0; e < 2; ++e) { const int j = 2 * j2 + e; const float co = t4[2 * e], si = t4[2 * e + 1];
        const float x1 = __builtin_bit_cast(float, (unsigned)(unsigned short)a[j] << 16), x2 = __builtin_bit_cast(float, (unsigned)(unsigned short)c[j] << 16);
        const float o1 = x1 * co - x2 * si, o2 = x2 * co + x1 * si;
        qr[4][j] = (short)(cvtpk_s(o1, o1) & 0xffffu); qr[5][j] = (short)(cvtpk_s(o2, o2) & 0xffffu); } }
  }
  float mhat = 0.f, l_reg = 0.f; f32x16 o[2]; o[0] = f32x16{}; o[1] = f32x16{}; f32x16 negm = f32x16{};
  const int qrel = wid * 32 + r32;
  int ks_cur = 0, vs_cur = 0;
  bf16x8 kf[2 * NPRE];
  WAIT_BAR(6);
  kload<0, NPRE>(kf, kp0);
  u32x4 pw0 = {0u, 0u, 0u, 0u}, pw1 = pw0, pw2 = pw0, pw3 = pw0;
#ifndef ATT_STAG
#define ATT_STAG 0
#endif
  const bool grpB = (ATT_STAG == 1) ? (wid >= 4) : (ATT_STAG == 2) ? ((wid & 1) != 0) : false; bool pend = false; int vs_pend = 0;
  for (int t = tb; t < NT; ++t) {
    if (t + 2 < NT) { WAIT_BAR(3); } else if (t + 1 < NT) { WAIT_BAR(1); } else { WAIT_BAR(0); }
    const int ks1 = (ks_cur + 1) & 3, vs1 = (vs_cur + 1) & 3, vs2 = (vs_cur + 2) & 3;
    if (t + 2 < NT) { DMA_V(t + 2, vs2); }
    if (t + 3 < NT) { DMA_K(t + 3, ((ks_cur + 3) & 3)); }
    if (pend) { if (!(ABL & 1)) pv(o, vb0 + vs_pend * VSLOT, __builtin_bit_cast(bf16x8, pw0), __builtin_bit_cast(bf16x8, pw1), __builtin_bit_cast(bf16x8, pw2), __builtin_bit_cast(bf16x8, pw3)); pend = false; }
    const int jb = t - 4 * qb;
    const bool vis = (KIND == 0) ? (t <= 4 * qb + (wid >> 1)) : ((jb < 0) || (64 * jb <= 32 * wid + 31));
    f32x16 p0, p1;
    if (vis) {
      bf16x8 kt[2 * (ND0 - NPRE)]; kload<NPRE, ND0>(kt, kp0 + ks_cur * KSLOT);
      if (ABL & 4) { p0 = negm; p1 = negm; asm volatile("" : "+v"(p0), "+v"(p1)); } else qkt<ND0, NPRE>(p0, p1, kf, kt, qr, negm);
    }
    if (t + 1 < NT) kload<0, NPRE>(kf, kp0 + ks1 * KSLOT);
    if (vis) {
      if (KIND == 1) { if (jb >= 0) cmask(p0, p1, jb, qrel, hi); }
      const float rm = rowmax(p0, p1);
      if (t == tb || __any(rm > THR)) {
        const float dl = (t == tb) ? rm : __builtin_fmaxf(rm, 0.f);
        mhat += dl;
#pragma unroll
        for (int r = 0; r < 16; ++r) { p0[r] -= dl; p1[r] -= dl; negm[r] = -mhat; }
        const float f = __builtin_amdgcn_exp2f(-dl); l_reg *= f;
        if (t > tb) {
          if (hi == 0) wsf[r32] = f;
          asm volatile("s_waitcnt lgkmcnt(0)" ::: "memory");
#pragma unroll
          for (int d_ = 0; d_ < 2; ++d_)
#pragma unroll
            for (int r = 0; r < 16; ++r) o[d_][r] *= wsf[crow(r, hi)];
          asm volatile("s_waitcnt lgkmcnt(0)" ::: "memory");
        }
      }
      float sacc = 0.f;
#pragma unroll
      for (int r = 0; r < 16; ++r) { if (!(ABL & 2)) { p0[r] = __builtin_amdgcn_exp2f(p0[r]); p1[r] = __builtin_amdgcn_exp2f(p1[r]); } sacc += p0[r] + p1[r]; }
      l_reg += sacc;
#define PKW(P, B) cvtpk_s(P[B], P[B + 1])
      pw0 = (u32x4){PKW(p0, 0), PKW(p0, 2), PKW(p0, 4), PKW(p0, 6)}; pw1 = (u32x4){PKW(p0, 8), PKW(p0, 10), PKW(p0, 12), PKW(p0, 14)};
      pw2 = (u32x4){PKW(p1, 0), PKW(p1, 2), PKW(p1, 4), PKW(p1, 6)}; pw3 = (u32x4){PKW(p1, 8), PKW(p1, 10), PKW(p1, 12), PKW(p1, 14)};
#undef PKW
      SBAR();
      if (ABL & 1) { asm volatile("" :: "v"(pw0), "v"(pw1), "v"(pw2), "v"(pw3)); }
      else if (!grpB) pv(o, vb0 + vs_cur * VSLOT, __builtin_bit_cast(bf16x8, pw0), __builtin_bit_cast(bf16x8, pw1), __builtin_bit_cast(bf16x8, pw2), __builtin_bit_cast(bf16x8, pw3));
      else { pend = true; vs_pend = vs_cur; }
    }
    ks_cur = ks1; vs_cur = vs1;
  }
  if (pend && !(ABL & 1)) pv(o, vb0 + vs_pend * VSLOT, __builtin_bit_cast(bf16x8, pw0), __builtin_bit_cast(bf16x8, pw1), __builtin_bit_cast(bf16x8, pw2), __builtin_bit_cast(bf16x8, pw3));
  { auto rr = __builtin_amdgcn_permlane32_swap(__float_as_uint(l_reg), __float_as_uint(l_reg), false, false); l_reg = __uint_as_float(rr[0]) + __uint_as_float(rr[1]); }
  if (hi == 0) wsf[32 + r32] = l_reg;
  asm volatile("s_waitcnt lgkmcnt(0)" ::: "memory");
  float rli[16];
#pragma unroll
  for (int r = 0; r < 16; ++r) rli[r] = __builtin_amdgcn_rcpf(wsf[32 + crow(r, hi)]);
  bf16* Ow = T.O + (rowbase + q0 + wid * 32) * 1024 + h * 64;
  { ATT_LAS bf16* stg = (ATT_LAS bf16*)(shm3 + LDS_OST) + wid * 2048;
#pragma unroll
    for (int r = 0; r < 16; ++r) { const int orow = crow(r, hi);
#pragma unroll
      for (int d0 = 0; d0 < 2; ++d0) { const float v = o[d0][r] * rli[r]; stg[orow * 64 + d0 * 32 + r32] = (bf16)(cvtpk_s(v, v) & 0xffffu); } }
    asm volatile("s_waitcnt lgkmcnt(0)" ::: "memory");
#pragma unroll
    for (int i = 0; i < 4; ++i) { const int row = i * 8 + (lane >> 3), ch = lane & 7; const u32x4 v = *(const ATT_LAS u32x4*)(stg + row * 64 + ch * 8); *(u32x4*)(Ow + (long)row * 1024 + ch * 8) = v; } }
  asm volatile("s_waitcnt lgkmcnt(0)\n\ts_barrier" ::: "memory");
#undef DMA_K
#undef DMA_V
}
#undef SBAR
#undef WAIT_BAR
#undef MX3
}
#ifndef MK_PER_PHASE
#define MK_PER_PHASE 0
#endif
constexpr int NWAVES = 8;
constexpr int BATCH = 8, SEQ = 4096, DM = 1024, M = BATCH * SEQ;
constexpr int NIN = 4096;
constexpr int NEXP = 32, XG_ROWS = 2 * M + NEXP * 256;
constexpr float EPS = 1e-6f, LOG2E = 1.4426950408889634f;
constexpr float C2F = 0.125f * LOG2E;
constexpr float C2M = 0.10206207261596577f * LOG2E;
constexpr int N_PHASES = 14;
constexpr size_t MiB = 1u << 20;
constexpr size_t WS_CTL = 0, CTL_ZERO_BYTES = 1 * MiB;
constexpr size_t WS_WIN = 1 * MiB, WS_WUQ = 9 * MiB, WS_WUKV = 9 * MiB + 512 * 1024, WS_WOA = 10 * MiB, WS_WOB = 11 * MiB, WS_WOUT = 12 * MiB, WS_WR = 14 * MiB, WS_WGU = 15 * MiB, WS_WDN = 47 * MiB;
constexpr size_t WS_CS = 63 * MiB, WS_LOGF = 67 * MiB, WS_EID = 68 * MiB, WS_SLOT = WS_EID + 256 * 1024, WS_WGT = WS_SLOT + 256 * 1024, WS_POS = WS_WGT + 256 * 1024, WS_WROW = 69 * MiB;
constexpr size_t WS_XN = 72 * MiB, WS_CQN = 72 * MiB, WS_CKVN = 88 * MiB, WS_VM = 96 * MiB, WS_KR = 128 * MiB;
constexpr size_t WS_Z0 = 136 * MiB, WS_Z1 = 152 * MiB, WS_QF = 184 * MiB, WS_KF = 224 * MiB, WS_VF = 264 * MiB, WS_OA = 296 * MiB, WS_OB = 328 * MiB, WS_MIX = 360 * MiB, WS_QM = 424 * MiB, WS_KM = 472 * MiB;
constexpr size_t WS_HN = 72 * MiB, WS_LG = 200 * MiB, WS_XG = 232 * MiB, WS_ACT = 376 * MiB, WS_YB = 72 * MiB, WS_END = 504 * MiB;
static_assert(WS_XG + (size_t)XG_ROWS * 2048 <= WS_ACT && WS_ACT + (size_t)XG_ROWS * 512 <= WS_END && WS_YB + (size_t)XG_ROWS * 2048 <= WS_XG, "moe map");
constexpr int CW_CNT = 8192;
constexpr int CW_TPRE = 128;
constexpr int CW_QK = 256;
constexpr int CW_AQ = 512;
constexpr int CW_BAR = 4096;
constexpr int RING_OFF = 0, RING_BYTES = 131072, LDSCTL_OFF = RING_BYTES, MISC_OFF = LDSCTL_OFF + 320, TP_OFF = LDSCTL_OFF + 1024, LDS_BYTES = 147456;

#define GAS __attribute__((address_space(1)))
#define LAS __attribute__((address_space(3)))
typedef unsigned short bf16;
typedef unsigned v4u __attribute__((ext_vector_type(4)));
typedef float f32x4 __attribute__((ext_vector_type(4)));
typedef short bf16x8 __attribute__((ext_vector_type(8)));
typedef GAS unsigned gu32;
typedef GAS unsigned long long gu64;
#define RLX_AGENT __ATOMIC_RELAXED, __HIP_MEMORY_SCOPE_AGENT
#define LDS_WAIT() asm volatile("s_waitcnt lgkmcnt(0)" ::: "memory")
#define VM_WAIT() asm volatile("s_waitcnt vmcnt(0)" ::: "memory")
__device__ __forceinline__ unsigned long long rt() { return __builtin_amdgcn_s_memrealtime(); }
__device__ __forceinline__ unsigned f2bf(float f) { unsigned u = __builtin_bit_cast(unsigned, f); return (u + 0x7fffu + ((u >> 16) & 1u)) >> 16; }
__device__ __forceinline__ unsigned pk2(float lo, float hi) { return f2bf(lo) | (f2bf(hi) << 16); }


#define XB_TMO      128
#define XB_XCNT(j)  (256  + 64 * (j))
#define XB_XSUB(j)  (1280 + 64 * (j))
#define XB_XGEN(j)  (2304 + 64 * (j))
#define XB_TOP      3328
#define XB_TOPGEN   3392
#define XCD_BAR_WORDS 3456
#define XB_SPIN_CAP (1u << 18)

__device__ __forceinline__ unsigned xb_ld(unsigned* p)              { return __hip_atomic_load(p, __ATOMIC_RELAXED, __HIP_MEMORY_SCOPE_AGENT); }
__device__ __forceinline__ unsigned xb_add(unsigned* p, unsigned v) { return __hip_atomic_fetch_add(p, v, __ATOMIC_RELAXED, __HIP_MEMORY_SCOPE_AGENT); }
__device__ __forceinline__ unsigned xb_xcc_id() { return (unsigned)__builtin_amdgcn_s_getreg((3 << 11) | 20) & 0xFu; }
#define XB_SPIN(cond, bar) do { unsigned _sp = 0; while (cond) { __builtin_amdgcn_s_sleep(1); \
    if ((++_sp & 255u) == 0u) { if (xb_ld(&(bar)[XB_TMO])) break; if (_sp > XB_SPIN_CAP) { atomicAdd(&(bar)[XB_TMO], 1u); break; } } } } while (0)

struct XcdBarrier {
    unsigned* bar; unsigned x;
    volatile LAS unsigned* st;
};

__device__ __forceinline__ XcdBarrier xcd_barrier_post(unsigned* bar, volatile LAS unsigned* st) {
    XcdBarrier b; b.bar = bar; b.x = xb_xcc_id(); b.st = st;
    if (threadIdx.x == 0) (void)xb_add(&bar[XB_XCNT(b.x)], 1u);
    return b;
}
__device__ __forceinline__ void xcd_barrier_complete(unsigned* bar, unsigned x, unsigned& nloc, unsigned& nx) {
    const unsigned G = gridDim.x * gridDim.y * gridDim.z;
    unsigned sum, cnt, mine, sp = 0u;
    for (;;) {
        sum = 0u; cnt = 0u; mine = 0u;
#pragma unroll
        for (unsigned j = 0; j < 16; ++j) { const unsigned c = xb_ld(&bar[XB_XCNT(j)]); sum += c; cnt += (c > 0u) ? 1u : 0u; mine = (j == x) ? c : mine; }
        if (sum == G) break;
        __builtin_amdgcn_s_sleep(1);
        if ((++sp & 255u) == 0u) { if (xb_ld(&bar[XB_TMO])) break; if (sp > XB_SPIN_CAP) { atomicAdd(&bar[XB_TMO], 1u); break; } }
    }
    nloc = mine > 0u ? mine : 1u; nx = cnt > 0u ? cnt : 1u;
}

__device__ __forceinline__ void xcd_barrier(const XcdBarrier& b) {
    asm volatile("s_waitcnt vmcnt(0)" ::: "memory");
    __syncthreads();
    if (threadIdx.x == 0) {
        unsigned* bar = b.bar;
        __builtin_amdgcn_s_waitcnt(0);
        unsigned nloc = b.st[0], nx = b.st[1];
        if (nloc == 0u) { xcd_barrier_complete(bar, b.x, nloc, nx); b.st[0] = nloc; b.st[1] = nx; }
        const unsigned old = xb_add(&bar[XB_XSUB(b.x)], 1u);
        const unsigned gen = old / nloc;
        if (old + 1u == (gen + 1u) * nloc) {
            __builtin_amdgcn_fence(__ATOMIC_RELEASE, "agent");
            asm volatile("s_waitcnt vmcnt(0)" ::: "memory");
            const unsigned og = xb_add(&bar[XB_TOP], 1u);
            const unsigned tg = og / nx;
            if (og + 1u == (tg + 1u) * nx) xb_add(&bar[XB_TOPGEN], 1u);
            else XB_SPIN(xb_ld(&bar[XB_TOPGEN]) == tg, bar);
            __builtin_amdgcn_fence(__ATOMIC_ACQUIRE, "agent");
            xb_add(&bar[XB_XGEN(b.x)], 1u);
            asm volatile("s_waitcnt vmcnt(0)" ::: "memory");
        } else {
            XB_SPIN(xb_ld(&bar[XB_XGEN(b.x)]) == gen, bar);
            __builtin_amdgcn_fence(__ATOMIC_ACQUIRE, "agent");
            asm volatile("s_waitcnt vmcnt(0)" ::: "memory");
        }
    }
    __syncthreads();
}


typedef unsigned v2u __attribute__((ext_vector_type(2)));
__device__ __forceinline__ float wave_sum(float v) {
#pragma unroll
    for (int o = 1; o < 64; o <<= 1) v += __shfl_xor(v, o);
    return v;
}
__device__ __forceinline__ float bf2f(unsigned short b) { return __builtin_bit_cast(float, (unsigned)b << 16); }
__device__ __forceinline__ float bflo(unsigned w) { return __builtin_bit_cast(float, w << 16); }
__device__ __forceinline__ float bfhi(unsigned w) { return __builtin_bit_cast(float, w & 0xffff0000u); }
__device__ __forceinline__ v4u pack8(f32x4 a, f32x4 b) { v4u w; w.x = pg8::cvt_pk_bf16(a[0], a[1]); w.y = pg8::cvt_pk_bf16(a[2], a[3]); w.z = pg8::cvt_pk_bf16(b[0], b[1]); w.w = pg8::cvt_pk_bf16(b[2], b[3]); return w; }
__device__ __forceinline__ float sigmoidf_(float x) { return __builtin_amdgcn_rcpf(1.0f + __builtin_amdgcn_exp2f(-x * LOG2E)); }

using pg8::Unit;
#define EPI_ROWS(...) int rb_ = u.pm * 256 + wr * 64 + fr; asm volatile("" : "+v"(rb_)); _Pragma("unroll") for (int ai = 0; ai < 2; ++ai) _Pragma("unroll") for (int m = 0; m < 4; ++m) { const size_t row = (size_t)(rb_ + ai * 128 + m * 16); \
        _Pragma("unroll") for (int bj = 0; bj < 2; ++bj) { const f32x4 v0 = acc[ai][bj][m][0], v1 = acc[ai][bj][m][1]; __VA_ARGS__ } }
struct EpiIn { static constexpr bool PERM = true, AFTER_DRAIN = false, MID = false;
    bf16* Z0; float* Z1; bf16 *QF, *KF, *VF, *GA, *GB;
    __device__ __forceinline__ void operator()(const f32x4 (&acc)[2][2][4][2], const Unit& u, int wr, int wc, int fr, int fq) const {
        const int pn = u.pn;
        EPI_ROWS({ const int ct = bj * 128 + wc * 32 + 8 * fq;
            if (pn == 0) { *(v4u*)(Z0 + row * 256 + ct) = pack8(v0, v1); }
            else if (pn == 1) { float* p = Z1 + row * 256 + ct; *(f32x4*)p = v0; *(f32x4*)(p + 4) = v1; }
            else if (pn < 4) { const int c = (pn - 2) * 256 + ct; *(v4u*)(QF + row * 640 + (c >> 6) * 80 + (c & 63)) = pack8(v0 * C2F, v1 * C2F); }
            else if (pn < 6) { const int c = (pn - 4) * 256 + ct; *(v4u*)(KF + row * 640 + (c >> 6) * 80 + (c & 63)) = pack8(v0, v1); }
            else if (pn < 8) { const int c = (pn - 6) * 256 + ct; *(v4u*)(VF + row * 512 + c) = pack8(v0, v1); }
            else { bf16* G = pn < 12 ? GA : GB; const int c = ((pn - 8) & 3) * 256 + ct; f32x4 s0, s1;
                _Pragma("unroll") for (int e = 0; e < 4; ++e) { s0[e] = sigmoidf_(v0[e]); s1[e] = sigmoidf_(v1[e]); }
                *(v4u*)(G + row * 1024 + c) = pack8(s0, s1); } })
    }
};
struct EpiQup { static constexpr bool PERM = true, AFTER_DRAIN = false, MID = false;
    bf16* QM;
    __device__ __forceinline__ void operator()(const f32x4 (&acc)[2][2][4][2], const Unit& u, int wr, int wc, int fr, int fq) const {
        EPI_ROWS({ const int ct = u.pn * 256 + bj * 128 + wc * 32 + 8 * fq; *(v4u*)(QM + row * 768 + ct) = pack8(v0 * C2M, v1 * C2M); })
    }
};
struct EpiKVup { static constexpr bool PERM = true, AFTER_DRAIN = false, MID = false;
    bf16 *KM, *VM;
    __device__ __forceinline__ void operator()(const f32x4 (&acc)[2][2][4][2], const Unit& u, int wr, int wc, int fr, int fq) const {
        bf16* D = u.pn < 2 ? KM : VM; const int c0 = (u.pn & 1) * 256;
        EPI_ROWS({ const int ct = bj * 128 + wc * 32 + 8 * fq; *(v4u*)(D + row * 512 + c0 + ct) = pack8(v0, v1); })
    }
};
struct EpiMix { static constexpr bool PERM = true, AFTER_DRAIN = false, MID = true;
    const bf16 *GA_, *GB_; bf16* MIX_;
    __device__ __forceinline__ void mid(f32x4 (&acc)[2][2][4][2], const Unit& u, int wr, int wc, int fr, int fq) const {
        int rb_ = u.pm * 256 + wr * 64 + fr; asm volatile("" : "+v"(rb_));
#pragma unroll
        for (int ai = 0; ai < 2; ++ai) { v4u ga[4][2], gb[4][2];
#pragma unroll
            for (int m = 0; m < 4; ++m)
#pragma unroll
                for (int bj = 0; bj < 2; ++bj) { const size_t off = (size_t)(rb_ + ai * 128 + m * 16) * 1024 + u.pn * 256 + bj * 128 + wc * 32 + 8 * fq; ga[m][bj] = *(const v4u*)(GA_ + off); gb[m][bj] = *(const v4u*)(GB_ + off); }
#pragma unroll
            for (int m = 0; m < 4; ++m)
#pragma unroll
                for (int bj = 0; bj < 2; ++bj) { const v4u a = ga[m][bj], b = gb[m][bj];
                    const f32x4 r0 = {bflo(a.x) * __builtin_amdgcn_rcpf(bflo(b.x)), bfhi(a.x) * __builtin_amdgcn_rcpf(bfhi(b.x)), bflo(a.y) * __builtin_amdgcn_rcpf(bflo(b.y)), bfhi(a.y) * __builtin_amdgcn_rcpf(bfhi(b.y))};
                    const f32x4 r1 = {bflo(a.z) * __builtin_amdgcn_rcpf(bflo(b.z)), bfhi(a.z) * __builtin_amdgcn_rcpf(bfhi(b.z)), bflo(a.w) * __builtin_amdgcn_rcpf(bflo(b.w)), bfhi(a.w) * __builtin_amdgcn_rcpf(bfhi(b.w))};
                    acc[ai][bj][m][0] *= r0; acc[ai][bj][m][1] *= r1; }
            asm volatile("" ::: "memory"); }
    }
    __device__ __forceinline__ void operator()(const f32x4 (&acc)[2][2][4][2], const Unit& u, int wr, int wc, int fr, int fq) const {
        EPI_ROWS({ const size_t off = row * 1024 + u.pn * 256 + bj * 128 + wc * 32 + 8 * fq; const v4u g = *(const v4u*)(GB_ + off);
            const f32x4 r0 = {bflo(g.x) * v0[0], bfhi(g.x) * v0[1], bflo(g.y) * v0[2], bfhi(g.y) * v0[3]}; const f32x4 r1 = {bflo(g.z) * v1[0], bfhi(g.z) * v1[1], bflo(g.w) * v1[2], bfhi(g.w) * v1[3]};
            *(v4u*)(MIX_ + off) = pack8(r0, r1); })
    }
};
struct EpiY { static constexpr bool PERM = true, AFTER_DRAIN = false, MID = false;
    bf16* Y_;
    __device__ __forceinline__ void operator()(const f32x4 (&acc)[2][2][4][2], const Unit& u, int wr, int wc, int fr, int fq) const {
        EPI_ROWS({ *(v4u*)(Y_ + row * 1024 + u.pn * 256 + bj * 128 + wc * 32 + 8 * fq) = pack8(v0, v1); })
    }
};
struct EpiLg { static constexpr bool PERM = true, AFTER_DRAIN = false, MID = false;
    float* LG;
    __device__ __forceinline__ void operator()(const f32x4 (&acc)[2][2][4][2], const Unit& u, int wr, int wc, int fr, int fq) const {
        EPI_ROWS({ if (bj == 0) { float* p = LG + row * 128 + wc * 32 + 8 * fq; *(f32x4*)p = v0; *(f32x4*)(p + 4) = v1; } })
    }
};
struct EpiGU { static constexpr bool PERM = true, AFTER_DRAIN = false, MID = false;
    bf16* ACT;
    __device__ __forceinline__ void operator()(const f32x4 (&acc)[2][2][4][2], const Unit& u, int wr, int wc, int fr, int fq) const {
        const int c0 = (u.pn & 1) * 128 + wc * 32 + 8 * fq; int rb_ = u.pm * 256 + wr * 64 + fr; asm volatile("" : "+v"(rb_));
#pragma unroll
        for (int ai = 0; ai < 2; ++ai)
#pragma unroll
            for (int m = 0; m < 4; ++m) { const size_t row = (size_t)(rb_ + ai * 128 + m * 16); f32x4 a0, a1;
#pragma unroll
                for (int e = 0; e < 4; ++e) { const float g0 = acc[ai][0][m][0][e], g1 = acc[ai][0][m][1][e]; a0[e] = g0 * sigmoidf_(g0) * acc[ai][1][m][0][e]; a1[e] = g1 * sigmoidf_(g1) * acc[ai][1][m][1][e]; }
                *(v4u*)(ACT + row * 256 + c0) = pack8(a0, a1); }
    }
};
struct EpiDown { static constexpr bool PERM = true, AFTER_DRAIN = false, MID = false;
    bf16* YB; const float* WROW;
    __device__ __forceinline__ void operator()(const f32x4 (&acc)[2][2][4][2], const Unit& u, int wr, int wc, int fr, int fq) const {
        const int c0 = (u.pn & 3) * 256;
        EPI_ROWS({ const float w = WROW[row]; *(v4u*)(YB + row * 1024 + c0 + bj * 128 + wc * 32 + 8 * fq) = pack8(v0 * w, v1 * w); })
    }
};
struct ExpertOrder {
    const LAS unsigned* tpre; int NJ, G, c;
    __device__ __forceinline__ bool next(int i, Unit& u) const {
        const int total = (int)tpre[NEXP] * NJ; const long L = (long)i * G + c; if (L >= total) return false;
        const int T = (int)L / NJ, j = (int)L % NJ; int e = 0;
#pragma unroll 1
        for (int k = 1; k < NEXP; ++k) e += ((int)tpre[k] <= T) ? 1 : 0;
        u.pm = T; u.pn = e * NJ + j; return true;
    }
    __device__ __forceinline__ void a_ready(const Unit&) const {}
    __device__ __forceinline__ void done(const Unit&) const {}
};

__device__ __forceinline__ void tr_item(const float* colp, int N, int k0, bf16* dst  , int K, bool lo, LAS float* scr, int lane) {
#pragma unroll 8
    for (int i = 0; i < 32; ++i) { const int kk = 2 * i + (lane >> 5); float v = colp ? colp[(size_t)(k0 + kk) * N] : 0.f;
        if (lo) v = v - bf2f((unsigned short)f2bf(v));
        scr[kk * 33 + (lane & 31)] = v; }
    LDS_WAIT(); asm volatile("" ::: "memory");
    const int c = lane & 7;
#pragma unroll
    for (int j = 0; j < 4; ++j) { const int n = (lane >> 3) + 8 * j; const LAS float* s = scr + (8 * c) * 33 + n;
        v4u o; o.x = pk2(s[0 * 33], s[1 * 33]); o.y = pk2(s[2 * 33], s[3 * 33]); o.z = pk2(s[4 * 33], s[5 * 33]); o.w = pk2(s[6 * 33], s[7 * 33]);
        *(GAS v4u*)(dst + (size_t)n * K + 8 * c) = o; }
    LDS_WAIT(); asm volatile("" ::: "memory");
}
__device__ __forceinline__ void tr_item4(const float* cp4, int N, bf16* dst  , int K, LAS float* scr, int lane) {
    const int c = lane & 7, kr0 = lane >> 3; f32x4 v[8];
#pragma unroll
    for (int i = 0; i < 8; ++i) v[i] = cp4 ? *(const f32x4*)(cp4 + (size_t)(8 * i) * N) : (f32x4){0.f, 0.f, 0.f, 0.f};
#pragma unroll
    for (int i = 0; i < 8; ++i) { LAS float* s = scr + (kr0 + 8 * i) * 33 + 4 * c; s[0] = v[i].x; s[1] = v[i].y; s[2] = v[i].z; s[3] = v[i].w; }
    LDS_WAIT(); asm volatile("" ::: "memory");
#pragma unroll
    for (int j = 0; j < 4; ++j) { const int n = kr0 + 8 * j; const LAS float* s = scr + (8 * c) * 33 + n;
        v4u o; o.x = pk2(s[0 * 33], s[1 * 33]); o.y = pk2(s[2 * 33], s[3 * 33]); o.z = pk2(s[4 * 33], s[5 * 33]); o.w = pk2(s[6 * 33], s[7 * 33]);
        *(GAS v4u*)(dst + (size_t)n * K + 8 * c) = o; }
    LDS_WAIT(); asm volatile("" ::: "memory");
}
constexpr int I7 = NEXP * 16 * 16, I8 = NEXP * 32 * 4;
__device__ __forceinline__ void conv_expert_item(int r, const float* w_e_gate, const float* w_e_up, const float* w_e_down, bf16* WGUp, bf16* WDNp, LAS float* scr, int lane) {
    const int c4 = 4 * (lane & 7), kr0 = lane >> 3;
    if (r < I7) { const int e = r / 256, q = r % 256, nb = q % 16, kb = q / 16, rr = nb * 32 + c4;
        const int j = rr >> 8, isup = (rr >> 7) & 1, cc = rr & 127; const float* src = (isup ? w_e_up : w_e_gate) + (size_t)e * 1024 * 256 + (size_t)(kb * 64 + kr0) * 256 + 128 * j + cc;
        tr_item4(src, 256, WGUp + ((size_t)e * 512 + nb * 32) * 1024 + kb * 64, 1024, scr, lane); }
    else { r -= I7; const int e = r / 128, q = r % 128, nb = q % 32, kb = q / 32; tr_item4(w_e_down + (size_t)e * 256 * 1024 + (size_t)(kb * 64 + kr0) * 1024 + nb * 32 + c4, 1024, WDNp + ((size_t)e * 1024 + nb * 32) * 256 + kb * 64, 256, scr, lane); }
}
__device__ __forceinline__ double inv_freq_d(int i) {
    const int q = i >> 2, r = i & 3;
    const double a = q == 0 ? 1.0 : q == 1 ? 0.1 : q == 2 ? 0.01 : 0.001;
    const double b = r == 0 ? 1.0 : r == 1 ? 0.5623413251903491 : r == 2 ? 0.31622776601683794 : 0.1778279410038923;
    return a * b;
}

struct Args { const float* in[22]; float* out; unsigned char* ws; int ph_lo, ph_hi; };

__global__ void __launch_bounds__(NWAVES * 64, 2) mk_fwd(Args args) {
    extern __shared__ __attribute__((aligned(16))) unsigned char lds[];
    LAS unsigned char* const L = (LAS unsigned char*)lds;
    volatile LAS unsigned* const MISC = (volatile LAS unsigned*)(L + MISC_OFF);
    const int tid = threadIdx.x, lane = tid & 63, wave = __builtin_amdgcn_readfirstlane(tid >> 6);
    const int G = gridDim.x; const int bx = blockIdx.x; const int vcu = (G % 8 == 0) ? (bx % 8) * (G / 8) + bx / 8 : bx;
    const int gw = vcu * NWAVES + wave, NGW = G * NWAVES;
    unsigned char* const ws = args.ws;
    gu32* const ctl = (gu32*)(ws + WS_CTL);
    const float* x = args.in[0]; const int* positions = (const int*)args.in[1]; const float* g_mix = args.in[2]; const float* w_in = args.in[3]; const float* b_forget = args.in[4];
    const float* g_cq = args.in[5]; const float* g_ckv = args.in[6]; const float* w_uq = args.in[7]; const float* w_uk = args.in[8]; const float* w_uv = args.in[9];
    const float* w_o_mla = args.in[10]; const float* w_o_fox = args.in[11]; const float* w_out = args.in[12]; const float* g_ffn = args.in[13]; const float* w_group = args.in[14];
    const float* b_group = args.in[15]; const float* w_router = args.in[16]; const float* b_router = args.in[17]; const float* w_e_gate = args.in[18]; const float* w_e_up = args.in[19];
    const float* w_e_down = args.in[20]; const float* g_final = args.in[21];
    float* const out = args.out;
#define WIN ((bf16*)(ws + WS_WIN))
#define WUQ ((bf16*)(ws + WS_WUQ))
#define WUKV ((bf16*)(ws + WS_WUKV))
#define WOA ((bf16*)(ws + WS_WOA))
#define WOB ((bf16*)(ws + WS_WOB))
#define WOUT ((bf16*)(ws + WS_WOUT))
#define WR ((bf16*)(ws + WS_WR))
#define WGU ((bf16*)(ws + WS_WGU))
#define WDN ((bf16*)(ws + WS_WDN))
#define CS ((float*)(ws + WS_CS))
#define LOGF ((float*)(ws + WS_LOGF))
#define EID ((int*)(ws + WS_EID))
#define SLOT ((int*)(ws + WS_SLOT))
#define WGT ((float*)(ws + WS_WGT))
#define POS ((int*)(ws + WS_POS))
#define WROW ((float*)(ws + WS_WROW))
#define XN ((bf16*)(ws + WS_XN))
#define CQN ((bf16*)(ws + WS_CQN))
#define CKVN ((bf16*)(ws + WS_CKVN))
#define VM ((bf16*)(ws + WS_VM))
#define KR ((bf16*)(ws + WS_KR))
#define Z0 ((bf16*)(ws + WS_Z0))
#define Z1 ((float*)(ws + WS_Z1))
#define QF ((bf16*)(ws + WS_QF))
#define KF ((bf16*)(ws + WS_KF))
#define VF ((bf16*)(ws + WS_VF))
#define OA ((bf16*)(ws + WS_OA))
#define OB ((bf16*)(ws + WS_OB))
#define MIX ((bf16*)(ws + WS_MIX))
#define QM ((bf16*)(ws + WS_QM))
#define KM ((bf16*)(ws + WS_KM))
#define HN ((bf16*)(ws + WS_HN))
#define LG ((float*)(ws + WS_LG))
#define XG ((bf16*)(ws + WS_XG))
#define ACT ((bf16*)(ws + WS_ACT))
#define YB ((bf16*)(ws + WS_YB))
#define GA ((bf16*)out)
#define GB ((bf16*)out + (size_t)M * 1024)
#define YM ((bf16*)(ws + WS_QM))

    for (int u = tid; u < (LDS_BYTES - LDSCTL_OFF) / 4; u += NWAVES * 64) ((LAS unsigned*)(L + LDSCTL_OFF))[u] = 0u;
    __syncthreads();
    XcdBarrier bar; bar.bar = (unsigned*)(ctl + CW_BAR); bar.x = 0; bar.st = nullptr;
    if (!MK_PER_PHASE) bar = xcd_barrier_post((unsigned*)(ctl + CW_BAR), MISC + 8);
    const int lo = args.ph_lo, hi = args.ph_hi;
#ifndef MK_REPEAT
#define MK_REPEAT -1
#endif
#ifndef MK_ONLY
#define MK_ONLY -1
#endif
#define IN(k) ((MK_ONLY < 0 || MK_ONLY == (k)) && lo <= (k) && (k) < hi)
#define SEAM(k) do { if (IN(k) && IN((k) + 1)) { if ((k) == 0) { cooperative_groups::this_grid().sync(); } else { xcd_barrier(bar); } } } while (0)

    if (IN(0)) for (int rep_ = 0; rep_ < ((MK_REPEAT == 0) ? 2 : 1); ++rep_) {
        LAS float* scr = (LAS float*)(L + RING_OFF + wave * 16384);
        constexpr int I0 = 128 * 16, I1 = 24 * 4, I2 = 32 * 2, I3 = 32 * 8, I4 = 32 * 8  , I5 = 32 * 16, I6 = 8 * 16;
        constexpr int NITEMS = I0 + I1 + I2; (void)I3; (void)I4; (void)I5; (void)I6;
        const int l31 = lane & 31, c4 = 4 * (lane & 7), kr0 = lane >> 3;
        for (int it = gw; it < NITEMS; it += NGW) {
            int r = it;
            if (r < I0) { const int nb = r % 128, kb = r / 128, n = nb * 32 + c4;
                int sc; if (n < 416) sc = n; else if (n < 424) sc = 1952 + (n - 416); else if (n < 512) sc = -1; else if (n < 2048) sc = n - 96; else sc = n - 88;
                tr_item4(sc >= 0 ? w_in + (size_t)(kb * 64 + kr0) * 4008 + sc : nullptr, 4008, WIN + (size_t)(nb * 32) * 1024 + kb * 64, 1024, scr, lane); continue; } r -= I0;
            if (r < I1) { const int nb = r % 24, kb = r / 24; tr_item4(w_uq + (size_t)(kb * 64 + kr0) * 768 + nb * 32 + c4, 768, WUQ + (size_t)(nb * 32) * 256 + kb * 64, 256, scr, lane); continue; } r -= I1;
            if (r < I2) { const int nb = r % 32, kb = r / 32, n = nb * 32 + c4; tr_item4((n < 512 ? w_uk + n : w_uv + (n - 512)) + (size_t)(kb * 64 + kr0) * 512, 512, WUKV + (size_t)(nb * 32) * 128 + kb * 64, 128, scr, lane); continue; }
        }
        for (int m = 2 * gw; m < M; m += 2 * NGW) {
            const GAS f32x4* xr = (const GAS f32x4*)(x + (size_t)m * DM) + lane; f32x4 v[8]; float s2a = 0.f, s2b = 0.f;
#pragma unroll
            for (int j = 0; j < 8; ++j) v[j] = xr[64 * j];
#pragma unroll
            for (int j = 0; j < 4; ++j) { s2a += (v[j].x * v[j].x + v[j].y * v[j].y) + (v[j].z * v[j].z + v[j].w * v[j].w); s2b += (v[4 + j].x * v[4 + j].x + v[4 + j].y * v[4 + j].y) + (v[4 + j].z * v[4 + j].z + v[4 + j].w * v[4 + j].w); }
            const float ra = 1.f / sqrtf(wave_sum(s2a) * (1.f / DM) + EPS), rb = 1.f / sqrtf(wave_sum(s2b) * (1.f / DM) + EPS);
            GAS unsigned long long* o8 = (GAS unsigned long long*)(XN + (size_t)m * DM) + lane;
#pragma unroll
            for (int j = 0; j < 8; ++j) { const f32x4 g = *((const f32x4*)g_mix + lane + 64 * (j & 3)); const float rs = j < 4 ? ra : rb;
                o8[64 * j] = (unsigned long long)pk2(v[j].x * rs * g.x, v[j].y * rs * g.y) | ((unsigned long long)pk2(v[j].z * rs * g.z, v[j].w * rs * g.w) << 32); }
        }
        for (int i = (vcu * NWAVES * 64 + tid); i < M * 16; i += G * NWAVES * 64) {
            const int m = i >> 4, f = i & 15; const double ang = (double)positions[m] * inv_freq_d(f); const double rev = ang * 0.15915494309189535; const float fr = (float)(rev - floor(rev));
            CS[2 * i] = __builtin_amdgcn_cosf(fr); CS[2 * i + 1] = __builtin_amdgcn_sinf(fr); }
    }
    SEAM(0);
    if (IN(1)) for (int rep_ = 0; rep_ < ((MK_REPEAT == 1) ? 2 : 1); ++rep_) {
        pg8::Gemm g{XN, WIN, M, NIN, DM}; pg8::StaticOrder S; S.init(M, NIN, G, bx);
        EpiIn E{Z0, Z1, QF, KF, VF, GA, GB};
        pg8::gemm_phase<EpiIn, pg8::StaticOrder, true, true>(L + RING_OFF, g, S, E);
    }
    SEAM(1);
    if (IN(2)) for (int rep_ = 0; rep_ < ((MK_REPEAT == 2) ? 2 : 1); ++rep_) {
        float* const BSUM = (float*)(ws + WS_EID);
        LAS float* part = (LAS float*)(L + RING_OFF);
        for (int vb = vcu; vb < 256; vb += G) { float lfsum = 0.f; const int g4 = lane >> 4, l16 = lane & 15;
#pragma unroll 2
        for (int it = 0; it < 4; ++it) { const size_t m = (size_t)vb * 128 + wave * 16 + it * 4 + g4;
            const v4u ra = *(const v4u*)(Z0 + m * 256 + l16 * 16), rb = *(const v4u*)(Z0 + m * 256 + l16 * 16 + 8);
            const float* z = Z1 + m * 256;
            const f32x4 ka = *(const f32x4*)(z + l16 * 8), kb = *(const f32x4*)(z + l16 * 8 + 4);
            const float x1 = z[128 + l16], x2 = z[144 + l16], cc = CS[m * 32 + 2 * l16], sn = CS[m * 32 + 2 * l16 + 1];
            const float fl = z[160 + (l16 & 7)];
            float q[16] = {bflo(ra.x), bfhi(ra.x), bflo(ra.y), bfhi(ra.y), bflo(ra.z), bfhi(ra.z), bflo(ra.w), bfhi(ra.w), bflo(rb.x), bfhi(rb.x), bflo(rb.y), bfhi(rb.y), bflo(rb.z), bfhi(rb.z), bflo(rb.w), bfhi(rb.w)};
            float sq = 0.f, sk = (ka.x * ka.x + ka.y * ka.y) + (ka.z * ka.z + ka.w * ka.w) + (kb.x * kb.x + kb.y * kb.y) + (kb.z * kb.z + kb.w * kb.w);
#pragma unroll
            for (int e = 0; e < 16; ++e) sq += q[e] * q[e];
#pragma unroll
            for (int o = 1; o < 16; o <<= 1) { sq += __shfl_xor(sq, o); sk += __shfl_xor(sk, o); }
            const float rq = 1.f / sqrtf(sq * (1.f / 256) + EPS), rk = 1.f / sqrtf(sk * (1.f / 128) + EPS);
            { const f32x4 g0 = *((const f32x4*)g_cq + l16 * 4), g1 = *((const f32x4*)g_cq + l16 * 4 + 1), g2 = *((const f32x4*)g_cq + l16 * 4 + 2), g3 = *((const f32x4*)g_cq + l16 * 4 + 3);
              v4u o0, o1; o0.x = pk2(q[0] * rq * g0.x, q[1] * rq * g0.y); o0.y = pk2(q[2] * rq * g0.z, q[3] * rq * g0.w); o0.z = pk2(q[4] * rq * g1.x, q[5] * rq * g1.y); o0.w = pk2(q[6] * rq * g1.z, q[7] * rq * g1.w);
              o1.x = pk2(q[8] * rq * g2.x, q[9] * rq * g2.y); o1.y = pk2(q[10] * rq * g2.z, q[11] * rq * g2.w); o1.z = pk2(q[12] * rq * g3.x, q[13] * rq * g3.y); o1.w = pk2(q[14] * rq * g3.z, q[15] * rq * g3.w);
              *(v4u*)(CQN + m * 256 + l16 * 16) = o0; *(v4u*)(CQN + m * 256 + l16 * 16 + 8) = o1; }
            { const f32x4 g0 = *((const f32x4*)g_ckv + l16 * 2), g1 = *((const f32x4*)g_ckv + l16 * 2 + 1);
              v4u o; o.x = pk2(ka.x * rk * g0.x, ka.y * rk * g0.y); o.y = pk2(ka.z * rk * g0.z, ka.w * rk * g0.w); o.z = pk2(kb.x * rk * g1.x, kb.y * rk * g1.y); o.w = pk2(kb.z * rk * g1.z, kb.w * rk * g1.w);
              *(v4u*)(CKVN + m * 128 + l16 * 8) = o; }
            KR[m * 32 + l16] = (bf16)f2bf(x1 * cc - x2 * sn); KR[m * 32 + 16 + l16] = (bf16)f2bf(x2 * cc + x1 * sn);
            if (l16 < 8) { const float xx = fl + b_forget[l16]; const float t = __expf(-fabsf(xx)); const float lfv = fminf(xx, 0.f) - __logf(1.f + t); LOGF[m * 8 + l16] = lfv; lfsum += lfv; }
            { const int hh = l16 >> 1, half = l16 & 1; v4u o = {0u, 0u, 0u, 0u}; *(v4u*)(KF + m * 640 + hh * 80 + 64 + half * 8) = o;
              if (half == 0) { o.x = 0x3F803F80u; o.y = 0x00003F80u; } *(v4u*)(QF + m * 640 + hh * 80 + 64 + half * 8) = o; }
        }
        lfsum += __shfl_xor(lfsum, 16); lfsum += __shfl_xor(lfsum, 32);
        if (lane < 8) part[wave * 8 + lane] = lfsum;
        __syncthreads();
        if (tid < 8) { float t = 0.f; for (int w = 0; w < 8; ++w) t += part[w * 8 + tid]; BSUM[vb * 8 + tid] = t; }
        __syncthreads();
        }
    }
    SEAM(2);
    if (IN(3)) for (int rep_ = 0; rep_ < ((MK_REPEAT == 3) ? 2 : 1); ++rep_) {
#ifndef NO_SCAN
        { const float* const BSUM = (const float*)(ws + WS_EID);
          for (int vb = vcu; vb < 256; vb += G) { const int b = vb >> 5, bi = vb & 31, hh = wave;
            double base = (lane < bi) ? (double)BSUM[(size_t)((b * 32 + lane) * 8 + hh)] : 0.0;
#pragma unroll
            for (int o = 1; o < 64; o <<= 1) base += __shfl_xor(base, o);
            const size_t t0 = (size_t)vb * 128 + 2 * lane; const float v0 = LOGF[t0 * 8 + hh], v1 = LOGF[(t0 + 1) * 8 + hh];
            const double sp = (double)v0 + (double)v1; double incl = sp;
#pragma unroll
            for (int o = 1; o < 64; o <<= 1) { const double t = __shfl_up(incl, o); if (lane >= o) incl += t; }
            const double run0 = base + (incl - sp) + (double)v0, run1 = run0 + (double)v1;
#pragma unroll
            for (int e = 0; e < 2; ++e) { const float gneg = (float)(-(e ? run1 : run0) * 1.4426950408889634);
                const unsigned b0 = f2bf(gneg); const float r1 = gneg - bf2f((unsigned short)b0); const unsigned b1 = f2bf(r1); const float r2 = r1 - bf2f((unsigned short)b1); const unsigned b2 = f2bf(r2);
                bf16* kf = KF + (t0 + e) * 640 + hh * 80 + 64; *(unsigned*)kf = b0 | (b1 << 16); *(unsigned*)(kf + 2) = b2;
                LOGF[(t0 + e) * 8 + hh] = bf2f((unsigned short)b0) + bf2f((unsigned short)b1) + bf2f((unsigned short)b2); }
            float qn = 0.f, kn = 0.f;
#pragma unroll
            for (int e = 0; e < 2; ++e) { const v4u* kp = (const v4u*)(KF + (t0 + e) * 640 + hh * 80); const v4u* qp = (const v4u*)(QF + (t0 + e) * 640 + hh * 80); float sk = 0.f, sq = 0.f;
#pragma unroll
                for (int c = 0; c < 8; ++c) { const v4u a = kp[c], q = qp[c];
                    sk += (bflo(a.x) * bflo(a.x) + bfhi(a.x) * bfhi(a.x)) + (bflo(a.y) * bflo(a.y) + bfhi(a.y) * bfhi(a.y)) + (bflo(a.z) * bflo(a.z) + bfhi(a.z) * bfhi(a.z)) + (bflo(a.w) * bflo(a.w) + bfhi(a.w) * bfhi(a.w));
                    sq += (bflo(q.x) * bflo(q.x) + bfhi(q.x) * bfhi(q.x)) + (bflo(q.y) * bflo(q.y) + bfhi(q.y) * bfhi(q.y)) + (bflo(q.z) * bflo(q.z) + bfhi(q.z) * bfhi(q.z)) + (bflo(q.w) * bflo(q.w) + bfhi(q.w) * bfhi(q.w)); }
                kn = fmaxf(kn, sk); qn = fmaxf(qn, sq); }
#pragma unroll
            for (int o = 1; o < 64; o <<= 1) { kn = fmaxf(kn, __shfl_xor(kn, o)); qn = fmaxf(qn, __shfl_xor(qn, o)); }
            if (lane == 0) { __hip_atomic_fetch_max(ctl + CW_QK + 2 * (b * 8 + hh), __float_as_uint(sqrtf(qn)), RLX_AGENT); __hip_atomic_fetch_max(ctl + CW_QK + 2 * (b * 8 + hh) + 1, __float_as_uint(sqrtf(kn)), RLX_AGENT); }
          } }
#endif
#ifndef NO_QUP
        { pg8::Gemm g{CQN, WUQ, M, 768, 256}; pg8::StaticOrder S; S.init(M, 768, G, bx); EpiQup E{QM};
          pg8::gemm_phase<EpiQup, pg8::StaticOrder, true, true>(L + RING_OFF, g, S, E); }
#endif
#ifndef NO_KVUP
        { pg8::Gemm g{CKVN, WUKV, M, 1024, 128}; pg8::StaticOrder S; S.init(M, 1024, G, bx); EpiKVup E{KM, VM};
          pg8::gemm_phase<EpiKVup, pg8::StaticOrder, true, true>(L + RING_OFF, g, S, E); }
#endif
    }
    SEAM(3);
    if (IN(4)) for (int rep_ = 0; rep_ < ((MK_REPEAT == 4) ? 2 : 1); ++rep_) {
        const att::AttnT TA{QM, KM, KR, VM, OA, CS, LOGF, (const unsigned*)(ctl + CW_QK)}; const att::AttnT TB{QF, KF, KF, VF, OA + 512, CS, LOGF, (const unsigned*)(ctl + CW_QK)};
        LAS int* qi = (LAS int*)(L + TP_OFF + 512);
        if (tid == 0) qi[0] = (int)__hip_atomic_fetch_add(ctl + CW_AQ, 1u, RLX_AGENT);
        __syncthreads();
        int idx = qi[0];
        constexpr int NLATE = I7 + I8 + 32 * 16 + 32 * 16 + 8 * 16, CONV_PER = 48, NQ = 2048 + NLATE / CONV_PER;
        static_assert(NLATE % CONV_PER == 0, "conv tickets");
        while (idx < NQ) {
            int nxt = 0; if (tid == 0) nxt = (int)__hip_atomic_fetch_add(ctl + CW_AQ, 1u, RLX_AGENT);
            const int r = idx & 1023, qb = 15 - (r >> 6), bh = r & 63;
            if (idx < 1024) att::attn_unit<0>(bh >> 3, bh & 7, qb, TA, (char*)lds + RING_OFF);
            else if (idx < 2048) att::attn_unit<1>(bh >> 3, bh & 7, qb, TB, (char*)lds + RING_OFF);
            else { LAS float* scr = (LAS float*)(L + RING_OFF + wave * 16384); const int l31 = lane & 31, c4 = 4 * (lane & 7), kr0 = lane >> 3;
#pragma unroll 1
                for (int k = 0; k < CONV_PER / NWAVES; ++k) { int r = (idx - 2048) * CONV_PER + wave * (CONV_PER / NWAVES) + k;
                    constexpr int J3 = 32 * 16, J5 = 32 * 16, J6 = 8 * 16;
                    if (r >= J6 + J3 + J5) { conv_expert_item(r - (J6 + J3 + J5), w_e_gate, w_e_up, w_e_down, WGU, WDN, scr, lane); continue; }
                    r = (r < J6) ? (r + J3 + J5) : (r - J6);
                    if (r < J3) { const int nb = r % 32, kb = r / 32;
                        const float* src = (kb < 8 ? w_o_mla + (size_t)(kb * 64 + kr0) * 1024 : w_o_fox + (size_t)((kb - 8) * 64 + kr0) * 1024) + nb * 32 + c4;
                        tr_item4(src, 1024, WOA + (size_t)(nb * 32) * 1024 + kb * 64, 1024, scr, lane); continue; } r -= J3;
                    if (r < J5) { const int nb = r % 32, kb = r / 32; tr_item4(w_out + (size_t)(kb * 64 + kr0) * 1024 + nb * 32 + c4, 1024, WOUT + (size_t)(nb * 32) * 1024 + kb * 64, 1024, scr, lane); continue; } r -= J5;
                    if (r < J6) { const int nb = r % 8, kb = r / 8, n = nb * 32 + l31; const int j = n & 63; const bool islo = (n >= 64 && n < 128); const bool valid = (n < 128) && (j < 36);
                        const float* cp = nullptr; int NN = 32; if (valid) { if (j < 4) { cp = w_group + j; NN = 4; } else { cp = w_router + (j - 4); NN = 32; } }
#pragma unroll 8
                        for (int i = 0; i < 32; ++i) { const int kk = 2 * i + (lane >> 5); float v = cp ? cp[(size_t)(kb * 64 + kk) * NN] : 0.f; if (islo) v = v - bf2f((unsigned short)f2bf(v)); scr[kk * 33 + l31] = v; }
                        LDS_WAIT(); asm volatile("" ::: "memory");
                        const int c = lane & 7; bf16* dst = WR + (size_t)(nb * 32) * 1024 + kb * 64;
#pragma unroll
                        for (int jj = 0; jj < 4; ++jj) { const int nn = (lane >> 3) + 8 * jj; const LAS float* sp = scr + (8 * c) * 33 + nn;
                            v4u o; o.x = pk2(sp[0 * 33], sp[1 * 33]); o.y = pk2(sp[2 * 33], sp[3 * 33]); o.z = pk2(sp[4 * 33], sp[5 * 33]); o.w = pk2(sp[6 * 33], sp[7 * 33]);
                            *(GAS v4u*)(dst + (size_t)nn * 1024 + 8 * c) = o; }
                        LDS_WAIT(); asm volatile("" ::: "memory"); } } }
            if (tid == 0) qi[0] = nxt;
            __syncthreads(); idx = qi[0];
        }
    }
#ifndef MK_ATT_PROBE
#define MK_ATT_PROBE -1
#endif
    if (MK_ATT_PROBE >= 0 && IN(4)) {
        const att::AttnT TA{QM, KM, KR, VM, MIX, CS, LOGF, (const unsigned*)(ctl + CW_QK)}; const att::AttnT TB{QF, KF, KF, VF, MIX + 512, CS, LOGF, (const unsigned*)(ctl + CW_QK)};
        for (int v = vcu; v < 256; v += G) { const int bh = v >> 2, sub = v & 3, b = bh >> 3, hh = bh & 7;
#pragma unroll 1
            for (int i = 0; i < 4; ++i) { const int qb = (i == 0) ? 15 - sub : (i == 1) ? 8 + sub : (i == 2) ? 7 - sub : sub;
                att::attn_unit<0, (MK_ATT_PROBE < 0 ? 0 : MK_ATT_PROBE)>(b, hh, qb, TA, (char*)lds + RING_OFF);
                att::attn_unit<1, (MK_ATT_PROBE < 0 ? 0 : MK_ATT_PROBE)>(b, hh, qb, TB, (char*)lds + RING_OFF); } }
    }
    SEAM(4);
    if (IN(5)) for (int rep_ = 0; rep_ < ((MK_REPEAT == 5) ? 2 : 1); ++rep_) {
        pg8::Gemm g{OA, WOA, M, 1024, 1024}; pg8::StaticOrder S; S.init(M, 1024, G, bx); EpiMix E{GA, GB, MIX}; pg8::gemm_phase<EpiMix, pg8::StaticOrder, true, true>(L + RING_OFF, g, S, E);
    }
    SEAM(5);
    if (IN(6)) for (int rep_ = 0; rep_ < ((MK_REPEAT == 6) ? 2 : 1); ++rep_) {
        pg8::Gemm g{MIX, WOUT, M, 1024, 1024}; pg8::StaticOrder S; S.init(M, 1024, G, bx); EpiY E{YM}; pg8::gemm_phase<EpiY, pg8::StaticOrder, true, true>(L + RING_OFF, g, S, E);
    }
    SEAM(6);
    if (IN(7)) for (int rep_ = 0; rep_ < ((MK_REPEAT == 7) ? 2 : 1); ++rep_) {
        for (int m0 = 2 * gw; m0 < M; m0 += 2 * NGW) {
            f32x4 v[8]; v2u yv[8];
#pragma unroll
            for (int j = 0; j < 8; ++j) { const size_t m = (size_t)m0 + (j >> 2); v[j] = *((const GAS f32x4*)(x + m * DM) + lane + 64 * (j & 3)); yv[j] = *((const v2u*)(YM + m * DM) + lane + 64 * (j & 3)); }
            float s2[2] = {0.f, 0.f};
#pragma unroll
            for (int j = 0; j < 8; ++j) { v[j].x += bflo(yv[j].x); v[j].y += bfhi(yv[j].x); v[j].z += bflo(yv[j].y); v[j].w += bfhi(yv[j].y); s2[j >> 2] += (v[j].x * v[j].x + v[j].y * v[j].y) + (v[j].z * v[j].z + v[j].w * v[j].w); }
            const float rs[2] = {1.f / sqrtf(wave_sum(s2[0]) * (1.f / DM) + EPS), 1.f / sqrtf(wave_sum(s2[1]) * (1.f / DM) + EPS)};
#pragma unroll
            for (int j = 0; j < 8; ++j) { const size_t m = (size_t)m0 + (j >> 2); const float rstd = rs[j >> 2];
                GAS unsigned long long* oh = (GAS unsigned long long*)(HN + m * DM) + lane + 64 * (j & 3); GAS unsigned long long* ol = (GAS unsigned long long*)(HN + ((size_t)M + m) * DM) + lane + 64 * (j & 3);
                const f32x4 g = *((const f32x4*)g_ffn + lane + 64 * (j & 3)); const f32x4 y = {v[j].x * rstd * g.x, v[j].y * rstd * g.y, v[j].z * rstd * g.z, v[j].w * rstd * g.w};
                const unsigned h0 = f2bf(y.x), h1 = f2bf(y.y), h2 = f2bf(y.z), h3 = f2bf(y.w);
                *oh = (unsigned long long)(h0 | (h1 << 16)) | ((unsigned long long)(h2 | (h3 << 16)) << 32);
                *ol = (unsigned long long)pk2(y.x - bf2f((unsigned short)h0), y.y - bf2f((unsigned short)h1)) | ((unsigned long long)pk2(y.z - bf2f((unsigned short)h2), y.w - bf2f((unsigned short)h3)) << 32); }
        }
    }
    SEAM(7);
    if (IN(8)) for (int rep_ = 0; rep_ < ((MK_REPEAT == 8) ? 2 : 1); ++rep_) {
        pg8::Gemm g{HN, WR, 2 * M, 256, 1024}; pg8::StaticOrder S; S.init(2 * M, 256, G, bx); EpiLg E{LG}; pg8::gemm_phase<EpiLg, pg8::StaticOrder, true, true>(L + RING_OFF, g, S, E);
    }
    SEAM(8);
    if (IN(9)) for (int rep_ = 0; rep_ < ((MK_REPEAT == 9) ? 2 : 1); ++rep_) {
        LAS unsigned* lc = (LAS unsigned*)(L + TP_OFF + 256);
        const int per = (M + G - 1) / G;
        for (int t0 = vcu * per; t0 < min(M, (vcu + 1) * per); t0 += NWAVES * 64) {
        if (tid < 64) lc[tid] = 0u;
        __syncthreads();
        const int t = t0 + tid; const bool act = (t < min(M, (vcu + 1) * per));
        int x0 = 0, x1 = 0; unsigned s0 = 0, s1 = 0; float w0 = 0.f, w1 = 0.f;
        if (act) {
            float lg[36];
            const float* a = LG + (size_t)t * 128; const float* b2 = LG + (size_t)(M + t) * 128;
#pragma unroll
            for (int q = 0; q < 9; ++q) { const f32x4 p0 = *(const f32x4*)(a + 4 * q), p1 = *(const f32x4*)(a + 64 + 4 * q), p2 = *(const f32x4*)(b2 + 4 * q), p3 = *(const f32x4*)(b2 + 64 + 4 * q);
#pragma unroll
                for (int e = 0; e < 4; ++e) lg[4 * q + e] = (p0[e] + p1[e]) + (p2[e] + p3[e]); }
#pragma unroll
            for (int j = 0; j < 4; ++j) lg[j] += b_group[j];
#pragma unroll
            for (int j = 0; j < 32; ++j) lg[4 + j] += b_router[j];
            int gi = 0; float gm = lg[0];
#pragma unroll
            for (int j = 1; j < 4; ++j) if (lg[j] > gm) { gm = lg[j]; gi = j; }
            float gs = 0.f;
#pragma unroll
            for (int j = 0; j < 4; ++j) gs += __expf(lg[j] - gm);
            const float gp = 1.f / gs;
            float sel[8];
#pragma unroll
            for (int e = 0; e < 8; ++e) sel[e] = gi == 0 ? lg[4 + e] : gi == 1 ? lg[12 + e] : gi == 2 ? lg[20 + e] : lg[28 + e];
            int e0 = 0; float m0 = sel[0];
#pragma unroll
            for (int e = 1; e < 8; ++e) if (sel[e] > m0) { m0 = sel[e]; e0 = e; }
            int e1 = -1; float m1 = -INFINITY;
#pragma unroll
            for (int e = 0; e < 8; ++e) if (e != e0 && sel[e] > m1) { m1 = sel[e]; e1 = e; }
            const float r = __expf(m1 - m0); w0 = gp / (1.f + r); w1 = gp * r / (1.f + r);
            x0 = gi * 8 + e0; x1 = gi * 8 + e1;
            s0 = __hip_atomic_fetch_add(lc + x0, 1u, __ATOMIC_RELAXED, __HIP_MEMORY_SCOPE_WORKGROUP); s1 = __hip_atomic_fetch_add(lc + x1, 1u, __ATOMIC_RELAXED, __HIP_MEMORY_SCOPE_WORKGROUP);
        }
        __syncthreads();
        if (tid < NEXP) { const unsigned c = lc[tid]; lc[32 + tid] = c ? __hip_atomic_fetch_add(ctl + CW_CNT + 64 * tid, c, RLX_AGENT) : 0u; }
        __syncthreads();
        if (act) { EID[2 * t] = x0; EID[2 * t + 1] = x1; SLOT[2 * t] = (int)(lc[32 + x0] + s0); SLOT[2 * t + 1] = (int)(lc[32 + x1] + s1); WGT[2 * t] = w0; WGT[2 * t + 1] = w1; }
        __syncthreads();
        }
    }
    SEAM(9);
    if (IN(10)) for (int rep_ = 0; rep_ < ((MK_REPEAT == 10) ? 2 : 1); ++rep_) {
        LAS unsigned* tp = (LAS unsigned*)(L + TP_OFF);
        if (tid == 0) { unsigned acc = 0; for (int e = 0; e < NEXP; ++e) { tp[e] = acc; acc += (__hip_atomic_load(ctl + CW_CNT + 64 * e, RLX_AGENT) + 255u) >> 8; } tp[NEXP] = acc;
            if (bx == 0) for (int e = 0; e <= NEXP; ++e) __hip_atomic_store(ctl + CW_TPRE + e, tp[e], RLX_AGENT); }
        __syncthreads();
        for (int m = gw; m < M; m += NGW) {
            const int x0 = EID[2 * m], x1 = EID[2 * m + 1]; const int p0 = (int)tp[x0] * 256 + SLOT[2 * m], p1 = (int)tp[x1] * 256 + SLOT[2 * m + 1];
            if (lane == 0) { POS[2 * m] = p0; POS[2 * m + 1] = p1; WROW[p0] = WGT[2 * m]; WROW[p1] = WGT[2 * m + 1]; }
            const v4u a = *((const v4u*)(HN + (size_t)m * DM) + lane), b2 = *((const v4u*)(HN + (size_t)m * DM) + 64 + lane);
            *((v4u*)(XG + (size_t)p0 * DM) + lane) = a; *((v4u*)(XG + (size_t)p0 * DM) + 64 + lane) = b2;
            *((v4u*)(XG + (size_t)p1 * DM) + lane) = a; *((v4u*)(XG + (size_t)p1 * DM) + 64 + lane) = b2;
        }
        __syncthreads();
    }
    SEAM(10);
    if (IN(11)) for (int rep_ = 0; rep_ < ((MK_REPEAT == 11) ? 2 : 1); ++rep_) {
        LAS unsigned* tp = (LAS unsigned*)(L + TP_OFF); if (tid <= NEXP) tp[tid] = __hip_atomic_load(ctl + CW_TPRE + tid, RLX_AGENT); __syncthreads();
        pg8::Gemm g{XG, WGU, XG_ROWS, NEXP * 512, 1024}; ExpertOrder S{tp, 2, G, bx}; EpiGU E{ACT};
        pg8::gemm_phase<EpiGU, ExpertOrder, true, true>(L + RING_OFF, g, S, E);
    }
    SEAM(11);
    if (IN(12)) for (int rep_ = 0; rep_ < ((MK_REPEAT == 12) ? 2 : 1); ++rep_) {
        LAS unsigned* tp = (LAS unsigned*)(L + TP_OFF); if (tid <= NEXP) tp[tid] = __hip_atomic_load(ctl + CW_TPRE + tid, RLX_AGENT); __syncthreads();
        pg8::Gemm g{ACT, WDN, XG_ROWS, NEXP * 1024, 256}; ExpertOrder S{tp, 4, G, bx}; EpiDown E{YB, WROW};
        pg8::gemm_phase<EpiDown, ExpertOrder, true, true>(L + RING_OFF, g, S, E);
    }
    SEAM(12);
    if (IN(13)) for (int rep_ = 0; rep_ < ((MK_REPEAT == 13) ? 2 : 1); ++rep_) {
        for (int m = gw; m < M; m += NGW) {
            const int p0 = POS[2 * m], p1 = POS[2 * m + 1];
            const GAS f32x4* xr = (const GAS f32x4*)(x + (size_t)m * DM) + lane; const v2u* yr = (const v2u*)(YM + (size_t)m * DM) + lane;
            const v2u* y0 = (const v2u*)(YB + (size_t)p0 * DM) + lane; const v2u* y1 = (const v2u*)(YB + (size_t)p1 * DM) + lane;
            f32x4 v[4]; v2u ya[4], yb[4], yc[4]; float s2 = 0.f;
#pragma unroll
            for (int j = 0; j < 4; ++j) { v[j] = xr[64 * j]; ya[j] = yr[64 * j]; yb[j] = y0[64 * j]; yc[j] = y1[64 * j]; }
#pragma unroll
            for (int j = 0; j < 4; ++j) {
                v[j].x += bflo(ya[j].x) + (bflo(yb[j].x) + bflo(yc[j].x)); v[j].y += bfhi(ya[j].x) + (bfhi(yb[j].x) + bfhi(yc[j].x)); v[j].z += bflo(ya[j].y) + (bflo(yb[j].y) + bflo(yc[j].y)); v[j].w += bfhi(ya[j].y) + (bfhi(yb[j].y) + bfhi(yc[j].y));
                s2 += (v[j].x * v[j].x + v[j].y * v[j].y) + (v[j].z * v[j].z + v[j].w * v[j].w); }
            const float rstd = 1.f / sqrtf(wave_sum(s2) * (1.f / DM) + EPS);
            GAS f32x4* orow = (GAS f32x4*)(out + (size_t)m * DM) + lane;
#pragma unroll
            for (int j = 0; j < 4; ++j) { const f32x4 g = *((const f32x4*)g_final + lane + 64 * j); orow[64 * j] = (f32x4){v[j].x * rstd * g.x, v[j].y * rstd * g.y, v[j].z * rstd * g.z, v[j].w * rstd * g.w}; }
        }
    }
#undef IN
#undef SEAM
}

extern "C" void kernel_launch(void* const* d_in, const int* in_sizes, int n_in, void* d_out, int out_size, void* d_ws, size_t ws_size, hipStream_t stream) {
    static int grid = 0;
    if (grid == 0) {
        if (n_in != 22 || in_sizes[0] != M * DM || out_size != M * DM || ws_size < WS_END) { fprintf(stderr, "kernel_launch: unexpected shapes (n_in %d, in0 %d, out %d, ws %zu); nothing launched\n", n_in, n_in > 0 ? in_sizes[0] : -1, out_size, ws_size); grid = -1; return; }
        int dev = 0, cus = 0, per_cu = 0;
        if (hipGetDevice(&dev) != hipSuccess || hipDeviceGetAttribute(&cus, hipDeviceAttributeMultiprocessorCount, dev) != hipSuccess) { grid = -1; return; }
        if (hipFuncSetAttribute((const void*)mk_fwd, hipFuncAttributeMaxDynamicSharedMemorySize, LDS_BYTES) != hipSuccess) { fprintf(stderr, "kernel_launch: hipFuncSetAttribute failed\n"); grid = -1; return; }
        if (hipOccupancyMaxActiveBlocksPerMultiprocessor(&per_cu, (const void*)mk_fwd, NWAVES * 64, LDS_BYTES) != hipSuccess || per_cu < 1) { fprintf(stderr, "kernel_launch: occupancy query says %d blocks/CU\n", per_cu); per_cu = 1; }
        (void)hipGetLastError();
        grid = cus;
    }
    if (grid < 0) return;
    if (hipMemsetAsync((char*)d_ws + WS_CTL, 0, CTL_ZERO_BYTES, stream) != hipSuccess) { fprintf(stderr, "kernel_launch: memset failed\n"); return; }
    Args a{};
    for (int i = 0; i < 22; ++i) a.in[i] = (const float*)d_in[i];
    a.out = (float*)d_out; a.ws = (unsigned char*)d_ws;
#if MK_PER_PHASE
#ifndef MK_REPEAT_L
#define MK_REPEAT_L -1
#endif
    for (int p = 0; p < N_PHASES; ++p) { a.ph_lo = p; a.ph_hi = p + 1; hipLaunchKernelGGL(mk_fwd, dim3(grid), dim3(NWAVES * 64), LDS_BYTES, stream, a);
        if (p == MK_REPEAT_L) hipLaunchKernelGGL(mk_fwd, dim3(grid), dim3(NWAVES * 64), LDS_BYTES, stream, a); }
#else
#ifndef MK_PREFIX
#define MK_PREFIX -1
#endif
    void* kargs[] = {&a};
    if (MK_PREFIX >= 0) {
        a.ph_lo = 0; a.ph_hi = MK_PREFIX + 1;
        (void)hipLaunchCooperativeKernel((const void*)mk_fwd, dim3(grid), dim3(NWAVES * 64), kargs, LDS_BYTES, stream);
        (void)hipMemsetAsync((char*)d_ws + WS_CTL, 0, CTL_ZERO_BYTES, stream);
    }
    a.ph_lo = 0; a.ph_hi = N_PHASES;
    hipError_t e = hipLaunchCooperativeKernel((const void*)mk_fwd, dim3(grid), dim3(NWAVES * 64), kargs, LDS_BYTES, stream);
    if (e != hipSuccess) fprintf(stderr, "kernel_launch: cooperative launch failed: %s (grid %d)\n", hipGetErrorString(e), grid);
#endif
}
```

```cpp
#include <hip/hip_runtime.h>
#include <hip/hip_bf16.h>
#include <hip/hip_cooperative_groups.h>
#include <cstdio>
#include <cstdint>
#include <cmath>
namespace pg8 {
#define PG8_LAS __attribute__((address_space(3)))
typedef unsigned short bf16_t;
typedef short bf16x8 __attribute__((ext_vector_type(8)));
typedef float f32x4 __attribute__((ext_vector_type(4)));
typedef unsigned u32x4 __attribute__((ext_vector_type(4)));
constexpr int BM = 256, BK = 64, HALF = 128, HTB = HALF * BK * 2  , STAGE_BYTES = 8 * HTB, NXCD = 8, WGM = 8;

__host__ __device__ __forceinline__ int lds_byte(int r, int c) { const int st = (r >> 4) * 2 + (c >> 5), rr = r & 15, cc = c & 31, ob = rr * 64 + cc * 2; return st * 1024 + (ob ^ (((ob >> 9) & 1) << 5)); }
__host__ __device__ __forceinline__ void stage_rc(int b, int& R, int& C) { const int st = b / 1024, sb = b % 1024, swz = sb ^ (((sb >> 9) & 1) << 5); R = (st >> 1) * 16 + swz / 64; C = (st & 1) * 32 + (swz % 64) / 2; }
__host__ __device__ __forceinline__ int perm32(int rho) { const int n = rho >> 4, i = rho & 15; return 8 * (i >> 2) + 4 * n + (i & 3); }

struct Unit { int pm, pn; };
struct Gemm { const bf16_t* A; const bf16_t* Bt; int M, N, K; const int* ridx = nullptr; };

struct StaticOrder {
    int nM, nN, nwg, G, c;
    __host__ __device__ void init(int M, int N, int G_, int c_) { nM = M / BM; nN = N / BM; nwg = nM * nN; G = G_; c = c_; }
    __host__ __device__ bool next(int i, Unit& u) const {
        const long L = (long)i * G + c; if (L >= nwg) return false;
        int wgid = (int)L; { const int q = nwg / NXCD, r = nwg % NXCD, xcd = wgid % NXCD, off = wgid / NXCD; wgid = (xcd < r ? xcd * (q + 1) : r * (q + 1) + (xcd - r) * q) + off; }
        const int nig = WGM * nN, gid = wgid / nig, fm = gid * WGM, gsz = (nM - fm) < WGM ? (nM - fm) : WGM;
        u.pm = fm + ((wgid % nig) % gsz); u.pn = (wgid % nig) / gsz; return true;
    }
    __device__ __forceinline__ void a_ready(const Unit&) const {}
    __device__ __forceinline__ void done(const Unit&) const {}
};

__device__ __forceinline__ unsigned cvt_pk_bf16(float lo, float hi) { unsigned r; asm volatile("v_cvt_pk_bf16_f32 %0, %1, %2" : "=v"(r) : "v"(lo), "v"(hi)); return r; }
typedef float f32x2 __attribute__((ext_vector_type(2)));
template <class Epi, class Sched, bool ALIGN_EPI = false, bool SP2 = false, bool GATHER = false>
__device__ __forceinline__ void gemm_phase(PG8_LAS unsigned char* lds, const Gemm g, const Sched& S, const Epi& E) {
    const int tid = threadIdx.x, wid = __builtin_amdgcn_readfirstlane(tid >> 6), lane = tid & 63, wr = wid >> 2, wc = wid & 3, fr = lane & 15, fq = lane >> 4;
    const int K = g.K; int nt = K / BK; asm volatile("" : "+s"(nt));
    unsigned voffA[2], voffB[2];
#pragma unroll
    for (int i = 0; i < 2; ++i) { int R, C; stage_rc(tid * 16 + i * 8192, R, C); const int Rb = Epi::PERM ? ((R & ~31) + perm32(R & 31)) : R;
        voffA[i] = (unsigned)(R * K + C) * 2u; voffB[i] = (unsigned)(Rb * K + C) * 2u; }
    unsigned vA0[2] = {0u, 0u}, vA1[2] = {0u, 0u}, nA0[2] = {0u, 0u}, nA1[2] = {0u, 0u}; int gR[2] = {0, 0}; unsigned gC[2] = {0u, 0u};
    if constexpr (GATHER) { static_assert(SP2, "GATHER is implemented for the SP2 loop only");
#pragma unroll
        for (int i = 0; i < 2; ++i) { int R, C; stage_rc(tid * 16 + i * 8192, R, C); gR[i] = R; gC[i] = (unsigned)C * 2u; } }
#define PG8_GOFF(pm_, o0, o1) do { _Pragma("unroll") for (int _i = 0; _i < 2; ++_i) { \
        o0[_i] = (unsigned)g.ridx[(size_t)(pm_) * BM + gR[_i]] * (unsigned)(K * 2) + gC[_i]; o1[_i] = (unsigned)g.ridx[(size_t)(pm_) * BM + HALF + gR[_i]] * (unsigned)(K * 2) + gC[_i]; } } while (0)
    const size_t kstep = (size_t)(BK * 2);
    const size_t hstep = (size_t)HALF * K * 2;
    const size_t tstep = 2 * hstep;
    const unsigned ldsw = (unsigned)wid * 1024u;
    const int aoff = lds_byte(wr * 64 + fr, fq * 8), boff = lds_byte(wc * 32 + fr, fq * 8);
#define PG8_SA(b, h) (((b) * 2 + (h)) * HTB)
#define PG8_SB(b, h) ((4 + (b) * 2 + (h)) * HTB)
#define PG8_STAGE(bufoff, gbase, voff) do { _Pragma("unroll") for (int _i = 0; _i < 2; ++_i) \
        __builtin_amdgcn_global_load_lds((const unsigned*)((const char*)(gbase) + (voff)[_i]), (PG8_LAS unsigned*)(lds + (bufoff) + ldsw + _i * 8192), 16, 0, 0); } while (0)
#define PG8_LDA(dst, b, h) do { _Pragma("unroll") for (int m = 0; m < 4; ++m) _Pragma("unroll") for (int k = 0; k < 2; ++k) dst[m][k] = *(const PG8_LAS bf16x8*)(lds + PG8_SA(b, h) + aoff + m * 2048 + k * 1024); } while (0)
#define PG8_LDB(dst, b, h) do { _Pragma("unroll") for (int n = 0; n < 2; ++n) _Pragma("unroll") for (int k = 0; k < 2; ++k) dst[n][k] = *(const PG8_LAS bf16x8*)(lds + PG8_SB(b, h) + boff + n * 2048 + k * 1024); } while (0)
#define PG8_MMA(ai, bj, At, Bt) do { __builtin_amdgcn_s_setprio(1); _Pragma("unroll") for (int m = 0; m < 4; ++m) _Pragma("unroll") for (int n = 0; n < 2; ++n) _Pragma("unroll") for (int k = 0; k < 2; ++k) \
        acc[ai][bj][m][n] = __builtin_amdgcn_mfma_f32_16x16x32_bf16(Bt[n][k], At[m][k], acc[ai][bj][m][n], 0, 0, 0); __builtin_amdgcn_s_setprio(0); } while (0)
#define PG8_WAIT_V(n) asm volatile("s_waitcnt vmcnt(" #n ")" ::: "memory")
#define PG8_WAIT_L(n) asm volatile("s_waitcnt lgkmcnt(" #n ")" ::: "memory")
#define PG8_BAR __builtin_amdgcn_s_barrier()
#define PG8_SCHED __builtin_amdgcn_sched_barrier(0)
    Unit cur, nxt; int ui = 0;
    if (!S.next(0, cur)) return;
    f32x4 acc[2][2][4][2];
#pragma unroll
    for (int a = 0; a < 2; ++a)
#pragma unroll
        for (int b = 0; b < 2; ++b)
#pragma unroll
            for (int m = 0; m < 4; ++m)
#pragma unroll
                for (int n = 0; n < 2; ++n) acc[a][b][m][n] = (f32x4){0.f, 0.f, 0.f, 0.f};
    bf16x8 At[4][2], B0[2][2], B1[2][2];
    const char* cA = (const char*)g.A + (GATHER ? (size_t)0 : (size_t)cur.pm * tstep); const char* cB = (const char*)g.Bt + (size_t)cur.pn * tstep;
    if constexpr (GATHER) { PG8_GOFF(cur.pm, vA0, vA1); nA0[0] = vA0[0]; nA0[1] = vA0[1]; nA1[0] = vA1[0]; nA1[1] = vA1[1]; }
    S.a_ready(cur);
    if constexpr (SP2) {
        PG8_STAGE(PG8_SB(0, 0), cB, voffB); PG8_STAGE(PG8_SB(0, 1), cB + hstep, voffB);
        if constexpr (GATHER) { PG8_STAGE(PG8_SA(0, 0), cA, vA0); PG8_STAGE(PG8_SA(0, 1), cA, vA1); } else { PG8_STAGE(PG8_SA(0, 0), cA, voffA); PG8_STAGE(PG8_SA(0, 1), cA + hstep, voffA); }
        if (wr == 1) PG8_BAR;
        PG8_WAIT_V(2); PG8_BAR;
        PG8_STAGE(PG8_SB(1, 0), cB + kstep, voffB); if constexpr (GATHER) { PG8_STAGE(PG8_SA(1, 0), cA + kstep, vA0); } else { PG8_STAGE(PG8_SA(1, 0), cA + kstep, voffA); } PG8_STAGE(PG8_SB(1, 1), cB + hstep + kstep, voffB);
        PG8_WAIT_V(6); PG8_BAR;
    } else {
        PG8_STAGE(PG8_SB(0, 0), cB, voffB); PG8_STAGE(PG8_SA(0, 0), cA, voffA); PG8_STAGE(PG8_SB(0, 1), cB + hstep, voffB); PG8_STAGE(PG8_SA(0, 1), cA + hstep, voffA);
        if (wr == 1) PG8_BAR;
        PG8_WAIT_V(4); PG8_BAR;
        PG8_STAGE(PG8_SB(1, 0), cB + kstep, voffB); PG8_STAGE(PG8_SA(1, 0), cA + kstep, voffA); PG8_STAGE(PG8_SB(1, 1), cB + hstep + kstep, voffB);
        PG8_WAIT_V(6); PG8_BAR;
    }
    for (;;) {
        const bool has_next = S.next(ui + 1, nxt);
        const char* nA = (has_next && !GATHER) ? (const char*)g.A + (size_t)nxt.pm * tstep : cA; const char* nB = has_next ? (const char*)g.Bt + (size_t)nxt.pn * tstep : cB;
        for (int t = 0; t < nt; t += 2) {
            if constexpr (Epi::MID) { if (t == (nt >> 1)) E.mid(acc, cur, wr, wc, fr, fq); }
            const bool last = (t == nt - 2);
            const char* a1 = cA + (size_t)(t + 1) * kstep;
            const char* a2 = last ? nA : cA + (size_t)(t + 2) * kstep; const char* b2 = last ? nB : cB + (size_t)(t + 2) * kstep;
            const char* a3 = a2 + kstep; const char* b3 = b2 + kstep;
            if (last && has_next) S.a_ready(nxt);
            unsigned sA0[2] = {0u, 0u}, sA1[2] = {0u, 0u};
            if constexpr (GATHER) { if (t + 4 == nt && has_next) PG8_GOFF(nxt.pm, nA0, nA1);
                sA0[0] = last ? nA0[0] : vA0[0]; sA0[1] = last ? nA0[1] : vA0[1]; sA1[0] = last ? nA1[0] : vA1[0]; sA1[1] = last ? nA1[1] : vA1[1]; }
            if constexpr (SP2) {
            PG8_LDB(B0, 0, 0); PG8_LDB(B1, 0, 1); PG8_SCHED; PG8_LDA(At, 0, 0); if constexpr (GATHER) { PG8_STAGE(PG8_SA(1, 1), a1, vA1); } else { PG8_STAGE(PG8_SA(1, 1), a1 + hstep, voffA); }
            PG8_WAIT_V(8); PG8_WAIT_L(0); PG8_BAR; PG8_MMA(0, 0, At, B0); PG8_MMA(0, 1, At, B1); PG8_BAR; PG8_SCHED;
            PG8_LDA(At, 0, 1); PG8_STAGE(PG8_SB(0, 0), b2, voffB); PG8_STAGE(PG8_SB(0, 1), b2 + hstep, voffB); if constexpr (GATHER) { PG8_STAGE(PG8_SA(0, 0), a2, sA0); } else { PG8_STAGE(PG8_SA(0, 0), a2, voffA); }
            PG8_WAIT_V(8); PG8_WAIT_L(0); PG8_BAR; PG8_MMA(1, 0, At, B0); PG8_MMA(1, 1, At, B1); PG8_BAR; PG8_SCHED;
            PG8_LDB(B0, 1, 0); PG8_LDB(B1, 1, 1); PG8_SCHED; PG8_LDA(At, 1, 0); if constexpr (GATHER) { PG8_STAGE(PG8_SA(0, 1), a2, sA1); } else { PG8_STAGE(PG8_SA(0, 1), a2 + hstep, voffA); }
            PG8_WAIT_V(8); PG8_WAIT_L(0); PG8_BAR; PG8_MMA(0, 0, At, B0); PG8_MMA(0, 1, At, B1); PG8_BAR; PG8_SCHED;
            PG8_LDA(At, 1, 1); PG8_STAGE(PG8_SB(1, 0), b3, voffB); PG8_STAGE(PG8_SB(1, 1), b3 + hstep, voffB); if constexpr (GATHER) { PG8_STAGE(PG8_SA(1, 0), a3, sA0); } else { PG8_STAGE(PG8_SA(1, 0), a3, voffA); }
            PG8_WAIT_V(8); PG8_WAIT_L(0); PG8_BAR; PG8_MMA(1, 0, At, B0); PG8_MMA(1, 1, At, B1); PG8_BAR; PG8_SCHED;
            } else {
            PG8_LDB(B0, 0, 0); PG8_SCHED; PG8_LDA(At, 0, 0); PG8_STAGE(PG8_SA(1, 1), a1 + hstep, voffA);
            PG8_WAIT_L(8); PG8_BAR; PG8_WAIT_L(0); PG8_MMA(0, 0, At, B0); PG8_BAR; PG8_SCHED;
            PG8_LDB(B1, 0, 1); PG8_STAGE(PG8_SB(0, 0), b2, voffB);
            PG8_BAR; PG8_WAIT_L(0); PG8_MMA(0, 1, At, B1); PG8_BAR;
            PG8_LDA(At, 0, 1); PG8_STAGE(PG8_SA(0, 0), a2, voffA);
            PG8_BAR; PG8_WAIT_L(0); PG8_MMA(1, 0, At, B0); PG8_BAR; PG8_SCHED;
            PG8_STAGE(PG8_SB(0, 1), b2 + hstep, voffB);
            PG8_WAIT_V(6); PG8_BAR; PG8_MMA(1, 1, At, B1); PG8_BAR;
            PG8_LDB(B0, 1, 0); PG8_SCHED; PG8_LDA(At, 1, 0); PG8_STAGE(PG8_SA(0, 1), a2 + hstep, voffA);
            PG8_WAIT_L(8); PG8_BAR; PG8_WAIT_L(0); PG8_MMA(0, 0, At, B0); PG8_BAR; PG8_SCHED;
            PG8_LDB(B1, 1, 1); PG8_STAGE(PG8_SB(1, 0), b3, voffB);
            PG8_BAR; PG8_WAIT_L(0); PG8_MMA(0, 1, At, B1); PG8_BAR;
            PG8_LDA(At, 1, 1); PG8_STAGE(PG8_SA(1, 0), a3, voffA);
            PG8_BAR; PG8_WAIT_L(0); PG8_MMA(1, 0, At, B0); PG8_BAR; PG8_SCHED;
            PG8_STAGE(PG8_SB(1, 1), b3 + hstep, voffB);
            PG8_WAIT_V(6); PG8_BAR; PG8_MMA(1, 1, At, B1); PG8_BAR;
            }
        }
        if constexpr (ALIGN_EPI) { if (wr == 0) PG8_BAR; }
        if constexpr (!Epi::AFTER_DRAIN) { E(acc, cur, wr, wc, fr, fq); S.done(cur); }
        if (!has_next) break;
#pragma unroll
        for (int a = 0; a < 2; ++a)
#pragma unroll
            for (int b = 0; b < 2; ++b)
#pragma unroll
                for (int m = 0; m < 4; ++m)
#pragma unroll
                    for (int n = 0; n < 2; ++n) acc[a][b][m][n] = (f32x4){0.f, 0.f, 0.f, 0.f};
        cur = nxt; cA = nA; cB = nB; ++ui;
        if constexpr (GATHER) { vA0[0] = nA0[0]; vA0[1] = nA0[1]; vA1[0] = nA1[0]; vA1[1] = nA1[1]; }
        if constexpr (ALIGN_EPI) { if (wr == 1) PG8_BAR; }
    }
    PG8_WAIT_V(0);
    if constexpr (!ALIGN_EPI) { if (wr == 0) PG8_BAR; }
    PG8_BAR;
    if constexpr (Epi::AFTER_DRAIN) { E.fused(acc, cur, wr, wc, fr, fq, lds, wid, lane); S.done(cur); }
#undef PG8_SA
#undef PG8_SB
#undef PG8_STAGE
#undef PG8_LDA
#undef PG8_LDB
#undef PG8_MMA
#undef PG8_WAIT_V
#undef PG8_WAIT_L
#undef PG8_BAR
#undef PG8_SCHED
#undef PG8_GOFF
}
}
namespace att {
typedef unsigned short bf16;
using bf16x8 = __attribute__((ext_vector_type(8))) short;
using s16x4 = __attribute__((ext_vector_type(4))) short;
using f32x16 = __attribute__((ext_vector_type(16))) float;
using u32x4 = __attribute__((ext_vector_type(4))) unsigned;
constexpr int SEQ = 4096, NW = 8, QB = 256, KVBLK = 64;
constexpr int KSLOT = 12288, VSLOT = 8192, NKS = 4, NVS = 4;
constexpr int LDS_K = 0, LDS_V = NKS * KSLOT, LDS_WS = LDS_V + NVS * VSLOT, LDS_OST = LDS_WS + NW * 256, LDS_BYTES = LDS_OST + NW * 4096;
constexpr float THR = 8.0f;
#define ATT_LAS __attribute__((address_space(3)))
#define SBAR() __builtin_amdgcn_sched_barrier(0)
#define WAIT_BAR(N) asm volatile("s_waitcnt vmcnt(" #N ") lgkmcnt(0)\n\ts_barrier" ::: "memory")
__device__ __forceinline__ int crow(int r, int hi) { return (r & 3) + 8 * (r >> 2) + 4 * hi; }
__device__ __forceinline__ void glds16(const void* gsrc, unsigned lds_dst) { unsigned keep;
  asm volatile("s_mov_b32 %0, m0\n\ts_mov_b32 m0, %2\n\ts_nop 0\n\tglobal_load_lds_dwordx4 %1, off\n\ts_mov_b32 m0, %0" : "=&s"(keep) : "v"(gsrc), "s"(lds_dst) : "memory"); }
typedef float f32x2_t __attribute__((ext_vector_type(2))); typedef __bf16 bf16x2_t __attribute__((ext_vector_type(2)));
__device__ __forceinline__ unsigned cvtpk_s(float lo, float hi) { f32x2_t v = {lo, hi}; bf16x2_t b = __builtin_convertvector(v, bf16x2_t); return __builtin_bit_cast(unsigned, b); }
typedef ATT_LAS const char* lds_cptr;
#define MX3(a, b, c) __builtin_fmaxf(__builtin_fmaxf((a), (b)), (c))
__device__ __forceinline__ float rowmax(const f32x16& p0, const f32x16& p1) {
  float a = MX3(p0[0], p0[1], p1[0]), b = MX3(p0[2], p0[3], p1[1]); a = MX3(a, p1[2], p1[3]);
#pragma unroll
  for (int r = 4; r < 16; r += 4) { a = MX3(a, p0[r], p0[r + 1]); b = MX3(b, p0[r + 2], p0[r + 3]); a = MX3(a, p1[r], p1[r + 1]); b = MX3(b, p1[r + 2], p1[r + 3]); }
  float m = __builtin_fmaxf(a, b); auto rr = __builtin_amdgcn_permlane32_swap(__float_as_uint(m), __float_as_uint(m), false, false);
  return __builtin_fmaxf(__uint_as_float(rr[0]), __uint_as_float(rr[1])); }
__device__ __forceinline__ void cmask(f32x16& p0, f32x16& p1, int jb, int qrel, int hi) {
  const int kb = 64 * jb + 4 * hi;
#pragma unroll
  for (int r = 0; r < 16; ++r) { const int kv = kb + (r & 3) + 8 * (r >> 2); if (kv > qrel) p0[r] = -INFINITY; if (kv + 32 > qrel) p1[r] = -INFINITY; } }
template <int D0A, int D0B> __device__ __forceinline__ void kload(bf16x8* kf, lds_cptr kp) {
#pragma unroll
  for (int d0 = D0A; d0 < D0B; ++d0) { kf[2 * (d0 - D0A)] = *(const ATT_LAS bf16x8*)(kp + d0 * 2048); kf[2 * (d0 - D0A) + 1] = *(const ATT_LAS bf16x8*)(kp + d0 * 2048 + 512); }
}
template <int ND0, int NPRE> __device__ __forceinline__ void qkt(f32x16& p0, f32x16& p1, const bf16x8* kf, const bf16x8* kt, const bf16x8* qr, const f32x16& negm) {
#pragma unroll
  for (int d0 = 0; d0 < ND0; ++d0) { const bf16x8 b0 = d0 < NPRE ? kf[2 * d0] : kt[2 * (d0 - NPRE)], b1 = d0 < NPRE ? kf[2 * d0 + 1] : kt[2 * (d0 - NPRE) + 1];
    if (d0 == 0) { p0 = __builtin_amdgcn_mfma_f32_32x32x16_bf16(b0, qr[0], negm, 0, 0, 0); p1 = __builtin_amdgcn_mfma_f32_32x32x16_bf16(b1, qr[0], negm, 0, 0, 0); }
    else { p0 = __builtin_amdgcn_mfma_f32_32x32x16_bf16(b0, qr[d0], p0, 0, 0, 0); p1 = __builtin_amdgcn_mfma_f32_32x32x16_bf16(b1, qr[d0], p1, 0, 0, 0); } }
}
__device__ __forceinline__ void pv(f32x16* o, int vb, bf16x8 pa0, bf16x8 pa1, bf16x8 pa2, bf16x8 pa3) {
#pragma unroll
  for (int d0 = 0; d0 < 2; ++d0) { s16x4 lo[4], hi[4];
#pragma unroll
    for (int ks = 0; ks < 4; ++ks) {
      asm volatile("ds_read_b64_tr_b16 %0,%1 offset:%c2" : "=&v"(lo[ks]) : "v"(vb), "i"(d0 * 4096 + ks * 1024) : "memory");
      asm volatile("ds_read_b64_tr_b16 %0,%1 offset:%c2" : "=&v"(hi[ks]) : "v"(vb), "i"(d0 * 4096 + ks * 1024 + 512) : "memory"); }
    asm volatile("s_waitcnt lgkmcnt(0)" ::: "memory"); SBAR();
#define PK(k) (bf16x8){lo[k][0], lo[k][1], lo[k][2], lo[k][3], hi[k][0], hi[k][1], hi[k][2], hi[k][3]}
    o[d0] = __builtin_amdgcn_mfma_f32_32x32x16_bf16(pa0, PK(0), o[d0], 0, 0, 0);
    o[d0] = __builtin_amdgcn_mfma_f32_32x32x16_bf16(pa1, PK(1), o[d0], 0, 0, 0);
    o[d0] = __builtin_amdgcn_mfma_f32_32x32x16_bf16(pa2, PK(2), o[d0], 0, 0, 0);
    o[d0] = __builtin_amdgcn_mfma_f32_32x32x16_bf16(pa3, PK(3), o[d0], 0, 0, 0);
#undef PK
  }
}
struct AttnT { const bf16* Q; const bf16* K; const bf16* KR; const bf16* V; bf16* O; const float* CS; const float* GB; const unsigned* QKM; };
template <int KIND, int ABL = 0> __device__ __forceinline__ void attn_unit(int b, int h, int qb, const AttnT& T, char* shm) {
#ifndef ATT_NPRE0
#define ATT_NPRE0 2
#endif
#ifndef ATT_NPRE1
#define ATT_NPRE1 3
#endif
  constexpr int NPRE = KIND == 0 ? ATT_NPRE0 : ATT_NPRE1;
  constexpr int ND0 = KIND == 0 ? 6 : 5, QP = KIND == 0 ? 768 : 640, HD = KIND == 0 ? 96 : 80;
  const int tid = threadIdx.x, lane = tid & 63, r32 = lane & 31, hi = lane >> 5; const int wid = __builtin_amdgcn_readfirstlane(tid >> 6);
  const long rowbase = (long)b * SEQ; const int q0 = qb * QB;
  const bf16* Qw = T.Q + (rowbase + q0 + wid * 32) * QP + h * HD;
  const unsigned lds0 = (unsigned)(uintptr_t)shm;
  const lds_cptr shm3 = (lds_cptr)shm;
  ATT_LAS float* wsf = (ATT_LAS float*)(shm3 + LDS_WS) + wid * 64;
  const bf16 *ksrcA, *ksrcB; long kstepA, kstepB; unsigned kdstB;
  const unsigned kdstA = lds0 + LDS_K + wid * 1024;
  if (KIND == 0) { ksrcA = T.K + (rowbase + lane) * 512 + h * 64 + wid * 8; ksrcB = T.KR + (rowbase + lane) * 32 + (wid & 3) * 8; kdstB = lds0 + LDS_K + (8 + (wid & 3)) * 1024; kstepA = 64 * 512; kstepB = 64 * 32; }
  else { ksrcA = T.K + (rowbase + lane) * 640 + h * 80 + wid * 8; ksrcB = T.K + (rowbase + lane) * 640 + h * 80 + (8 + (wid & 1)) * 8; kdstB = lds0 + LDS_K + (8 + (wid & 1)) * 1024; kstepA = 64 * 640; kstepB = 64 * 640; }
  const bf16* vsrc = T.V + (rowbase + 16 * (wid & 3) + (lane >> 2)) * 512 + h * 64 + (wid >> 2) * 32 + (lane & 3) * 8;
  const unsigned vdst = lds0 + LDS_V + wid * 1024;
#define DMA_K(t, s) do { glds16(ksrcA + (long)(t) * kstepA, (unsigned)__builtin_amdgcn_readfirstlane(kdstA + (s) * KSLOT)); \
                         glds16(ksrcB + (long)(t) * kstepB, (unsigned)__builtin_amdgcn_readfirstlane(kdstB + (s) * KSLOT)); } while (0)
#define DMA_V(t, s) do { glds16(vsrc + (long)(t) * (64 * 512), (unsigned)__builtin_amdgcn_readfirstlane(vdst + (s) * VSLOT)); } while (0)
  const int vb0 = (int)(lds0 + LDS_V) + ((lane >> 4) & 1) * 32 + (lane & 3) * 8 + (4 * hi + ((lane & 15) >> 2)) * 64;
  const lds_cptr kp0 = shm3 + LDS_K + hi * 1024 + r32 * 16;
  const int NT = (q0 + QB) / KVBLK;
  int tb = 0;
  if (KIND == 1) {
    const float qmax = __uint_as_float(T.QKM[2 * (b * 8 + h)]), kmax = __uint_as_float(T.QKM[2 * (b * 8 + h) + 1]);
    const float qk2 = 2.02f * qmax * kmax, gq0 = T.GB[(rowbase + q0) * 8 + h];
    const float ge = (lane < 4 * qb) ? T.GB[(rowbase + 64 * lane + 63) * 8 + h] : 3.0e38f;
    const unsigned long long bal = __ballot(qk2 + ge - gq0 >= -40.f);
    tb = __builtin_amdgcn_readfirstlane((int)__builtin_ctzll(bal));
  }
  DMA_K(tb, 0); DMA_V(tb, 0); DMA_K(tb + 1, 1); DMA_V(tb + 1, 1); DMA_K(tb + 2, 2);
  bf16x8 qr[ND0];
#pragma unroll
  for (int d0 = 0; d0 < ND0; ++d0) qr[d0] = *reinterpret_cast<const bf16x8*>(&Qw[(long)r32 * QP + d0 * 16 + hi * 8]);
  if (KIND == 0) {
    const float* cs = T.CS + (rowbase + q0 + wid * 32 + r32) * 32 + 16 * hi;
    typedef float f32x4_t __attribute__((ext_vector_type(4)));
    bf16x8 a = qr[4], c = qr[5];
#pragma unroll
    for (int j2 = 0; j2 < 4; ++j2) { const f32x4_t t4 = *(const f32x4_t*)(cs + 4 * j2);
#pragma unroll
      for (int e = 0; e < 2; ++e) { const int j = 2 * j2 + e; const float co = t4[2 * e], si = t4[2 * e + 1];
        const float x1 = __builtin_bit_cast(float, (unsigned)(unsigned short)a[j] << 16), x2 = __builtin_bit_cast(float, (unsigned)(unsigned short)c[j] << 16);
        const float o1 = x1 * co - x2 * si, o2 = x2 * co + x1 * si;
        qr[4][j] = (short)(cvtpk_s(o1, o1) & 0xffffu); qr[5][j] = (short)(cvtpk_s(o2, o2) & 0xffffu); } }
  }
  float mhat = 0.f, l_reg = 0.f; f32x16 o[2]; o[0] = f32x16{}; o[1] = f32x16{}; f32x16 negm = f32x16{};
  const int qrel = wid * 32 + r32;
  int ks_cur = 0, vs_cur = 0;
  bf16x8 kf[2 * NPRE];
  WAIT_BAR(6);
  kload<0, NPRE>(kf, kp0);
  u32x4 pw0 = {0u, 0u, 0u, 0u}, pw1 = pw0, pw2 = pw0, pw3 = pw0;
#ifndef ATT_STAG
#define ATT_STAG 0
#endif
  const bool grpB = (ATT_STAG == 1) ? (wid >= 4) : (ATT_STAG == 2) ? ((wid & 1) != 0) : false; bool pend = false; int vs_pend = 0;
  for (int t = tb; t < NT; ++t) {
    if (t + 2 < NT) { WAIT_BAR(3); } else if (t + 1 < NT) { WAIT_BAR(1); } else { WAIT_BAR(0); }
    const int ks1 = (ks_cur + 1) & 3, vs1 = (vs_cur + 1) & 3, vs2 = (vs_cur + 2) & 3;
    if (t + 2 < NT) { DMA_V(t + 2, vs2); }
    if (t + 3 < NT) { DMA_K(t + 3, ((ks_cur + 3) & 3)); }
    if (pend) { if (!(ABL & 1)) pv(o, vb0 + vs_pend * VSLOT, __builtin_bit_cast(bf16x8, pw0), __builtin_bit_cast(bf16x8, pw1), __builtin_bit_cast(bf16x8, pw2), __builtin_bit_cast(bf16x8, pw3)); pend = false; }
    const int jb = t - 4 * qb;
    const bool vis = (KIND == 0) ? (t <= 4 * qb + (wid >> 1)) : ((jb < 0) || (64 * jb <= 32 * wid + 31));
    f32x16 p0, p1;
    if (vis) {
      bf16x8 kt[2 * (ND0 - NPRE)]; kload<NPRE, ND0>(kt, kp0 + ks_cur * KSLOT);
      if (ABL & 4) { p0 = negm; p1 = negm; asm volatile("" : "+v"(p0), "+v"(p1)); } else qkt<ND0, NPRE>(p0, p1, kf, kt, qr, negm);
    }
    if (t + 1 < NT) kload<0, NPRE>(kf, kp0 + ks1 * KSLOT);
    if (vis) {
      if (KIND == 1) { if (jb >= 0) cmask(p0, p1, jb, qrel, hi); }
      const float rm = rowmax(p0, p1);
      if (t == tb || __any(rm > THR)) {
        const float dl = (t == tb) ? rm : __builtin_fmaxf(rm, 0.f);
        mhat += dl;
#pragma unroll
        for (int r = 0; r < 16; ++r) { p0[r] -= dl; p1[r] -= dl; negm[r] = -mhat; }
        const float f = __builtin_amdgcn_exp2f(-dl); l_reg *= f;
        if (t > tb) {
          if (hi == 0) wsf[r32] = f;
          asm volatile("s_waitcnt lgkmcnt(0)" ::: "memory");
#pragma unroll
          for (int d_ = 0; d_ < 2; ++d_)
#pragma unroll
            for (int r = 0; r < 16; ++r) o[d_][r] *= wsf[crow(r, hi)];
          asm volatile("s_waitcnt lgkmcnt(0)" ::: "memory");
        }
      }
      float sacc = 0.f;
#pragma unroll
      for (int r = 0; r < 16; ++r) { if (!(ABL & 2)) { p0[r] = __builtin_amdgcn_exp2f(p0[r]); p1[r] = __builtin_amdgcn_exp2f(p1[r]); } sacc += p0[r] + p1[r]; }
      l_reg += sacc;
#define PKW(P, B) cvtpk_s(P[B], P[B + 1])
      pw0 = (u32x4){PKW(p0, 0), PKW(p0, 2), PKW(p0, 4), PKW(p0, 6)}; pw1 = (u32x4){PKW(p0, 8), PKW(p0, 10), PKW(p0, 12), PKW(p0, 14)};
      pw2 = (u32x4){PKW(p1, 0), PKW(p1, 2), PKW(p1, 4), PKW(p1, 6)}; pw3 = (u32x4){PKW(p1, 8), PKW(p1, 10), PKW(p1, 12), PKW(p1, 14)};
#undef PKW
      SBAR();
      if (ABL & 1) { asm volatile("" :: "v"(pw0), "v"(pw1), "v"(pw2), "v"(pw3)); }
      else if (!grpB) pv(o, vb0 + vs_cur * VSLOT, __builtin_bit_cast(bf16x8, pw0), __builtin_bit_cast(bf16x8, pw1), __builtin_bit_cast(bf16x8, pw2), __builtin_bit_cast(bf16x8, pw3));
      else { pend = true; vs_pend = vs_cur; }
    }
    ks_cur = ks1; vs_cur = vs1;
  }
  if (pend && !(ABL & 1)) pv(o, vb0 + vs_pend * VSLOT, __builtin_bit_cast(bf16x8, pw0), __builtin_bit_cast(bf16x8, pw1), __builtin_bit_cast(bf16x8, pw2), __builtin_bit_cast(bf16x8, pw3));
  { auto rr = __builtin_amdgcn_permlane32_swap(__float_as_uint(l_reg), __float_as_uint(l_reg), false, false); l_reg = __uint_as_float(rr[0]) + __uint_as_float(rr[1]); }
  if (hi == 0) wsf[32 + r32] = l_reg;
  asm volatile("s_waitcnt lgkmcnt(0)" ::: "memory");
  float rli[16];
#pragma unroll
  for (int r = 0; r < 16; ++r) rli[r] = __builtin_amdgcn_rcpf(wsf[32 + crow(r, hi)]);
  bf16* Ow = T.O + (rowbase + q0 + wid * 32) * 1024 + h * 64;
  { ATT_LAS bf16* stg = (ATT_LAS bf16*)(shm3 + LDS_OST) + wid * 2048;
#pragma unroll
    for (int r = 0; r < 16; ++r) { const int orow = crow(r, hi);
#pragma unroll
      for (int d0 = 0; d0 < 2; ++d0) { const float v = o[d0][r] * rli[r]; stg[orow * 64 + d0 * 32 + r32] = (bf16)(cvtpk_s(v, v) & 0xffffu); } }
    asm volatile("s_waitcnt lgkmcnt(0)" ::: "memory");
#pragma unroll
    for (int i = 0; i < 4; ++i) { const int row = i * 8 + (lane >> 3), ch = lane & 7; const u32x4 v = *(const ATT_LAS u32x4*)(stg + row * 64 + ch * 8); *(u32x4*)(Ow + (long)row * 1024 + ch * 8) = v; } }
  asm volatile("s_waitcnt lgkmcnt(0)\n\ts_barrier" ::: "memory");
#undef DMA_K
#undef DMA_V
}
#undef SBAR
#undef WAIT_BAR
#undef MX3
}
#ifndef MK_PER_PHASE
#define MK_PER_PHASE 0
#endif
constexpr int NWAVES = 8;
constexpr int BATCH = 8, SEQ = 4096, DM = 1024, M = BATCH * SEQ;
constexpr int NIN = 4096;
constexpr int NEXP = 32, XG_ROWS = 2 * M + NEXP * 256;
constexpr float EPS = 1e-6f, LOG2E = 1.4426950408889634f;
constexpr float C2F = 0.125f * LOG2E;
constexpr float C2M = 0.10206207261596577f * LOG2E;
constexpr int N_PHASES = 14;
constexpr size_t MiB = 1u << 20;
constexpr size_t WS_CTL = 0, CTL_ZERO_BYTES = 1 * MiB;
constexpr size_t WS_WIN = 1 * MiB, WS_WUQ = 9 * MiB, WS_WUKV = 9 * MiB + 512 * 1024, WS_WOA = 10 * MiB, WS_WOB = 11 * MiB, WS_WOUT = 12 * MiB, WS_WR = 14 * MiB, WS_WGU = 15 * MiB, WS_WDN = 47 * MiB;
constexpr size_t WS_CS = 63 * MiB, WS_LOGF = 67 * MiB, WS_EID = 68 * MiB, WS_SLOT = WS_EID + 256 * 1024, WS_WGT = WS_SLOT + 256 * 1024, WS_POS = WS_WGT + 256 * 1024, WS_WROW = 69 * MiB;
constexpr size_t WS_XN = 72 * MiB, WS_CQN = 72 * MiB, WS_CKVN = 88 * MiB, WS_VM = 96 * MiB, WS_KR = 128 * MiB;
constexpr size_t WS_Z0 = 136 * MiB, WS_Z1 = 152 * MiB, WS_QF = 184 * MiB, WS_KF = 224 * MiB, WS_VF = 264 * MiB, WS_OA = 296 * MiB, WS_OB = 328 * MiB, WS_MIX = 360 * MiB, WS_QM = 424 * MiB, WS_KM = 472 * MiB;
constexpr size_t WS_HN = 72 * MiB, WS_LG = 200 * MiB, WS_XG = 232 * MiB, WS_ACT = 376 * MiB, WS_YB = 72 * MiB, WS_END = 504 * MiB;
static_assert(WS_XG + (size_t)XG_ROWS * 2048 <= WS_ACT && WS_ACT + (size_t)XG_ROWS * 512 <= WS_END && WS_YB + (size_t)XG_ROWS * 2048 <= WS_XG, "moe map");
constexpr int CW_CNT = 8192;
constexpr int CW_TPRE = 128;
constexpr int CW_QK = 256;
constexpr int CW_AQ = 512;
constexpr int CW_BAR = 4096;
constexpr int RING_OFF = 0, RING_BYTES = 131072, LDSCTL_OFF = RING_BYTES, MISC_OFF = LDSCTL_OFF + 320, TP_OFF = LDSCTL_OFF + 1024, LDS_BYTES = 147456;

#define GAS __attribute__((address_space(1)))
#define LAS __attribute__((address_space(3)))
typedef unsigned short bf16;
typedef unsigned v4u __attribute__((ext_vector_type(4)));
typedef float f32x4 __attribute__((ext_vector_type(4)));
typedef short bf16x8 __attribute__((ext_vector_type(8)));
typedef GAS unsigned gu32;
typedef GAS unsigned long long gu64;
#define RLX_AGENT __ATOMIC_RELAXED, __HIP_MEMORY_SCOPE_AGENT
#define LDS_WAIT() asm volatile("s_waitcnt lgkmcnt(0)" ::: "memory")
#define VM_WAIT() asm volatile("s_waitcnt vmcnt(0)" ::: "memory")
__device__ __forceinline__ unsigned long long rt() { return __builtin_amdgcn_s_memrealtime(); }
__device__ __forceinline__ unsigned f2bf(float f) { unsigned u = __builtin_bit_cast(unsigned, f); return (u + 0x7fffu + ((u >> 16) & 1u)) >> 16; }
__device__ __forceinline__ unsigned pk2(float lo, float hi) { return f2bf(lo) | (f2bf(hi) << 16); }


#define XB_TMO      128
#define XB_XCNT(j)  (256  + 64 * (j))
#define XB_XSUB(j)  (1280 + 64 * (j))
#define XB_XGEN(j)  (2304 + 64 * (j))
#define XB_TOP      3328
#define XB_TOPGEN   3392
#define XCD_BAR_WORDS 3456
#define XB_SPIN_CAP (1u << 18)

__device__ __forceinline__ unsigned xb_ld(unsigned* p)              { return __hip_atomic_load(p, __ATOMIC_RELAXED, __HIP_MEMORY_SCOPE_AGENT); }
__device__ __forceinline__ unsigned xb_add(unsigned* p, unsigned v) { return __hip_atomic_fetch_add(p, v, __ATOMIC_RELAXED, __HIP_MEMORY_SCOPE_AGENT); }
__device__ __forceinline__ unsigned xb_xcc_id() { return (unsigned)__builtin_amdgcn_s_getreg((3 << 11) | 20) & 0xFu; }
#define XB_SPIN(cond, bar) do { unsigned _sp = 0; while (cond) { __builtin_amdgcn_s_sleep(1); \
    if ((++_sp & 255u) == 0u) { if (xb_ld(&(bar)[XB_TMO])) break; if (_sp > XB_SPIN_CAP) { atomicAdd(&(bar)[XB_TMO], 1u); break; } } } } while (0)

struct XcdBarrier {
    unsigned* bar; unsigned x;
    volatile LAS unsigned* st;
};

__device__ __forceinline__ XcdBarrier xcd_barrier_post(unsigned* bar, volatile LAS unsigned* st) {
    XcdBarrier b; b.bar = bar; b.x = xb_xcc_id(); b.st = st;
    if (threadIdx.x == 0) (void)xb_add(&bar[XB_XCNT(b.x)], 1u);
    return b;
}
__device__ __forceinline__ void xcd_barrier_complete(unsigned* bar, unsigned x, unsigned& nloc, unsigned& nx) {
    const unsigned G = gridDim.x * gridDim.y * gridDim.z;
    unsigned sum, cnt, mine, sp = 0u;
    for (;;) {
        sum = 0u; cnt = 0u; mine = 0u;
#pragma unroll
        for (unsigned j = 0; j < 16; ++j) { const unsigned c = xb_ld(&bar[XB_XCNT(j)]); sum += c; cnt += (c > 0u) ? 1u : 0u; mine = (j == x) ? c : mine; }
        if (sum == G) break;
        __builtin_amdgcn_s_sleep(1);
        if ((++sp & 255u) == 0u) { if (xb_ld(&bar[XB_TMO])) break; if (sp > XB_SPIN_CAP) { atomicAdd(&bar[XB_TMO], 1u); break; } }
    }
    nloc = mine > 0u ? mine : 1u; nx = cnt > 0u ? cnt : 1u;
}

__device__ __forceinline__ void xcd_barrier(const XcdBarrier& b) {
    asm volatile("s_waitcnt vmcnt(0)" ::: "memory");
    __syncthreads();
    if (threadIdx.x == 0) {
        unsigned* bar = b.bar;
        __builtin_amdgcn_s_waitcnt(0);
        unsigned nloc = b.st[0], nx = b.st[1];
        if (nloc == 0u) { xcd_barrier_complete(bar, b.x, nloc, nx); b.st[0] = nloc; b.st[1] = nx; }
        const unsigned old = xb_add(&bar[XB_XSUB(b.x)], 1u);
        const unsigned gen = old / nloc;
        if (old + 1u == (gen + 1u) * nloc) {
            __builtin_amdgcn_fence(__ATOMIC_RELEASE, "agent");
            asm volatile("s_waitcnt vmcnt(0)" ::: "memory");
            const unsigned og = xb_add(&bar[XB_TOP], 1u);
            const unsigned tg = og / nx;
            if (og + 1u == (tg + 1u) * nx) xb_add(&bar[XB_TOPGEN], 1u);
            else XB_SPIN(xb_ld(&bar[XB_TOPGEN]) == tg, bar);
            __builtin_amdgcn_fence(__ATOMIC_ACQUIRE, "agent");
            xb_add(&bar[XB_XGEN(b.x)], 1u);
            asm volatile("s_waitcnt vmcnt(0)" ::: "memory");
        } else {
            XB_SPIN(xb_ld(&bar[XB_XGEN(b.x)]) == gen, bar);
            __builtin_amdgcn_fence(__ATOMIC_ACQUIRE, "agent");
            asm volatile("s_waitcnt vmcnt(0)" ::: "memory");
        }
    }
    __syncthreads();
}


typedef unsigned v2u __attribute__((ext_vector_type(2)));
__device__ __forceinline__ float wave_sum(float v) {
#pragma unroll
    for (int o = 1; o < 64; o <<= 1) v += __shfl_xor(v, o);
    return v;
}
__device__ __forceinline__ float bf2f(unsigned short b) { return __builtin_bit_cast(float, (unsigned)b << 16); }
__device__ __forceinline__ float bflo(unsigned w) { return __builtin_bit_cast(float, w << 16); }
__device__ __forceinline__ float bfhi(unsigned w) { return __builtin_bit_cast(float, w & 0xffff0000u); }
__device__ __forceinline__ v4u pack8(f32x4 a, f32x4 b) { v4u w; w.x = pg8::cvt_pk_bf16(a[0], a[1]); w.y = pg8::cvt_pk_bf16(a[2], a[3]); w.z = pg8::cvt_pk_bf16(b[0], b[1]); w.w = pg8::cvt_pk_bf16(b[2], b[3]); return w; }
__device__ __forceinline__ float sigmoidf_(float x) { return __builtin_amdgcn_rcpf(1.0f + __builtin_amdgcn_exp2f(-x * LOG2E)); }

using pg8::Unit;
#define EPI_ROWS(...) int rb_ = u.pm * 256 + wr * 64 + fr; asm volatile("" : "+v"(rb_)); _Pragma("unroll") for (int ai = 0; ai < 2; ++ai) _Pragma("unroll") for (int m = 0; m < 4; ++m) { const size_t row = (size_t)(rb_ + ai * 128 + m * 16); \
        _Pragma("unroll") for (int bj = 0; bj < 2; ++bj) { const f32x4 v0 = acc[ai][bj][m][0], v1 = acc[ai][bj][m][1]; __VA_ARGS__ } }
struct EpiIn { static constexpr bool PERM = true, AFTER_DRAIN = false, MID = false;
    bf16* Z0; float* Z1; bf16 *QF, *KF, *VF, *GA, *GB;
    __device__ __forceinline__ void operator()(const f32x4 (&acc)[2][2][4][2], const Unit& u, int wr, int wc, int fr, int fq) const {
        const int pn = u.pn;
        EPI_ROWS({ const int ct = bj * 128 + wc * 32 + 8 * fq;
            if (pn == 0) { *(v4u*)(Z0 + row * 256 + ct) = pack8(v0, v1); }
            else if (pn == 1) { float* p = Z1 + row * 256 + ct; *(f32x4*)p = v0; *(f32x4*)(p + 4) = v1; }
            else if (pn < 4) { const int c = (pn - 2) * 256 + ct; *(v4u*)(QF + row * 640 + (c >> 6) * 80 + (c & 63)) = pack8(v0 * C2F, v1 * C2F); }
            else if (pn < 6) { const int c = (pn - 4) * 256 + ct; *(v4u*)(KF + row * 640 + (c >> 6) * 80 + (c & 63)) = pack8(v0, v1); }
            else if (pn < 8) { const int c = (pn - 6) * 256 + ct; *(v4u*)(VF + row * 512 + c) = pack8(v0, v1); }
            else { bf16* G = pn < 12 ? GA : GB; const int c = ((pn - 8) & 3) * 256 + ct; f32x4 s0, s1;
                _Pragma("unroll") for (int e = 0; e < 4; ++e) { s0[e] = sigmoidf_(v0[e]); s1[e] = sigmoidf_(v1[e]); }
                *(v4u*)(G + row * 1024 + c) = pack8(s0, s1); } })
    }
};
struct EpiQup { static constexpr bool PERM = true, AFTER_DRAIN = false, MID = false;
    bf16* QM;
    __device__ __forceinline__ void operator()(const f32x4 (&acc)[2][2][4][2], const Unit& u, int wr, int wc, int fr, int fq) const {
        EPI_ROWS({ const int ct = u.pn * 256 + bj * 128 + wc * 32 + 8 * fq; *(v4u*)(QM + row * 768 + ct) = pack8(v0 * C2M, v1 * C2M); })
    }
};
struct EpiKVup { static constexpr bool PERM = true, AFTER_DRAIN = false, MID = false;
    bf16 *KM, *VM;
    __device__ __forceinline__ void operator()(const f32x4 (&acc)[2][2][4][2], const Unit& u, int wr, int wc, int fr, int fq) const {
        bf16* D = u.pn < 2 ? KM : VM; const int c0 = (u.pn & 1) * 256;
        EPI_ROWS({ const int ct = bj * 128 + wc * 32 + 8 * fq; *(v4u*)(D + row * 512 + c0 + ct) = pack8(v0, v1); })
    }
};
struct EpiMix { static constexpr bool PERM = true, AFTER_DRAIN = false, MID = true;
    const bf16 *GA_, *GB_; bf16* MIX_;
    __device__ __forceinline__ void mid(f32x4 (&acc)[2][2][4][2], const Unit& u, int wr, int wc, int fr, int fq) const {
        int rb_ = u.pm * 256 + wr * 64 + fr; asm volatile("" : "+v"(rb_));
#pragma unroll
        for (int ai = 0; ai < 2; ++ai) { v4u ga[4][2], gb[4][2];
#pragma unroll
            for (int m = 0; m < 4; ++m)
#pragma unroll
                for (int bj = 0; bj < 2; ++bj) { const size_t off = (size_t)(rb_ + ai * 128 + m * 16) * 1024 + u.pn * 256 + bj * 128 + wc * 32 + 8 * fq; ga[m][bj] = *(const v4u*)(GA_ + off); gb[m][bj] = *(const v4u*)(GB_ + off); }
#pragma unroll
            for (int m = 0; m < 4; ++m)
#pragma unroll
                for (int bj = 0; bj < 2; ++bj) { const v4u a = ga[m][bj], b = gb[m][bj];
                    const f32x4 r0 = {bflo(a.x) * __builtin_amdgcn_rcpf(bflo(b.x)), bfhi(a.x) * __builtin_amdgcn_rcpf(bfhi(b.x)), bflo(a.y) * __builtin_amdgcn_rcpf(bflo(b.y)), bfhi(a.y) * __builtin_amdgcn_rcpf(bfhi(b.y))};
                    const f32x4 r1 = {bflo(a.z) * __builtin_amdgcn_rcpf(bflo(b.z)), bfhi(a.z) * __builtin_amdgcn_rcpf(bfhi(b.z)), bflo(a.w) * __builtin_amdgcn_rcpf(bflo(b.w)), bfhi(a.w) * __builtin_amdgcn_rcpf(bfhi(b.w))};
                    acc[ai][bj][m][0] *= r0; acc[ai][bj][m][1] *= r1; }
            asm volatile("" ::: "memory"); }
    }
    __device__ __forceinline__ void operator()(const f32x4 (&acc)[2][2][4][2], const Unit& u, int wr, int wc, int fr, int fq) const {
        EPI_ROWS({ const size_t off = row * 1024 + u.pn * 256 + bj * 128 + wc * 32 + 8 * fq; const v4u g = *(const v4u*)(GB_ + off);
            const f32x4 r0 = {bflo(g.x) * v0[0], bfhi(g.x) * v0[1], bflo(g.y) * v0[2], bfhi(g.y) * v0[3]}; const f32x4 r1 = {bflo(g.z) * v1[0], bfhi(g.z) * v1[1], bflo(g.w) * v1[2], bfhi(g.w) * v1[3]};
            *(v4u*)(MIX_ + off) = pack8(r0, r1); })
    }
};
struct EpiY { static constexpr bool PERM = true, AFTER_DRAIN = false, MID = false;
    bf16* Y_;
    __device__ __forceinline__ void operator()(const f32x4 (&acc)[2][2][4][2], const Unit& u, int wr, int wc, int fr, int fq) const {
        EPI_ROWS({ *(v4u*)(Y_ + row * 1024 + u.pn * 256 + bj * 128 + wc * 32 + 8 * fq) = pack8(v0, v1); })
    }
};
struct EpiLg { static constexpr bool PERM = true, AFTER_DRAIN = false, MID = false;
    float* LG;
    __device__ __forceinline__ void operator()(const f32x4 (&acc)[2][2][4][2], const Unit& u, int wr, int wc, int fr, int fq) const {
        EPI_ROWS({ if (bj == 0) { float* p = LG + row * 128 + wc * 32 + 8 * fq; *(f32x4*)p = v0; *(f32x4*)(p + 4) = v1; } })
    }
};
struct EpiGU { static constexpr bool PERM = true, AFTER_DRAIN = false, MID = false;
    bf16* ACT;
    __device__ __forceinline__ void operator()(const f32x4 (&acc)[2][2][4][2], const Unit& u, int wr, int wc, int fr, int fq) const {
        const int c0 = (u.pn & 1) * 128 + wc * 32 + 8 * fq; int rb_ = u.pm * 256 + wr * 64 + fr; asm volatile("" : "+v"(rb_));
#pragma unroll
        for (int ai = 0; ai < 2; ++ai)
#pragma unroll
            for (int m = 0; m < 4; ++m) { const size_t row = (size_t)(rb_ + ai * 128 + m * 16); f32x4 a0, a1;
#pragma unroll
                for (int e = 0; e < 4; ++e) { const float g0 = acc[ai][0][m][0][e], g1 = acc[ai][0][m][1][e]; a0[e] = g0 * sigmoidf_(g0) * acc[ai][1][m][0][e]; a1[e] = g1 * sigmoidf_(g1) * acc[ai][1][m][1][e]; }
                *(v4u*)(ACT + row * 256 + c0) = pack8(a0, a1); }
    }
};
struct EpiDown { static constexpr bool PERM = true, AFTER_DRAIN = false, MID = false;
    bf16* YB; const float* WROW;
    __device__ __forceinline__ void operator()(const f32x4 (&acc)[2][2][4][2], const Unit& u, int wr, int wc, int fr, int fq) const {
        const int c0 = (u.pn & 3) * 256;
        EPI_ROWS({ const float w = WROW[row]; *(v4u*)(YB + row * 1024 + c0 + bj * 128 + wc * 32 + 8 * fq) = pack8(v0 * w, v1 * w); })
    }
};
struct ExpertOrder {
    const LAS unsigned* tpre; int NJ, G, c;
    __device__ __forceinline__ bool next(int i, Unit& u) const {
        const int total = (int)tpre[NEXP] * NJ; const long L = (long)i * G + c; if (L >= total) return false;
        const int T = (int)L / NJ, j = (int)L % NJ; int e = 0;
#pragma unroll 1
        for (int k = 1; k < NEXP; ++k) e += ((int)tpre[k] <= T) ? 1 : 0;
        u.pm = T; u.pn = e * NJ + j; return true;
    }
    __device__ __forceinline__ void a_ready(const Unit&) const {}
    __device__ __forceinline__ void done(const Unit&) const {}
};

__device__ __forceinline__ void tr_item(const float* colp, int N, int k0, bf16* dst  , int K, bool lo, LAS float* scr, int lane) {
#pragma unroll 8
    for (int i = 0; i < 32; ++i) { const int kk = 2 * i + (lane >> 5); float v = colp ? colp[(size_t)(k0 + kk) * N] : 0.f;
        if (lo) v = v - bf2f((unsigned short)f2bf(v));
        scr[kk * 33 + (lane & 31)] = v; }
    LDS_WAIT(); asm volatile("" ::: "memory");
    const int c = lane & 7;
#pragma unroll
    for (int j = 0; j < 4; ++j) { const int n = (lane >> 3) + 8 * j; const LAS float* s = scr + (8 * c) * 33 + n;
        v4u o; o.x = pk2(s[0 * 33], s[1 * 33]); o.y = pk2(s[2 * 33], s[3 * 33]); o.z = pk2(s[4 * 33], s[5 * 33]); o.w = pk2(s[6 * 33], s[7 * 33]);
        *(GAS v4u*)(dst + (size_t)n * K + 8 * c) = o; }
    LDS_WAIT(); asm volatile("" ::: "memory");
}
__device__ __forceinline__ void tr_item4(const float* cp4, int N, bf16* dst  , int K, LAS float* scr, int lane) {
    const int c = lane & 7, kr0 = lane >> 3; f32x4 v[8];
#pragma unroll
    for (int i = 0; i < 8; ++i) v[i] = cp4 ? *(const f32x4*)(cp4 + (size_t)(8 * i) * N) : (f32x4){0.f, 0.f, 0.f, 0.f};
#pragma unroll
    for (int i = 0; i < 8; ++i) { LAS float* s = scr + (kr0 + 8 * i) * 33 + 4 * c; s[0] = v[i].x; s[1] = v[i].y; s[2] = v[i].z; s[3] = v[i].w; }
    LDS_WAIT(); asm volatile("" ::: "memory");
#pragma unroll
    for (int j = 0; j < 4; ++j) { const int n = kr0 + 8 * j; const LAS float* s = scr + (8 * c) * 33 + n;
        v4u o; o.x = pk2(s[0 * 33], s[1 * 33]); o.y = pk2(s[2 * 33], s[3 * 33]); o.z = pk2(s[4 * 33], s[5 * 33]); o.w = pk2(s[6 * 33], s[7 * 33]);
        *(GAS v4u*)(dst + (size_t)n * K + 8 * c) = o; }
    LDS_WAIT(); asm volatile("" ::: "memory");
}
constexpr int I7 = NEXP * 16 * 16, I8 = NEXP * 32 * 4;
__device__ __forceinline__ void conv_expert_item(int r, const float* w_e_gate, const float* w_e_up, const float* w_e_down, bf16* WGUp, bf16* WDNp, LAS float* scr, int lane) {
    const int c4 = 4 * (lane & 7), kr0 = lane >> 3;
    if (r < I7) { const int e = r / 256, q = r % 256, nb = q % 16, kb = q / 16, rr = nb * 32 + c4;
        const int j = rr >> 8, isup = (rr >> 7) & 1, cc = rr & 127; const float* src = (isup ? w_e_up : w_e_gate) + (size_t)e * 1024 * 256 + (size_t)(kb * 64 + kr0) * 256 + 128 * j + cc;
        tr_item4(src, 256, WGUp + ((size_t)e * 512 + nb * 32) * 1024 + kb * 64, 1024, scr, lane); }
    else { r -= I7; const int e = r / 128, q = r % 128, nb = q % 32, kb = q / 32; tr_item4(w_e_down + (size_t)e * 256 * 1024 + (size_t)(kb * 64 + kr0) * 1024 + nb * 32 + c4, 1024, WDNp + ((size_t)e * 1024 + nb * 32) * 256 + kb * 64, 256, scr, lane); }
}
__device__ __forceinline__ double inv_freq_d(int i) {
    const int q = i >> 2, r = i & 3;
    const double a = q == 0 ? 1.0 : q == 1 ? 0.1 : q == 2 ? 0.01 : 0.001;
    const double b = r == 0 ? 1.0 : r == 1 ? 0.5623413251903491 : r == 2 ? 0.31622776601683794 : 0.1778279410038923;
    return a * b;
}

struct Args { const float* in[22]; float* out; unsigned char* ws; int ph_lo, ph_hi; };

__global__ void __launch_bounds__(NWAVES * 64, 2) mk_fwd(Args args) {
    extern __shared__ __attribute__((aligned(16))) unsigned char lds[];
    LAS unsigned char* const L = (LAS unsigned char*)lds;
    volatile LAS unsigned* const MISC = (volatile LAS unsigned*)(L + MISC_OFF);
    const int tid = threadIdx.x, lane = tid & 63, wave = __builtin_amdgcn_readfirstlane(tid >> 6);
    const int G = gridDim.x; const int bx = blockIdx.x; const int vcu = (G % 8 == 0) ? (bx % 8) * (G / 8) + bx / 8 : bx;
    const int gw = vcu * NWAVES + wave, NGW = G * NWAVES;
    unsigned char* const ws = args.ws;
    gu32* const ctl = (gu32*)(ws + WS_CTL);
    const float* x = args.in[0]; const int* positions = (const int*)args.in[1]; const float* g_mix = args.in[2]; const float* w_in = args.in[3]; const float* b_forget = args.in[4];
    const float* g_cq = args.in[5]; const float* g_ckv = args.in[6]; const float* w_uq = args.in[7]; const float* w_uk = args.in[8]; const float* w_uv = args.in[9];
    const float* w_o_mla = args.in[10]; const float* w_o_fox = args.in[11]; const float* w_out = args.in[12]; const float* g_ffn = args.in[13]; const float* w_group = args.in[14];
    const float* b_group = args.in[15]; const float* w_router = args.in[16]; const float* b_router = args.in[17]; const float* w_e_gate = args.in[18]; const float* w_e_up = args.in[19];
    const float* w_e_down = args.in[20]; const float* g_final = args.in[21];
    float* const out = args.out;
#define WIN ((bf16*)(ws + WS_WIN))
#define WUQ ((bf16*)(ws + WS_WUQ))
#define WUKV ((bf16*)(ws + WS_WUKV))
#define WOA ((bf16*)(ws + WS_WOA))
#define WOB ((bf16*)(ws + WS_WOB))
#define WOUT ((bf16*)(ws + WS_WOUT))
#define WR ((bf16*)(ws + WS_WR))
#define WGU ((bf16*)(ws + WS_WGU))
#define WDN ((bf16*)(ws + WS_WDN))
#define CS ((float*)(ws + WS_CS))
#define LOGF ((float*)(ws + WS_LOGF))
#define EID ((int*)(ws + WS_EID))
#define SLOT ((int*)(ws + WS_SLOT))
#define WGT ((float*)(ws + WS_WGT))
#define POS ((int*)(ws + WS_POS))
#define WROW ((float*)(ws + WS_WROW))
#define XN ((bf16*)(ws + WS_XN))
#define CQN ((bf16*)(ws + WS_CQN))
#define CKVN ((bf16*)(ws + WS_CKVN))
#define VM ((bf16*)(ws + WS_VM))
#define KR ((bf16*)(ws + WS_KR))
#define Z0 ((bf16*)(ws + WS_Z0))
#define Z1 ((float*)(ws + WS_Z1))
#define QF ((bf16*)(ws + WS_QF))
#define KF ((bf16*)(ws + WS_KF))
#define VF ((bf16*)(ws + WS_VF))
#define OA ((bf16*)(ws + WS_OA))
#define OB ((bf16*)(ws + WS_OB))
#define MIX ((bf16*)(ws + WS_MIX))
#define QM ((bf16*)(ws + WS_QM))
#define KM ((bf16*)(ws + WS_KM))
#define HN ((bf16*)(ws + WS_HN))
#define LG ((float*)(ws + WS_LG))
#define XG ((bf16*)(ws + WS_XG))
#define ACT ((bf16*)(ws + WS_ACT))
#define YB ((bf16*)(ws + WS_YB))
#define GA ((bf16*)out)
#define GB ((bf16*)out + (size_t)M * 1024)
#define YM ((bf16*)(ws + WS_QM))

    for (int u = tid; u < (LDS_BYTES - LDSCTL_OFF) / 4; u += NWAVES * 64) ((LAS unsigned*)(L + LDSCTL_OFF))[u] = 0u;
    __syncthreads();
    XcdBarrier bar; bar.bar = (unsigned*)(ctl + CW_BAR); bar.x = 0; bar.st = nullptr;
    if (!MK_PER_PHASE) bar = xcd_barrier_post((unsigned*)(ctl + CW_BAR), MISC + 8);
    const int lo = args.ph_lo, hi = args.ph_hi;
#ifndef MK_REPEAT
#define MK_REPEAT -1
#endif
#ifndef MK_ONLY
#define MK_ONLY -1
#endif
#define IN(k) ((MK_ONLY < 0 || MK_ONLY == (k)) && lo <= (k) && (k) < hi)
#define SEAM(k) do { if (IN(k) && IN((k) + 1)) { if ((k) == 0) { cooperative_groups::this_grid().sync(); } else { xcd_barrier(bar); } } } while (0)

    if (IN(0)) for (int rep_ = 0; rep_ < ((MK_REPEAT == 0) ? 2 : 1); ++rep_) {
        LAS float* scr = (LAS float*)(L + RING_OFF + wave * 16384);
        constexpr int I0 = 128 * 16, I1 = 24 * 4, I2 = 32 * 2, I3 = 32 * 8, I4 = 32 * 8  , I5 = 32 * 16, I6 = 8 * 16;
        constexpr int NITEMS = I0 + I1 + I2; (void)I3; (void)I4; (void)I5; (void)I6;
        const int l31 = lane & 31, c4 = 4 * (lane & 7), kr0 = lane >> 3;
        for (int it = gw; it < NITEMS; it += NGW) {
            int r = it;
            if (r < I0) { const int nb = r % 128, kb = r / 128, n = nb * 32 + c4;
                int sc; if (n < 416) sc = n; else if (n < 424) sc = 1952 + (n - 416); else if (n < 512) sc = -1; else if (n < 2048) sc = n - 96; else sc = n - 88;
                tr_item4(sc >= 0 ? w_in + (size_t)(kb * 64 + kr0) * 4008 + sc : nullptr, 4008, WIN + (size_t)(nb * 32) * 1024 + kb * 64, 1024, scr, lane); continue; } r -= I0;
            if (r < I1) { const int nb = r % 24, kb = r / 24; tr_item4(w_uq + (size_t)(kb * 64 + kr0) * 768 + nb * 32 + c4, 768, WUQ + (size_t)(nb * 32) * 256 + kb * 64, 256, scr, lane); continue; } r -= I1;
            if (r < I2) { const int nb = r % 32, kb = r / 32, n = nb * 32 + c4; tr_item4((n < 512 ? w_uk + n : w_uv + (n - 512)) + (size_t)(kb * 64 + kr0) * 512, 512, WUKV + (size_t)(nb * 32) * 128 + kb * 64, 128, scr, lane); continue; }
        }
        for (int m = 2 * gw; m < M; m += 2 * NGW) {
            const GAS f32x4* xr = (const GAS f32x4*)(x + (size_t)m * DM) + lane; f32x4 v[8]; float s2a = 0.f, s2b = 0.f;
#pragma unroll
            for (int j = 0; j < 8; ++j) v[j] = xr[64 * j];
#pragma unroll
            for (int j = 0; j < 4; ++j) { s2a += (v[j].x * v[j].x + v[j].y * v[j].y) + (v[j].z * v[j].z + v[j].w * v[j].w); s2b += (v[4 + j].x * v[4 + j].x + v[4 + j].y * v[4 + j].y) + (v[4 + j].z * v[4 + j].z + v[4 + j].w * v[4 + j].w); }
            const float ra = 1.f / sqrtf(wave_sum(s2a) * (1.f / DM) + EPS), rb = 1.f / sqrtf(wave_sum(s2b) * (1.f / DM) + EPS);
            GAS unsigned long long* o8 = (GAS unsigned long long*)(XN + (size_t)m * DM) + lane;
#pragma unroll
            for (int j = 0; j < 8; ++j) { const f32x4 g = *((const f32x4*)g_mix + lane + 64 * (j & 3)); const float rs = j < 4 ? ra : rb;
                o8[64 * j] = (unsigned long long)pk2(v[j].x * rs * g.x, v[j].y * rs * g.y) | ((unsigned long long)pk2(v[j].z * rs * g.z, v[j].w * rs * g.w) << 32); }
        }
        for (int i = (vcu * NWAVES * 64 + tid); i < M * 16; i += G * NWAVES * 64) {
            const int m = i >> 4, f = i & 15; const double ang = (double)positions[m] * inv_freq_d(f); const double rev = ang * 0.15915494309189535; const float fr = (float)(rev - floor(rev));
            CS[2 * i] = __builtin_amdgcn_cosf(fr); CS[2 * i + 1] = __builtin_amdgcn_sinf(fr); }
    }
    SEAM(0);
    if (IN(1)) for (int rep_ = 0; rep_ < ((MK_REPEAT == 1) ? 2 : 1); ++rep_) {
        pg8::Gemm g{XN, WIN, M, NIN, DM}; pg8::StaticOrder S; S.init(M, NIN, G, bx);
        EpiIn E{Z0, Z1, QF, KF, VF, GA, GB};
        pg8::gemm_phase<EpiIn, pg8::StaticOrder, true, true>(L + RING_OFF, g, S, E);
    }
    SEAM(1);
    if (IN(2)) for (int rep_ = 0; rep_ < ((MK_REPEAT == 2) ? 2 : 1); ++rep_) {
        float* const BSUM = (float*)(ws + WS_EID);
        LAS float* part = (LAS float*)(L + RING_OFF);
        for (int vb = vcu; vb < 256; vb += G) { float lfsum = 0.f; const int g4 = lane >> 4, l16 = lane & 15;
#pragma unroll 2
        for (int it = 0; it < 4; ++it) { const size_t m = (size_t)vb * 128 + wave * 16 + it * 4 + g4;
            const v4u ra = *(const v4u*)(Z0 + m * 256 + l16 * 16), rb = *(const v4u*)(Z0 + m * 256 + l16 * 16 + 8);
            const float* z = Z1 + m * 256;
            const f32x4 ka = *(const f32x4*)(z + l16 * 8), kb = *(const f32x4*)(z + l16 * 8 + 4);
            const float x1 = z[128 + l16], x2 = z[144 + l16], cc = CS[m * 32 + 2 * l16], sn = CS[m * 32 + 2 * l16 + 1];
            const float fl = z[160 + (l16 & 7)];
            float q[16] = {bflo(ra.x), bfhi(ra.x), bflo(ra.y), bfhi(ra.y), bflo(ra.z), bfhi(ra.z), bflo(ra.w), bfhi(ra.w), bflo(rb.x), bfhi(rb.x), bflo(rb.y), bfhi(rb.y), bflo(rb.z), bfhi(rb.z), bflo(rb.w), bfhi(rb.w)};
            float sq = 0.f, sk = (ka.x * ka.x + ka.y * ka.y) + (ka.z * ka.z + ka.w * ka.w) + (kb.x * kb.x + kb.y * kb.y) + (kb.z * kb.z + kb.w * kb.w);
#pragma unroll
            for (int e = 0; e < 16; ++e) sq += q[e] * q[e];
#pragma unroll
            for (int o = 1; o < 16; o <<= 1) { sq += __shfl_xor(sq, o); sk += __shfl_xor(sk, o); }
            const float rq = 1.f / sqrtf(sq * (1.f / 256) + EPS), rk = 1.f / sqrtf(sk * (1.f / 128) + EPS);
            { const f32x4 g0 = *((const f32x4*)g_cq + l16 * 4), g1 = *((const f32x4*)g_cq + l16 * 4 + 1), g2 = *((const f32x4*)g_cq + l16 * 4 + 2), g3 = *((const f32x4*)g_cq + l16 * 4 + 3);
              v4u o0, o1; o0.x = pk2(q[0] * rq * g0.x, q[1] * rq * g0.y); o0.y = pk2(q[2] * rq * g0.z, q[3] * rq * g0.w); o0.z = pk2(q[4] * rq * g1.x, q[5] * rq * g1.y); o0.w = pk2(q[6] * rq * g1.z, q[7] * rq * g1.w);
              o1.x = pk2(q[8] * rq * g2.x, q[9] * rq * g2.y); o1.y = pk2(q[10] * rq * g2.z, q[11] * rq * g2.w); o1.z = pk2(q[12] * rq * g3.x, q[13] * rq * g3.y); o1.w = pk2(q[14] * rq * g3.z, q[15] * rq * g3.w);
              *(v4u*)(CQN + m * 256 + l16 * 16) = o0; *(v4u*)(CQN + m * 256 + l16 * 16 + 8) = o1; }
            { const f32x4 g0 = *((const f32x4*)g_ckv + l16 * 2), g1 = *((const f32x4*)g_ckv + l16 * 2 + 1);
              v4u o; o.x = pk2(ka.x * rk * g0.x, ka.y * rk * g0.y); o.y = pk2(ka.z * rk * g0.z, ka.w * rk * g0.w); o.z = pk2(kb.x * rk * g1.x, kb.y * rk * g1.y); o.w = pk2(kb.z * rk * g1.z, kb.w * rk * g1.w);
              *(v4u*)(CKVN + m * 128 + l16 * 8) = o; }
            KR[m * 32 + l16] = (bf16)f2bf(x1 * cc - x2 * sn); KR[m * 32 + 16 + l16] = (bf16)f2bf(x2 * cc + x1 * sn);
            if (l16 < 8) { const float xx = fl + b_forget[l16]; const float t = __expf(-fabsf(xx)); const float lfv = fminf(xx, 0.f) - __logf(1.f + t); LOGF[m * 8 + l16] = lfv; lfsum += lfv; }
            { const int hh = l16 >> 1, half = l16 & 1; v4u o = {0u, 0u, 0u, 0u}; *(v4u*)(KF + m * 640 + hh * 80 + 64 + half * 8) = o;
              if (half == 0) { o.x = 0x3F803F80u; o.y = 0x00003F80u; } *(v4u*)(QF + m * 640 + hh * 80 + 64 + half * 8) = o; }
        }
        lfsum += __shfl_xor(lfsum, 16); lfsum += __shfl_xor(lfsum, 32);
        if (lane < 8) part[wave * 8 + lane] = lfsum;
        __syncthreads();
        if (tid < 8) { float t = 0.f; for (int w = 0; w < 8; ++w) t += part[w * 8 + tid]; BSUM[vb * 8 + tid] = t; }
        __syncthreads();
        }
    }
    SEAM(2);
    if (IN(3)) for (int rep_ = 0; rep_ < ((MK_REPEAT == 3) ? 2 : 1); ++rep_) {
#ifndef NO_SCAN
        { const float* const BSUM = (const float*)(ws + WS_EID);
          for (int vb = vcu; vb < 256; vb += G) { const int b = vb >> 5, bi = vb & 31, hh = wave;
            double base = (lane < bi) ? (double)BSUM[(size_t)((b * 32 + lane) * 8 + hh)] : 0.0;
#pragma unroll
            for (int o = 1; o < 64; o <<= 1) base += __shfl_xor(base, o);
            const size_t t0 = (size_t)vb * 128 + 2 * lane; const float v0 = LOGF[t0 * 8 + hh], v1 = LOGF[(t0 + 1) * 8 + hh];
            const double sp = (double)v0 + (double)v1; double incl = sp;
#pragma unroll
            for (int o = 1; o < 64; o <<= 1) { const double t = __shfl_up(incl, o); if (lane >= o) incl += t; }
            const double run0 = base + (incl - sp) + (double)v0, run1 = run0 + (double)v1;
#pragma unroll
            for (int e = 0; e < 2; ++e) { const float gneg = (float)(-(e ? run1 : run0) * 1.4426950408889634);
                const unsigned b0 = f2bf(gneg); const float r1 = gneg - bf2f((unsigned short)b0); const unsigned b1 = f2bf(r1); const float r2 = r1 - bf2f((unsigned short)b1); const unsigned b2 = f2bf(r2);
                bf16* kf = KF + (t0 + e) * 640 + hh * 80 + 64; *(unsigned*)kf = b0 | (b1 << 16); *(unsigned*)(kf + 2) = b2;
                LOGF[(t0 + e) * 8 + hh] = bf2f((unsigned short)b0) + bf2f((unsigned short)b1) + bf2f((unsigned short)b2); }
            float qn = 0.f, kn = 0.f;
#pragma unroll
            for (int e = 0; e < 2; ++e) { const v4u* kp = (const v4u*)(KF + (t0 + e) * 640 + hh * 80); const v4u* qp = (const v4u*)(QF + (t0 + e) * 640 + hh * 80); float sk = 0.f, sq = 0.f;
#pragma unroll
                for (int c = 0; c < 8; ++c) { const v4u a = kp[c], q = qp[c];
                    sk += (bflo(a.x) * bflo(a.x) + bfhi(a.x) * bfhi(a.x)) + (bflo(a.y) * bflo(a.y) + bfhi(a.y) * bfhi(a.y)) + (bflo(a.z) * bflo(a.z) + bfhi(a.z) * bfhi(a.z)) + (bflo(a.w) * bflo(a.w) + bfhi(a.w) * bfhi(a.w));
                    sq += (bflo(q.x) * bflo(q.x) + bfhi(q.x) * bfhi(q.x)) + (bflo(q.y) * bflo(q.y) + bfhi(q.y) * bfhi(q.y)) + (bflo(q.z) * bflo(q.z) + bfhi(q.z) * bfhi(q.z)) + (bflo(q.w) * bflo(q.w) + bfhi(q.w) * bfhi(q.w)); }
                kn = fmaxf(kn, sk); qn = fmaxf(qn, sq); }
#pragma unroll
            for (int o = 1; o < 64; o <<= 1) { kn = fmaxf(kn, __shfl_xor(kn, o)); qn = fmaxf(qn, __shfl_xor(qn, o)); }
            if (lane == 0) { __hip_atomic_fetch_max(ctl + CW_QK + 2 * (b * 8 + hh), __float_as_uint(sqrtf(qn)), RLX_AGENT); __hip_atomic_fetch_max(ctl + CW_QK + 2 * (b * 8 + hh) + 1, __float_as_uint(sqrtf(kn)), RLX_AGENT); }
          } }
#endif
#ifndef NO_QUP
        { pg8::Gemm g{CQN, WUQ, M, 768, 256}; pg8::StaticOrder S; S.init(M, 768, G, bx); EpiQup E{QM};
          pg8::gemm_phase<EpiQup, pg8::StaticOrder, true, true>(L + RING_OFF, g, S, E); }
#endif
#ifndef NO_KVUP
        { pg8::Gemm g{CKVN, WUKV, M, 1024, 128}; pg8::StaticOrder S; S.init(M, 1024, G, bx); EpiKVup E{KM, VM};
          pg8::gemm_phase<EpiKVup, pg8::StaticOrder, true, true>(L + RING_OFF, g, S, E); }
#endif
    }
    SEAM(3);
    if (IN(4)) for (int rep_ = 0; rep_ < ((MK_REPEAT == 4) ? 2 : 1); ++rep_) {
        const att::AttnT TA{QM, KM, KR, VM, OA, CS, LOGF, (const unsigned*)(ctl + CW_QK)}; const att::AttnT TB{QF, KF, KF, VF, OA + 512, CS, LOGF, (const unsigned*)(ctl + CW_QK)};
        LAS int* qi = (LAS int*)(L + TP_OFF + 512);
        if (tid == 0) qi[0] = (int)__hip_atomic_fetch_add(ctl + CW_AQ, 1u, RLX_AGENT);
        __syncthreads();
        int idx = qi[0];
        constexpr int NLATE = I7 + I8 + 32 * 16 + 32 * 16 + 8 * 16, CONV_PER = 48, NQ = 2048 + NLATE / CONV_PER;
        static_assert(NLATE % CONV_PER == 0, "conv tickets");
        while (idx < NQ) {
            int nxt = 0; if (tid == 0) nxt = (int)__hip_atomic_fetch_add(ctl + CW_AQ, 1u, RLX_AGENT);
            const int r = idx & 1023, qb = 15 - (r >> 6), bh = r & 63;
            if (idx < 1024) att::attn_unit<0>(bh >> 3, bh & 7, qb, TA, (char*)lds + RING_OFF);
            else if (idx < 2048) att::attn_unit<1>(bh >> 3, bh & 7, qb, TB, (char*)lds + RING_OFF);
            else { LAS float* scr = (LAS float*)(L + RING_OFF + wave * 16384); const int l31 = lane & 31, c4 = 4 * (lane & 7), kr0 = lane >> 3;
#pragma unroll 1
                for (int k = 0; k < CONV_PER / NWAVES; ++k) { int r = (idx - 2048) * CONV_PER + wave * (CONV_PER / NWAVES) + k;
                    constexpr int J3 = 32 * 16, J5 = 32 * 16, J6 = 8 * 16;
                    if (r >= J6 + J3 + J5) { conv_expert_item(r - (J6 + J3 + J5), w_e_gate, w_e_up, w_e_down, WGU, WDN, scr, lane); continue; }
                    r = (r < J6) ? (r + J3 + J5) : (r - J6);
                    if (r < J3) { const int nb = r % 32, kb = r / 32;
                        const float* src = (kb < 8 ? w_o_mla + (size_t)(kb * 64 + kr0) * 1024 : w_o_fox + (size_t)((kb - 8) * 64 + kr0) * 1024) + nb * 32 + c4;
                        tr_item4(src, 1024, WOA + (size_t)(nb * 32) * 1024 + kb * 64, 1024, scr, lane); continue; } r -= J3;
                    if (r < J5) { const int nb = r % 32, kb = r / 32; tr_item4(w_out + (size_t)(kb * 64 + kr0) * 1024 + nb * 32 + c4, 1024, WOUT + (size_t)(nb * 32) * 1024 + kb * 64, 1024, scr, lane); continue; } r -= J5;
                    if (r < J6) { const int nb = r % 8, kb = r / 8, n = nb * 32 + l31; const int j = n & 63; const bool islo = (n >= 64 && n < 128); const bool valid = (n < 128) && (j < 36);
                        const float* cp = nullptr; int NN = 32; if (valid) { if (j < 4) { cp = w_group + j; NN = 4; } else { cp = w_router + (j - 4); NN = 32; } }
#pragma unroll 8
                        for (int i = 0; i < 32; ++i) { const int kk = 2 * i + (lane >> 5); float v = cp ? cp[(size_t)(kb * 64 + kk) * NN] : 0.f; if (islo) v = v - bf2f((unsigned short)f2bf(v)); scr[kk * 33 + l31] = v; }
                        LDS_WAIT(); asm volatile("" ::: "memory");
                        const int c = lane & 7; bf16* dst = WR + (size_t)(nb * 32) * 1024 + kb * 64;
#pragma unroll
                        for (int jj = 0; jj < 4; ++jj) { const int nn = (lane >> 3) + 8 * jj; const LAS float* sp = scr + (8 * c) * 33 + nn;
                            v4u o; o.x = pk2(sp[0 * 33], sp[1 * 33]); o.y = pk2(sp[2 * 33], sp[3 * 33]); o.z = pk2(sp[4 * 33], sp[5 * 33]); o.w = pk2(sp[6 * 33], sp[7 * 33]);
                            *(GAS v4u*)(dst + (size_t)nn * 1024 + 8 * c) = o; }
                        LDS_WAIT(); asm volatile("" ::: "memory"); } } }
            if (tid == 0) qi[0] = nxt;
            __syncthreads(); idx = qi[0];
        }
    }
#ifndef MK_ATT_PROBE
#define MK_ATT_PROBE -1
#endif
    if (MK_ATT_PROBE >= 0 && IN(4)) {
        const att::AttnT TA{QM, KM, KR, VM, MIX, CS, LOGF, (const unsigned*)(ctl + CW_QK)}; const att::AttnT TB{QF, KF, KF, VF, MIX + 512, CS, LOGF, (const unsigned*)(ctl + CW_QK)};
        for (int v = vcu; v < 256; v += G) { const int bh = v >> 2, sub = v & 3, b = bh >> 3, hh = bh & 7;
#pragma unroll 1
            for (int i = 0; i < 4; ++i) { const int qb = (i == 0) ? 15 - sub : (i == 1) ? 8 + sub : (i == 2) ? 7 - sub : sub;
                att::attn_unit<0, (MK_ATT_PROBE < 0 ? 0 : MK_ATT_PROBE)>(b, hh, qb, TA, (char*)lds + RING_OFF);
                att::attn_unit<1, (MK_ATT_PROBE < 0 ? 0 : MK_ATT_PROBE)>(b, hh, qb, TB, (char*)lds + RING_OFF); } }
    }
    SEAM(4);
    if (IN(5)) for (int rep_ = 0; rep_ < ((MK_REPEAT == 5) ? 2 : 1); ++rep_) {
        pg8::Gemm g{OA, WOA, M, 1024, 1024}; pg8::StaticOrder S; S.init(M, 1024, G, bx); EpiMix E{GA, GB, MIX}; pg8::gemm_phase<EpiMix, pg8::StaticOrder, true, true>(L + RING_OFF, g, S, E);
    }
    SEAM(5);
    if (IN(6)) for (int rep_ = 0; rep_ < ((MK_REPEAT == 6) ? 2 : 1); ++rep_) {
        pg8::Gemm g{MIX, WOUT, M, 1024, 1024}; pg8::StaticOrder S; S.init(M, 1024, G, bx); EpiY E{YM}; pg8::gemm_phase<EpiY, pg8::StaticOrder, true, true>(L + RING_OFF, g, S, E);
    }
    SEAM(6);
    if (IN(7)) for (int rep_ = 0; rep_ < ((MK_REPEAT == 7) ? 2 : 1); ++rep_) {
        for (int m0 = 2 * gw; m0 < M; m0 += 2 * NGW) {
            f32x4 v[8]; v2u yv[8];
#pragma unroll
            for (int j = 0; j < 8; ++j) { const size_t m = (size_t)m0 + (j >> 2); v[j] = *((const GAS f32x4*)(x + m * DM) + lane + 64 * (j & 3)); yv[j] = *((const v2u*)(YM + m * DM) + lane + 64 * (j & 3)); }
            float s2[2] = {0.f, 0.f};
#pragma unroll
            for (int j = 0; j < 8; ++j) { v[j].x += bflo(yv[j].x); v[j].y += bfhi(yv[j].x); v[j].z += bflo(yv[j].y); v[j].w += bfhi(yv[j].y); s2[j >> 2] += (v[j].x * v[j].x + v[j].y * v[j].y) + (v[j].z * v[j].z + v[j].w * v[j].w); }
            const float rs[2] = {1.f / sqrtf(wave_sum(s2[0]) * (1.f / DM) + EPS), 1.f / sqrtf(wave_sum(s2[1]) * (1.f / DM) + EPS)};
#pragma unroll
            for (int j = 0; j < 8; ++j) { const size_t m = (size_t)m0 + (j >> 2); const float rstd = rs[j >> 2];
                GAS unsigned long long* oh = (GAS unsigned long long*)(HN + m * DM) + lane + 64 * (j & 3); GAS unsigned long long* ol = (GAS unsigned long long*)(HN + ((size_t)M + m) * DM) + lane + 64 * (j & 3);
                const f32x4 g = *((const f32x4*)g_ffn + lane + 64 * (j & 3)); const f32x4 y = {v[j].x * rstd * g.x, v[j].y * rstd * g.y, v[j].z * rstd * g.z, v[j].w * rstd * g.w};
                const unsigned h0 = f2bf(y.x), h1 = f2bf(y.y), h2 = f2bf(y.z), h3 = f2bf(y.w);
                *oh = (unsigned long long)(h0 | (h1 << 16)) | ((unsigned long long)(h2 | (h3 << 16)) << 32);
                *ol = (unsigned long long)pk2(y.x - bf2f((unsigned short)h0), y.y - bf2f((unsigned short)h1)) | ((unsigned long long)pk2(y.z - bf2f((unsigned short)h2), y.w - bf2f((unsigned short)h3)) << 32); }
        }
    }
    SEAM(7);
    if (IN(8)) for (int rep_ = 0; rep_ < ((MK_REPEAT == 8) ? 2 : 1); ++rep_) {
        pg8::Gemm g{HN, WR, 2 * M, 256, 1024}; pg8::StaticOrder S; S.init(2 * M, 256, G, bx); EpiLg E{LG}; pg8::gemm_phase<EpiLg, pg8::StaticOrder, true, true>(L + RING_OFF, g, S, E);
    }
    SEAM(8);
    if (IN(9)) for (int rep_ = 0; rep_ < ((MK_REPEAT == 9) ? 2 : 1); ++rep_) {
        LAS unsigned* lc = (LAS unsigned*)(L + TP_OFF + 256);
        const int per = (M + G - 1) / G;
        for (int t0 = vcu * per; t0 < min(M, (vcu + 1) * per); t0 += NWAVES * 64) {
        if (tid < 64) lc[tid] = 0u;
        __syncthreads();
        const int t = t0 + tid; const bool act = (t < min(M, (vcu + 1) * per));
        int x0 = 0, x1 = 0; unsigned s0 = 0, s1 = 0; float w0 = 0.f, w1 = 0.f;
        if (act) {
            float lg[36];
            const float* a = LG + (size_t)t * 128; const float* b2 = LG + (size_t)(M + t) * 128;
#pragma unroll
            for (int q = 0; q < 9; ++q) { const f32x4 p0 = *(const f32x4*)(a + 4 * q), p1 = *(const f32x4*)(a + 64 + 4 * q), p2 = *(const f32x4*)(b2 + 4 * q), p3 = *(const f32x4*)(b2 + 64 + 4 * q);
#pragma unroll
                for (int e = 0; e < 4; ++e) lg[4 * q + e] = (p0[e] + p1[e]) + (p2[e] + p3[e]); }
#pragma unroll
            for (int j = 0; j < 4; ++j) lg[j] += b_group[j];
#pragma unroll
            for (int j = 0; j < 32; ++j) lg[4 + j] += b_router[j];
            int gi = 0; float gm = lg[0];
#pragma unroll
            for (int j = 1; j < 4; ++j) if (lg[j] > gm) { gm = lg[j]; gi = j; }
            float gs = 0.f;
#pragma unroll
            for (int j = 0; j < 4; ++j) gs += __expf(lg[j] - gm);
            const float gp = 1.f / gs;
            float sel[8];
#pragma unroll
            for (int e = 0; e < 8; ++e) sel[e] = gi == 0 ? lg[4 + e] : gi == 1 ? lg[12 + e] : gi == 2 ? lg[20 + e] : lg[28 + e];
            int e0 = 0; float m0 = sel[0];
#pragma unroll
            for (int e = 1; e < 8; ++e) if (sel[e] > m0) { m0 = sel[e]; e0 = e; }
            int e1 = -1; float m1 = -INFINITY;
#pragma unroll
            for (int e = 0; e < 8; ++e) if (e != e0 && sel[e] > m1) { m1 = sel[e]; e1 = e; }
            const float r = __expf(m1 - m0); w0 = gp / (1.f + r); w1 = gp * r / (1.f + r);
            x0 = gi * 8 + e0; x1 = gi * 8 + e1;
            s0 = __hip_atomic_fetch_add(lc + x0, 1u, __ATOMIC_RELAXED, __HIP_MEMORY_SCOPE_WORKGROUP); s1 = __hip_atomic_fetch_add(lc + x1, 1u, __ATOMIC_RELAXED, __HIP_MEMORY_SCOPE_WORKGROUP);
        }
        __syncthreads();
        if (tid < NEXP) { const unsigned c = lc[tid]; lc[32 + tid] = c ? __hip_atomic_fetch_add(ctl + CW_CNT + 64 * tid, c, RLX_AGENT) : 0u; }
        __syncthreads();
        if (act) { EID[2 * t] = x0; EID[2 * t + 1] = x1; SLOT[2 * t] = (int)(lc[32 + x0] + s0); SLOT[2 * t + 1] = (int)(lc[32 + x1] + s1); WGT[2 * t] = w0; WGT[2 * t + 1] = w1; }
        __syncthreads();
        }
    }
    SEAM(9);
    if (IN(10)) for (int rep_ = 0; rep_ < ((MK_REPEAT == 10) ? 2 : 1); ++rep_) {
        LAS unsigned* tp = (LAS unsigned*)(L + TP_OFF);
        if (tid == 0) { unsigned acc = 0; for (int e = 0; e < NEXP; ++e) { tp[e] = acc; acc += (__hip_atomic_load(ctl + CW_CNT + 64 * e, RLX_AGENT) + 255u) >> 8; } tp[NEXP] = acc;
            if (bx == 0) for (int e = 0; e <= NEXP; ++e) __hip_atomic_store(ctl + CW_TPRE + e, tp[e], RLX_AGENT); }
        __syncthreads();
        int* const IDX = (int*)(ws + WS_WROW + 512 * 1024);
        for (int m = vcu * NWAVES * 64 + tid; m < M; m += G * NWAVES * 64) {
            const int x0 = EID[2 * m], x1 = EID[2 * m + 1]; const int p0 = (int)tp[x0] * 256 + SLOT[2 * m], p1 = (int)tp[x1] * 256 + SLOT[2 * m + 1];
            POS[2 * m] = p0; POS[2 * m + 1] = p1; WROW[p0] = WGT[2 * m]; WROW[p1] = WGT[2 * m + 1]; IDX[p0] = m; IDX[p1] = m;
        }
        for (int e = vcu; e < NEXP; e += G) { const int r0 = (int)tp[e] * 256 + (int)__hip_atomic_load(ctl + CW_CNT + 64 * e, RLX_AGENT), r1 = (int)tp[e + 1] * 256;
            for (int r = r0 + tid; r < r1; r += NWAVES * 64) IDX[r] = 0; }
        __syncthreads();
    }
    SEAM(10);
    if (IN(11)) for (int rep_ = 0; rep_ < ((MK_REPEAT == 11) ? 2 : 1); ++rep_) {
        LAS unsigned* tp = (LAS unsigned*)(L + TP_OFF); if (tid <= NEXP) tp[tid] = __hip_atomic_load(ctl + CW_TPRE + tid, RLX_AGENT); __syncthreads();
        pg8::Gemm g{HN, WGU, XG_ROWS, NEXP * 512, 1024, (const int*)(ws + WS_WROW + 512 * 1024)}; ExpertOrder S{tp, 2, G, bx}; EpiGU E{ACT};
        pg8::gemm_phase<EpiGU, ExpertOrder, true, true, true>(L + RING_OFF, g, S, E);
    }
    SEAM(11);
    if (IN(12)) for (int rep_ = 0; rep_ < ((MK_REPEAT == 12) ? 2 : 1); ++rep_) {
        LAS unsigned* tp = (LAS unsigned*)(L + TP_OFF); if (tid <= NEXP) tp[tid] = __hip_atomic_load(ctl + CW_TPRE + tid, RLX_AGENT); __syncthreads();
        pg8::Gemm g{ACT, WDN, XG_ROWS, NEXP * 1024, 256}; ExpertOrder S{tp, 4, G, bx}; EpiDown E{YB, WROW};
        pg8::gemm_phase<EpiDown, ExpertOrder, true, true>(L + RING_OFF, g, S, E);
    }
    SEAM(12);
    if (IN(13)) for (int rep_ = 0; rep_ < ((MK_REPEAT == 13) ? 2 : 1); ++rep_) {
        for (int m = gw; m < M; m += NGW) {
            const int p0 = POS[2 * m], p1 = POS[2 * m + 1];
            const GAS f32x4* xr = (const GAS f32x4*)(x + (size_t)m * DM) + lane; const v2u* yr = (const v2u*)(YM + (size_t)m * DM) + lane;
            const v2u* y0 = (const v2u*)(YB + (size_t)p0 * DM) + lane; const v2u* y1 = (const v2u*)(YB + (size_t)p1 * DM) + lane;
            f32x4 v[4]; v2u ya[4], yb[4], yc[4]; float s2 = 0.f;
#pragma unroll
            for (int j = 0; j < 4; ++j) { v[j] = xr[64 * j]; ya[j] = yr[64 * j]; yb[j] = y0[64 * j]; yc[j] = y1[64 * j]; }
#pragma unroll
            for (int j = 0; j < 4; ++j) {
                v[j].x += bflo(ya[j].x) + (bflo(yb[j].x) + bflo(yc[j].x)); v[j].y += bfhi(ya[j].x) + (bfhi(yb[j].x) + bfhi(yc[j].x)); v[j].z += bflo(ya[j].y) + (bflo(yb[j].y) + bflo(yc[j].y)); v[j].w += bfhi(ya[j].y) + (bfhi(yb[j].y) + bfhi(yc[j].y));
                s2 += (v[j].x * v[j].x + v[j].y * v[j].y) + (v[j].z * v[j].z + v[j].w * v[j].w); }
            const float rstd = 1.f / sqrtf(wave_sum(s2) * (1.f / DM) + EPS);
            GAS f32x4* orow = (GAS f32x4*)(out + (size_t)m * DM) + lane;
#pragma unroll
            for (int j = 0; j < 4; ++j) { const f32x4 g = *((const f32x4*)g_final + lane + 64 * j); orow[64 * j] = (f32x4){v[j].x * rstd * g.x, v[j].y * rstd * g.y, v[j].z * rstd * g.z, v[j].w * rstd * g.w}; }
        }
    }
#undef IN
#undef SEAM
}

extern "C" void kernel_launch(void* const* d_in, const int* in_sizes, int n_in, void* d_out, int out_size, void* d_ws, size_t ws_size, hipStream_t stream) {
    static int grid = 0;
    if (grid == 0) {
        if (n_in != 22 || in_sizes[0] != M * DM || out_size != M * DM || ws_size < WS_END) { fprintf(stderr, "kernel_launch: unexpected shapes (n_in %d, in0 %d, out %d, ws %zu); nothing launched\n", n_in, n_in > 0 ? in_sizes[0] : -1, out_size, ws_size); grid = -1; return; }
        int dev = 0, cus = 0, per_cu = 0;
        if (hipGetDevice(&dev) != hipSuccess || hipDeviceGetAttribute(&cus, hipDeviceAttributeMultiprocessorCount, dev) != hipSuccess) { grid = -1; return; }
        if (hipFuncSetAttribute((const void*)mk_fwd, hipFuncAttributeMaxDynamicSharedMemorySize, LDS_BYTES) != hipSuccess) { fprintf(stderr, "kernel_launch: hipFuncSetAttribute failed\n"); grid = -1; return; }
        if (hipOccupancyMaxActiveBlocksPerMultiprocessor(&per_cu, (const void*)mk_fwd, NWAVES * 64, LDS_BYTES) != hipSuccess || per_cu < 1) { fprintf(stderr, "kernel_launch: occupancy query says %d blocks/CU\n", per_cu); per_cu = 1; }
        (void)hipGetLastError();
        grid = cus;
    }
    if (grid < 0) return;
    if (hipMemsetAsync((char*)d_ws + WS_CTL, 0, CTL_ZERO_BYTES, stream) != hipSuccess) { fprintf(stderr, "kernel_launch: memset failed\n"); return; }
    Args a{};
    for (int i = 0; i < 22; ++i) a.in[i] = (const float*)d_in[i];
    a.out = (float*)d_out; a.ws = (unsigned char*)d_ws;
#if MK_PER_PHASE
#ifndef MK_REPEAT_L
#define MK_REPEAT_L -1
#endif
    for (int p = 0; p < N_PHASES; ++p) { a.ph_lo = p; a.ph_hi = p + 1; hipLaunchKernelGGL(mk_fwd, dim3(grid), dim3(NWAVES * 64), LDS_BYTES, stream, a);
        if (p == MK_REPEAT_L) hipLaunchKernelGGL(mk_fwd, dim3(grid), dim3(NWAVES * 64), LDS_BYTES, stream, a); }
#else
#ifndef MK_PREFIX
#define MK_PREFIX -1
#endif
    void* kargs[] = {&a};
    if (MK_PREFIX >= 0) {
        a.ph_lo = 0; a.ph_hi = MK_PREFIX + 1;
        (void)hipLaunchCooperativeKernel((const void*)mk_fwd, dim3(grid), dim3(NWAVES * 64), kargs, LDS_BYTES, stream);
        (void)hipMemsetAsync((char*)d_ws + WS_CTL, 0, CTL_ZERO_BYTES, stream);
    }
    a.ph_lo = 0; a.ph_hi = N_PHASES;
    hipError_t e = hipLaunchCooperativeKernel((const void*)mk_fwd, dim3(grid), dim3(NWAVES * 64), kargs, LDS_BYTES, stream);
    if (e != hipSuccess) fprintf(stderr, "kernel_launch: cooperative launch failed: %s (grid %d)\n", hipGetErrorString(e), grid);
#endif
}
```

```cpp
#include <hip/hip_runtime.h>
#include <hip/hip_bf16.h>
#include <hip/hip_cooperative_groups.h>
#include <cstdio>
#include <cstdint>
#include <cmath>
namespace pg8 {
#define PG8_LAS __attribute__((address_space(3)))
typedef unsigned short bf16_t;
typedef short bf16x8 __attribute__((ext_vector_type(8)));
typedef float f32x4 __attribute__((ext_vector_type(4)));
typedef unsigned u32x4 __attribute__((ext_vector_type(4)));
constexpr int BM = 256, BK = 64, HALF = 128, HTB = HALF * BK * 2  , STAGE_BYTES = 8 * HTB, NXCD = 8, WGM = 8;

__host__ __device__ __forceinline__ int lds_byte(int r, int c) { const int st = (r >> 4) * 2 + (c >> 5), rr = r & 15, cc = c & 31, ob = rr * 64 + cc * 2; return st * 1024 + (ob ^ (((ob >> 9) & 1) << 5)); }
__host__ __device__ __forceinline__ void stage_rc(int b, int& R, int& C) { const int st = b / 1024, sb = b % 1024, swz = sb ^ (((sb >> 9) & 1) << 5); R = (st >> 1) * 16 + swz / 64; C = (st & 1) * 32 + (swz % 64) / 2; }
__host__ __device__ __forceinline__ int perm32(int rho) { const int n = rho >> 4, i = rho & 15; return 8 * (i >> 2) + 4 * n + (i & 3); }

struct Unit { int pm, pn; };
struct Gemm { const bf16_t* A; const bf16_t* Bt; int M, N, K; const int* ridx = nullptr; };

struct StaticOrder {
    int nM, nN, nwg, G, c;
    __host__ __device__ void init(int M, int N, int G_, int c_) { nM = M / BM; nN = N / BM; nwg = nM * nN; G = G_; c = c_; }
    __host__ __device__ bool next(int i, Unit& u) const {
        const long L = (long)i * G + c; if (L >= nwg) return false;
        int wgid = (int)L; { const int q = nwg / NXCD, r = nwg % NXCD, xcd = wgid % NXCD, off = wgid / NXCD; wgid = (xcd < r ? xcd * (q + 1) : r * (q + 1) + (xcd - r) * q) + off; }
        const int nig = WGM * nN, gid = wgid / nig, fm = gid * WGM, gsz = (nM - fm) < WGM ? (nM - fm) : WGM;
        u.pm = fm + ((wgid % nig) % gsz); u.pn = (wgid % nig) / gsz; return true;
    }
    __device__ __forceinline__ void a_ready(const Unit&) const {}
    __device__ __forceinline__ void done(const Unit&) const {}
};

__device__ __forceinline__ unsigned cvt_pk_bf16(float lo, float hi) { unsigned r; asm volatile("v_cvt_pk_bf16_f32 %0, %1, %2" : "=v"(r) : "v"(lo), "v"(hi)); return r; }
typedef float f32x2 __attribute__((ext_vector_type(2)));
template <class Epi, class Sched, bool ALIGN_EPI = false, bool SP2 = false, bool GATHER = false>
__device__ __forceinline__ void gemm_phase(PG8_LAS unsigned char* lds, const Gemm g, const Sched& S, const Epi& E) {
    const int tid = threadIdx.x, wid = __builtin_amdgcn_readfirstlane(tid >> 6), lane = tid & 63, wr = wid >> 2, wc = wid & 3, fr = lane & 15, fq = lane >> 4;
    const int K = g.K; int nt = K / BK; asm volatile("" : "+s"(nt));
    unsigned voffA[2], voffB[2];
#pragma unroll
    for (int i = 0; i < 2; ++i) { int R, C; stage_rc(tid * 16 + i * 8192, R, C); const int Rb = Epi::PERM ? ((R & ~31) + perm32(R & 31)) : R;
        voffA[i] = (unsigned)(R * K + C) * 2u; voffB[i] = (unsigned)(Rb * K + C) * 2u; }
    unsigned vA0[2] = {0u, 0u}, vA1[2] = {0u, 0u}, nA0[2] = {0u, 0u}, nA1[2] = {0u, 0u}; int gR[2] = {0, 0}; unsigned gC[2] = {0u, 0u};
    if constexpr (GATHER) { static_assert(SP2, "GATHER is implemented for the SP2 loop only");
#pragma unroll
        for (int i = 0; i < 2; ++i) { int R, C; stage_rc(tid * 16 + i * 8192, R, C); gR[i] = R; gC[i] = (unsigned)C * 2u; } }
#define PG8_GOFF(pm_, o0, o1) do { _Pragma("unroll") for (int _i = 0; _i < 2; ++_i) { \
        o0[_i] = (unsigned)g.ridx[(size_t)(pm_) * BM + gR[_i]] * (unsigned)(K * 2) + gC[_i]; o1[_i] = (unsigned)g.ridx[(size_t)(pm_) * BM + HALF + gR[_i]] * (unsigned)(K * 2) + gC[_i]; } } while (0)
    const size_t kstep = (size_t)(BK * 2);
    const size_t hstep = (size_t)HALF * K * 2;
    const size_t tstep = 2 * hstep;
    const unsigned ldsw = (unsigned)wid * 1024u;
    const int aoff = lds_byte(wr * 64 + fr, fq * 8), boff = lds_byte(wc * 32 + fr, fq * 8);
#define PG8_SA(b, h) (((b) * 2 + (h)) * HTB)
#define PG8_SB(b, h) ((4 + (b) * 2 + (h)) * HTB)
#define PG8_STAGE(bufoff, gbase, voff) do { _Pragma("unroll") for (int _i = 0; _i < 2; ++_i) \
        __builtin_amdgcn_global_load_lds((const unsigned*)((const char*)(gbase) + (voff)[_i]), (PG8_LAS unsigned*)(lds + (bufoff) + ldsw + _i * 8192), 16, 0, 0); } while (0)
#define PG8_LDA(dst, b, h) do { _Pragma("unroll") for (int m = 0; m < 4; ++m) _Pragma("unroll") for (int k = 0; k < 2; ++k) dst[m][k] = *(const PG8_LAS bf16x8*)(lds + PG8_SA(b, h) + aoff + m * 2048 + k * 1024); } while (0)
#define PG8_LDB(dst, b, h) do { _Pragma("unroll") for (int n = 0; n < 2; ++n) _Pragma("unroll") for (int k = 0; k < 2; ++k) dst[n][k] = *(const PG8_LAS bf16x8*)(lds + PG8_SB(b, h) + boff + n * 2048 + k * 1024); } while (0)
#define PG8_MMA(ai, bj, At, Bt) do { __builtin_amdgcn_s_setprio(1); _Pragma("unroll") for (int m = 0; m < 4; ++m) _Pragma("unroll") for (int n = 0; n < 2; ++n) _Pragma("unroll") for (int k = 0; k < 2; ++k) \
        acc[ai][bj][m][n] = __builtin_amdgcn_mfma_f32_16x16x32_bf16(Bt[n][k], At[m][k], acc[ai][bj][m][n], 0, 0, 0); __builtin_amdgcn_s_setprio(0); } while (0)
#define PG8_WAIT_V(n) asm volatile("s_waitcnt vmcnt(" #n ")" ::: "memory")
#define PG8_WAIT_L(n) asm volatile("s_waitcnt lgkmcnt(" #n ")" ::: "memory")
#define PG8_BAR __builtin_amdgcn_s_barrier()
#define PG8_SCHED __builtin_amdgcn_sched_barrier(0)
    Unit cur, nxt; int ui = 0;
    if (!S.next(0, cur)) return;
    f32x4 acc[2][2][4][2];
#pragma unroll
    for (int a = 0; a < 2; ++a)
#pragma unroll
        for (int b = 0; b < 2; ++b)
#pragma unroll
            for (int m = 0; m < 4; ++m)
#pragma unroll
                for (int n = 0; n < 2; ++n) acc[a][b][m][n] = (f32x4){0.f, 0.f, 0.f, 0.f};
    bf16x8 At[4][2], B0[2][2], B1[2][2];
    const char* cA = (const char*)g.A + (GATHER ? (size_t)0 : (size_t)cur.pm * tstep); const char* cB = (const char*)g.Bt + (size_t)cur.pn * tstep;
    if constexpr (GATHER) { PG8_GOFF(cur.pm, vA0, vA1); nA0[0] = vA0[0]; nA0[1] = vA0[1]; nA1[0] = vA1[0]; nA1[1] = vA1[1]; }
    S.a_ready(cur);
    if constexpr (SP2) {
        PG8_STAGE(PG8_SB(0, 0), cB, voffB); PG8_STAGE(PG8_SB(0, 1), cB + hstep, voffB);
        if constexpr (GATHER) { PG8_STAGE(PG8_SA(0, 0), cA, vA0); PG8_STAGE(PG8_SA(0, 1), cA, vA1); } else { PG8_STAGE(PG8_SA(0, 0), cA, voffA); PG8_STAGE(PG8_SA(0, 1), cA + hstep, voffA); }
        if (wr == 1) PG8_BAR;
        PG8_WAIT_V(2); PG8_BAR;
        PG8_STAGE(PG8_SB(1, 0), cB + kstep, voffB); if constexpr (GATHER) { PG8_STAGE(PG8_SA(1, 0), cA + kstep, vA0); } else { PG8_STAGE(PG8_SA(1, 0), cA + kstep, voffA); } PG8_STAGE(PG8_SB(1, 1), cB + hstep + kstep, voffB);
        PG8_WAIT_V(6); PG8_BAR;
    } else {
        PG8_STAGE(PG8_SB(0, 0), cB, voffB); PG8_STAGE(PG8_SA(0, 0), cA, voffA); PG8_STAGE(PG8_SB(0, 1), cB + hstep, voffB); PG8_STAGE(PG8_SA(0, 1), cA + hstep, voffA);
        if (wr == 1) PG8_BAR;
        PG8_WAIT_V(4); PG8_BAR;
        PG8_STAGE(PG8_SB(1, 0), cB + kstep, voffB); PG8_STAGE(PG8_SA(1, 0), cA + kstep, voffA); PG8_STAGE(PG8_SB(1, 1), cB + hstep + kstep, voffB);
        PG8_WAIT_V(6); PG8_BAR;
    }
    for (;;) {
        const bool has_next = S.next(ui + 1, nxt);
        const char* nA = (has_next && !GATHER) ? (const char*)g.A + (size_t)nxt.pm * tstep : cA; const char* nB = has_next ? (const char*)g.Bt + (size_t)nxt.pn * tstep : cB;
        for (int t = 0; t < nt; t += 2) {
            if constexpr (Epi::MID) { if (t == (nt >> 1)) E.mid(acc, cur, wr, wc, fr, fq); }
            const bool last = (t == nt - 2);
            const char* a1 = cA + (size_t)(t + 1) * kstep;
            const char* a2 = last ? nA : cA + (size_t)(t + 2) * kstep; const char* b2 = last ? nB : cB + (size_t)(t + 2) * kstep;
            const char* a3 = a2 + kstep; const char* b3 = b2 + kstep;
            if (last && has_next) S.a_ready(nxt);
            unsigned sA0[2] = {0u, 0u}, sA1[2] = {0u, 0u};
            if constexpr (GATHER) { if (t + 4 == nt && has_next) PG8_GOFF(nxt.pm, nA0, nA1);
                sA0[0] = last ? nA0[0] : vA0[0]; sA0[1] = last ? nA0[1] : vA0[1]; sA1[0] = last ? nA1[0] : vA1[0]; sA1[1] = last ? nA1[1] : vA1[1]; }
            if constexpr (SP2) {
            PG8_LDB(B0, 0, 0); PG8_LDB(B1, 0, 1); PG8_SCHED; PG8_LDA(At, 0, 0); if constexpr (GATHER) { PG8_STAGE(PG8_SA(1, 1), a1, vA1); } else { PG8_STAGE(PG8_SA(1, 1), a1 + hstep, voffA); }
            PG8_WAIT_V(8); PG8_WAIT_L(0); PG8_BAR; PG8_MMA(0, 0, At, B0); PG8_MMA(0, 1, At, B1); PG8_BAR; PG8_SCHED;
            PG8_LDA(At, 0, 1); PG8_STAGE(PG8_SB(0, 0), b2, voffB); PG8_STAGE(PG8_SB(0, 1), b2 + hstep, voffB); if constexpr (GATHER) { PG8_STAGE(PG8_SA(0, 0), a2, sA0); } else { PG8_STAGE(PG8_SA(0, 0), a2, voffA); }
            PG8_WAIT_V(8); PG8_WAIT_L(0); PG8_BAR; PG8_MMA(1, 0, At, B0); PG8_MMA(1, 1, At, B1); PG8_BAR; PG8_SCHED;
            PG8_LDB(B0, 1, 0); PG8_LDB(B1, 1, 1); PG8_SCHED; PG8_LDA(At, 1, 0); if constexpr (GATHER) { PG8_STAGE(PG8_SA(0, 1), a2, sA1); } else { PG8_STAGE(PG8_SA(0, 1), a2 + hstep, voffA); }
            PG8_WAIT_V(8); PG8_WAIT_L(0); PG8_BAR; PG8_MMA(0, 0, At, B0); PG8_MMA(0, 1, At, B1); PG8_BAR; PG8_SCHED;
            PG8_LDA(At, 1, 1); PG8_STAGE(PG8_SB(1, 0), b3, voffB); PG8_STAGE(PG8_SB(1, 1), b3 + hstep, voffB); if constexpr (GATHER) { PG8_STAGE(PG8_SA(1, 0), a3, sA0); } else { PG8_STAGE(PG8_SA(1, 0), a3, voffA); }
            PG8_WAIT_V(8); PG8_WAIT_L(0); PG8_BAR; PG8_MMA(1, 0, At, B0); PG8_MMA(1, 1, At, B1); PG8_BAR; PG8_SCHED;
            } else {
            PG8_LDB(B0, 0, 0); PG8_SCHED; PG8_LDA(At, 0, 0); PG8_STAGE(PG8_SA(1, 1), a1 + hstep, voffA);
            PG8_WAIT_L(8); PG8_BAR; PG8_WAIT_L(0); PG8_MMA(0, 0, At, B0); PG8_BAR; PG8_SCHED;
            PG8_LDB(B1, 0, 1); PG8_STAGE(PG8_SB(0, 0), b2, voffB);
            PG8_BAR; PG8_WAIT_L(0); PG8_MMA(0, 1, At, B1); PG8_BAR;
            PG8_LDA(At, 0, 1); PG8_STAGE(PG8_SA(0, 0), a2, voffA);
            PG8_BAR; PG8_WAIT_L(0); PG8_MMA(1, 0, At, B0); PG8_BAR; PG8_SCHED;
            PG8_STAGE(PG8_SB(0, 1), b2 + hstep, voffB);
            PG8_WAIT_V(6); PG8_BAR; PG8_MMA(1, 1, At, B1); PG8_BAR;
            PG8_LDB(B0, 1, 0); PG8_SCHED; PG8_LDA(At, 1, 0); PG8_STAGE(PG8_SA(0, 1), a2 + hstep, voffA);
            PG8_WAIT_L(8); PG8_BAR; PG8_WAIT_L(0); PG8_MMA(0, 0, At, B0); PG8_BAR; PG8_SCHED;
            PG8_LDB(B1, 1, 1); PG8_STAGE(PG8_SB(1, 0), b3, voffB);
            PG8_BAR; PG8_WAIT_L(0); PG8_MMA(0, 1, At, B1); PG8_BAR;
            PG8_LDA(At, 1, 1); PG8_STAGE(PG8_SA(1, 0), a3, voffA);
            PG8_BAR; PG8_WAIT_L(0); PG8_MMA(1, 0, At, B0); PG8_BAR; PG8_SCHED;
            PG8_STAGE(PG8_SB(1, 1), b3 + hstep, voffB);
            PG8_WAIT_V(6); PG8_BAR; PG8_MMA(1, 1, At, B1); PG8_BAR;
            }
        }
        if constexpr (ALIGN_EPI) { if (wr == 0) PG8_BAR; }
        if constexpr (!Epi::AFTER_DRAIN) { E(acc, cur, wr, wc, fr, fq); S.done(cur); }
        if (!has_next) break;
#pragma unroll
        for (int a = 0; a < 2; ++a)
#pragma unroll
            for (int b = 0; b < 2; ++b)
#pragma unroll
                for (int m = 0; m < 4; ++m)
#pragma unroll
                    for (int n = 0; n < 2; ++n) acc[a][b][m][n] = (f32x4){0.f, 0.f, 0.f, 0.f};
        cur = nxt; cA = nA; cB = nB; ++ui;
        if constexpr (GATHER) { vA0[0] = nA0[0]; vA0[1] = nA0[1]; vA1[0] = nA1[0]; vA1[1] = nA1[1]; }
        if constexpr (ALIGN_EPI) { if (wr == 1) PG8_BAR; }
    }
    PG8_WAIT_V(0);
    if constexpr (!ALIGN_EPI) { if (wr == 0) PG8_BAR; }
    PG8_BAR;
    if constexpr (Epi::AFTER_DRAIN) { E.fused(acc, cur, wr, wc, fr, fq, lds, wid, lane); S.done(cur); }
#undef PG8_SA
#undef PG8_SB
#undef PG8_STAGE
#undef PG8_LDA
#undef PG8_LDB
#undef PG8_MMA
#undef PG8_WAIT_V
#undef PG8_WAIT_L
#undef PG8_BAR
#undef PG8_SCHED
#undef PG8_GOFF
}
}
namespace att {
typedef unsigned short bf16;
using bf16x8 = __attribute__((ext_vector_type(8))) short;
using s16x4 = __attribute__((ext_vector_type(4))) short;
using f32x16 = __attribute__((ext_vector_type(16))) float;
using u32x4 = __attribute__((ext_vector_type(4))) unsigned;
constexpr int SEQ = 4096, NW = 8, QB = 256, KVBLK = 64;
constexpr int KSLOT = 12288, VSLOT = 8192, NKS = 4, NVS = 4;
constexpr int LDS_K = 0, LDS_V = NKS * KSLOT, LDS_WS = LDS_V + NVS * VSLOT, LDS_OST = LDS_WS + NW * 256, LDS_BYTES = LDS_OST + NW * 4096;
constexpr float THR = 8.0f;
#define ATT_LAS __attribute__((address_space(3)))
#define SBAR() __builtin_amdgcn_sched_barrier(0)
#define WAIT_BAR(N) asm volatile("s_waitcnt vmcnt(" #N ") lgkmcnt(0)\n\ts_barrier" ::: "memory")
__device__ __forceinline__ int crow(int r, int hi) { return (r & 3) + 8 * (r >> 2) + 4 * hi; }
__device__ __forceinline__ void glds16(const void* gsrc, unsigned lds_dst) { unsigned keep;
  asm volatile("s_mov_b32 %0, m0\n\ts_mov_b32 m0, %2\n\ts_nop 0\n\tglobal_load_lds_dwordx4 %1, off\n\ts_mov_b32 m0, %0" : "=&s"(keep) : "v"(gsrc), "s"(lds_dst) : "memory"); }
typedef float f32x2_t __attribute__((ext_vector_type(2))); typedef __bf16 bf16x2_t __attribute__((ext_vector_type(2)));
__device__ __forceinline__ unsigned cvtpk_s(float lo, float hi) { f32x2_t v = {lo, hi}; bf16x2_t b = __builtin_convertvector(v, bf16x2_t); return __builtin_bit_cast(unsigned, b); }
typedef ATT_LAS const char* lds_cptr;
#define MX3(a, b, c) __builtin_fmaxf(__builtin_fmaxf((a), (b)), (c))
__device__ __forceinline__ float rowmax(const f32x16& p0, const f32x16& p1) {
  float a = MX3(p0[0], p0[1], p1[0]), b = MX3(p0[2], p0[3], p1[1]); a = MX3(a, p1[2], p1[3]);
#pragma unroll
  for (int r = 4; r < 16; r += 4) { a = MX3(a, p0[r], p0[r + 1]); b = MX3(b, p0[r + 2], p0[r + 3]); a = MX3(a, p1[r], p1[r + 1]); b = MX3(b, p1[r + 2], p1[r + 3]); }
  float m = __builtin_fmaxf(a, b); auto rr = __builtin_amdgcn_permlane32_swap(__float_as_uint(m), __float_as_uint(m), false, false);
  return __builtin_fmaxf(__uint_as_float(rr[0]), __uint_as_float(rr[1])); }
__device__ __forceinline__ void cmask(f32x16& p0, f32x16& p1, int jb, int qrel, int hi) {
  const int kb = 64 * jb + 4 * hi;
#pragma unroll
  for (int r = 0; r < 16; ++r) { const int kv = kb + (r & 3) + 8 * (r >> 2); if (kv > qrel) p0[r] = -INFINITY; if (kv + 32 > qrel) p1[r] = -INFINITY; } }
template <int D0A, int D0B> __device__ __forceinline__ void kload(bf16x8* kf, lds_cptr kp) {
#pragma unroll
  for (int d0 = D0A; d0 < D0B; ++d0) { kf[2 * (d0 - D0A)] = *(const ATT_LAS bf16x8*)(kp + d0 * 2048); kf[2 * (d0 - D0A) + 1] = *(const ATT_LAS bf16x8*)(kp + d0 * 2048 + 512); }
}
template <int ND0, int NPRE> __device__ __forceinline__ void qkt(f32x16& p0, f32x16& p1, const bf16x8* kf, const bf16x8* kt, const bf16x8* qr, const f32x16& negm) {
#pragma unroll
  for (int d0 = 0; d0 < ND0; ++d0) { const bf16x8 b0 = d0 < NPRE ? kf[2 * d0] : kt[2 * (d0 - NPRE)], b1 = d0 < NPRE ? kf[2 * d0 + 1] : kt[2 * (d0 - NPRE) + 1];
    if (d0 == 0) { p0 = __builtin_amdgcn_mfma_f32_32x32x16_bf16(b0, qr[0], negm, 0, 0, 0); p1 = __builtin_amdgcn_mfma_f32_32x32x16_bf16(b1, qr[0], negm, 0, 0, 0); }
    else { p0 = __builtin_amdgcn_mfma_f32_32x32x16_bf16(b0, qr[d0], p0, 0, 0, 0); p1 = __builtin_amdgcn_mfma_f32_32x32x16_bf16(b1, qr[d0], p1, 0, 0, 0); } }
}
__device__ __forceinline__ void pv(f32x16* o, int vb, bf16x8 pa0, bf16x8 pa1, bf16x8 pa2, bf16x8 pa3) {
#pragma unroll
  for (int d0 = 0; d0 < 2; ++d0) { s16x4 lo[4], hi[4];
#pragma unroll
    for (int ks = 0; ks < 4; ++ks) {
      asm volatile("ds_read_b64_tr_b16 %0,%1 offset:%c2" : "=&v"(lo[ks]) : "v"(vb), "i"(d0 * 4096 + ks * 1024) : "memory");
      asm volatile("ds_read_b64_tr_b16 %0,%1 offset:%c2" : "=&v"(hi[ks]) : "v"(vb), "i"(d0 * 4096 + ks * 1024 + 512) : "memory"); }
    asm volatile("s_waitcnt lgkmcnt(0)" ::: "memory"); SBAR();
#define PK(k) (bf16x8){lo[k][0], lo[k][1], lo[k][2], lo[k][3], hi[k][0], hi[k][1], hi[k][2], hi[k][3]}
    o[d0] = __builtin_amdgcn_mfma_f32_32x32x16_bf16(pa0, PK(0), o[d0], 0, 0, 0);
    o[d0] = __builtin_amdgcn_mfma_f32_32x32x16_bf16(pa1, PK(1), o[d0], 0, 0, 0);
    o[d0] = __builtin_amdgcn_mfma_f32_32x32x16_bf16(pa2, PK(2), o[d0], 0, 0, 0);
    o[d0] = __builtin_amdgcn_mfma_f32_32x32x16_bf16(pa3, PK(3), o[d0], 0, 0, 0);
#undef PK
  }
}
struct AttnT { const bf16* Q; const bf16* K; const bf16* KR; const bf16* V; bf16* O; const float* CS; const float* GB; const unsigned* QKM; const bf16* ZERO; };
template <int KIND, int ABL = 0> __device__ __forceinline__ void attn_unit(int b, int h, int qb, const AttnT& T, char* shm) {
#ifndef ATT_NPRE0
#define ATT_NPRE0 2
#endif
#ifndef ATT_NPRE1
#define ATT_NPRE1 3
#endif
  constexpr int NPRE = KIND == 0 ? ATT_NPRE0 : ATT_NPRE1;
  constexpr int ND0 = KIND == 0 ? 6 : 5, QP = KIND == 0 ? 768 : 512, HD = KIND == 0 ? 96 : 64;
  const int tid = threadIdx.x, lane = tid & 63, r32 = lane & 31, hi = lane >> 5; const int wid = __builtin_amdgcn_readfirstlane(tid >> 6);
  const long rowbase = (long)b * SEQ; const int q0 = qb * QB;
  const bf16* Qw = T.Q + (rowbase + q0 + wid * 32) * QP + h * HD;
  const unsigned lds0 = (unsigned)(uintptr_t)shm;
  const lds_cptr shm3 = (lds_cptr)shm;
  ATT_LAS float* wsf = (ATT_LAS float*)(shm3 + LDS_WS) + wid * 64;
  const bf16 *ksrcA, *ksrcB; long kstepA, kstepB; unsigned kdstB;
  const unsigned kdstA = lds0 + LDS_K + wid * 1024;
  if (KIND == 0) { ksrcA = T.K + (rowbase + lane) * 512 + h * 64 + wid * 8; ksrcB = T.KR + (rowbase + lane) * 32 + (wid & 3) * 8; kdstB = lds0 + LDS_K + (8 + (wid & 3)) * 1024; kstepA = 64 * 512; kstepB = 64 * 32; }
  else { ksrcA = T.K + (rowbase + lane) * 512 + h * 64 + wid * 8;
    ksrcB = (wid & 1) ? T.ZERO : T.KR + ((long)h * (8 * SEQ) + rowbase + lane) * 8; kdstB = lds0 + LDS_K + (8 + (wid & 1)) * 1024; kstepA = 64 * 512; kstepB = (wid & 1) ? 0 : 64 * 8; }
  const bf16* vsrc = T.V + (rowbase + 16 * (wid & 3) + (lane >> 2)) * 512 + h * 64 + (wid >> 2) * 32 + (lane & 3) * 8;
  const unsigned vdst = lds0 + LDS_V + wid * 1024;
#define DMA_K(t, s) do { glds16(ksrcA + (long)(t) * kstepA, (unsigned)__builtin_amdgcn_readfirstlane(kdstA + (s) * KSLOT)); \
                         glds16(ksrcB + (long)(t) * kstepB, (unsigned)__builtin_amdgcn_readfirstlane(kdstB + (s) * KSLOT)); } while (0)
#define DMA_V(t, s) do { glds16(vsrc + (long)(t) * (64 * 512), (unsigned)__builtin_amdgcn_readfirstlane(vdst + (s) * VSLOT)); } while (0)
  const int vb0 = (int)(lds0 + LDS_V) + ((lane >> 4) & 1) * 32 + (lane & 3) * 8 + (4 * hi + ((lane & 15) >> 2)) * 64;
  const lds_cptr kp0 = shm3 + LDS_K + hi * 1024 + r32 * 16;
  const int NT = (q0 + QB) / KVBLK;
  int tb = 0;
  if (KIND == 1) {
    const float qmax = __uint_as_float(T.QKM[2 * (b * 8 + h)]), kmax = __uint_as_float(T.QKM[2 * (b * 8 + h) + 1]);
    const float* gbh = T.GB + (long)h * (8 * SEQ) + rowbase;
    const float qk2 = 2.02f * qmax * kmax, gq0 = gbh[q0];
    const float ge = (lane < 4 * qb) ? gbh[64 * lane + 63] : 3.0e38f;
    const unsigned long long bal = __ballot(qk2 + ge - gq0 >= -40.f);
    tb = __builtin_amdgcn_readfirstlane((int)__builtin_ctzll(bal));
  }
  DMA_K(tb, 0); DMA_V(tb, 0); DMA_K(tb + 1, 1); DMA_V(tb + 1, 1); DMA_K(tb + 2, 2);
  bf16x8 qr[ND0];
#pragma unroll
  for (int d0 = 0; d0 < (KIND == 0 ? ND0 : 4); ++d0) qr[d0] = *reinterpret_cast<const bf16x8*>(&Qw[(long)r32 * QP + d0 * 16 + hi * 8]);
  if (KIND == 1) { const short one = (short)0x3F80; qr[4] = hi ? (bf16x8){0, 0, 0, 0, 0, 0, 0, 0} : (bf16x8){one, one, one, 0, 0, 0, 0, 0}; }
  if (KIND == 0) {
    const float* cs = T.CS + (rowbase + q0 + wid * 32 + r32) * 32 + 16 * hi;
    typedef float f32x4_t __attribute__((ext_vector_type(4)));
    bf16x8 a = qr[4], c = qr[5];
#pragma unroll
    for (int j2 = 0; j2 < 4; ++j2) { const f32x4_t t4 = *(const f32x4_t*)(cs + 4 * j2);
#pragma unroll
      for (int e = 0; e < 2; ++e) { const int j = 2 * j2 + e; const float co = t4[2 * e], si = t4[2 * e + 1];
        const float x1 = __builtin_bit_cast(float, (unsigned)(unsigned short)a[j] << 16), x2 = __builtin_bit_cast(float, (unsigned)(unsigned short)c[j] << 16);
        const float o1 = x1 * co - x2 * si, o2 = x2 * co + x1 * si;
        qr[4][j] = (short)(cvtpk_s(o1, o1) & 0xffffu); qr[5][j] = (short)(cvtpk_s(o2, o2) & 0xffffu); } }
  }
  float mhat = 0.f, l_reg = 0.f; f32x16 o[2]; o[0] = f32x16{}; o[1] = f32x16{}; f32x16 negm = f32x16{};
  const int qrel = wid * 32 + r32;
  int ks_cur = 0, vs_cur = 0;
  bf16x8 kf[2 * NPRE];
  WAIT_BAR(6);
  kload<0, NPRE>(kf, kp0);
  u32x4 pw0 = {0u, 0u, 0u, 0u}, pw1 = pw0, pw2 = pw0, pw3 = pw0;
#ifndef ATT_STAG
#define ATT_STAG 0
#endif
  const bool grpB = (ATT_STAG == 1) ? (wid >= 4) : (ATT_STAG == 2) ? ((wid & 1) != 0) : false; bool pend = false; int vs_pend = 0;
  for (int t = tb; t < NT; ++t) {
    if (t + 2 < NT) { WAIT_BAR(3); } else if (t + 1 < NT) { WAIT_BAR(1); } else { WAIT_BAR(0); }
    const int ks1 = (ks_cur + 1) & 3, vs1 = (vs_cur + 1) & 3, vs2 = (vs_cur + 2) & 3;
    if (t + 2 < NT) { DMA_V(t + 2, vs2); }
    if (t + 3 < NT) { DMA_K(t + 3, ((ks_cur + 3) & 3)); }
    if (pend) { if (!(ABL & 1)) pv(o, vb0 + vs_pend * VSLOT, __builtin_bit_cast(bf16x8, pw0), __builtin_bit_cast(bf16x8, pw1), __builtin_bit_cast(bf16x8, pw2), __builtin_bit_cast(bf16x8, pw3)); pend = false; }
    const int jb = t - 4 * qb;
    const bool vis = (KIND == 0) ? (t <= 4 * qb + (wid >> 1)) : ((jb < 0) || (64 * jb <= 32 * wid + 31));
    f32x16 p0, p1;
    if (vis) {
      bf16x8 kt[2 * (ND0 - NPRE)]; kload<NPRE, ND0>(kt, kp0 + ks_cur * KSLOT);
      if (ABL & 4) { p0 = negm; p1 = negm; asm volatile("" : "+v"(p0), "+v"(p1)); } else qkt<ND0, NPRE>(p0, p1, kf, kt, qr, negm);
    }
    if (t + 1 < NT) kload<0, NPRE>(kf, kp0 + ks1 * KSLOT);
    if (vis) {
      if (KIND == 1) { if (jb >= 0) cmask(p0, p1, jb, qrel, hi); }
      const float rm = rowmax(p0, p1);
      if (t == tb || __any(rm > THR)) {
        const float dl = (t == tb) ? rm : __builtin_fmaxf(rm, 0.f);
        mhat += dl;
#pragma unroll
        for (int r = 0; r < 16; ++r) { p0[r] -= dl; p1[r] -= dl; negm[r] = -mhat; }
        const float f = __builtin_amdgcn_exp2f(-dl); l_reg *= f;
        if (t > tb) {
          if (hi == 0) wsf[r32] = f;
          asm volatile("s_waitcnt lgkmcnt(0)" ::: "memory");
#pragma unroll
          for (int d_ = 0; d_ < 2; ++d_)
#pragma unroll
            for (int r = 0; r < 16; ++r) o[d_][r] *= wsf[crow(r, hi)];
          asm volatile("s_waitcnt lgkmcnt(0)" ::: "memory");
        }
      }
      float sacc = 0.f;
#pragma unroll
      for (int r = 0; r < 16; ++r) { if (!(ABL & 2)) { p0[r] = __builtin_amdgcn_exp2f(p0[r]); p1[r] = __builtin_amdgcn_exp2f(p1[r]); } sacc += p0[r] + p1[r]; }
      l_reg += sacc;
#define PKW(P, B) cvtpk_s(P[B], P[B + 1])
      pw0 = (u32x4){PKW(p0, 0), PKW(p0, 2), PKW(p0, 4), PKW(p0, 6)}; pw1 = (u32x4){PKW(p0, 8), PKW(p0, 10), PKW(p0, 12), PKW(p0, 14)};
      pw2 = (u32x4){PKW(p1, 0), PKW(p1, 2), PKW(p1, 4), PKW(p1, 6)}; pw3 = (u32x4){PKW(p1, 8), PKW(p1, 10), PKW(p1, 12), PKW(p1, 14)};
#undef PKW
      SBAR();
      if (ABL & 1) { asm volatile("" :: "v"(pw0), "v"(pw1), "v"(pw2), "v"(pw3)); }
      else if (!grpB) pv(o, vb0 + vs_cur * VSLOT, __builtin_bit_cast(bf16x8, pw0), __builtin_bit_cast(bf16x8, pw1), __builtin_bit_cast(bf16x8, pw2), __builtin_bit_cast(bf16x8, pw3));
      else { pend = true; vs_pend = vs_cur; }
    }
    ks_cur = ks1; vs_cur = vs1;
  }
  if (pend && !(ABL & 1)) pv(o, vb0 + vs_pend * VSLOT, __builtin_bit_cast(bf16x8, pw0), __builtin_bit_cast(bf16x8, pw1), __builtin_bit_cast(bf16x8, pw2), __builtin_bit_cast(bf16x8, pw3));
  { auto rr = __builtin_amdgcn_permlane32_swap(__float_as_uint(l_reg), __float_as_uint(l_reg), false, false); l_reg = __uint_as_float(rr[0]) + __uint_as_float(rr[1]); }
  if (hi == 0) wsf[32 + r32] = l_reg;
  asm volatile("s_waitcnt lgkmcnt(0)" ::: "memory");
  float rli[16];
#pragma unroll
  for (int r = 0; r < 16; ++r) rli[r] = __builtin_amdgcn_rcpf(wsf[32 + crow(r, hi)]);
  bf16* Ow = T.O + (rowbase + q0 + wid * 32) * 1024 + h * 64;
  { ATT_LAS bf16* stg = (ATT_LAS bf16*)(shm3 + LDS_OST) + wid * 2048;
#pragma unroll
    for (int r = 0; r < 16; ++r) { const int orow = crow(r, hi);
#pragma unroll
      for (int d0 = 0; d0 < 2; ++d0) { const float v = o[d0][r] * rli[r]; stg[orow * 64 + d0 * 32 + r32] = (bf16)(cvtpk_s(v, v) & 0xffffu); } }
    asm volatile("s_waitcnt lgkmcnt(0)" ::: "memory");
#pragma unroll
    for (int i = 0; i < 4; ++i) { const int row = i * 8 + (lane >> 3), ch = lane & 7; const u32x4 v = *(const ATT_LAS u32x4*)(stg + row * 64 + ch * 8); *(u32x4*)(Ow + (long)row * 1024 + ch * 8) = v; } }
  asm volatile("s_waitcnt lgkmcnt(0)\n\ts_barrier" ::: "memory");
#undef DMA_K
#undef DMA_V
}
#undef SBAR
#undef WAIT_BAR
#undef MX3
}
#ifndef MK_PER_PHASE
#define MK_PER_PHASE 0
#endif
constexpr int NWAVES = 8;
constexpr int BATCH = 8, SEQ = 4096, DM = 1024, M = BATCH * SEQ;
constexpr int NIN = 4096;
constexpr int NEXP = 32, XG_ROWS = 2 * M + NEXP * 256;
constexpr float EPS = 1e-6f, LOG2E = 1.4426950408889634f;
constexpr float C2F = 0.125f * LOG2E;
constexpr float C2M = 0.10206207261596577f * LOG2E;
constexpr int N_PHASES = 14;
constexpr size_t MiB = 1u << 20;
constexpr size_t WS_CTL = 0, CTL_ZERO_BYTES = 1 * MiB;
constexpr size_t WS_WIN = 1 * MiB, WS_WUQ = 9 * MiB, WS_WUKV = 9 * MiB + 512 * 1024, WS_WOA = 10 * MiB, WS_WOB = 11 * MiB, WS_WOUT = 12 * MiB, WS_WR = 14 * MiB, WS_WGU = 15 * MiB, WS_WDN = 47 * MiB;
constexpr size_t WS_CS = 63 * MiB, WS_LOGF = 67 * MiB, WS_EID = 68 * MiB, WS_SLOT = WS_EID + 256 * 1024, WS_WGT = WS_SLOT + 256 * 1024, WS_POS = WS_WGT + 256 * 1024, WS_WROW = 69 * MiB;
constexpr size_t WS_XN = 72 * MiB, WS_CQN = 72 * MiB, WS_CKVN = 88 * MiB, WS_VM = 96 * MiB, WS_KR = 128 * MiB;
constexpr size_t WS_Z0 = 136 * MiB, WS_Z1 = 152 * MiB, WS_QF = 184 * MiB, WS_KF = 224 * MiB, WS_VF = 264 * MiB, WS_OA = 296 * MiB, WS_OB = 328 * MiB, WS_MIX = 360 * MiB, WS_QM = 424 * MiB, WS_KM = 472 * MiB;
constexpr size_t WS_HN = 72 * MiB, WS_LG = 200 * MiB, WS_XG = 232 * MiB, WS_ACT = 376 * MiB, WS_YB = 72 * MiB, WS_END = 504 * MiB;
static_assert(WS_XG + (size_t)XG_ROWS * 2048 <= WS_ACT && WS_ACT + (size_t)XG_ROWS * 512 <= WS_END && WS_YB + (size_t)XG_ROWS * 2048 <= WS_XG, "moe map");
constexpr int CW_CNT = 8192;
constexpr int CW_TPRE = 128;
constexpr int CW_QK = 256;
constexpr int CW_AQ = 512;
constexpr int CW_ZERO = 1024;
constexpr int CW_BAR = 4096;
constexpr int RING_OFF = 0, RING_BYTES = 131072, LDSCTL_OFF = RING_BYTES, MISC_OFF = LDSCTL_OFF + 320, TP_OFF = LDSCTL_OFF + 1024, LDS_BYTES = 147456;

#define GAS __attribute__((address_space(1)))
#define LAS __attribute__((address_space(3)))
typedef unsigned short bf16;
typedef unsigned v4u __attribute__((ext_vector_type(4)));
typedef float f32x4 __attribute__((ext_vector_type(4)));
typedef short bf16x8 __attribute__((ext_vector_type(8)));
typedef GAS unsigned gu32;
typedef GAS unsigned long long gu64;
#define RLX_AGENT __ATOMIC_RELAXED, __HIP_MEMORY_SCOPE_AGENT
#define LDS_WAIT() asm volatile("s_waitcnt lgkmcnt(0)" ::: "memory")
#define VM_WAIT() asm volatile("s_waitcnt vmcnt(0)" ::: "memory")
__device__ __forceinline__ unsigned long long rt() { return __builtin_amdgcn_s_memrealtime(); }
__device__ __forceinline__ unsigned f2bf(float f) { unsigned u = __builtin_bit_cast(unsigned, f); return (u + 0x7fffu + ((u >> 16) & 1u)) >> 16; }
__device__ __forceinline__ unsigned pk2(float lo, float hi) { return f2bf(lo) | (f2bf(hi) << 16); }


#define XB_TMO      128
#define XB_XCNT(j)  (256  + 64 * (j))
#define XB_XSUB(j)  (1280 + 64 * (j))
#define XB_XGEN(j)  (2304 + 64 * (j))
#define XB_TOP      3328
#define XB_TOPGEN   3392
#define XCD_BAR_WORDS 3456
#define XB_SPIN_CAP (1u << 18)

__device__ __forceinline__ unsigned xb_ld(unsigned* p)              { return __hip_atomic_load(p, __ATOMIC_RELAXED, __HIP_MEMORY_SCOPE_AGENT); }
__device__ __forceinline__ unsigned xb_add(unsigned* p, unsigned v) { return __hip_atomic_fetch_add(p, v, __ATOMIC_RELAXED, __HIP_MEMORY_SCOPE_AGENT); }
__device__ __forceinline__ unsigned xb_xcc_id() { return (unsigned)__builtin_amdgcn_s_getreg((3 << 11) | 20) & 0xFu; }
#define XB_SPIN(cond, bar) do { unsigned _sp = 0; while (cond) { __builtin_amdgcn_s_sleep(1); \
    if ((++_sp & 255u) == 0u) { if (xb_ld(&(bar)[XB_TMO])) break; if (_sp > XB_SPIN_CAP) { atomicAdd(&(bar)[XB_TMO], 1u); break; } } } } while (0)

struct XcdBarrier {
    unsigned* bar; unsigned x;
    volatile LAS unsigned* st;
};

__device__ __forceinline__ XcdBarrier xcd_barrier_post(unsigned* bar, volatile LAS unsigned* st) {
    XcdBarrier b; b.bar = bar; b.x = xb_xcc_id(); b.st = st;
    if (threadIdx.x == 0) (void)xb_add(&bar[XB_XCNT(b.x)], 1u);
    return b;
}
__device__ __forceinline__ void xcd_barrier_complete(unsigned* bar, unsigned x, unsigned& nloc, unsigned& nx) {
    const unsigned G = gridDim.x * gridDim.y * gridDim.z;
    unsigned sum, cnt, mine, sp = 0u;
    for (;;) {
        sum = 0u; cnt = 0u; mine = 0u;
#pragma unroll
        for (unsigned j = 0; j < 16; ++j) { const unsigned c = xb_ld(&bar[XB_XCNT(j)]); sum += c; cnt += (c > 0u) ? 1u : 0u; mine = (j == x) ? c : mine; }
        if (sum == G) break;
        __builtin_amdgcn_s_sleep(1);
        if ((++sp & 255u) == 0u) { if (xb_ld(&bar[XB_TMO])) break; if (sp > XB_SPIN_CAP) { atomicAdd(&bar[XB_TMO], 1u); break; } }
    }
    nloc = mine > 0u ? mine : 1u; nx = cnt > 0u ? cnt : 1u;
}

__device__ __forceinline__ void xcd_barrier(const XcdBarrier& b) {
    asm volatile("s_waitcnt vmcnt(0)" ::: "memory");
    __syncthreads();
    if (threadIdx.x == 0) {
        unsigned* bar = b.bar;
        __builtin_amdgcn_s_waitcnt(0);
        unsigned nloc = b.st[0], nx = b.st[1];
        if (nloc == 0u) { xcd_barrier_complete(bar, b.x, nloc, nx); b.st[0] = nloc; b.st[1] = nx; }
        const unsigned old = xb_add(&bar[XB_XSUB(b.x)], 1u);
        const unsigned gen = old / nloc;
        if (old + 1u == (gen + 1u) * nloc) {
            __builtin_amdgcn_fence(__ATOMIC_RELEASE, "agent");
            asm volatile("s_waitcnt vmcnt(0)" ::: "memory");
            const unsigned og = xb_add(&bar[XB_TOP], 1u);
            const unsigned tg = og / nx;
            if (og + 1u == (tg + 1u) * nx) xb_add(&bar[XB_TOPGEN], 1u);
            else XB_SPIN(xb_ld(&bar[XB_TOPGEN]) == tg, bar);
            __builtin_amdgcn_fence(__ATOMIC_ACQUIRE, "agent");
            xb_add(&bar[XB_XGEN(b.x)], 1u);
            asm volatile("s_waitcnt vmcnt(0)" ::: "memory");
        } else {
            XB_SPIN(xb_ld(&bar[XB_XGEN(b.x)]) == gen, bar);
            __builtin_amdgcn_fence(__ATOMIC_ACQUIRE, "agent");
            asm volatile("s_waitcnt vmcnt(0)" ::: "memory");
        }
    }
    __syncthreads();
}


typedef unsigned v2u __attribute__((ext_vector_type(2)));
__device__ __forceinline__ float wave_sum(float v) {
#pragma unroll
    for (int o = 1; o < 64; o <<= 1) v += __shfl_xor(v, o);
    return v;
}
__device__ __forceinline__ float bf2f(unsigned short b) { return __builtin_bit_cast(float, (unsigned)b << 16); }
__device__ __forceinline__ float bflo(unsigned w) { return __builtin_bit_cast(float, w << 16); }
__device__ __forceinline__ float bfhi(unsigned w) { return __builtin_bit_cast(float, w & 0xffff0000u); }
__device__ __forceinline__ v4u pack8(f32x4 a, f32x4 b) { v4u w; w.x = pg8::cvt_pk_bf16(a[0], a[1]); w.y = pg8::cvt_pk_bf16(a[2], a[3]); w.z = pg8::cvt_pk_bf16(b[0], b[1]); w.w = pg8::cvt_pk_bf16(b[2], b[3]); return w; }
__device__ __forceinline__ unsigned pack4_u8(f32x4 g) {
    const unsigned a = (unsigned)(g[0] * 255.f + 0.5f), b = (unsigned)(g[1] * 255.f + 0.5f), c = (unsigned)(g[2] * 255.f + 0.5f), d = (unsigned)(g[3] * 255.f + 0.5f); return a | (b << 8) | (c << 16) | (d << 24); }
__device__ __forceinline__ f32x4 unpack4_u8(unsigned w) { return (f32x4){(float)(w & 255u), (float)((w >> 8) & 255u), (float)((w >> 16) & 255u), (float)(w >> 24)}; }
__device__ __forceinline__ float sigmoidf_(float x) { return __builtin_amdgcn_rcpf(1.0f + __builtin_amdgcn_exp2f(-x * LOG2E)); }

using pg8::Unit;
#define EPI_ROWS(...) int rb_ = u.pm * 256 + wr * 64 + fr; asm volatile("" : "+v"(rb_)); _Pragma("unroll") for (int ai = 0; ai < 2; ++ai) _Pragma("unroll") for (int m = 0; m < 4; ++m) { const size_t row = (size_t)(rb_ + ai * 128 + m * 16); \
        _Pragma("unroll") for (int bj = 0; bj < 2; ++bj) { const f32x4 v0 = acc[ai][bj][m][0], v1 = acc[ai][bj][m][1]; __VA_ARGS__ } }
struct EpiIn { static constexpr bool PERM = true, AFTER_DRAIN = false, MID = false;
    bf16* Z0; float* Z1; bf16 *QF, *KF, *VF, *GA, *GB;
    __device__ __forceinline__ void operator()(const f32x4 (&acc)[2][2][4][2], const Unit& u, int wr, int wc, int fr, int fq) const {
        const int pn = u.pn;
        EPI_ROWS({ const int ct = bj * 128 + wc * 32 + 8 * fq;
            if (pn == 0) { *(v4u*)(Z0 + row * 256 + ct) = pack8(v0, v1); }
            else if (pn == 1) { float* p = Z1 + row * 256 + ct; *(f32x4*)p = v0; *(f32x4*)(p + 4) = v1; }
            else if (pn < 4) { const int c = (pn - 2) * 256 + ct; *(v4u*)(QF + row * 512 + c) = pack8(v0 * C2F, v1 * C2F); }
            else if (pn < 6) { const int c = (pn - 4) * 256 + ct; *(v4u*)(KF + row * 512 + c) = pack8(v0, v1); }
            else if (pn < 8) { const int c = (pn - 6) * 256 + ct; *(v4u*)(VF + row * 512 + c) = pack8(v0, v1); }
            else { bf16* G = pn < 12 ? GA : GB; const int c = ((pn - 8) & 3) * 256 + ct; f32x4 s0, s1;
                _Pragma("unroll") for (int e = 0; e < 4; ++e) { s0[e] = sigmoidf_(v0[e]); s1[e] = sigmoidf_(v1[e]); }
                v2u q; q.x = pack4_u8(s0); q.y = pack4_u8(s1); *(v2u*)((unsigned char*)G + row * 1024 + c) = q; } })
    }
};
struct EpiQup { static constexpr bool PERM = true, AFTER_DRAIN = false, MID = false;
    bf16* QM;
    __device__ __forceinline__ void operator()(const f32x4 (&acc)[2][2][4][2], const Unit& u, int wr, int wc, int fr, int fq) const {
        EPI_ROWS({ const int ct = u.pn * 256 + bj * 128 + wc * 32 + 8 * fq; *(v4u*)(QM + row * 768 + ct) = pack8(v0 * C2M, v1 * C2M); })
    }
};
struct EpiKVup { static constexpr bool PERM = true, AFTER_DRAIN = false, MID = false;
    bf16 *KM, *VM;
    __device__ __forceinline__ void operator()(const f32x4 (&acc)[2][2][4][2], const Unit& u, int wr, int wc, int fr, int fq) const {
        bf16* D = u.pn < 2 ? KM : VM; const int c0 = (u.pn & 1) * 256;
        EPI_ROWS({ const int ct = bj * 128 + wc * 32 + 8 * fq; *(v4u*)(D + row * 512 + c0 + ct) = pack8(v0, v1); })
    }
};
struct EpiMix { static constexpr bool PERM = true, AFTER_DRAIN = false, MID = true;
    const unsigned char *GA_, *GB_; bf16* MIX_;
    __device__ __forceinline__ void mid(f32x4 (&acc)[2][2][4][2], const Unit& u, int wr, int wc, int fr, int fq) const {
        int rb_ = u.pm * 256 + wr * 64 + fr; asm volatile("" : "+v"(rb_));
#pragma unroll
        for (int ai = 0; ai < 2; ++ai) { v2u ga[4][2], gb[4][2];
#pragma unroll
            for (int m = 0; m < 4; ++m)
#pragma unroll
                for (int bj = 0; bj < 2; ++bj) { const size_t off = (size_t)(rb_ + ai * 128 + m * 16) * 1024 + u.pn * 256 + bj * 128 + wc * 32 + 8 * fq; ga[m][bj] = *(const v2u*)(GA_ + off); gb[m][bj] = *(const v2u*)(GB_ + off); }
#pragma unroll
            for (int m = 0; m < 4; ++m)
#pragma unroll
                for (int bj = 0; bj < 2; ++bj) { const f32x4 a0 = unpack4_u8(ga[m][bj].x), a1 = unpack4_u8(ga[m][bj].y); f32x4 b0 = unpack4_u8(gb[m][bj].x), b1 = unpack4_u8(gb[m][bj].y);
#pragma unroll
                    for (int e = 0; e < 4; ++e) { b0[e] = __builtin_amdgcn_rcpf(__builtin_fmaxf(b0[e], 1.f)); b1[e] = __builtin_amdgcn_rcpf(__builtin_fmaxf(b1[e], 1.f)); }
                    acc[ai][bj][m][0] *= a0 * b0; acc[ai][bj][m][1] *= a1 * b1; }
            asm volatile("" ::: "memory"); }
    }
    __device__ __forceinline__ void operator()(const f32x4 (&acc)[2][2][4][2], const Unit& u, int wr, int wc, int fr, int fq) const {
        EPI_ROWS({ const size_t off = row * 1024 + u.pn * 256 + bj * 128 + wc * 32 + 8 * fq; const v2u g = *(const v2u*)(GB_ + off);
            f32x4 b0 = unpack4_u8(g.x), b1 = unpack4_u8(g.y);
            _Pragma("unroll") for (int e = 0; e < 4; ++e) { b0[e] = __builtin_fmaxf(b0[e], 1.f) * (1.f / 255.f); b1[e] = __builtin_fmaxf(b1[e], 1.f) * (1.f / 255.f); }
            *(v4u*)(MIX_ + off) = pack8(v0 * b0, v1 * b1); })
    }
};
struct EpiY { static constexpr bool PERM = true, AFTER_DRAIN = false, MID = false;
    bf16* Y_;
    __device__ __forceinline__ void operator()(const f32x4 (&acc)[2][2][4][2], const Unit& u, int wr, int wc, int fr, int fq) const {
        EPI_ROWS({ *(v4u*)(Y_ + row * 1024 + u.pn * 256 + bj * 128 + wc * 32 + 8 * fq) = pack8(v0, v1); })
    }
};
struct EpiLg { static constexpr bool PERM = true, AFTER_DRAIN = false, MID = false;
    float* LG;
    __device__ __forceinline__ void operator()(const f32x4 (&acc)[2][2][4][2], const Unit& u, int wr, int wc, int fr, int fq) const {
        EPI_ROWS({ if (bj == 0) { float* p = LG + row * 128 + wc * 32 + 8 * fq; *(f32x4*)p = v0; *(f32x4*)(p + 4) = v1; } })
    }
};
struct EpiGU { static constexpr bool PERM = true, AFTER_DRAIN = false, MID = false;
    bf16* ACT;
    __device__ __forceinline__ void operator()(const f32x4 (&acc)[2][2][4][2], const Unit& u, int wr, int wc, int fr, int fq) const {
        const int c0 = (u.pn & 1) * 128 + wc * 32 + 8 * fq; int rb_ = u.pm * 256 + wr * 64 + fr; asm volatile("" : "+v"(rb_));
#pragma unroll
        for (int ai = 0; ai < 2; ++ai)
#pragma unroll
            for (int m = 0; m < 4; ++m) { const size_t row = (size_t)(rb_ + ai * 128 + m * 16); f32x4 a0, a1;
#pragma unroll
                for (int e = 0; e < 4; ++e) { const float g0 = acc[ai][0][m][0][e], g1 = acc[ai][0][m][1][e]; a0[e] = g0 * sigmoidf_(g0) * acc[ai][1][m][0][e]; a1[e] = g1 * sigmoidf_(g1) * acc[ai][1][m][1][e]; }
                *(v4u*)(ACT + row * 256 + c0) = pack8(a0, a1); }
    }
};
struct EpiDown { static constexpr bool PERM = true, AFTER_DRAIN = false, MID = false;
    bf16* YB; const float* WROW;
    __device__ __forceinline__ void operator()(const f32x4 (&acc)[2][2][4][2], const Unit& u, int wr, int wc, int fr, int fq) const {
        const int c0 = (u.pn & 3) * 256;
        EPI_ROWS({ const float w = WROW[row]; *(v4u*)(YB + row * 1024 + c0 + bj * 128 + wc * 32 + 8 * fq) = pack8(v0 * w, v1 * w); })
    }
};
struct ExpertOrder {
    const LAS unsigned* tpre; int NJ, G, c;
    __device__ __forceinline__ bool next(int i, Unit& u) const {
        const int total = (int)tpre[NEXP] * NJ; const long L = (long)i * G + c; if (L >= total) return false;
        const int T = (int)L / NJ, j = (int)L % NJ; int e = 0;
#pragma unroll 1
        for (int k = 1; k < NEXP; ++k) e += ((int)tpre[k] <= T) ? 1 : 0;
        u.pm = T; u.pn = e * NJ + j; return true;
    }
    __device__ __forceinline__ void a_ready(const Unit&) const {}
    __device__ __forceinline__ void done(const Unit&) const {}
};

__device__ __forceinline__ void tr_item(const float* colp, int N, int k0, bf16* dst  , int K, bool lo, LAS float* scr, int lane) {
#pragma unroll 8
    for (int i = 0; i < 32; ++i) { const int kk = 2 * i + (lane >> 5); float v = colp ? colp[(size_t)(k0 + kk) * N] : 0.f;
        if (lo) v = v - bf2f((unsigned short)f2bf(v));
        scr[kk * 33 + (lane & 31)] = v; }
    LDS_WAIT(); asm volatile("" ::: "memory");
    const int c = lane & 7;
#pragma unroll
    for (int j = 0; j < 4; ++j) { const int n = (lane >> 3) + 8 * j; const LAS float* s = scr + (8 * c) * 33 + n;
        v4u o; o.x = pk2(s[0 * 33], s[1 * 33]); o.y = pk2(s[2 * 33], s[3 * 33]); o.z = pk2(s[4 * 33], s[5 * 33]); o.w = pk2(s[6 * 33], s[7 * 33]);
        *(GAS v4u*)(dst + (size_t)n * K + 8 * c) = o; }
    LDS_WAIT(); asm volatile("" ::: "memory");
}
__device__ __forceinline__ void tr_item4(const float* cp4, int N, bf16* dst  , int K, LAS float* scr, int lane) {
    const int c = lane & 7, kr0 = lane >> 3; f32x4 v[8];
#pragma unroll
    for (int i = 0; i < 8; ++i) v[i] = cp4 ? *(const f32x4*)(cp4 + (size_t)(8 * i) * N) : (f32x4){0.f, 0.f, 0.f, 0.f};
#pragma unroll
    for (int i = 0; i < 8; ++i) { LAS float* s = scr + (kr0 + 8 * i) * 33 + 4 * c; s[0] = v[i].x; s[1] = v[i].y; s[2] = v[i].z; s[3] = v[i].w; }
    LDS_WAIT(); asm volatile("" ::: "memory");
#pragma unroll
    for (int j = 0; j < 4; ++j) { const int n = kr0 + 8 * j; const LAS float* s = scr + (8 * c) * 33 + n;
        v4u o; o.x = pk2(s[0 * 33], s[1 * 33]); o.y = pk2(s[2 * 33], s[3 * 33]); o.z = pk2(s[4 * 33], s[5 * 33]); o.w = pk2(s[6 * 33], s[7 * 33]);
        *(GAS v4u*)(dst + (size_t)n * K + 8 * c) = o; }
    LDS_WAIT(); asm volatile("" ::: "memory");
}
constexpr int I7 = NEXP * 16 * 16, I8 = NEXP * 32 * 4;
__device__ __forceinline__ void conv_expert_item(int r, const float* w_e_gate, const float* w_e_up, const float* w_e_down, bf16* WGUp, bf16* WDNp, LAS float* scr, int lane) {
    const int c4 = 4 * (lane & 7), kr0 = lane >> 3;
    if (r < I7) { const int e = r / 256, q = r % 256, nb = q % 16, kb = q / 16, rr = nb * 32 + c4;
        const int j = rr >> 8, isup = (rr >> 7) & 1, cc = rr & 127; const float* src = (isup ? w_e_up : w_e_gate) + (size_t)e * 1024 * 256 + (size_t)(kb * 64 + kr0) * 256 + 128 * j + cc;
        tr_item4(src, 256, WGUp + ((size_t)e * 512 + nb * 32) * 1024 + kb * 64, 1024, scr, lane); }
    else { r -= I7; const int e = r / 128, q = r % 128, nb = q % 32, kb = q / 32; tr_item4(w_e_down + (size_t)e * 256 * 1024 + (size_t)(kb * 64 + kr0) * 1024 + nb * 32 + c4, 1024, WDNp + ((size_t)e * 1024 + nb * 32) * 256 + kb * 64, 256, scr, lane); }
}
__device__ __forceinline__ double inv_freq_d(int i) {
    const int q = i >> 2, r = i & 3;
    const double a = q == 0 ? 1.0 : q == 1 ? 0.1 : q == 2 ? 0.01 : 0.001;
    const double b = r == 0 ? 1.0 : r == 1 ? 0.5623413251903491 : r == 2 ? 0.31622776601683794 : 0.1778279410038923;
    return a * b;
}

struct Args { const float* in[22]; float* out; unsigned char* ws; int ph_lo, ph_hi; };

__global__ void __launch_bounds__(NWAVES * 64, 2) mk_fwd(Args args) {
    extern __shared__ __attribute__((aligned(16))) unsigned char lds[];
    LAS unsigned char* const L = (LAS unsigned char*)lds;
    volatile LAS unsigned* const MISC = (volatile LAS unsigned*)(L + MISC_OFF);
    const int tid = threadIdx.x, lane = tid & 63, wave = __builtin_amdgcn_readfirstlane(tid >> 6);
    const int G = gridDim.x; const int bx = blockIdx.x; const int vcu = (G % 8 == 0) ? (bx % 8) * (G / 8) + bx / 8 : bx;
    const int gw = vcu * NWAVES + wave, NGW = G * NWAVES;
    unsigned char* const ws = args.ws;
    gu32* const ctl = (gu32*)(ws + WS_CTL);
    const float* x = args.in[0]; const int* positions = (const int*)args.in[1]; const float* g_mix = args.in[2]; const float* w_in = args.in[3]; const float* b_forget = args.in[4];
    const float* g_cq = args.in[5]; const float* g_ckv = args.in[6]; const float* w_uq = args.in[7]; const float* w_uk = args.in[8]; const float* w_uv = args.in[9];
    const float* w_o_mla = args.in[10]; const float* w_o_fox = args.in[11]; const float* w_out = args.in[12]; const float* g_ffn = args.in[13]; const float* w_group = args.in[14];
    const float* b_group = args.in[15]; const float* w_router = args.in[16]; const float* b_router = args.in[17]; const float* w_e_gate = args.in[18]; const float* w_e_up = args.in[19];
    const float* w_e_down = args.in[20]; const float* g_final = args.in[21];
    float* const out = args.out;
#define WIN ((bf16*)(ws + WS_WIN))
#define WUQ ((bf16*)(ws + WS_WUQ))
#define WUKV ((bf16*)(ws + WS_WUKV))
#define WOA ((bf16*)(ws + WS_WOA))
#define WOB ((bf16*)(ws + WS_WOB))
#define WOUT ((bf16*)(ws + WS_WOUT))
#define WR ((bf16*)(ws + WS_WR))
#define WGU ((bf16*)(ws + WS_WGU))
#define WDN ((bf16*)(ws + WS_WDN))
#define CS ((float*)(ws + WS_CS))
#define LOGF ((float*)(ws + WS_LOGF))
#define EID ((int*)(ws + WS_EID))
#define SLOT ((int*)(ws + WS_SLOT))
#define WGT ((float*)(ws + WS_WGT))
#define POS ((int*)(ws + WS_POS))
#define WROW ((float*)(ws + WS_WROW))
#define XN ((bf16*)(ws + WS_XN))
#define CQN ((bf16*)(ws + WS_CQN))
#define CKVN ((bf16*)(ws + WS_CKVN))
#define VM ((bf16*)(ws + WS_VM))
#define KR ((bf16*)(ws + WS_KR))
#define KBIAS ((bf16*)(ws + WS_KR + 2 * MiB))
#define GBH ((float*)(ws + WS_KR + 6 * MiB))
#define Z0 ((bf16*)(ws + WS_Z0))
#define Z1 ((float*)(ws + WS_Z1))
#define QF ((bf16*)(ws + WS_QF))
#define KF ((bf16*)(ws + WS_KF))
#define VF ((bf16*)(ws + WS_VF))
#define OA ((bf16*)(ws + WS_OA))
#define OB ((bf16*)(ws + WS_OB))
#define MIX ((bf16*)(ws + WS_MIX))
#define QM ((bf16*)(ws + WS_QM))
#define KM ((bf16*)(ws + WS_KM))
#define HN ((bf16*)(ws + WS_HN))
#define LG ((float*)(ws + WS_LG))
#define XG ((bf16*)(ws + WS_XG))
#define ACT ((bf16*)(ws + WS_ACT))
#define YB ((bf16*)(ws + WS_YB))
#define GA ((bf16*)out)
#define GB ((bf16*)((unsigned char*)out + (size_t)M * 1024))
#define YM ((bf16*)(ws + WS_QM))

    for (int u = tid; u < (LDS_BYTES - LDSCTL_OFF) / 4; u += NWAVES * 64) ((LAS unsigned*)(L + LDSCTL_OFF))[u] = 0u;
    __syncthreads();
    XcdBarrier bar; bar.bar = (unsigned*)(ctl + CW_BAR); bar.x = 0; bar.st = nullptr;
    if (!MK_PER_PHASE) bar = xcd_barrier_post((unsigned*)(ctl + CW_BAR), MISC + 8);
    const int lo = args.ph_lo, hi = args.ph_hi;
#ifndef MK_REPEAT
#define MK_REPEAT -1
#endif
#ifndef MK_ONLY
#define MK_ONLY -1
#endif
#define IN(k) ((MK_ONLY < 0 || MK_ONLY == (k)) && lo <= (k) && (k) < hi)
#define SEAM(k) do { if (IN(k) && IN((k) + 1)) { xcd_barrier(bar); } } while (0)
    if (args.ph_hi < 0) cooperative_groups::this_grid().sync();

    if (IN(0)) for (int rep_ = 0; rep_ < ((MK_REPEAT == 0) ? 2 : 1); ++rep_) {
        LAS float* scr = (LAS float*)(L + RING_OFF + wave * 16384);
        constexpr int I0 = 128 * 16, I1 = 24 * 4, I2 = 32 * 2, I3 = 32 * 8, I4 = 32 * 8  , I5 = 32 * 16, I6 = 8 * 16;
        constexpr int NITEMS = I0 + I1 + I2; (void)I3; (void)I4; (void)I5; (void)I6;
        const int l31 = lane & 31, c4 = 4 * (lane & 7), kr0 = lane >> 3;
        for (int it = gw; it < NITEMS; it += NGW) {
            int r = it;
            if (r < I0) { const int nb = r % 128, kb = r / 128, n = nb * 32 + c4;
                int sc; if (n < 416) sc = n; else if (n < 424) sc = 1952 + (n - 416); else if (n < 512) sc = -1; else if (n < 2048) sc = n - 96; else sc = n - 88;
                tr_item4(sc >= 0 ? w_in + (size_t)(kb * 64 + kr0) * 4008 + sc : nullptr, 4008, WIN + (size_t)(nb * 32) * 1024 + kb * 64, 1024, scr, lane); continue; } r -= I0;
            if (r < I1) { const int nb = r % 24, kb = r / 24; tr_item4(w_uq + (size_t)(kb * 64 + kr0) * 768 + nb * 32 + c4, 768, WUQ + (size_t)(nb * 32) * 256 + kb * 64, 256, scr, lane); continue; } r -= I1;
            if (r < I2) { const int nb = r % 32, kb = r / 32, n = nb * 32 + c4; tr_item4((n < 512 ? w_uk + n : w_uv + (n - 512)) + (size_t)(kb * 64 + kr0) * 512, 512, WUKV + (size_t)(nb * 32) * 128 + kb * 64, 128, scr, lane); continue; }
        }
        for (int m = 2 * gw; m < M; m += 2 * NGW) {
            const GAS f32x4* xr = (const GAS f32x4*)(x + (size_t)m * DM) + lane; f32x4 v[8]; float s2a = 0.f, s2b = 0.f;
#pragma unroll
            for (int j = 0; j < 8; ++j) v[j] = xr[64 * j];
#pragma unroll
            for (int j = 0; j < 4; ++j) { s2a += (v[j].x * v[j].x + v[j].y * v[j].y) + (v[j].z * v[j].z + v[j].w * v[j].w); s2b += (v[4 + j].x * v[4 + j].x + v[4 + j].y * v[4 + j].y) + (v[4 + j].z * v[4 + j].z + v[4 + j].w * v[4 + j].w); }
            const float ra = 1.f / sqrtf(wave_sum(s2a) * (1.f / DM) + EPS), rb = 1.f / sqrtf(wave_sum(s2b) * (1.f / DM) + EPS);
            GAS unsigned long long* o8 = (GAS unsigned long long*)(XN + (size_t)m * DM) + lane;
#pragma unroll
            for (int j = 0; j < 8; ++j) { const f32x4 g = *((const f32x4*)g_mix + lane + 64 * (j & 3)); const float rs = j < 4 ? ra : rb;
                o8[64 * j] = (unsigned long long)pk2(v[j].x * rs * g.x, v[j].y * rs * g.y) | ((unsigned long long)pk2(v[j].z * rs * g.z, v[j].w * rs * g.w) << 32); }
        }
        for (int i = (vcu * NWAVES * 64 + tid); i < M * 16; i += G * NWAVES * 64) {
            const int m = i >> 4, f = i & 15; const double ang = (double)positions[m] * inv_freq_d(f); const double rev = ang * 0.15915494309189535; const float fr = (float)(rev - floor(rev));
            CS[2 * i] = __builtin_amdgcn_cosf(fr); CS[2 * i + 1] = __builtin_amdgcn_sinf(fr); }
    }
    SEAM(0);
    if (IN(1)) for (int rep_ = 0; rep_ < ((MK_REPEAT == 1) ? 2 : 1); ++rep_) {
        pg8::Gemm g{XN, WIN, M, NIN, DM}; pg8::StaticOrder S; S.init(M, NIN, G, bx);
        EpiIn E{Z0, Z1, QF, KF, VF, GA, GB};
        pg8::gemm_phase<EpiIn, pg8::StaticOrder, true, true>(L + RING_OFF, g, S, E);
    }
    SEAM(1);
    if (IN(2)) for (int rep_ = 0; rep_ < ((MK_REPEAT == 2) ? 2 : 1); ++rep_) {
        float* const BSUM = (float*)(ws + WS_EID);
        LAS float* part = (LAS float*)(L + RING_OFF);
        for (int vb = vcu; vb < 256; vb += G) { float lfsum = 0.f; const int g4 = lane >> 4, l16 = lane & 15;
#pragma unroll 2
        for (int it = 0; it < 4; ++it) { const size_t m = (size_t)vb * 128 + wave * 16 + it * 4 + g4;
            const v4u ra = *(const v4u*)(Z0 + m * 256 + l16 * 16), rb = *(const v4u*)(Z0 + m * 256 + l16 * 16 + 8);
            const float* z = Z1 + m * 256;
            const f32x4 ka = *(const f32x4*)(z + l16 * 8), kb = *(const f32x4*)(z + l16 * 8 + 4);
            const float x1 = z[128 + l16], x2 = z[144 + l16], cc = CS[m * 32 + 2 * l16], sn = CS[m * 32 + 2 * l16 + 1];
            const float fl = z[160 + (l16 & 7)];
            float q[16] = {bflo(ra.x), bfhi(ra.x), bflo(ra.y), bfhi(ra.y), bflo(ra.z), bfhi(ra.z), bflo(ra.w), bfhi(ra.w), bflo(rb.x), bfhi(rb.x), bflo(rb.y), bfhi(rb.y), bflo(rb.z), bfhi(rb.z), bflo(rb.w), bfhi(rb.w)};
            float sq = 0.f, sk = (ka.x * ka.x + ka.y * ka.y) + (ka.z * ka.z + ka.w * ka.w) + (kb.x * kb.x + kb.y * kb.y) + (kb.z * kb.z + kb.w * kb.w);
#pragma unroll
            for (int e = 0; e < 16; ++e) sq += q[e] * q[e];
#pragma unroll
            for (int o = 1; o < 16; o <<= 1) { sq += __shfl_xor(sq, o); sk += __shfl_xor(sk, o); }
            const float rq = 1.f / sqrtf(sq * (1.f / 256) + EPS), rk = 1.f / sqrtf(sk * (1.f / 128) + EPS);
            { const f32x4 g0 = *((const f32x4*)g_cq + l16 * 4), g1 = *((const f32x4*)g_cq + l16 * 4 + 1), g2 = *((const f32x4*)g_cq + l16 * 4 + 2), g3 = *((const f32x4*)g_cq + l16 * 4 + 3);
              v4u o0, o1; o0.x = pk2(q[0] * rq * g0.x, q[1] * rq * g0.y); o0.y = pk2(q[2] * rq * g0.z, q[3] * rq * g0.w); o0.z = pk2(q[4] * rq * g1.x, q[5] * rq * g1.y); o0.w = pk2(q[6] * rq * g1.z, q[7] * rq * g1.w);
              o1.x = pk2(q[8] * rq * g2.x, q[9] * rq * g2.y); o1.y = pk2(q[10] * rq * g2.z, q[11] * rq * g2.w); o1.z = pk2(q[12] * rq * g3.x, q[13] * rq * g3.y); o1.w = pk2(q[14] * rq * g3.z, q[15] * rq * g3.w);
              *(v4u*)(CQN + m * 256 + l16 * 16) = o0; *(v4u*)(CQN + m * 256 + l16 * 16 + 8) = o1; }
            { const f32x4 g0 = *((const f32x4*)g_ckv + l16 * 2), g1 = *((const f32x4*)g_ckv + l16 * 2 + 1);
              v4u o; o.x = pk2(ka.x * rk * g0.x, ka.y * rk * g0.y); o.y = pk2(ka.z * rk * g0.z, ka.w * rk * g0.w); o.z = pk2(kb.x * rk * g1.x, kb.y * rk * g1.y); o.w = pk2(kb.z * rk * g1.z, kb.w * rk * g1.w);
              *(v4u*)(CKVN + m * 128 + l16 * 8) = o; }
            KR[m * 32 + l16] = (bf16)f2bf(x1 * cc - x2 * sn); KR[m * 32 + 16 + l16] = (bf16)f2bf(x2 * cc + x1 * sn);
            if (l16 < 8) { const float xx = fl + b_forget[l16]; const float t = __expf(-fabsf(xx)); const float lfv = fminf(xx, 0.f) - __logf(1.f + t); LOGF[m * 8 + l16] = lfv; lfsum += lfv; }
        }
        lfsum += __shfl_xor(lfsum, 16); lfsum += __shfl_xor(lfsum, 32);
        if (lane < 8) part[wave * 8 + lane] = lfsum;
        __syncthreads();
        if (tid < 8) { float t = 0.f; for (int w = 0; w < 8; ++w) t += part[w * 8 + tid]; BSUM[vb * 8 + tid] = t; }
        __syncthreads();
        }
    }
    SEAM(2);
    if (IN(3)) for (int rep_ = 0; rep_ < ((MK_REPEAT == 3) ? 2 : 1); ++rep_) {
#ifndef NO_SCAN
        { const float* const BSUM = (const float*)(ws + WS_EID);
          for (int vb = vcu; vb < 256; vb += G) { const int b = vb >> 5, bi = vb & 31, hh = wave;
            double base = (lane < bi) ? (double)BSUM[(size_t)((b * 32 + lane) * 8 + hh)] : 0.0;
#pragma unroll
            for (int o = 1; o < 64; o <<= 1) base += __shfl_xor(base, o);
            const size_t t0 = (size_t)vb * 128 + 2 * lane; const float v0 = LOGF[t0 * 8 + hh], v1 = LOGF[(t0 + 1) * 8 + hh];
            const double sp = (double)v0 + (double)v1; double incl = sp;
#pragma unroll
            for (int o = 1; o < 64; o <<= 1) { const double t = __shfl_up(incl, o); if (lane >= o) incl += t; }
            const double run0 = base + (incl - sp) + (double)v0, run1 = run0 + (double)v1;
#pragma unroll
            for (int e = 0; e < 2; ++e) { const float gneg = (float)(-(e ? run1 : run0) * 1.4426950408889634);
                const unsigned b0 = f2bf(gneg); const float r1 = gneg - bf2f((unsigned short)b0); const unsigned b1 = f2bf(r1); const float r2 = r1 - bf2f((unsigned short)b1); const unsigned b2 = f2bf(r2);
                *(v4u*)(KBIAS + ((size_t)hh * M + t0 + e) * 8) = (v4u){b0 | (b1 << 16), b2, 0u, 0u};
                GBH[(size_t)hh * M + t0 + e] = bf2f((unsigned short)b0) + bf2f((unsigned short)b1) + bf2f((unsigned short)b2); }
            float qn = 0.f, kn = 0.f;
#pragma unroll
            for (int e = 0; e < 2; ++e) { const v4u* kp = (const v4u*)(KF + (t0 + e) * 512 + hh * 64); const v4u* qp = (const v4u*)(QF + (t0 + e) * 512 + hh * 64); float sk = 0.f, sq = 0.f;
#pragma unroll
                for (int c = 0; c < 8; ++c) { const v4u a = kp[c], q = qp[c];
                    sk += (bflo(a.x) * bflo(a.x) + bfhi(a.x) * bfhi(a.x)) + (bflo(a.y) * bflo(a.y) + bfhi(a.y) * bfhi(a.y)) + (bflo(a.z) * bflo(a.z) + bfhi(a.z) * bfhi(a.z)) + (bflo(a.w) * bflo(a.w) + bfhi(a.w) * bfhi(a.w));
                    sq += (bflo(q.x) * bflo(q.x) + bfhi(q.x) * bfhi(q.x)) + (bflo(q.y) * bflo(q.y) + bfhi(q.y) * bfhi(q.y)) + (bflo(q.z) * bflo(q.z) + bfhi(q.z) * bfhi(q.z)) + (bflo(q.w) * bflo(q.w) + bfhi(q.w) * bfhi(q.w)); }
                kn = fmaxf(kn, sk); qn = fmaxf(qn, sq); }
#pragma unroll
            for (int o = 1; o < 64; o <<= 1) { kn = fmaxf(kn, __shfl_xor(kn, o)); qn = fmaxf(qn, __shfl_xor(qn, o)); }
            if (lane == 0) { __hip_atomic_fetch_max(ctl + CW_QK + 2 * (b * 8 + hh), __float_as_uint(sqrtf(qn)), RLX_AGENT); __hip_atomic_fetch_max(ctl + CW_QK + 2 * (b * 8 + hh) + 1, __float_as_uint(sqrtf(kn)), RLX_AGENT); }
          } }
#endif
#ifndef NO_QUP
        { pg8::Gemm g{CQN, WUQ, M, 768, 256}; pg8::StaticOrder S; S.init(M, 768, G, bx); EpiQup E{QM};
          pg8::gemm_phase<EpiQup, pg8::StaticOrder, true, true>(L + RING_OFF, g, S, E); }
#endif
#ifndef NO_KVUP
        { pg8::Gemm g{CKVN, WUKV, M, 1024, 128}; pg8::StaticOrder S; S.init(M, 1024, G, bx); EpiKVup E{KM, VM};
          pg8::gemm_phase<EpiKVup, pg8::StaticOrder, true, true>(L + RING_OFF, g, S, E); }
#endif
    }
    SEAM(3);
    if (IN(4)) for (int rep_ = 0; rep_ < ((MK_REPEAT == 4) ? 2 : 1); ++rep_) {
        const att::AttnT TA{QM, KM, KR, VM, OA, CS, LOGF, (const unsigned*)(ctl + CW_QK), (const bf16*)(ctl + CW_ZERO)}; const att::AttnT TB{QF, KF, KBIAS, VF, OA + 512, CS, GBH, (const unsigned*)(ctl + CW_QK), (const bf16*)(ctl + CW_ZERO)};
        LAS int* qi = (LAS int*)(L + TP_OFF + 512);
        if (tid == 0) qi[0] = (int)__hip_atomic_fetch_add(ctl + CW_AQ, 1u, RLX_AGENT);
        __syncthreads();
        int idx = qi[0];
        constexpr int NLATE = I7 + I8 + 32 * 16 + 32 * 16 + 8 * 16, CONV_PER = 48, NQ = 2048 + NLATE / CONV_PER;
        static_assert(NLATE % CONV_PER == 0, "conv tickets");
        while (idx < NQ) {
            int nxt = 0; if (tid == 0) nxt = (int)__hip_atomic_fetch_add(ctl + CW_AQ, 1u, RLX_AGENT);
            const int r = idx & 1023, qb = 15 - (r >> 6), bh = r & 63;
            if (idx < 1024) att::attn_unit<0>(bh >> 3, bh & 7, qb, TA, (char*)lds + RING_OFF);
            else if (idx < 2048) att::attn_unit<1>(bh >> 3, bh & 7, qb, TB, (char*)lds + RING_OFF);
            else { LAS float* scr = (LAS float*)(L + RING_OFF + wave * 16384); const int l31 = lane & 31, c4 = 4 * (lane & 7), kr0 = lane >> 3;
#pragma unroll 1
                for (int k = 0; k < CONV_PER / NWAVES; ++k) { int r = (idx - 2048) * CONV_PER + wave * (CONV_PER / NWAVES) + k;
                    constexpr int J3 = 32 * 16, J5 = 32 * 16, J6 = 8 * 16;
                    if (r >= J6 + J3 + J5) { conv_expert_item(r - (J6 + J3 + J5), w_e_gate, w_e_up, w_e_down, WGU, WDN, scr, lane); continue; }
                    r = (r < J6) ? (r + J3 + J5) : (r - J6);
                    if (r < J3) { const int nb = r % 32, kb = r / 32;
                        const float* src = (kb < 8 ? w_o_mla + (size_t)(kb * 64 + kr0) * 1024 : w_o_fox + (size_t)((kb - 8) * 64 + kr0) * 1024) + nb * 32 + c4;
                        tr_item4(src, 1024, WOA + (size_t)(nb * 32) * 1024 + kb * 64, 1024, scr, lane); continue; } r -= J3;
                    if (r < J5) { const int nb = r % 32, kb = r / 32; tr_item4(w_out + (size_t)(kb * 64 + kr0) * 1024 + nb * 32 + c4, 1024, WOUT + (size_t)(nb * 32) * 1024 + kb * 64, 1024, scr, lane); continue; } r -= J5;
                    if (r < J6) { const int nb = r % 8, kb = r / 8, n = nb * 32 + l31; const int j = n & 63; const bool islo = (n >= 64 && n < 128); const bool valid = (n < 128) && (j < 36);
                        const float* cp = nullptr; int NN = 32; if (valid) { if (j < 4) { cp = w_group + j; NN = 4; } else { cp = w_router + (j - 4); NN = 32; } }
#pragma unroll 8
                        for (int i = 0; i < 32; ++i) { const int kk = 2 * i + (lane >> 5); float v = cp ? cp[(size_t)(kb * 64 + kk) * NN] : 0.f; if (islo) v = v - bf2f((unsigned short)f2bf(v)); scr[kk * 33 + l31] = v; }
                        LDS_WAIT(); asm volatile("" ::: "memory");
                        const int c = lane & 7; bf16* dst = WR + (size_t)(nb * 32) * 1024 + kb * 64;
#pragma unroll
                        for (int jj = 0; jj < 4; ++jj) { const int nn = (lane >> 3) + 8 * jj; const LAS float* sp = scr + (8 * c) * 33 + nn;
                            v4u o; o.x = pk2(sp[0 * 33], sp[1 * 33]); o.y = pk2(sp[2 * 33], sp[3 * 33]); o.z = pk2(sp[4 * 33], sp[5 * 33]); o.w = pk2(sp[6 * 33], sp[7 * 33]);
                            *(GAS v4u*)(dst + (size_t)nn * 1024 + 8 * c) = o; }
                        LDS_WAIT(); asm volatile("" ::: "memory"); } } }
            if (tid == 0) qi[0] = nxt;
            __syncthreads(); idx = qi[0];
        }
    }
#ifndef MK_ATT_PROBE
#define MK_ATT_PROBE -1
#endif
    if (MK_ATT_PROBE >= 0 && IN(4)) {
        const att::AttnT TA{QM, KM, KR, VM, MIX, CS, LOGF, (const unsigned*)(ctl + CW_QK), (const bf16*)(ctl + CW_ZERO)}; const att::AttnT TB{QF, KF, KBIAS, VF, MIX + 512, CS, GBH, (const unsigned*)(ctl + CW_QK), (const bf16*)(ctl + CW_ZERO)};
        for (int v = vcu; v < 256; v += G) { const int bh = v >> 2, sub = v & 3, b = bh >> 3, hh = bh & 7;
#pragma unroll 1
            for (int i = 0; i < 4; ++i) { const int qb = (i == 0) ? 15 - sub : (i == 1) ? 8 + sub : (i == 2) ? 7 - sub : sub;
                att::attn_unit<0, (MK_ATT_PROBE < 0 ? 0 : MK_ATT_PROBE)>(b, hh, qb, TA, (char*)lds + RING_OFF);
                att::attn_unit<1, (MK_ATT_PROBE < 0 ? 0 : MK_ATT_PROBE)>(b, hh, qb, TB, (char*)lds + RING_OFF); } }
    }
    SEAM(4);
    if (IN(5)) for (int rep_ = 0; rep_ < ((MK_REPEAT == 5) ? 2 : 1); ++rep_) {
        pg8::Gemm g{OA, WOA, M, 1024, 1024}; pg8::StaticOrder S; S.init(M, 1024, G, bx); EpiMix E{(const unsigned char*)GA, (const unsigned char*)GB, MIX}; pg8::gemm_phase<EpiMix, pg8::StaticOrder, true, true>(L + RING_OFF, g, S, E);
    }
    SEAM(5);
    if (IN(6)) for (int rep_ = 0; rep_ < ((MK_REPEAT == 6) ? 2 : 1); ++rep_) {
        pg8::Gemm g{MIX, WOUT, M, 1024, 1024}; pg8::StaticOrder S; S.init(M, 1024, G, bx); EpiY E{YM}; pg8::gemm_phase<EpiY, pg8::StaticOrder, true, true>(L + RING_OFF, g, S, E);
    }
    SEAM(6);
    if (IN(7)) for (int rep_ = 0; rep_ < ((MK_REPEAT == 7) ? 2 : 1); ++rep_) {
        for (int m0 = 2 * gw; m0 < M; m0 += 2 * NGW) {
            f32x4 v[8]; v2u yv[8];
#pragma unroll
            for (int j = 0; j < 8; ++j) { const size_t m = (size_t)m0 + (j >> 2); v[j] = *((const GAS f32x4*)(x + m * DM) + lane + 64 * (j & 3)); yv[j] = *((const v2u*)(YM + m * DM) + lane + 64 * (j & 3)); }
            float s2[2] = {0.f, 0.f};
#pragma unroll
            for (int j = 0; j < 8; ++j) { v[j].x += bflo(yv[j].x); v[j].y += bfhi(yv[j].x); v[j].z += bflo(yv[j].y); v[j].w += bfhi(yv[j].y); s2[j >> 2] += (v[j].x * v[j].x + v[j].y * v[j].y) + (v[j].z * v[j].z + v[j].w * v[j].w); }
            const float rs[2] = {1.f / sqrtf(wave_sum(s2[0]) * (1.f / DM) + EPS), 1.f / sqrtf(wave_sum(s2[1]) * (1.f / DM) + EPS)};
#pragma unroll
            for (int j = 0; j < 8; ++j) { const size_t m = (size_t)m0 + (j >> 2); const float rstd = rs[j >> 2];
                GAS unsigned long long* oh = (GAS unsigned long long*)(HN + m * DM) + lane + 64 * (j & 3); GAS unsigned long long* ol = (GAS unsigned long long*)(HN + ((size_t)M + m) * DM) + lane + 64 * (j & 3);
                const f32x4 g = *((const f32x4*)g_ffn + lane + 64 * (j & 3)); const f32x4 y = {v[j].x * rstd * g.x, v[j].y * rstd * g.y, v[j].z * rstd * g.z, v[j].w * rstd * g.w};
                const unsigned h0 = f2bf(y.x), h1 = f2bf(y.y), h2 = f2bf(y.z), h3 = f2bf(y.w);
                *oh = (unsigned long long)(h0 | (h1 << 16)) | ((unsigned long long)(h2 | (h3 << 16)) << 32);
                *ol = (unsigned long long)pk2(y.x - bf2f((unsigned short)h0), y.y - bf2f((unsigned short)h1)) | ((unsigned long long)pk2(y.z - bf2f((unsigned short)h2), y.w - bf2f((unsigned short)h3)) << 32); }
        }
    }
    SEAM(7);
    if (IN(8)) for (int rep_ = 0; rep_ < ((MK_REPEAT == 8) ? 2 : 1); ++rep_) {
        pg8::Gemm g{HN, WR, 2 * M, 256, 1024}; pg8::StaticOrder S; S.init(2 * M, 256, G, bx); EpiLg E{LG}; pg8::gemm_phase<EpiLg, pg8::StaticOrder, true, true>(L + RING_OFF, g, S, E);
    }
    SEAM(8);
    if (IN(9)) for (int rep_ = 0; rep_ < ((MK_REPEAT == 9) ? 2 : 1); ++rep_) {
        LAS unsigned* lc = (LAS unsigned*)(L + TP_OFF + 256);
        const int per = (M + G - 1) / G;
        for (int t0 = vcu * per; t0 < min(M, (vcu + 1) * per); t0 += NWAVES * 64) {
        if (tid < 64) lc[tid] = 0u;
        __syncthreads();
        const int t = t0 + tid; const bool act = (t < min(M, (vcu + 1) * per));
        int x0 = 0, x1 = 0; unsigned s0 = 0, s1 = 0; float w0 = 0.f, w1 = 0.f;
        if (act) {
            float lg[36];
            const float* a = LG + (size_t)t * 128; const float* b2 = LG + (size_t)(M + t) * 128;
#pragma unroll
            for (int q = 0; q < 9; ++q) { const f32x4 p0 = *(const f32x4*)(a + 4 * q), p1 = *(const f32x4*)(a + 64 + 4 * q), p2 = *(const f32x4*)(b2 + 4 * q), p3 = *(const f32x4*)(b2 + 64 + 4 * q);
#pragma unroll
                for (int e = 0; e < 4; ++e) lg[4 * q + e] = (p0[e] + p1[e]) + (p2[e] + p3[e]); }
#pragma unroll
            for (int j = 0; j < 4; ++j) lg[j] += b_group[j];
#pragma unroll
            for (int j = 0; j < 32; ++j) lg[4 + j] += b_router[j];
            int gi = 0; float gm = lg[0];
#pragma unroll
            for (int j = 1; j < 4; ++j) if (lg[j] > gm) { gm = lg[j]; gi = j; }
            float gs = 0.f;
#pragma unroll
            for (int j = 0; j < 4; ++j) gs += __expf(lg[j] - gm);
            const float gp = 1.f / gs;
            float sel[8];
#pragma unroll
            for (int e = 0; e < 8; ++e) sel[e] = gi == 0 ? lg[4 + e] : gi == 1 ? lg[12 + e] : gi == 2 ? lg[20 + e] : lg[28 + e];
            int e0 = 0; float m0 = sel[0];
#pragma unroll
            for (int e = 1; e < 8; ++e) if (sel[e] > m0) { m0 = sel[e]; e0 = e; }
            int e1 = -1; float m1 = -INFINITY;
#pragma unroll
            for (int e = 0; e < 8; ++e) if (e != e0 && sel[e] > m1) { m1 = sel[e]; e1 = e; }
            const float r = __expf(m1 - m0); w0 = gp / (1.f + r); w1 = gp * r / (1.f + r);
            x0 = gi * 8 + e0; x1 = gi * 8 + e1;
            s0 = __hip_atomic_fetch_add(lc + x0, 1u, __ATOMIC_RELAXED, __HIP_MEMORY_SCOPE_WORKGROUP); s1 = __hip_atomic_fetch_add(lc + x1, 1u, __ATOMIC_RELAXED, __HIP_MEMORY_SCOPE_WORKGROUP);
        }
        __syncthreads();
        if (tid < NEXP) { const unsigned c = lc[tid]; lc[32 + tid] = c ? __hip_atomic_fetch_add(ctl + CW_CNT + 64 * tid, c, RLX_AGENT) : 0u; }
        __syncthreads();
        if (act) { EID[2 * t] = x0; EID[2 * t + 1] = x1; SLOT[2 * t] = (int)(lc[32 + x0] + s0); SLOT[2 * t + 1] = (int)(lc[32 + x1] + s1); WGT[2 * t] = w0; WGT[2 * t + 1] = w1; }
        __syncthreads();
        }
    }
    SEAM(9);
    if (IN(10)) for (int rep_ = 0; rep_ < ((MK_REPEAT == 10) ? 2 : 1); ++rep_) {
        LAS unsigned* tp = (LAS unsigned*)(L + TP_OFF);
        if (tid == 0) { unsigned acc = 0; for (int e = 0; e < NEXP; ++e) { tp[e] = acc; acc += (__hip_atomic_load(ctl + CW_CNT + 64 * e, RLX_AGENT) + 255u) >> 8; } tp[NEXP] = acc;
            if (bx == 0) for (int e = 0; e <= NEXP; ++e) __hip_atomic_store(ctl + CW_TPRE + e, tp[e], RLX_AGENT); }
        __syncthreads();
        int* const IDX = (int*)(ws + WS_WROW + 512 * 1024);
        for (int m = vcu * NWAVES * 64 + tid; m < M; m += G * NWAVES * 64) {
            const int x0 = EID[2 * m], x1 = EID[2 * m + 1]; const int p0 = (int)tp[x0] * 256 + SLOT[2 * m], p1 = (int)tp[x1] * 256 + SLOT[2 * m + 1];
            POS[2 * m] = p0; POS[2 * m + 1] = p1; WROW[p0] = WGT[2 * m]; WROW[p1] = WGT[2 * m + 1]; IDX[p0] = m; IDX[p1] = m;
        }
        for (int e = vcu; e < NEXP; e += G) { const int r0 = (int)tp[e] * 256 + (int)__hip_atomic_load(ctl + CW_CNT + 64 * e, RLX_AGENT), r1 = (int)tp[e + 1] * 256;
            for (int r = r0 + tid; r < r1; r += NWAVES * 64) IDX[r] = 0; }
        __syncthreads();
    }
    SEAM(10);
    if (IN(11)) for (int rep_ = 0; rep_ < ((MK_REPEAT == 11) ? 2 : 1); ++rep_) {
        LAS unsigned* tp = (LAS unsigned*)(L + TP_OFF); if (tid <= NEXP) tp[tid] = __hip_atomic_load(ctl + CW_TPRE + tid, RLX_AGENT); __syncthreads();
        pg8::Gemm g{HN, WGU, XG_ROWS, NEXP * 512, 1024, (const int*)(ws + WS_WROW + 512 * 1024)}; ExpertOrder S{tp, 2, G, bx}; EpiGU E{ACT};
        pg8::gemm_phase<EpiGU, ExpertOrder, true, true, true>(L + RING_OFF, g, S, E);
    }
    SEAM(11);
    if (IN(12)) for (int rep_ = 0; rep_ < ((MK_REPEAT == 12) ? 2 : 1); ++rep_) {
        LAS unsigned* tp = (LAS unsigned*)(L + TP_OFF); if (tid <= NEXP) tp[tid] = __hip_atomic_load(ctl + CW_TPRE + tid, RLX_AGENT); __syncthreads();
        pg8::Gemm g{ACT, WDN, XG_ROWS, NEXP * 1024, 256}; ExpertOrder S{tp, 4, G, bx}; EpiDown E{YB, WROW};
        pg8::gemm_phase<EpiDown, ExpertOrder, true, true>(L + RING_OFF, g, S, E);
    }
    SEAM(12);
    if (IN(13)) for (int rep_ = 0; rep_ < ((MK_REPEAT == 13) ? 2 : 1); ++rep_) {
        for (int m = gw; m < M; m += NGW) {
            const int p0 = POS[2 * m], p1 = POS[2 * m + 1];
            const GAS f32x4* xr = (const GAS f32x4*)(x + (size_t)m * DM) + lane; const v2u* yr = (const v2u*)(YM + (size_t)m * DM) + lane;
            const v2u* y0 = (const v2u*)(YB + (size_t)p0 * DM) + lane; const v2u* y1 = (const v2u*)(YB + (size_t)p1 * DM) + lane;
            f32x4 v[4]; v2u ya[4], yb[4], yc[4]; float s2 = 0.f;
#pragma unroll
            for (int j = 0; j < 4; ++j) { v[j] = xr[64 * j]; ya[j] = yr[64 * j]; yb[j] = y0[64 * j]; yc[j] = y1[64 * j]; }
#pragma unroll
            for (int j = 0; j < 4; ++j) {
                v[j].x += bflo(ya[j].x) + (bflo(yb[j].x) + bflo(yc[j].x)); v[j].y += bfhi(ya[j].x) + (bfhi(yb[j].x) + bfhi(yc[j].x)); v[j].z += bflo(ya[j].y) + (bflo(yb[j].y) + bflo(yc[j].y)); v[j].w += bfhi(ya[j].y) + (bfhi(yb[j].y) + bfhi(yc[j].y));
                s2 += (v[j].x * v[j].x + v[j].y * v[j].y) + (v[j].z * v[j].z + v[j].w * v[j].w); }
            const float rstd = 1.f / sqrtf(wave_sum(s2) * (1.f / DM) + EPS);
            GAS f32x4* orow = (GAS f32x4*)(out + (size_t)m * DM) + lane;
#pragma unroll
            for (int j = 0; j < 4; ++j) { const f32x4 g = *((const f32x4*)g_final + lane + 64 * j); orow[64 * j] = (f32x4){v[j].x * rstd * g.x, v[j].y * rstd * g.y, v[j].z * rstd * g.z, v[j].w * rstd * g.w}; }
        }
    }
#undef IN
#undef SEAM
}

extern "C" void kernel_launch(void* const* d_in, const int* in_sizes, int n_in, void* d_out, int out_size, void* d_ws, size_t ws_size, hipStream_t stream) {
    static int grid = 0;
    if (grid == 0) {
        if (n_in != 22 || in_sizes[0] != M * DM || out_size != M * DM || ws_size < WS_END) { fprintf(stderr, "kernel_launch: unexpected shapes (n_in %d, in0 %d, out %d, ws %zu); nothing launched\n", n_in, n_in > 0 ? in_sizes[0] : -1, out_size, ws_size); grid = -1; return; }
        int dev = 0, cus = 0, per_cu = 0;
        if (hipGetDevice(&dev) != hipSuccess || hipDeviceGetAttribute(&cus, hipDeviceAttributeMultiprocessorCount, dev) != hipSuccess) { grid = -1; return; }
        if (hipFuncSetAttribute((const void*)mk_fwd, hipFuncAttributeMaxDynamicSharedMemorySize, LDS_BYTES) != hipSuccess) { fprintf(stderr, "kernel_launch: hipFuncSetAttribute failed\n"); grid = -1; return; }
        if (hipOccupancyMaxActiveBlocksPerMultiprocessor(&per_cu, (const void*)mk_fwd, NWAVES * 64, LDS_BYTES) != hipSuccess || per_cu < 1) { fprintf(stderr, "kernel_launch: occupancy query says %d blocks/CU\n", per_cu); per_cu = 1; }
        (void)hipGetLastError();
        grid = cus;
    }
    if (grid < 0) return;
    if (hipMemsetAsync((char*)d_ws + WS_CTL, 0, CTL_ZERO_BYTES, stream) != hipSuccess) { fprintf(stderr, "kernel_launch: memset failed\n"); return; }
    Args a{};
    for (int i = 0; i < 22; ++i) a.in[i] = (const float*)d_in[i];
    a.out = (float*)d_out; a.ws = (unsigned char*)d_ws;
#if MK_PER_PHASE
#ifndef MK_REPEAT_L
#define MK_REPEAT_L -1
#endif
    for (int p = 0; p < N_PHASES; ++p) { a.ph_lo = p; a.ph_hi = p + 1; hipLaunchKernelGGL(mk_fwd, dim3(grid), dim3(NWAVES * 64), LDS_BYTES, stream, a);
        if (p == MK_REPEAT_L) hipLaunchKernelGGL(mk_fwd, dim3(grid), dim3(NWAVES * 64), LDS_BYTES, stream, a); }
#else
#ifndef MK_PREFIX
#define MK_PREFIX -1
#endif
    void* kargs[] = {&a};
    if (MK_PREFIX >= 0) {
        a.ph_lo = 0; a.ph_hi = MK_PREFIX + 1;
        (void)hipLaunchCooperativeKernel((const void*)mk_fwd, dim3(grid), dim3(NWAVES * 64), kargs, LDS_BYTES, stream);
        (void)hipMemsetAsync((char*)d_ws + WS_CTL, 0, CTL_ZERO_BYTES, stream);
    }
    a.ph_lo = 0; a.ph_hi = N_PHASES;
    hipError_t e = hipLaunchCooperativeKernel((const void*)mk_fwd, dim3(grid), dim3(NWAVES * 64), kargs, LDS_BYTES, stream);
    if (e != hipSuccess) fprintf(stderr, "kernel_launch: cooperative launch failed: %s (grid %d)\n", hipGetErrorString(e), grid);
#endif
}
```

```cpp
#include <hip/hip_runtime.h>
#include <hip/hip_bf16.h>
#include <hip/hip_cooperative_groups.h>
#include <cstdio>
#include <cstdint>
#include <cmath>
namespace pg8 {
#define PG8_LAS __attribute__((address_space(3)))
typedef unsigned short bf16_t;
typedef short bf16x8 __attribute__((ext_vector_type(8)));
typedef float f32x4 __attribute__((ext_vector_type(4)));
typedef unsigned u32x4 __attribute__((ext_vector_type(4)));
constexpr int BM = 256, BK = 64, HALF = 128, HTB = HALF * BK * 2  , STAGE_BYTES = 8 * HTB, NXCD = 8, WGM = 8;

__host__ __device__ __forceinline__ int lds_byte(int r, int c) { const int st = (r >> 4) * 2 + (c >> 5), rr = r & 15, cc = c & 31, ob = rr * 64 + cc * 2; return st * 1024 + (ob ^ (((ob >> 9) & 1) << 5)); }
__host__ __device__ __forceinline__ void stage_rc(int b, int& R, int& C) { const int st = b / 1024, sb = b % 1024, swz = sb ^ (((sb >> 9) & 1) << 5); R = (st >> 1) * 16 + swz / 64; C = (st & 1) * 32 + (swz % 64) / 2; }
__host__ __device__ __forceinline__ int perm32(int rho) { const int n = rho >> 4, i = rho & 15; return 8 * (i >> 2) + 4 * n + (i & 3); }

struct Unit { int pm, pn; };
struct Gemm { const bf16_t* A; const bf16_t* Bt; int M, N, K; const int* ridx = nullptr; };

struct StaticOrder {
    int nM, nN, nwg, G, c;
    __host__ __device__ void init(int M, int N, int G_, int c_) { nM = M / BM; nN = N / BM; nwg = nM * nN; G = G_; c = c_; }
    __host__ __device__ bool next(int i, Unit& u) const {
        const long L = (long)i * G + c; if (L >= nwg) return false;
        int wgid = (int)L; { const int q = nwg / NXCD, r = nwg % NXCD, xcd = wgid % NXCD, off = wgid / NXCD; wgid = (xcd < r ? xcd * (q + 1) : r * (q + 1) + (xcd - r) * q) + off; }
        const int nig = WGM * nN, gid = wgid / nig, fm = gid * WGM, gsz = (nM - fm) < WGM ? (nM - fm) : WGM;
        u.pm = fm + ((wgid % nig) % gsz); u.pn = (wgid % nig) / gsz; return true;
    }
    __device__ __forceinline__ void a_ready(const Unit&) const {}
    __device__ __forceinline__ void done(const Unit&) const {}
};

__device__ __forceinline__ unsigned cvt_pk_bf16(float lo, float hi) { unsigned r; asm volatile("v_cvt_pk_bf16_f32 %0, %1, %2" : "=v"(r) : "v"(lo), "v"(hi)); return r; }
typedef float f32x2 __attribute__((ext_vector_type(2)));
template <class Epi, class Sched, bool ALIGN_EPI = false, bool SP2 = false, bool GATHER = false>
__device__ __forceinline__ void gemm_phase(PG8_LAS unsigned char* lds, const Gemm g, const Sched& S, const Epi& E) {
    const int tid = threadIdx.x, wid = __builtin_amdgcn_readfirstlane(tid >> 6), lane = tid & 63, wr = wid >> 2, wc = wid & 3, fr = lane & 15, fq = lane >> 4;
    const int K = g.K; int nt = K / BK; asm volatile("" : "+s"(nt));
    unsigned voffA[2], voffB0[2], voffB1[2];
#pragma unroll
    for (int i = 0; i < 2; ++i) { int R, C; stage_rc(tid * 16 + i * 8192, R, C); const int Rb = Epi::PERM ? ((R & ~31) + perm32(R & 31)) : R;
        voffA[i] = (unsigned)(R * K + C) * 2u;
        if (Epi::PERM) { const int rb0 = 64 * (R >> 5) + perm32(R & 31); voffB0[i] = (unsigned)(rb0 * K + C) * 2u; voffB1[i] = (unsigned)((rb0 + 32) * K + C) * 2u; }
        else { voffB0[i] = (unsigned)(Rb * K + C) * 2u; voffB1[i] = (unsigned)((Rb + HALF) * K + C) * 2u; } }
    unsigned vA0[2] = {0u, 0u}, vA1[2] = {0u, 0u}, nA0[2] = {0u, 0u}, nA1[2] = {0u, 0u}; int gR[2] = {0, 0}; unsigned gC[2] = {0u, 0u};
    if constexpr (GATHER) { static_assert(SP2, "GATHER is implemented for the SP2 loop only");
#pragma unroll
        for (int i = 0; i < 2; ++i) { int R, C; stage_rc(tid * 16 + i * 8192, R, C); gR[i] = R; gC[i] = (unsigned)C * 2u; } }
#define PG8_GOFF(pm_, o0, o1) do { _Pragma("unroll") for (int _i = 0; _i < 2; ++_i) { \
        o0[_i] = (unsigned)g.ridx[(size_t)(pm_) * BM + gR[_i]] * (unsigned)(K * 2) + gC[_i]; o1[_i] = (unsigned)g.ridx[(size_t)(pm_) * BM + HALF + gR[_i]] * (unsigned)(K * 2) + gC[_i]; } } while (0)
    const size_t kstep = (size_t)(BK * 2);
    const size_t hstep = (size_t)HALF * K * 2;
    const size_t tstep = 2 * hstep;
    const unsigned ldsw = (unsigned)wid * 1024u;
    const int aoff = lds_byte(wr * 64 + fr, fq * 8), boff = lds_byte(wc * 32 + fr, fq * 8);
#define PG8_SA(b, h) (((b) * 2 + (h)) * HTB)
#define PG8_SB(b, h) ((4 + (b) * 2 + (h)) * HTB)
#define PG8_STAGE(bufoff, gbase, voff) do { _Pragma("unroll") for (int _i = 0; _i < 2; ++_i) \
        __builtin_amdgcn_global_load_lds((const unsigned*)((const char*)(gbase) + (voff)[_i]), (PG8_LAS unsigned*)(lds + (bufoff) + ldsw + _i * 8192), 16, 0, 0); } while (0)
#define PG8_LDA(dst, b, h) do { _Pragma("unroll") for (int m = 0; m < 4; ++m) _Pragma("unroll") for (int k = 0; k < 2; ++k) dst[m][k] = *(const PG8_LAS bf16x8*)(lds + PG8_SA(b, h) + aoff + m * 2048 + k * 1024); } while (0)
#define PG8_LDB(dst, b, h) do { _Pragma("unroll") for (int n = 0; n < 2; ++n) _Pragma("unroll") for (int k = 0; k < 2; ++k) dst[n][k] = *(const PG8_LAS bf16x8*)(lds + PG8_SB(b, h) + boff + n * 2048 + k * 1024); } while (0)
#define PG8_MMA(ai, bj, At, Bt) do { __builtin_amdgcn_s_setprio(1); _Pragma("unroll") for (int m = 0; m < 4; ++m) _Pragma("unroll") for (int n = 0; n < 2; ++n) _Pragma("unroll") for (int k = 0; k < 2; ++k) \
        acc[ai][bj][m][n] = __builtin_amdgcn_mfma_f32_16x16x32_bf16(Bt[n][k], At[m][k], acc[ai][bj][m][n], 0, 0, 0); __builtin_amdgcn_s_setprio(0); } while (0)
#define PG8_WAIT_V(n) asm volatile("s_waitcnt vmcnt(" #n ")" ::: "memory")
#define PG8_WAIT_L(n) asm volatile("s_waitcnt lgkmcnt(" #n ")" ::: "memory")
#define PG8_BAR __builtin_amdgcn_s_barrier()
#define PG8_SCHED __builtin_amdgcn_sched_barrier(0)
    Unit cur, nxt; int ui = 0;
    if (!S.next(0, cur)) return;
    f32x4 acc[2][2][4][2];
#pragma unroll
    for (int a = 0; a < 2; ++a)
#pragma unroll
        for (int b = 0; b < 2; ++b)
#pragma unroll
            for (int m = 0; m < 4; ++m)
#pragma unroll
                for (int n = 0; n < 2; ++n) acc[a][b][m][n] = (f32x4){0.f, 0.f, 0.f, 0.f};
    bf16x8 At[4][2], B0[2][2], B1[2][2];
    const char* cA = (const char*)g.A + (GATHER ? (size_t)0 : (size_t)cur.pm * tstep); const char* cB = (const char*)g.Bt + (size_t)cur.pn * tstep;
    if constexpr (GATHER) { PG8_GOFF(cur.pm, vA0, vA1); nA0[0] = vA0[0]; nA0[1] = vA0[1]; nA1[0] = vA1[0]; nA1[1] = vA1[1]; }
    S.a_ready(cur);
    if constexpr (SP2) {
        PG8_STAGE(PG8_SB(0, 0), cB, voffB0); PG8_STAGE(PG8_SB(0, 1), cB, voffB1);
        if constexpr (GATHER) { PG8_STAGE(PG8_SA(0, 0), cA, vA0); PG8_STAGE(PG8_SA(0, 1), cA, vA1); } else { PG8_STAGE(PG8_SA(0, 0), cA, voffA); PG8_STAGE(PG8_SA(0, 1), cA + hstep, voffA); }
        if (wr == 1) PG8_BAR;
        PG8_WAIT_V(2); PG8_BAR;
        PG8_STAGE(PG8_SB(1, 0), cB + kstep, voffB0); if constexpr (GATHER) { PG8_STAGE(PG8_SA(1, 0), cA + kstep, vA0); } else { PG8_STAGE(PG8_SA(1, 0), cA + kstep, voffA); } PG8_STAGE(PG8_SB(1, 1), cB + kstep, voffB1);
        PG8_WAIT_V(6); PG8_BAR;
    } else {
        PG8_STAGE(PG8_SB(0, 0), cB, voffB0); PG8_STAGE(PG8_SA(0, 0), cA, voffA); PG8_STAGE(PG8_SB(0, 1), cB, voffB1); PG8_STAGE(PG8_SA(0, 1), cA + hstep, voffA);
        if (wr == 1) PG8_BAR;
        PG8_WAIT_V(4); PG8_BAR;
        PG8_STAGE(PG8_SB(1, 0), cB + kstep, voffB0); PG8_STAGE(PG8_SA(1, 0), cA + kstep, voffA); PG8_STAGE(PG8_SB(1, 1), cB + kstep, voffB1);
        PG8_WAIT_V(6); PG8_BAR;
    }
    for (;;) {
        const bool has_next = S.next(ui + 1, nxt);
        const char* nA = (has_next && !GATHER) ? (const char*)g.A + (size_t)nxt.pm * tstep : cA; const char* nB = has_next ? (const char*)g.Bt + (size_t)nxt.pn * tstep : cB;
        for (int t = 0; t < nt; t += 2) {
            if constexpr (Epi::MID) { if (t == (nt >> 1)) E.mid(acc, cur, wr, wc, fr, fq); }
            const bool last = (t == nt - 2);
            const char* a1 = cA + (size_t)(t + 1) * kstep;
            const char* a2 = last ? nA : cA + (size_t)(t + 2) * kstep; const char* b2 = last ? nB : cB + (size_t)(t + 2) * kstep;
            const char* a3 = a2 + kstep; const char* b3 = b2 + kstep;
            if (last && has_next) S.a_ready(nxt);
            unsigned sA0[2] = {0u, 0u}, sA1[2] = {0u, 0u};
            if constexpr (GATHER) { if (t + 4 == nt && has_next) PG8_GOFF(nxt.pm, nA0, nA1);
                sA0[0] = last ? nA0[0] : vA0[0]; sA0[1] = last ? nA0[1] : vA0[1]; sA1[0] = last ? nA1[0] : vA1[0]; sA1[1] = last ? nA1[1] : vA1[1]; }
            if constexpr (SP2) {
            PG8_LDB(B0, 0, 0); PG8_LDB(B1, 0, 1); PG8_SCHED; PG8_LDA(At, 0, 0); if constexpr (GATHER) { PG8_STAGE(PG8_SA(1, 1), a1, vA1); } else { PG8_STAGE(PG8_SA(1, 1), a1 + hstep, voffA); }
            PG8_WAIT_V(8); PG8_WAIT_L(0); PG8_BAR; PG8_MMA(0, 0, At, B0); PG8_MMA(0, 1, At, B1); PG8_BAR; PG8_SCHED;
            PG8_LDA(At, 0, 1); PG8_STAGE(PG8_SB(0, 0), b2, voffB0); PG8_STAGE(PG8_SB(0, 1), b2, voffB1); if constexpr (GATHER) { PG8_STAGE(PG8_SA(0, 0), a2, sA0); } else { PG8_STAGE(PG8_SA(0, 0), a2, voffA); }
            PG8_WAIT_V(8); PG8_WAIT_L(0); PG8_BAR; PG8_MMA(1, 0, At, B0); PG8_MMA(1, 1, At, B1); PG8_BAR; PG8_SCHED;
            PG8_LDB(B0, 1, 0); PG8_LDB(B1, 1, 1); PG8_SCHED; PG8_LDA(At, 1, 0); if constexpr (GATHER) { PG8_STAGE(PG8_SA(0, 1), a2, sA1); } else { PG8_STAGE(PG8_SA(0, 1), a2 + hstep, voffA); }
            PG8_WAIT_V(8); PG8_WAIT_L(0); PG8_BAR; PG8_MMA(0, 0, At, B0); PG8_MMA(0, 1, At, B1); PG8_BAR; PG8_SCHED;
            PG8_LDA(At, 1, 1); PG8_STAGE(PG8_SB(1, 0), b3, voffB0); PG8_STAGE(PG8_SB(1, 1), b3, voffB1); if constexpr (GATHER) { PG8_STAGE(PG8_SA(1, 0), a3, sA0); } else { PG8_STAGE(PG8_SA(1, 0), a3, voffA); }
            PG8_WAIT_V(8); PG8_WAIT_L(0); PG8_BAR; PG8_MMA(1, 0, At, B0); PG8_MMA(1, 1, At, B1); PG8_BAR; PG8_SCHED;
            } else {
            PG8_LDB(B0, 0, 0); PG8_SCHED; PG8_LDA(At, 0, 0); PG8_STAGE(PG8_SA(1, 1), a1 + hstep, voffA);
            PG8_WAIT_L(8); PG8_BAR; PG8_WAIT_L(0); PG8_MMA(0, 0, At, B0); PG8_BAR; PG8_SCHED;
            PG8_LDB(B1, 0, 1); PG8_STAGE(PG8_SB(0, 0), b2, voffB0);
            PG8_BAR; PG8_WAIT_L(0); PG8_MMA(0, 1, At, B1); PG8_BAR;
            PG8_LDA(At, 0, 1); PG8_STAGE(PG8_SA(0, 0), a2, voffA);
            PG8_BAR; PG8_WAIT_L(0); PG8_MMA(1, 0, At, B0); PG8_BAR; PG8_SCHED;
            PG8_STAGE(PG8_SB(0, 1), b2, voffB1);
            PG8_WAIT_V(6); PG8_BAR; PG8_MMA(1, 1, At, B1); PG8_BAR;
            PG8_LDB(B0, 1, 0); PG8_SCHED; PG8_LDA(At, 1, 0); PG8_STAGE(PG8_SA(0, 1), a2 + hstep, voffA);
            PG8_WAIT_L(8); PG8_BAR; PG8_WAIT_L(0); PG8_MMA(0, 0, At, B0); PG8_BAR; PG8_SCHED;
            PG8_LDB(B1, 1, 1); PG8_STAGE(PG8_SB(1, 0), b3, voffB0);
            PG8_BAR; PG8_WAIT_L(0); PG8_MMA(0, 1, At, B1); PG8_BAR;
            PG8_LDA(At, 1, 1); PG8_STAGE(PG8_SA(1, 0), a3, voffA);
            PG8_BAR; PG8_WAIT_L(0); PG8_MMA(1, 0, At, B0); PG8_BAR; PG8_SCHED;
            PG8_STAGE(PG8_SB(1, 1), b3, voffB1);
            PG8_WAIT_V(6); PG8_BAR; PG8_MMA(1, 1, At, B1); PG8_BAR;
            }
        }
        if constexpr (ALIGN_EPI) { if (wr == 0) PG8_BAR; }
        if constexpr (!Epi::AFTER_DRAIN) { E(acc, cur, wr, wc, fr, fq); S.done(cur); }
        if (!has_next) break;
#pragma unroll
        for (int a = 0; a < 2; ++a)
#pragma unroll
            for (int b = 0; b < 2; ++b)
#pragma unroll
                for (int m = 0; m < 4; ++m)
#pragma unroll
                    for (int n = 0; n < 2; ++n) acc[a][b][m][n] = (f32x4){0.f, 0.f, 0.f, 0.f};
        cur = nxt; cA = nA; cB = nB; ++ui;
        if constexpr (GATHER) { vA0[0] = nA0[0]; vA0[1] = nA0[1]; vA1[0] = nA1[0]; vA1[1] = nA1[1]; }
        if constexpr (ALIGN_EPI) { if (wr == 1) PG8_BAR; }
    }
    PG8_WAIT_V(0);
    if constexpr (!ALIGN_EPI) { if (wr == 0) PG8_BAR; }
    PG8_BAR;
    if constexpr (Epi::AFTER_DRAIN) { E.fused(acc, cur, wr, wc, fr, fq, lds, wid, lane); S.done(cur); }
#undef PG8_SA
#undef PG8_SB
#undef PG8_STAGE
#undef PG8_LDA
#undef PG8_LDB
#undef PG8_MMA
#undef PG8_WAIT_V
#undef PG8_WAIT_L
#undef PG8_BAR
#undef PG8_SCHED
#undef PG8_GOFF
}
}
namespace att {
typedef unsigned short bf16;
using bf16x8 = __attribute__((ext_vector_type(8))) short;
using s16x4 = __attribute__((ext_vector_type(4))) short;
using f32x16 = __attribute__((ext_vector_type(16))) float;
using u32x4 = __attribute__((ext_vector_type(4))) unsigned;
constexpr int SEQ = 4096, NW = 8, QB = 256, KVBLK = 64;
constexpr int KSLOT = 12288, VSLOT = 8192, NKS = 4, NVS = 4;
constexpr int LDS_K = 0, LDS_V = NKS * KSLOT, LDS_WS = LDS_V + NVS * VSLOT, LDS_OST = LDS_WS + NW * 256, LDS_BYTES = LDS_OST + NW * 4096;
constexpr float THR = 8.0f;
#define ATT_LAS __attribute__((address_space(3)))
#define SBAR() __builtin_amdgcn_sched_barrier(0)
#define WAIT_BAR(N) asm volatile("s_waitcnt vmcnt(" #N ") lgkmcnt(0)\n\ts_barrier" ::: "memory")
__device__ __forceinline__ int crow(int r, int hi) { return (r & 3) + 8 * (r >> 2) + 4 * hi; }
__device__ __forceinline__ void glds16(const void* gsrc, unsigned lds_dst) { unsigned keep;
  asm volatile("s_mov_b32 %0, m0\n\ts_mov_b32 m0, %2\n\ts_nop 0\n\tglobal_load_lds_dwordx4 %1, off\n\ts_mov_b32 m0, %0" : "=&s"(keep) : "v"(gsrc), "s"(lds_dst) : "memory"); }
typedef float f32x2_t __attribute__((ext_vector_type(2))); typedef __bf16 bf16x2_t __attribute__((ext_vector_type(2)));
__device__ __forceinline__ unsigned cvtpk_s(float lo, float hi) { f32x2_t v = {lo, hi}; bf16x2_t b = __builtin_convertvector(v, bf16x2_t); return __builtin_bit_cast(unsigned, b); }
typedef ATT_LAS const char* lds_cptr;
#define MX3(a, b, c) __builtin_fmaxf(__builtin_fmaxf((a), (b)), (c))
__device__ __forceinline__ float rowmax(const f32x16& p0, const f32x16& p1) {
  float a = MX3(p0[0], p0[1], p1[0]), b = MX3(p0[2], p0[3], p1[1]); a = MX3(a, p1[2], p1[3]);
#pragma unroll
  for (int r = 4; r < 16; r += 4) { a = MX3(a, p0[r], p0[r + 1]); b = MX3(b, p0[r + 2], p0[r + 3]); a = MX3(a, p1[r], p1[r + 1]); b = MX3(b, p1[r + 2], p1[r + 3]); }
  float m = __builtin_fmaxf(a, b); auto rr = __builtin_amdgcn_permlane32_swap(__float_as_uint(m), __float_as_uint(m), false, false);
  return __builtin_fmaxf(__uint_as_float(rr[0]), __uint_as_float(rr[1])); }
__device__ __forceinline__ void cmask(f32x16& p0, f32x16& p1, int jb, int qrel, int hi) {
  const int kb = 64 * jb + 4 * hi;
#pragma unroll
  for (int r = 0; r < 16; ++r) { const int kv = kb + (r & 3) + 8 * (r >> 2); if (kv > qrel) p0[r] = -INFINITY; if (kv + 32 > qrel) p1[r] = -INFINITY; } }
template <int D0A, int D0B> __device__ __forceinline__ void kload(bf16x8* kf, lds_cptr kp) {
#pragma unroll
  for (int d0 = D0A; d0 < D0B; ++d0) { kf[2 * (d0 - D0A)] = *(const ATT_LAS bf16x8*)(kp + d0 * 2048); kf[2 * (d0 - D0A) + 1] = *(const ATT_LAS bf16x8*)(kp + d0 * 2048 + 512); }
}
template <int ND0, int NPRE> __device__ __forceinline__ void qkt(f32x16& p0, f32x16& p1, const bf16x8* kf, const bf16x8* kt, const bf16x8* qr, const f32x16& negm) {
#pragma unroll
  for (int d0 = 0; d0 < ND0; ++d0) { const bf16x8 b0 = d0 < NPRE ? kf[2 * d0] : kt[2 * (d0 - NPRE)], b1 = d0 < NPRE ? kf[2 * d0 + 1] : kt[2 * (d0 - NPRE) + 1];
    if (d0 == 0) { p0 = __builtin_amdgcn_mfma_f32_32x32x16_bf16(b0, qr[0], negm, 0, 0, 0); p1 = __builtin_amdgcn_mfma_f32_32x32x16_bf16(b1, qr[0], negm, 0, 0, 0); }
    else { p0 = __builtin_amdgcn_mfma_f32_32x32x16_bf16(b0, qr[d0], p0, 0, 0, 0); p1 = __builtin_amdgcn_mfma_f32_32x32x16_bf16(b1, qr[d0], p1, 0, 0, 0); } }
}
__device__ __forceinline__ void pv(f32x16* o, int vb, bf16x8 pa0, bf16x8 pa1, bf16x8 pa2, bf16x8 pa3) {
#pragma unroll
  for (int d0 = 0; d0 < 2; ++d0) { s16x4 lo[4], hi[4];
#pragma unroll
    for (int ks = 0; ks < 4; ++ks) {
      asm volatile("ds_read_b64_tr_b16 %0,%1 offset:%c2" : "=&v"(lo[ks]) : "v"(vb), "i"(d0 * 4096 + ks * 1024) : "memory");
      asm volatile("ds_read_b64_tr_b16 %0,%1 offset:%c2" : "=&v"(hi[ks]) : "v"(vb), "i"(d0 * 4096 + ks * 1024 + 512) : "memory"); }
    asm volatile("s_waitcnt lgkmcnt(0)" ::: "memory"); SBAR();
#define PK(k) (bf16x8){lo[k][0], lo[k][1], lo[k][2], lo[k][3], hi[k][0], hi[k][1], hi[k][2], hi[k][3]}
    o[d0] = __builtin_amdgcn_mfma_f32_32x32x16_bf16(pa0, PK(0), o[d0], 0, 0, 0);
    o[d0] = __builtin_amdgcn_mfma_f32_32x32x16_bf16(pa1, PK(1), o[d0], 0, 0, 0);
    o[d0] = __builtin_amdgcn_mfma_f32_32x32x16_bf16(pa2, PK(2), o[d0], 0, 0, 0);
    o[d0] = __builtin_amdgcn_mfma_f32_32x32x16_bf16(pa3, PK(3), o[d0], 0, 0, 0);
#undef PK
  }
}
struct AttnT { const bf16* Q; const bf16* K; const bf16* KR; const bf16* V; bf16* O; const float* CS; const float* GB; const unsigned* QKM; const bf16* ZERO; const float* QN2; const float* DG; };
template <int KIND, int ABL = 0> __device__ __forceinline__ void attn_unit(int b, int h, int qb, const AttnT& T, char* shm) {
#ifndef ATT_NPRE0
#define ATT_NPRE0 2
#endif
#ifndef ATT_NPRE1
#define ATT_NPRE1 3
#endif
  constexpr int NPRE = KIND == 0 ? ATT_NPRE0 : ATT_NPRE1;
  constexpr int ND0 = KIND == 0 ? 6 : 5, QP = KIND == 0 ? 768 : 512, HD = KIND == 0 ? 96 : 64;
  const int tid = threadIdx.x, lane = tid & 63, r32 = lane & 31, hi = lane >> 5; const int wid = __builtin_amdgcn_readfirstlane(tid >> 6);
  const long rowbase = (long)b * SEQ; const int q0 = qb * QB;
  const bf16* Qw = T.Q + (rowbase + q0 + wid * 32) * QP + h * HD;
  const unsigned lds0 = (unsigned)(uintptr_t)shm;
  const lds_cptr shm3 = (lds_cptr)shm;
  ATT_LAS float* wsf = (ATT_LAS float*)(shm3 + LDS_WS) + wid * 64;
  const bf16 *ksrcA, *ksrcB; long kstepA, kstepB; unsigned kdstB;
  const unsigned kdstA = lds0 + LDS_K + wid * 1024;
  if (KIND == 0) { ksrcA = T.K + (rowbase + lane) * 512 + h * 64 + wid * 8; ksrcB = T.KR + (rowbase + lane) * 32 + (wid & 3) * 8; kdstB = lds0 + LDS_K + (8 + (wid & 3)) * 1024; kstepA = 64 * 512; kstepB = 64 * 32; }
  else { ksrcA = T.K + (rowbase + lane) * 512 + h * 64 + wid * 8;
    ksrcB = (wid & 1) ? T.ZERO : T.KR + ((long)h * (8 * SEQ) + rowbase + lane) * 8; kdstB = lds0 + LDS_K + (8 + (wid & 1)) * 1024; kstepA = 64 * 512; kstepB = (wid & 1) ? 0 : 64 * 8; }
  const bf16* vsrc = T.V + (rowbase + 16 * (wid & 3) + (lane >> 2)) * 512 + h * 64 + (wid >> 2) * 32 + (lane & 3) * 8;
  const unsigned vdst = lds0 + LDS_V + wid * 1024;
#define DMA_K(t, s) do { glds16(ksrcA + (long)(t) * kstepA, (unsigned)__builtin_amdgcn_readfirstlane(kdstA + (s) * KSLOT)); \
                         glds16(ksrcB + (long)(t) * kstepB, (unsigned)__builtin_amdgcn_readfirstlane(kdstB + (s) * KSLOT)); } while (0)
#define DMA_V(t, s) do { glds16(vsrc + (long)(t) * (64 * 512), (unsigned)__builtin_amdgcn_readfirstlane(vdst + (s) * VSLOT)); } while (0)
  const int vb0 = (int)(lds0 + LDS_V) + ((lane >> 4) & 1) * 32 + (lane & 3) * 8 + (4 * hi + ((lane & 15) >> 2)) * 64;
  const lds_cptr kp0 = shm3 + LDS_K + hi * 1024 + r32 * 16;
  const int NT = (q0 + QB) / KVBLK;
  int tb = 0;
  if (KIND == 1) {
    const float kmax = __uint_as_float(T.QKM[2 * (b * 8 + h) + 1]) * 1.01f;
    const float* gbh = T.GB + (long)h * (8 * SEQ) + rowbase; const float* qn2 = T.QN2 + (long)h * (8 * SEQ) + rowbase; const float* dg = T.DG + (long)h * (8 * SEQ) + rowbase;
    float rm_ = -3.0e38f;
#pragma unroll
    for (int j = 0; j < 4; ++j) { const int i = q0 + lane + 64 * j; rm_ = __builtin_fmaxf(rm_, sqrtf(qn2[i]) * kmax - gbh[i] - dg[i]); }
#pragma unroll
    for (int o = 1; o < 64; o <<= 1) rm_ = __builtin_fmaxf(rm_, __shfl_xor(rm_, o));
    const float ge = (lane < 4 * qb) ? gbh[64 * lane + 63] : 3.0e38f;
    const unsigned long long bal = __ballot(rm_ + ge + 0.5f >= -40.f);
    tb = __builtin_amdgcn_readfirstlane((int)__builtin_ctzll(bal));
  }
  DMA_K(tb, 0); DMA_V(tb, 0); DMA_K(tb + 1, 1); DMA_V(tb + 1, 1); DMA_K(tb + 2, 2);
  bf16x8 qr[ND0];
#pragma unroll
  for (int d0 = 0; d0 < (KIND == 0 ? ND0 : 4); ++d0) qr[d0] = *reinterpret_cast<const bf16x8*>(&Qw[(long)r32 * QP + d0 * 16 + hi * 8]);
  if (KIND == 1) { const short one = (short)0x3F80; qr[4] = hi ? (bf16x8){0, 0, 0, 0, 0, 0, 0, 0} : (bf16x8){one, one, one, 0, 0, 0, 0, 0}; }
  if (KIND == 0) {
    const float* cs = T.CS + (rowbase + q0 + wid * 32 + r32) * 32 + 16 * hi;
    typedef float f32x4_t __attribute__((ext_vector_type(4)));
    bf16x8 a = qr[4], c = qr[5];
#pragma unroll
    for (int j2 = 0; j2 < 4; ++j2) { const f32x4_t t4 = *(const f32x4_t*)(cs + 4 * j2);
#pragma unroll
      for (int e = 0; e < 2; ++e) { const int j = 2 * j2 + e; const float co = t4[2 * e], si = t4[2 * e + 1];
        const float x1 = __builtin_bit_cast(float, (unsigned)(unsigned short)a[j] << 16), x2 = __builtin_bit_cast(float, (unsigned)(unsigned short)c[j] << 16);
        const float o1 = x1 * co - x2 * si, o2 = x2 * co + x1 * si;
        qr[4][j] = (short)(cvtpk_s(o1, o1) & 0xffffu); qr[5][j] = (short)(cvtpk_s(o2, o2) & 0xffffu); } }
  }
  float mhat = 0.f, l_reg = 0.f; f32x16 o[2]; o[0] = f32x16{}; o[1] = f32x16{}; f32x16 negm = f32x16{};
  const int qrel = wid * 32 + r32;
  int ks_cur = 0, vs_cur = 0;
  bf16x8 kf[2 * NPRE];
  WAIT_BAR(6);
  kload<0, NPRE>(kf, kp0);
  u32x4 pw0 = {0u, 0u, 0u, 0u}, pw1 = pw0, pw2 = pw0, pw3 = pw0;
#ifndef ATT_STAG
#define ATT_STAG 0
#endif
  const bool grpB = (ATT_STAG == 1) ? (wid >= 4) : (ATT_STAG == 2) ? ((wid & 1) != 0) : false; bool pend = false; int vs_pend = 0;
  for (int t = tb; t < NT; ++t) {
    if (t + 2 < NT) { WAIT_BAR(3); } else if (t + 1 < NT) { WAIT_BAR(1); } else { WAIT_BAR(0); }
    const int ks1 = (ks_cur + 1) & 3, vs1 = (vs_cur + 1) & 3, vs2 = (vs_cur + 2) & 3;
    if (t + 2 < NT) { DMA_V(t + 2, vs2); }
    if (t + 3 < NT) { DMA_K(t + 3, ((ks_cur + 3) & 3)); }
    if (pend) { if (!(ABL & 1)) pv(o, vb0 + vs_pend * VSLOT, __builtin_bit_cast(bf16x8, pw0), __builtin_bit_cast(bf16x8, pw1), __builtin_bit_cast(bf16x8, pw2), __builtin_bit_cast(bf16x8, pw3)); pend = false; }
    const int jb = t - 4 * qb;
    const bool vis = (KIND == 0) ? (t <= 4 * qb + (wid >> 1)) : ((jb < 0) || (64 * jb <= 32 * wid + 31));
    f32x16 p0, p1;
    if (vis) {
      bf16x8 kt[2 * (ND0 - NPRE)]; kload<NPRE, ND0>(kt, kp0 + ks_cur * KSLOT);
      if (ABL & 4) { p0 = negm; p1 = negm; asm volatile("" : "+v"(p0), "+v"(p1)); } else qkt<ND0, NPRE>(p0, p1, kf, kt, qr, negm);
    }
    if (t + 1 < NT) kload<0, NPRE>(kf, kp0 + ks1 * KSLOT);
    if (vis) {
      if (KIND == 1) { if (jb >= 0) cmask(p0, p1, jb, qrel, hi); }
      const float rm = rowmax(p0, p1);
      if (t == tb || __any(rm > THR)) {
        const float dl = (t == tb) ? rm : __builtin_fmaxf(rm, 0.f);
        mhat += dl;
#pragma unroll
        for (int r = 0; r < 16; ++r) { p0[r] -= dl; p1[r] -= dl; negm[r] = -mhat; }
        const float f = __builtin_amdgcn_exp2f(-dl); l_reg *= f;
        if (t > tb) {
          if (hi == 0) wsf[r32] = f;
          asm volatile("s_waitcnt lgkmcnt(0)" ::: "memory");
#pragma unroll
          for (int d_ = 0; d_ < 2; ++d_)
#pragma unroll
            for (int r = 0; r < 16; ++r) o[d_][r] *= wsf[crow(r, hi)];
          asm volatile("s_waitcnt lgkmcnt(0)" ::: "memory");
        }
      }
      float sacc = 0.f;
#pragma unroll
      for (int r = 0; r < 16; ++r) { if (!(ABL & 2)) { p0[r] = __builtin_amdgcn_exp2f(p0[r]); p1[r] = __builtin_amdgcn_exp2f(p1[r]); } sacc += p0[r] + p1[r]; }
      l_reg += sacc;
#define PKW(P, B) cvtpk_s(P[B], P[B + 1])
      pw0 = (u32x4){PKW(p0, 0), PKW(p0, 2), PKW(p0, 4), PKW(p0, 6)}; pw1 = (u32x4){PKW(p0, 8), PKW(p0, 10), PKW(p0, 12), PKW(p0, 14)};
      pw2 = (u32x4){PKW(p1, 0), PKW(p1, 2), PKW(p1, 4), PKW(p1, 6)}; pw3 = (u32x4){PKW(p1, 8), PKW(p1, 10), PKW(p1, 12), PKW(p1, 14)};
#undef PKW
      SBAR();
      if (ABL & 1) { asm volatile("" :: "v"(pw0), "v"(pw1), "v"(pw2), "v"(pw3)); }
      else if (!grpB) pv(o, vb0 + vs_cur * VSLOT, __builtin_bit_cast(bf16x8, pw0), __builtin_bit_cast(bf16x8, pw1), __builtin_bit_cast(bf16x8, pw2), __builtin_bit_cast(bf16x8, pw3));
      else { pend = true; vs_pend = vs_cur; }
    }
    ks_cur = ks1; vs_cur = vs1;
  }
  if (pend && !(ABL & 1)) pv(o, vb0 + vs_pend * VSLOT, __builtin_bit_cast(bf16x8, pw0), __builtin_bit_cast(bf16x8, pw1), __builtin_bit_cast(bf16x8, pw2), __builtin_bit_cast(bf16x8, pw3));
  { auto rr = __builtin_amdgcn_permlane32_swap(__float_as_uint(l_reg), __float_as_uint(l_reg), false, false); l_reg = __uint_as_float(rr[0]) + __uint_as_float(rr[1]); }
  if (hi == 0) wsf[32 + r32] = l_reg;
  asm volatile("s_waitcnt lgkmcnt(0)" ::: "memory");
  float rli[16];
#pragma unroll
  for (int r = 0; r < 16; ++r) rli[r] = __builtin_amdgcn_rcpf(wsf[32 + crow(r, hi)]);
  bf16* Ow = T.O + (rowbase + q0 + wid * 32) * 1024 + h * 64;
  { ATT_LAS bf16* stg = (ATT_LAS bf16*)(shm3 + LDS_OST) + wid * 2048;
#pragma unroll
    for (int r = 0; r < 16; ++r) { const int orow = crow(r, hi);
#pragma unroll
      for (int d0 = 0; d0 < 2; ++d0) { const float v = o[d0][r] * rli[r]; stg[orow * 64 + d0 * 32 + r32] = (bf16)(cvtpk_s(v, v) & 0xffffu); } }
    asm volatile("s_waitcnt lgkmcnt(0)" ::: "memory");
#pragma unroll
    for (int i = 0; i < 4; ++i) { const int row = i * 8 + (lane >> 3), ch = lane & 7; const u32x4 v = *(const ATT_LAS u32x4*)(stg + row * 64 + ch * 8); *(u32x4*)(Ow + (long)row * 1024 + ch * 8) = v; } }
  asm volatile("s_waitcnt lgkmcnt(0)\n\ts_barrier" ::: "memory");
#undef DMA_K
#undef DMA_V
}
#undef SBAR
#undef WAIT_BAR
#undef MX3
}
#ifndef MK_PER_PHASE
#define MK_PER_PHASE 0
#endif
constexpr int NWAVES = 8;
constexpr int BATCH = 8, SEQ = 4096, DM = 1024, M = BATCH * SEQ;
constexpr int NIN = 4096;
constexpr int NEXP = 32, XG_ROWS = 2 * M + NEXP * 256;
constexpr float EPS = 1e-6f, LOG2E = 1.4426950408889634f;
constexpr float C2F = 0.125f * LOG2E;
constexpr float C2M = 0.10206207261596577f * LOG2E;
constexpr int N_PHASES = 14;
constexpr size_t MiB = 1u << 20;
constexpr size_t WS_CTL = 0, CTL_ZERO_BYTES = 1 * MiB;
constexpr size_t WS_WIN = 1 * MiB, WS_WUQ = 9 * MiB, WS_WUKV = 9 * MiB + 512 * 1024, WS_WOA = 10 * MiB, WS_WOB = 11 * MiB, WS_WOUT = 12 * MiB, WS_WR = 14 * MiB, WS_WGU = 15 * MiB, WS_WDN = 47 * MiB;
constexpr size_t WS_CS = 63 * MiB, WS_LOGF = 67 * MiB, WS_EID = 68 * MiB, WS_SLOT = WS_EID + 256 * 1024, WS_WGT = WS_SLOT + 256 * 1024, WS_POS = WS_WGT + 256 * 1024, WS_WROW = 69 * MiB;
constexpr size_t WS_XN = 72 * MiB, WS_CQN = 136 * MiB, WS_CKVN = 152 * MiB, WS_KRR = 160 * MiB  , WS_VM = 96 * MiB, WS_KR = 128 * MiB;
constexpr size_t WS_Z0 = 136 * MiB, WS_Z1 = 152 * MiB, WS_QF = 184 * MiB, WS_KF = 224 * MiB, WS_VF = 264 * MiB, WS_OA = 296 * MiB, WS_OB = 328 * MiB, WS_MIX = 360 * MiB, WS_QM = 424 * MiB, WS_KM = 472 * MiB;
constexpr size_t WS_HN = 72 * MiB, WS_LG = 200 * MiB, WS_XG = 232 * MiB, WS_ACT = 376 * MiB, WS_YB = 72 * MiB, WS_END = 504 * MiB;
static_assert(WS_XG + (size_t)XG_ROWS * 2048 <= WS_ACT && WS_ACT + (size_t)XG_ROWS * 512 <= WS_END && WS_YB + (size_t)XG_ROWS * 2048 <= WS_XG, "moe map");
constexpr int CW_CNT = 8192;
constexpr int CW_TPRE = 128;
constexpr int CW_QK = 256;
constexpr int CW_AQ = 512;
constexpr int CW_ZERO = 1024;
constexpr int CW_BAR = 4096;
constexpr int RING_OFF = 0, RING_BYTES = 131072, LDSCTL_OFF = RING_BYTES, MISC_OFF = LDSCTL_OFF + 320, TP_OFF = LDSCTL_OFF + 1024, LDS_BYTES = 147456;

#define GAS __attribute__((address_space(1)))
#define LAS __attribute__((address_space(3)))
typedef unsigned short bf16;
typedef unsigned v4u __attribute__((ext_vector_type(4)));
typedef float f32x4 __attribute__((ext_vector_type(4)));
typedef short bf16x8 __attribute__((ext_vector_type(8)));
typedef GAS unsigned gu32;
typedef GAS unsigned long long gu64;
#define RLX_AGENT __ATOMIC_RELAXED, __HIP_MEMORY_SCOPE_AGENT
#define LDS_WAIT() asm volatile("s_waitcnt lgkmcnt(0)" ::: "memory")
#define VM_WAIT() asm volatile("s_waitcnt vmcnt(0)" ::: "memory")
__device__ __forceinline__ unsigned long long rt() { return __builtin_amdgcn_s_memrealtime(); }
__device__ __forceinline__ unsigned f2bf(float f) { unsigned u = __builtin_bit_cast(unsigned, f); return (u + 0x7fffu + ((u >> 16) & 1u)) >> 16; }
__device__ __forceinline__ unsigned pk2(float lo, float hi) { return f2bf(lo) | (f2bf(hi) << 16); }


#define XB_TMO      128
#define XB_XCNT(j)  (256  + 64 * (j))
#define XB_XSUB(j)  (1280 + 64 * (j))
#define XB_XGEN(j)  (2304 + 64 * (j))
#define XB_TOP      3328
#define XB_TOPGEN   3392
#define XCD_BAR_WORDS 3456
#define XB_SPIN_CAP (1u << 18)

__device__ __forceinline__ unsigned xb_ld(unsigned* p)              { return __hip_atomic_load(p, __ATOMIC_RELAXED, __HIP_MEMORY_SCOPE_AGENT); }
__device__ __forceinline__ unsigned xb_add(unsigned* p, unsigned v) { return __hip_atomic_fetch_add(p, v, __ATOMIC_RELAXED, __HIP_MEMORY_SCOPE_AGENT); }
__device__ __forceinline__ unsigned xb_xcc_id() { return (unsigned)__builtin_amdgcn_s_getreg((3 << 11) | 20) & 0xFu; }
#define XB_SPIN(cond, bar) do { unsigned _sp = 0; while (cond) { __builtin_amdgcn_s_sleep(1); \
    if ((++_sp & 255u) == 0u) { if (xb_ld(&(bar)[XB_TMO])) break; if (_sp > XB_SPIN_CAP) { atomicAdd(&(bar)[XB_TMO], 1u); break; } } } } while (0)

struct XcdBarrier {
    unsigned* bar; unsigned x;
    volatile LAS unsigned* st;
};

__device__ __forceinline__ XcdBarrier xcd_barrier_post(unsigned* bar, volatile LAS unsigned* st) {
    XcdBarrier b; b.bar = bar; b.x = xb_xcc_id(); b.st = st;
    if (threadIdx.x == 0) (void)xb_add(&bar[XB_XCNT(b.x)], 1u);
    return b;
}
__device__ __forceinline__ void xcd_barrier_complete(unsigned* bar, unsigned x, unsigned& nloc, unsigned& nx) {
    const unsigned G = gridDim.x * gridDim.y * gridDim.z;
    unsigned sum, cnt, mine, sp = 0u;
    for (;;) {
        sum = 0u; cnt = 0u; mine = 0u;
#pragma unroll
        for (unsigned j = 0; j < 16; ++j) { const unsigned c = xb_ld(&bar[XB_XCNT(j)]); sum += c; cnt += (c > 0u) ? 1u : 0u; mine = (j == x) ? c : mine; }
        if (sum == G) break;
        __builtin_amdgcn_s_sleep(1);
        if ((++sp & 255u) == 0u) { if (xb_ld(&bar[XB_TMO])) break; if (sp > XB_SPIN_CAP) { atomicAdd(&bar[XB_TMO], 1u); break; } }
    }
    nloc = mine > 0u ? mine : 1u; nx = cnt > 0u ? cnt : 1u;
}

__device__ __forceinline__ void xcd_barrier(const XcdBarrier& b) {
    asm volatile("s_waitcnt vmcnt(0)" ::: "memory");
    __syncthreads();
    if (threadIdx.x == 0) {
        unsigned* bar = b.bar;
        __builtin_amdgcn_s_waitcnt(0);
        unsigned nloc = b.st[0], nx = b.st[1];
        if (nloc == 0u) { xcd_barrier_complete(bar, b.x, nloc, nx); b.st[0] = nloc; b.st[1] = nx; }
        const unsigned old = xb_add(&bar[XB_XSUB(b.x)], 1u);
        const unsigned gen = old / nloc;
        if (old + 1u == (gen + 1u) * nloc) {
            __builtin_amdgcn_fence(__ATOMIC_RELEASE, "agent");
            asm volatile("s_waitcnt vmcnt(0)" ::: "memory");
            const unsigned og = xb_add(&bar[XB_TOP], 1u);
            const unsigned tg = og / nx;
            if (og + 1u == (tg + 1u) * nx) xb_add(&bar[XB_TOPGEN], 1u);
            else XB_SPIN(xb_ld(&bar[XB_TOPGEN]) == tg, bar);
            __builtin_amdgcn_fence(__ATOMIC_ACQUIRE, "agent");
            xb_add(&bar[XB_XGEN(b.x)], 1u);
            asm volatile("s_waitcnt vmcnt(0)" ::: "memory");
        } else {
            XB_SPIN(xb_ld(&bar[XB_XGEN(b.x)]) == gen, bar);
            __builtin_amdgcn_fence(__ATOMIC_ACQUIRE, "agent");
            asm volatile("s_waitcnt vmcnt(0)" ::: "memory");
        }
    }
    __syncthreads();
}


typedef unsigned v2u __attribute__((ext_vector_type(2)));
__device__ __forceinline__ float wave_sum(float v) {
#pragma unroll
    for (int o = 1; o < 64; o <<= 1) v += __shfl_xor(v, o);
    return v;
}
__device__ __forceinline__ float bf2f(unsigned short b) { return __builtin_bit_cast(float, (unsigned)b << 16); }
__device__ __forceinline__ float bflo(unsigned w) { return __builtin_bit_cast(float, w << 16); }
__device__ __forceinline__ float bfhi(unsigned w) { return __builtin_bit_cast(float, w & 0xffff0000u); }
__device__ __forceinline__ v4u pack8(f32x4 a, f32x4 b) { v4u w; w.x = pg8::cvt_pk_bf16(a[0], a[1]); w.y = pg8::cvt_pk_bf16(a[2], a[3]); w.z = pg8::cvt_pk_bf16(b[0], b[1]); w.w = pg8::cvt_pk_bf16(b[2], b[3]); return w; }
__device__ __forceinline__ unsigned pack4_u8(f32x4 g) {
    const unsigned a = (unsigned)(g[0] * 255.f + 0.5f), b = (unsigned)(g[1] * 255.f + 0.5f), c = (unsigned)(g[2] * 255.f + 0.5f), d = (unsigned)(g[3] * 255.f + 0.5f); return a | (b << 8) | (c << 16) | (d << 24); }
__device__ __forceinline__ f32x4 unpack4_u8(unsigned w) { return (f32x4){(float)(w & 255u), (float)((w >> 8) & 255u), (float)((w >> 16) & 255u), (float)(w >> 24)}; }
__device__ __forceinline__ float sigmoidf_(float x) { return __builtin_amdgcn_rcpf(1.0f + __builtin_amdgcn_exp2f(-x * LOG2E)); }

using pg8::Unit;
#define EPI_PAIRS(...) int rb_ = u.pm * 256 + wr * 64 + fr; asm volatile("" : "+v"(rb_)); _Pragma("unroll") for (int ai = 0; ai < 2; ++ai) _Pragma("unroll") for (int m = 0; m < 4; ++m) { const size_t row = (size_t)(rb_ + ai * 128 + m * 16); \
        const f32x4 v00 = acc[ai][0][m][0], v01 = acc[ai][0][m][1], v10 = acc[ai][1][m][0], v11 = acc[ai][1][m][1]; __VA_ARGS__ }
__device__ __forceinline__ unsigned dpp_x1(unsigned v) { return (unsigned)__builtin_amdgcn_update_dpp(0, (int)v, 0xB1, 0xF, 0xF, false); }
__device__ __forceinline__ void store_pair16(bf16* p, size_t pitch, int fr, int fq, v4u P0, v4u P1) {
    const bool odd = (fr & 1) != 0; const v4u X = odd ? P0 : P1; v4u Y; Y.x = dpp_x1(X.x); Y.y = dpp_x1(X.y); Y.z = dpp_x1(X.z); Y.w = dpp_x1(X.w);
    bf16* a1 = odd ? p - pitch + 32 + 8 * fq : p + 8 * fq; bf16* a2 = odd ? p + 32 + 8 * fq : p + pitch + 8 * fq;
    *(v4u*)a1 = odd ? Y : P0; *(v4u*)a2 = odd ? P1 : Y;
}
__device__ __forceinline__ void store_pair8(unsigned char* p, size_t pitch, int fr, int fq, v2u P0, v2u P1) {
    const bool odd = (fr & 1) != 0; const v2u X = odd ? P0 : P1; v2u Y; Y.x = dpp_x1(X.x); Y.y = dpp_x1(X.y);
    unsigned char* a1 = odd ? p - pitch + 32 + 8 * fq : p + 8 * fq; unsigned char* a2 = odd ? p + 32 + 8 * fq : p + pitch + 8 * fq;
    *(v2u*)a1 = odd ? Y : P0; *(v2u*)a2 = odd ? P1 : Y;
}
struct EpiIn { static constexpr bool PERM = true, AFTER_DRAIN = false, MID = false;
    unsigned char* ws_; unsigned char* out_;
    const float *g_cq_, *g_ckv_, *b_forget_; LAS float* ex;
    __device__ __forceinline__ void operator()(const f32x4 (&acc)[2][2][4][2], const Unit& u, int wr, int wc, int fr, int fq) const {
        const int pn = u.pn;
        { int fr_ = fr, fq_ = fq; asm volatile("" : "+v"(fr_), "+v"(fq_)); fr = fr_; fq = fq_; }
        if (pn == 0) {
            { EPI_PAIRS({ float ss = 0.f;
                _Pragma("unroll") for (int e = 0; e < 4; ++e) ss += (v00[e] * v00[e] + v01[e] * v01[e]) + (v10[e] * v10[e] + v11[e] * v11[e]);
                ss += __shfl_xor(ss, 16); ss += __shfl_xor(ss, 32);
                if (fq == 0) ex[(ai * 128 + wr * 64 + m * 16 + fr) * 4 + wc] = ss; (void)row; }) }
            asm volatile("s_waitcnt lgkmcnt(0)" ::: "memory"); __builtin_amdgcn_s_barrier(); asm volatile("" ::: "memory");
            const float* gp = g_cq_ + 64 * wc + 8 * fq;
            { EPI_PAIRS({ const f32x4 pr = *(const LAS f32x4*)(ex + (ai * 128 + wr * 64 + m * 16 + fr) * 4); const float rs = 1.f / sqrtf(((pr[0] + pr[1]) + (pr[2] + pr[3])) * (1.f / 256) + EPS);
                const v4u P0 = pack8(v00 * (*(const f32x4*)gp * rs), v01 * (*(const f32x4*)(gp + 4) * rs)); const v4u P1 = pack8(v10 * (*(const f32x4*)(gp + 32) * rs), v11 * (*(const f32x4*)(gp + 36) * rs));
                store_pair16((bf16*)(ws_ + WS_CQN) + row * 256 + 64 * wc, 256, fr, fq, P0, P1); asm volatile("" ::: "memory"); }) }
        } else if (pn == 1) {
            { EPI_PAIRS({
                if (wc < 2) { float ss = 0.f;
                    _Pragma("unroll") for (int e = 0; e < 4; ++e) ss += (v00[e] * v00[e] + v01[e] * v01[e]) + (v10[e] * v10[e] + v11[e] * v11[e]);
                    ss += __shfl_xor(ss, 16); ss += __shfl_xor(ss, 32);
                    if (fq == 0) ex[(ai * 128 + wr * 64 + m * 16 + fr) * 4 + wc] = ss; }
                else if (wc == 2) {
                    if (fq == 0) { f32x4 l0; f32x4 l1;
                        _Pragma("unroll") for (int e = 0; e < 4; ++e) { const float x0 = v10[e] + b_forget_[e], x1 = v11[e] + b_forget_[4 + e];
                            l0[e] = fminf(x0, 0.f) - __logf(1.f + __expf(-fabsf(x0))); l1[e] = fminf(x1, 0.f) - __logf(1.f + __expf(-fabsf(x1))); }
                        *(f32x4*)((float*)(ws_ + WS_LOGF) + row * 8) = l0; *(f32x4*)((float*)(ws_ + WS_LOGF) + row * 8 + 4) = l1;
                        LAS float* lp = ex + 1024 + (ai * 128 + wr * 64 + m * 16 + fr) * 8; *(LAS f32x4*)lp = l0; *(LAS f32x4*)(lp + 4) = l1; } } }) }
            asm volatile("s_waitcnt lgkmcnt(0)" ::: "memory"); __builtin_amdgcn_s_barrier(); asm volatile("" ::: "memory");
            if (wr == 0 && wc == 0 && fq == 0) { const int a2 = fr >> 3, j = fr & 7; float t = 0.f;
#pragma unroll 8
                for (int r = 0; r < 128; ++r) t += ex[1024 + (a2 * 128 + r) * 8 + j];
                ((float*)(ws_ + WS_EID))[(size_t)(2 * u.pm + a2) * 8 + j] = t; }
            if (wc < 2) { const float* gp = g_ckv_ + 64 * wc + 8 * fq;
                { EPI_PAIRS({ const LAS float* pr = ex + (ai * 128 + wr * 64 + m * 16 + fr) * 4; const float rs = 1.f / sqrtf((pr[0] + pr[1]) * (1.f / 128) + EPS);
                    const v4u P0 = pack8(v00 * (*(const f32x4*)gp * rs), v01 * (*(const f32x4*)(gp + 4) * rs)); const v4u P1 = pack8(v10 * (*(const f32x4*)(gp + 32) * rs), v11 * (*(const f32x4*)(gp + 36) * rs));
                    store_pair16((bf16*)(ws_ + WS_CKVN) + row * 128 + 64 * wc, 128, fr, fq, P0, P1); asm volatile("" ::: "memory"); }) } }
            else if (wc == 2) {
                { EPI_PAIRS({ float* p = (float*)(ws_ + WS_KRR + 2 * MiB) + row * 32 + 8 * fq; *(f32x4*)p = v00; *(f32x4*)(p + 4) = v01; (void)v10; (void)v11; }) } }
        } else {
        EPI_PAIRS({
            if (pn < 4) { store_pair16((bf16*)(ws_ + WS_QF) + row * 512 + (pn - 2) * 256 + 64 * wc, 512, fr, fq, pack8(v00 * C2F, v01 * C2F), pack8(v10 * C2F, v11 * C2F)); }
            else if (pn < 6) { store_pair16((bf16*)(ws_ + WS_KF) + row * 512 + (pn - 4) * 256 + 64 * wc, 512, fr, fq, pack8(v00, v01), pack8(v10, v11)); }
            else if (pn < 8) { store_pair16((bf16*)(ws_ + WS_VF) + row * 512 + (pn - 6) * 256 + 64 * wc, 512, fr, fq, pack8(v00, v01), pack8(v10, v11)); }
            else { unsigned char* G = out_ + (pn < 12 ? (size_t)0 : (size_t)M * 1024); f32x4 s00, s01, s10, s11;
                _Pragma("unroll") for (int e = 0; e < 4; ++e) { s00[e] = sigmoidf_(v00[e]); s01[e] = sigmoidf_(v01[e]); s10[e] = sigmoidf_(v10[e]); s11[e] = sigmoidf_(v11[e]); }
                v2u q0; q0.x = pack4_u8(s00); q0.y = pack4_u8(s01); v2u q1; q1.x = pack4_u8(s10); q1.y = pack4_u8(s11);
                store_pair8(G + row * 1024 + ((pn - 8) & 3) * 256 + 64 * wc, 1024, fr, fq, q0, q1); } })
        }
    }
};
struct EpiQup { static constexpr bool PERM = true, AFTER_DRAIN = false, MID = false;
    bf16* QM;
    __device__ __forceinline__ void operator()(const f32x4 (&acc)[2][2][4][2], const Unit& u, int wr, int wc, int fr, int fq) const {
        EPI_PAIRS({ store_pair16(QM + row * 768 + u.pn * 256 + 64 * wc, 768, fr, fq, pack8(v00 * C2M, v01 * C2M), pack8(v10 * C2M, v11 * C2M)); })
    }
};
struct EpiKVup { static constexpr bool PERM = true, AFTER_DRAIN = false, MID = false;
    bf16 *KM, *VM;
    __device__ __forceinline__ void operator()(const f32x4 (&acc)[2][2][4][2], const Unit& u, int wr, int wc, int fr, int fq) const {
        bf16* D = u.pn < 2 ? KM : VM; const int c0 = (u.pn & 1) * 256;
        EPI_PAIRS({ store_pair16(D + row * 512 + c0 + 64 * wc, 512, fr, fq, pack8(v00, v01), pack8(v10, v11)); })
    }
};
struct EpiMix { static constexpr bool PERM = true, AFTER_DRAIN = false, MID = true;
    const unsigned char *GA_, *GB_; bf16* MIX_;
    __device__ __forceinline__ void mid(f32x4 (&acc)[2][2][4][2], const Unit& u, int wr, int wc, int fr, int fq) const {
        int rb_ = u.pm * 256 + wr * 64 + fr; asm volatile("" : "+v"(rb_));
#pragma unroll
        for (int ai = 0; ai < 2; ++ai) { v2u ga[4][2], gb[4][2];
#pragma unroll
            for (int m = 0; m < 4; ++m)
#pragma unroll
                for (int bj = 0; bj < 2; ++bj) { const size_t off = (size_t)(rb_ + ai * 128 + m * 16) * 1024 + u.pn * 256 + 64 * wc + 32 * bj + 8 * fq; ga[m][bj] = *(const v2u*)(GA_ + off); gb[m][bj] = *(const v2u*)(GB_ + off); }
#pragma unroll
            for (int m = 0; m < 4; ++m)
#pragma unroll
                for (int bj = 0; bj < 2; ++bj) { const f32x4 a0 = unpack4_u8(ga[m][bj].x), a1 = unpack4_u8(ga[m][bj].y); f32x4 b0 = unpack4_u8(gb[m][bj].x), b1 = unpack4_u8(gb[m][bj].y);
#pragma unroll
                    for (int e = 0; e < 4; ++e) { b0[e] = __builtin_amdgcn_rcpf(__builtin_fmaxf(b0[e], 1.f)); b1[e] = __builtin_amdgcn_rcpf(__builtin_fmaxf(b1[e], 1.f)); }
                    acc[ai][bj][m][0] *= a0 * b0; acc[ai][bj][m][1] *= a1 * b1; }
            asm volatile("" ::: "memory"); }
    }
    __device__ __forceinline__ void operator()(const f32x4 (&acc)[2][2][4][2], const Unit& u, int wr, int wc, int fr, int fq) const {
        EPI_PAIRS({ const size_t off = row * 1024 + u.pn * 256 + 64 * wc; const v2u g0 = *(const v2u*)(GB_ + off + 8 * fq), g1 = *(const v2u*)(GB_ + off + 32 + 8 * fq);
            f32x4 b00 = unpack4_u8(g0.x), b01 = unpack4_u8(g0.y), b10 = unpack4_u8(g1.x), b11 = unpack4_u8(g1.y);
            _Pragma("unroll") for (int e = 0; e < 4; ++e) { b00[e] = __builtin_fmaxf(b00[e], 1.f) * (1.f / 255.f); b01[e] = __builtin_fmaxf(b01[e], 1.f) * (1.f / 255.f); b10[e] = __builtin_fmaxf(b10[e], 1.f) * (1.f / 255.f); b11[e] = __builtin_fmaxf(b11[e], 1.f) * (1.f / 255.f); }
            store_pair16(MIX_ + off, 1024, fr, fq, pack8(v00 * b00, v01 * b01), pack8(v10 * b10, v11 * b11)); })
    }
};
struct EpiY { static constexpr bool PERM = true, AFTER_DRAIN = false, MID = false;
    bf16* Y_;
    __device__ __forceinline__ void operator()(const f32x4 (&acc)[2][2][4][2], const Unit& u, int wr, int wc, int fr, int fq) const {
        EPI_PAIRS({ store_pair16(Y_ + row * 1024 + u.pn * 256 + 64 * wc, 1024, fr, fq, pack8(v00, v01), pack8(v10, v11)); })
    }
};
struct EpiLg { static constexpr bool PERM = true, AFTER_DRAIN = false, MID = false;
    float* LG;
    __device__ __forceinline__ void operator()(const f32x4 (&acc)[2][2][4][2], const Unit& u, int wr, int wc, int fr, int fq) const {
        if (wc < 2) { EPI_PAIRS({ float* p = LG + row * 128 + 64 * wc + 8 * fq; *(f32x4*)p = v00; *(f32x4*)(p + 4) = v01; *(f32x4*)(p + 32) = v10; *(f32x4*)(p + 36) = v11; }) }
    }
};
struct EpiGU { static constexpr bool PERM = true, AFTER_DRAIN = false, MID = false;
    bf16* ACT;
    __device__ __forceinline__ void operator()(const f32x4 (&acc)[2][2][4][2], const Unit& u, int wr, int wc, int fr, int fq) const {
        const int c0 = (u.pn & 1) * 128 + wc * 32 + 8 * fq;
        EPI_PAIRS({ f32x4 a0; f32x4 a1;
            _Pragma("unroll") for (int e = 0; e < 4; ++e) { a0[e] = v00[e] * sigmoidf_(v00[e]) * v10[e]; a1[e] = v01[e] * sigmoidf_(v01[e]) * v11[e]; }
            *(v4u*)(ACT + row * 256 + c0) = pack8(a0, a1); })
    }
};
struct EpiDown { static constexpr bool PERM = true, AFTER_DRAIN = false, MID = false;
    bf16* YB; const float* WROW;
    __device__ __forceinline__ void operator()(const f32x4 (&acc)[2][2][4][2], const Unit& u, int wr, int wc, int fr, int fq) const {
        const int c0 = (u.pn & 3) * 256;
        EPI_PAIRS({ const float w = WROW[row]; store_pair16(YB + row * 1024 + c0 + 64 * wc, 1024, fr, fq, pack8(v00 * w, v01 * w), pack8(v10 * w, v11 * w)); })
    }
};
struct ExpertOrder {
    const LAS unsigned* tpre; int NJ, G, c;
    __device__ __forceinline__ bool next(int i, Unit& u) const {
        const int total = (int)tpre[NEXP] * NJ; const long L = (long)i * G + c; if (L >= total) return false;
        const int T = (int)L / NJ, j = (int)L % NJ; int e = 0;
#pragma unroll 1
        for (int k = 1; k < NEXP; ++k) e += ((int)tpre[k] <= T) ? 1 : 0;
        u.pm = T; u.pn = e * NJ + j; return true;
    }
    __device__ __forceinline__ void a_ready(const Unit&) const {}
    __device__ __forceinline__ void done(const Unit&) const {}
};

__device__ __forceinline__ void tr_item(const float* colp, int N, int k0, bf16* dst  , int K, bool lo, LAS float* scr, int lane) {
#pragma unroll 8
    for (int i = 0; i < 32; ++i) { const int kk = 2 * i + (lane >> 5); float v = colp ? colp[(size_t)(k0 + kk) * N] : 0.f;
        if (lo) v = v - bf2f((unsigned short)f2bf(v));
        scr[kk * 33 + (lane & 31)] = v; }
    LDS_WAIT(); asm volatile("" ::: "memory");
    const int c = lane & 7;
#pragma unroll
    for (int j = 0; j < 4; ++j) { const int n = (lane >> 3) + 8 * j; const LAS float* s = scr + (8 * c) * 33 + n;
        v4u o; o.x = pk2(s[0 * 33], s[1 * 33]); o.y = pk2(s[2 * 33], s[3 * 33]); o.z = pk2(s[4 * 33], s[5 * 33]); o.w = pk2(s[6 * 33], s[7 * 33]);
        *(GAS v4u*)(dst + (size_t)n * K + 8 * c) = o; }
    LDS_WAIT(); asm volatile("" ::: "memory");
}
__device__ __forceinline__ void tr_item4(const float* cp4, int N, bf16* dst  , int K, LAS float* scr, int lane) {
    const int c = lane & 7, kr0 = lane >> 3; f32x4 v[8];
#pragma unroll
    for (int i = 0; i < 8; ++i) v[i] = cp4 ? *(const f32x4*)(cp4 + (size_t)(8 * i) * N) : (f32x4){0.f, 0.f, 0.f, 0.f};
#pragma unroll
    for (int i = 0; i < 8; ++i) { LAS float* s = scr + (kr0 + 8 * i) * 33 + 4 * c; s[0] = v[i].x; s[1] = v[i].y; s[2] = v[i].z; s[3] = v[i].w; }
    LDS_WAIT(); asm volatile("" ::: "memory");
#pragma unroll
    for (int j = 0; j < 4; ++j) { const int n = kr0 + 8 * j; const LAS float* s = scr + (8 * c) * 33 + n;
        v4u o; o.x = pk2(s[0 * 33], s[1 * 33]); o.y = pk2(s[2 * 33], s[3 * 33]); o.z = pk2(s[4 * 33], s[5 * 33]); o.w = pk2(s[6 * 33], s[7 * 33]);
        *(GAS v4u*)(dst + (size_t)n * K + 8 * c) = o; }
    LDS_WAIT(); asm volatile("" ::: "memory");
}
constexpr int I7 = NEXP * 16 * 16, I8 = NEXP * 32 * 4;
__device__ __forceinline__ void conv_expert_item(int r, const float* w_e_gate, const float* w_e_up, const float* w_e_down, bf16* WGUp, bf16* WDNp, LAS float* scr, int lane) {
    const int c4 = 4 * (lane & 7), kr0 = lane >> 3;
    if (r < I7) { const int e = r / 256, q = r % 256, nb = q % 16, kb = q / 16, rr = nb * 32 + c4;
        const int j = rr >> 8, g = (rr >> 6) & 3, isup = (rr >> 5) & 1, cc = 32 * g + (rr & 31); const float* src = (isup ? w_e_up : w_e_gate) + (size_t)e * 1024 * 256 + (size_t)(kb * 64 + kr0) * 256 + 128 * j + cc;
        tr_item4(src, 256, WGUp + ((size_t)e * 512 + nb * 32) * 1024 + kb * 64, 1024, scr, lane); }
    else { r -= I7; const int e = r / 128, q = r % 128, nb = q % 32, kb = q / 32; tr_item4(w_e_down + (size_t)e * 256 * 1024 + (size_t)(kb * 64 + kr0) * 1024 + nb * 32 + c4, 1024, WDNp + ((size_t)e * 1024 + nb * 32) * 256 + kb * 64, 256, scr, lane); }
}
__device__ __forceinline__ double inv_freq_d(int i) {
    const int q = i >> 2, r = i & 3;
    const double a = q == 0 ? 1.0 : q == 1 ? 0.1 : q == 2 ? 0.01 : 0.001;
    const double b = r == 0 ? 1.0 : r == 1 ? 0.5623413251903491 : r == 2 ? 0.31622776601683794 : 0.1778279410038923;
    return a * b;
}

struct Args { const float* in[22]; float* out; unsigned char* ws; int ph_lo, ph_hi; };

__global__ void __launch_bounds__(NWAVES * 64, 2) mk_fwd(Args args) {
    extern __shared__ __attribute__((aligned(16))) unsigned char lds[];
    LAS unsigned char* const L = (LAS unsigned char*)lds;
    volatile LAS unsigned* const MISC = (volatile LAS unsigned*)(L + MISC_OFF);
    const int tid = threadIdx.x, lane = tid & 63, wave = __builtin_amdgcn_readfirstlane(tid >> 6);
    const int G = gridDim.x; const int bx = blockIdx.x; const int vcu = (G % 8 == 0) ? (bx % 8) * (G / 8) + bx / 8 : bx;
    const int gw = vcu * NWAVES + wave, NGW = G * NWAVES;
    unsigned char* const ws = args.ws;
    gu32* const ctl = (gu32*)(ws + WS_CTL);
    const float* x = args.in[0]; const int* positions = (const int*)args.in[1]; const float* g_mix = args.in[2]; const float* w_in = args.in[3]; const float* b_forget = args.in[4];
    const float* g_cq = args.in[5]; const float* g_ckv = args.in[6]; const float* w_uq = args.in[7]; const float* w_uk = args.in[8]; const float* w_uv = args.in[9];
    const float* w_o_mla = args.in[10]; const float* w_o_fox = args.in[11]; const float* w_out = args.in[12]; const float* g_ffn = args.in[13]; const float* w_group = args.in[14];
    const float* b_group = args.in[15]; const float* w_router = args.in[16]; const float* b_router = args.in[17]; const float* w_e_gate = args.in[18]; const float* w_e_up = args.in[19];
    const float* w_e_down = args.in[20]; const float* g_final = args.in[21];
    float* const out = args.out;
#define WIN ((bf16*)(ws + WS_WIN))
#define WUQ ((bf16*)(ws + WS_WUQ))
#define WUKV ((bf16*)(ws + WS_WUKV))
#define WOA ((bf16*)(ws + WS_WOA))
#define WOB ((bf16*)(ws + WS_WOB))
#define WOUT ((bf16*)(ws + WS_WOUT))
#define WR ((bf16*)(ws + WS_WR))
#define WGU ((bf16*)(ws + WS_WGU))
#define WDN ((bf16*)(ws + WS_WDN))
#define CS ((float*)(ws + WS_CS))
#define LOGF ((float*)(ws + WS_LOGF))
#define EID ((int*)(ws + WS_EID))
#define SLOT ((int*)(ws + WS_SLOT))
#define WGT ((float*)(ws + WS_WGT))
#define POS ((int*)(ws + WS_POS))
#define WROW ((float*)(ws + WS_WROW))
#define XN ((bf16*)(ws + WS_XN))
#define CQN ((bf16*)(ws + WS_CQN))
#define CKVN ((bf16*)(ws + WS_CKVN))
#define VM ((bf16*)(ws + WS_VM))
#define KR ((bf16*)(ws + WS_KRR))
#define KRF ((float*)(ws + WS_KRR + 2 * MiB))
#define KBIAS ((bf16*)(ws + WS_KR + 2 * MiB))
#define GBH ((float*)(ws + WS_KR + 6 * MiB))
#define DGQ ((float*)(ws + WS_KR + 7 * MiB))
#define QN2 ((float*)(ws + WS_EID + 16384))
#define Z0 ((bf16*)(ws + WS_Z0))
#define Z1 ((float*)(ws + WS_Z1))
#define QF ((bf16*)(ws + WS_QF))
#define KF ((bf16*)(ws + WS_KF))
#define VF ((bf16*)(ws + WS_VF))
#define OA ((bf16*)(ws + WS_OA))
#define OB ((bf16*)(ws + WS_OB))
#define MIX ((bf16*)(ws + WS_MIX))
#define QM ((bf16*)(ws + WS_QM))
#define KM ((bf16*)(ws + WS_KM))
#define HN ((bf16*)(ws + WS_HN))
#define LG ((float*)(ws + WS_LG))
#define XG ((bf16*)(ws + WS_XG))
#define ACT ((bf16*)(ws + WS_ACT))
#define YB ((bf16*)(ws + WS_YB))
#define GA ((bf16*)out)
#define GB ((bf16*)((unsigned char*)out + (size_t)M * 1024))
#define YM ((bf16*)(ws + WS_QM))

    for (int u = tid; u < (LDS_BYTES - LDSCTL_OFF) / 4; u += NWAVES * 64) ((LAS unsigned*)(L + LDSCTL_OFF))[u] = 0u;
    __syncthreads();
    XcdBarrier bar; bar.bar = (unsigned*)(ctl + CW_BAR); bar.x = 0; bar.st = nullptr;
    if (!MK_PER_PHASE) bar = xcd_barrier_post((unsigned*)(ctl + CW_BAR), MISC + 8);
    const int lo = args.ph_lo, hi = args.ph_hi;
#ifndef MK_REPEAT
#define MK_REPEAT -1
#endif
#ifndef MK_ONLY
#define MK_ONLY -1
#endif
#define IN(k) ((MK_ONLY < 0 || MK_ONLY == (k)) && lo <= (k) && (k) < hi)
#define SEAM(k) do { if (IN(k) && IN((k) + 1)) { xcd_barrier(bar); } } while (0)
    if (args.ph_hi < 0) cooperative_groups::this_grid().sync();

    if (IN(0)) for (int rep_ = 0; rep_ < ((MK_REPEAT == 0) ? 2 : 1); ++rep_) {
        LAS float* scr = (LAS float*)(L + RING_OFF + wave * 16384);
        constexpr int I0 = 128 * 16, I1 = 24 * 4, I2 = 32 * 2, I3 = 32 * 8, I4 = 32 * 8  , I5 = 32 * 16, I6 = 8 * 16;
        constexpr int NITEMS = I0 + I1 + I2; (void)I3; (void)I4; (void)I5; (void)I6;
        const int l31 = lane & 31, c4 = 4 * (lane & 7), kr0 = lane >> 3;
        for (int it = gw; it < NITEMS; it += NGW) {
            int r = it;
            if (r < I0) { const int nb = r % 128, kb = r / 128, n = nb * 32 + c4;
                int sc; if (n < 416) sc = n; else if (n < 424) sc = 1952 + (n - 416); else if (n < 512) sc = -1; else if (n < 2048) sc = n - 96; else sc = n - 88;
                tr_item4(sc >= 0 ? w_in + (size_t)(kb * 64 + kr0) * 4008 + sc : nullptr, 4008, WIN + (size_t)(nb * 32) * 1024 + kb * 64, 1024, scr, lane); continue; } r -= I0;
            if (r < I1) { const int nb = r % 24, kb = r / 24; tr_item4(w_uq + (size_t)(kb * 64 + kr0) * 768 + nb * 32 + c4, 768, WUQ + (size_t)(nb * 32) * 256 + kb * 64, 256, scr, lane); continue; } r -= I1;
            if (r < I2) { const int nb = r % 32, kb = r / 32, n = nb * 32 + c4; tr_item4((n < 512 ? w_uk + n : w_uv + (n - 512)) + (size_t)(kb * 64 + kr0) * 512, 512, WUKV + (size_t)(nb * 32) * 128 + kb * 64, 128, scr, lane); continue; }
        }
        for (int m = 2 * gw; m < M; m += 2 * NGW) {
            const GAS f32x4* xr = (const GAS f32x4*)(x + (size_t)m * DM) + lane; f32x4 v[8]; float s2a = 0.f, s2b = 0.f;
#pragma unroll
            for (int j = 0; j < 8; ++j) v[j] = xr[64 * j];
#pragma unroll
            for (int j = 0; j < 4; ++j) { s2a += (v[j].x * v[j].x + v[j].y * v[j].y) + (v[j].z * v[j].z + v[j].w * v[j].w); s2b += (v[4 + j].x * v[4 + j].x + v[4 + j].y * v[4 + j].y) + (v[4 + j].z * v[4 + j].z + v[4 + j].w * v[4 + j].w); }
            const float ra = 1.f / sqrtf(wave_sum(s2a) * (1.f / DM) + EPS), rb = 1.f / sqrtf(wave_sum(s2b) * (1.f / DM) + EPS);
            GAS unsigned long long* o8 = (GAS unsigned long long*)(XN + (size_t)m * DM) + lane;
#pragma unroll
            for (int j = 0; j < 8; ++j) { const f32x4 g = *((const f32x4*)g_mix + lane + 64 * (j & 3)); const float rs = j < 4 ? ra : rb;
                o8[64 * j] = (unsigned long long)pk2(v[j].x * rs * g.x, v[j].y * rs * g.y) | ((unsigned long long)pk2(v[j].z * rs * g.z, v[j].w * rs * g.w) << 32); }
        }
        for (int i = (vcu * NWAVES * 64 + tid); i < M * 16; i += G * NWAVES * 64) {
            const int m = i >> 4, f = i & 15; const double ang = (double)positions[m] * inv_freq_d(f); const double rev = ang * 0.15915494309189535; const float fr = (float)(rev - floor(rev));
            CS[2 * i] = __builtin_amdgcn_cosf(fr); CS[2 * i + 1] = __builtin_amdgcn_sinf(fr); }
    }
    SEAM(0);
    if (IN(1)) for (int rep_ = 0; rep_ < ((MK_REPEAT == 1) ? 2 : 1); ++rep_) {
        pg8::Gemm g{XN, WIN, M, NIN, DM}; pg8::StaticOrder S; S.init(M, NIN, G, bx);
        EpiIn E{ws, (unsigned char*)out, g_cq, g_ckv, b_forget, (LAS float*)(L + LDSCTL_OFF + 4096)};
        pg8::gemm_phase<EpiIn, pg8::StaticOrder, true, true>(L + RING_OFF, g, S, E);
    }
    SEAM(1);
    SEAM(2);
    if (IN(3)) for (int rep_ = 0; rep_ < ((MK_REPEAT == 3) ? 2 : 1); ++rep_) {
#ifndef NO_SCAN
        { for (int vb = vcu; vb < 256; vb += G) { const int b = vb >> 5, bi = vb & 31, hh = wave;
            { const size_t tok = (size_t)vb * 128 + wave * 16 + (lane >> 2); const int i0 = 4 * (lane & 3);
              const f32x4 x1 = *(const f32x4*)(KRF + tok * 32 + i0), x2 = *(const f32x4*)(KRF + tok * 32 + 16 + i0); const f32x4 ca = *(const f32x4*)(CS + tok * 32 + 2 * i0), cb = *(const f32x4*)(CS + tok * 32 + 2 * i0 + 4);
              const float co[4] = {ca[0], ca[2], cb[0], cb[2]}, si[4] = {ca[1], ca[3], cb[1], cb[3]};
              v2u o1, o2; o1.x = pk2(x1[0] * co[0] - x2[0] * si[0], x1[1] * co[1] - x2[1] * si[1]); o1.y = pk2(x1[2] * co[2] - x2[2] * si[2], x1[3] * co[3] - x2[3] * si[3]);
              o2.x = pk2(x2[0] * co[0] + x1[0] * si[0], x2[1] * co[1] + x1[1] * si[1]); o2.y = pk2(x2[2] * co[2] + x1[2] * si[2], x2[3] * co[3] + x1[3] * si[3]);
              *(v2u*)(KR + tok * 32 + i0) = o1; *(v2u*)(KR + tok * 32 + 16 + i0) = o2; }
            double base = (lane < bi) ? (double)((const float*)(ws + WS_EID))[(size_t)((b * 32 + lane) * 8 + hh)] : 0.0;
#pragma unroll
            for (int o = 1; o < 64; o <<= 1) base += __shfl_xor(base, o);
            const size_t t0 = (size_t)vb * 128 + 2 * lane; const float v0 = LOGF[t0 * 8 + hh], v1 = LOGF[(t0 + 1) * 8 + hh];
            const double sp = (double)v0 + (double)v1; double incl = sp;
#pragma unroll
            for (int o = 1; o < 64; o <<= 1) { const double t = __shfl_up(incl, o); if (lane >= o) incl += t; }
            const double run0 = base + (incl - sp) + (double)v0, run1 = run0 + (double)v1;
#pragma unroll
            for (int e = 0; e < 2; ++e) { const float gneg = (float)(-(e ? run1 : run0) * 1.4426950408889634);
                const unsigned b0 = f2bf(gneg); const float r1 = gneg - bf2f((unsigned short)b0); const unsigned b1 = f2bf(r1); const float r2 = r1 - bf2f((unsigned short)b1); const unsigned b2 = f2bf(r2);
                *(v4u*)(KBIAS + ((size_t)hh * M + t0 + e) * 8) = (v4u){b0 | (b1 << 16), b2, 0u, 0u};
                GBH[(size_t)hh * M + t0 + e] = bf2f((unsigned short)b0) + bf2f((unsigned short)b1) + bf2f((unsigned short)b2); }
            float qn = 0.f, kn = 0.f;
            LAS float* nst = (LAS float*)(L + RING_OFF) + wave * 256;
#pragma unroll 4
            for (int it = 0; it < 16; ++it) { const size_t tok = (size_t)vb * 128 + it * 8 + (lane >> 3);
                const v4u a = *(const v4u*)(KF + tok * 512 + hh * 64 + (lane & 7) * 8), q = *(const v4u*)(QF + tok * 512 + hh * 64 + (lane & 7) * 8);
                float sk = (bflo(a.x) * bflo(a.x) + bfhi(a.x) * bfhi(a.x)) + (bflo(a.y) * bflo(a.y) + bfhi(a.y) * bfhi(a.y)) + (bflo(a.z) * bflo(a.z) + bfhi(a.z) * bfhi(a.z)) + (bflo(a.w) * bflo(a.w) + bfhi(a.w) * bfhi(a.w));
                float sq = (bflo(q.x) * bflo(q.x) + bfhi(q.x) * bfhi(q.x)) + (bflo(q.y) * bflo(q.y) + bfhi(q.y) * bfhi(q.y)) + (bflo(q.z) * bflo(q.z) + bfhi(q.z) * bfhi(q.z)) + (bflo(q.w) * bflo(q.w) + bfhi(q.w) * bfhi(q.w));
                float dt = (bflo(a.x) * bflo(q.x) + bfhi(a.x) * bfhi(q.x)) + (bflo(a.y) * bflo(q.y) + bfhi(a.y) * bfhi(q.y)) + (bflo(a.z) * bflo(q.z) + bfhi(a.z) * bfhi(q.z)) + (bflo(a.w) * bflo(q.w) + bfhi(a.w) * bfhi(q.w));
#pragma unroll
                for (int o = 1; o < 8; o <<= 1) { sk += __shfl_xor(sk, o); sq += __shfl_xor(sq, o); dt += __shfl_xor(dt, o); }
                if ((lane & 7) == 0) { nst[it * 8 + (lane >> 3)] = sq; nst[128 + it * 8 + (lane >> 3)] = dt; }
                kn = fmaxf(kn, sk); qn = fmaxf(qn, sq); }
            LDS_WAIT(); asm volatile("" ::: "memory");
            { typedef float f32x2v __attribute__((ext_vector_type(2))); const size_t o2 = (size_t)hh * M + (size_t)vb * 128 + 2 * lane;
              *(f32x2v*)(QN2 + o2) = (f32x2v){nst[2 * lane], nst[2 * lane + 1]}; *(f32x2v*)(DGQ + o2) = (f32x2v){nst[128 + 2 * lane], nst[128 + 2 * lane + 1]}; }
            LDS_WAIT(); asm volatile("" ::: "memory");
#pragma unroll
            for (int o = 1; o < 64; o <<= 1) { kn = fmaxf(kn, __shfl_xor(kn, o)); qn = fmaxf(qn, __shfl_xor(qn, o)); }
            if (lane == 0) { __hip_atomic_fetch_max(ctl + CW_QK + 2 * (b * 8 + hh), __float_as_uint(sqrtf(qn)), RLX_AGENT); __hip_atomic_fetch_max(ctl + CW_QK + 2 * (b * 8 + hh) + 1, __float_as_uint(sqrtf(kn)), RLX_AGENT); }
          } }
#endif
#ifndef NO_QUP
        { pg8::Gemm g{CQN, WUQ, M, 768, 256}; pg8::StaticOrder S; S.init(M, 768, G, bx); EpiQup E{QM};
          pg8::gemm_phase<EpiQup, pg8::StaticOrder, true, true>(L + RING_OFF, g, S, E); }
#endif
#ifndef NO_KVUP
        { pg8::Gemm g{CKVN, WUKV, M, 1024, 128}; pg8::StaticOrder S; S.init(M, 1024, G, bx); EpiKVup E{KM, VM};
          pg8::gemm_phase<EpiKVup, pg8::StaticOrder, true, true>(L + RING_OFF, g, S, E); }
#endif
    }
    SEAM(3);
    if (IN(4)) for (int rep_ = 0; rep_ < ((MK_REPEAT == 4) ? 2 : 1); ++rep_) {
        const att::AttnT TA{QM, KM, KR, VM, OA, CS, LOGF, (const unsigned*)(ctl + CW_QK), (const bf16*)(ctl + CW_ZERO), nullptr, nullptr}; const att::AttnT TB{QF, KF, KBIAS, VF, OA + 512, CS, GBH, (const unsigned*)(ctl + CW_QK), (const bf16*)(ctl + CW_ZERO), QN2, DGQ};
        LAS int* qi = (LAS int*)(L + TP_OFF + 512);
        if (tid == 0) qi[0] = (int)__hip_atomic_fetch_add(ctl + CW_AQ, 1u, RLX_AGENT);
        __syncthreads();
        int idx = qi[0];
        constexpr int NLATE = I7 + I8 + 32 * 16 + 32 * 16 + 8 * 16, CONV_PER = 48, NQ = 2048 + NLATE / CONV_PER;
        static_assert(NLATE % CONV_PER == 0, "conv tickets");
        while (idx < NQ) {
            int nxt = 0; if (tid == 0) nxt = (int)__hip_atomic_fetch_add(ctl + CW_AQ, 1u, RLX_AGENT);
            constexpr int NCONV = NLATE / CONV_PER; const bool isconv = ((idx & 7) == 7) && ((idx >> 3) < NCONV); const int cidx = idx >> 3;
            const int aidx = idx - min(NCONV, (idx + 1) >> 3);
            const int r = aidx & 1023, qb = 15 - (r >> 6), bh = r & 63;
            if (!isconv && aidx < 1024) att::attn_unit<0>(bh >> 3, bh & 7, qb, TA, (char*)lds + RING_OFF);
            else if (!isconv) att::attn_unit<1>(bh >> 3, bh & 7, qb, TB, (char*)lds + RING_OFF);
            else { LAS float* scr = (LAS float*)(L + RING_OFF + wave * 16384); const int l31 = lane & 31, c4 = 4 * (lane & 7), kr0 = lane >> 3;
#pragma unroll 1
                for (int k = 0; k < CONV_PER / NWAVES; ++k) { int r = cidx * CONV_PER + wave * (CONV_PER / NWAVES) + k;
                    constexpr int J3 = 32 * 16, J5 = 32 * 16, J6 = 8 * 16;
                    if (r >= J6 + J3 + J5) { conv_expert_item(r - (J6 + J3 + J5), w_e_gate, w_e_up, w_e_down, WGU, WDN, scr, lane); continue; }
                    r = (r < J6) ? (r + J3 + J5) : (r - J6);
                    if (r < J3) { const int nb = r % 32, kb = r / 32;
                        const float* src = (kb < 8 ? w_o_mla + (size_t)(kb * 64 + kr0) * 1024 : w_o_fox + (size_t)((kb - 8) * 64 + kr0) * 1024) + nb * 32 + c4;
                        tr_item4(src, 1024, WOA + (size_t)(nb * 32) * 1024 + kb * 64, 1024, scr, lane); continue; } r -= J3;
                    if (r < J5) { const int nb = r % 32, kb = r / 32; tr_item4(w_out + (size_t)(kb * 64 + kr0) * 1024 + nb * 32 + c4, 1024, WOUT + (size_t)(nb * 32) * 1024 + kb * 64, 1024, scr, lane); continue; } r -= J5;
                    if (r < J6) { const int nb = r % 8, kb = r / 8, n = nb * 32 + l31; const int j = n & 63; const bool islo = (n >= 64 && n < 128); const bool valid = (n < 128) && (j < 36);
                        const float* cp = nullptr; int NN = 32; if (valid) { if (j < 4) { cp = w_group + j; NN = 4; } else { cp = w_router + (j - 4); NN = 32; } }
#pragma unroll 8
                        for (int i = 0; i < 32; ++i) { const int kk = 2 * i + (lane >> 5); float v = cp ? cp[(size_t)(kb * 64 + kk) * NN] : 0.f; if (islo) v = v - bf2f((unsigned short)f2bf(v)); scr[kk * 33 + l31] = v; }
                        LDS_WAIT(); asm volatile("" ::: "memory");
                        const int c = lane & 7; bf16* dst = WR + (size_t)(nb * 32) * 1024 + kb * 64;
#pragma unroll
                        for (int jj = 0; jj < 4; ++jj) { const int nn = (lane >> 3) + 8 * jj; const LAS float* sp = scr + (8 * c) * 33 + nn;
                            v4u o; o.x = pk2(sp[0 * 33], sp[1 * 33]); o.y = pk2(sp[2 * 33], sp[3 * 33]); o.z = pk2(sp[4 * 33], sp[5 * 33]); o.w = pk2(sp[6 * 33], sp[7 * 33]);
                            *(GAS v4u*)(dst + (size_t)nn * 1024 + 8 * c) = o; }
                        LDS_WAIT(); asm volatile("" ::: "memory"); } } }
            if (tid == 0) qi[0] = nxt;
            __syncthreads(); idx = qi[0];
        }
    }
#ifndef MK_ATT_PROBE
#define MK_ATT_PROBE -1
#endif
    if (MK_ATT_PROBE >= 0 && IN(4)) {
        const att::AttnT TA{QM, KM, KR, VM, MIX, CS, LOGF, (const unsigned*)(ctl + CW_QK), (const bf16*)(ctl + CW_ZERO), nullptr, nullptr}; const att::AttnT TB{QF, KF, KBIAS, VF, MIX + 512, CS, GBH, (const unsigned*)(ctl + CW_QK), (const bf16*)(ctl + CW_ZERO), QN2, DGQ};
        for (int v = vcu; v < 256; v += G) { const int bh = v >> 2, sub = v & 3, b = bh >> 3, hh = bh & 7;
#pragma unroll 1
            for (int i = 0; i < 4; ++i) { const int qb = (i == 0) ? 15 - sub : (i == 1) ? 8 + sub : (i == 2) ? 7 - sub : sub;
                att::attn_unit<0, (MK_ATT_PROBE < 0 ? 0 : MK_ATT_PROBE)>(b, hh, qb, TA, (char*)lds + RING_OFF);
                att::attn_unit<1, (MK_ATT_PROBE < 0 ? 0 : MK_ATT_PROBE)>(b, hh, qb, TB, (char*)lds + RING_OFF); } }
    }
    SEAM(4);
    if (IN(5)) for (int rep_ = 0; rep_ < ((MK_REPEAT == 5) ? 2 : 1); ++rep_) {
        pg8::Gemm g{OA, WOA, M, 1024, 1024}; pg8::StaticOrder S; S.init(M, 1024, G, bx); EpiMix E{(const unsigned char*)GA, (const unsigned char*)GB, MIX}; pg8::gemm_phase<EpiMix, pg8::StaticOrder, true, true>(L + RING_OFF, g, S, E);
    }
    SEAM(5);
    if (IN(6)) for (int rep_ = 0; rep_ < ((MK_REPEAT == 6) ? 2 : 1); ++rep_) {
        pg8::Gemm g{MIX, WOUT, M, 1024, 1024}; pg8::StaticOrder S; S.init(M, 1024, G, bx); EpiY E{YM}; pg8::gemm_phase<EpiY, pg8::StaticOrder, true, true>(L + RING_OFF, g, S, E);
    }
    SEAM(6);
    if (IN(7)) for (int rep_ = 0; rep_ < ((MK_REPEAT == 7) ? 2 : 1); ++rep_) {
        for (int m0 = 2 * gw; m0 < M; m0 += 2 * NGW) {
            f32x4 v[8]; v2u yv[8];
#pragma unroll
            for (int j = 0; j < 8; ++j) { const size_t m = (size_t)m0 + (j >> 2); v[j] = *((const GAS f32x4*)(x + m * DM) + lane + 64 * (j & 3)); yv[j] = *((const v2u*)(YM + m * DM) + lane + 64 * (j & 3)); }
            float s2[2] = {0.f, 0.f};
#pragma unroll
            for (int j = 0; j < 8; ++j) { v[j].x += bflo(yv[j].x); v[j].y += bfhi(yv[j].x); v[j].z += bflo(yv[j].y); v[j].w += bfhi(yv[j].y); s2[j >> 2] += (v[j].x * v[j].x + v[j].y * v[j].y) + (v[j].z * v[j].z + v[j].w * v[j].w); }
            const float rs[2] = {1.f / sqrtf(wave_sum(s2[0]) * (1.f / DM) + EPS), 1.f / sqrtf(wave_sum(s2[1]) * (1.f / DM) + EPS)};
#pragma unroll
            for (int j = 0; j < 8; ++j) { const size_t m = (size_t)m0 + (j >> 2); const float rstd = rs[j >> 2];
                GAS unsigned long long* oh = (GAS unsigned long long*)(HN + m * DM) + lane + 64 * (j & 3); GAS unsigned long long* ol = (GAS unsigned long long*)(HN + ((size_t)M + m) * DM) + lane + 64 * (j & 3);
                const f32x4 g = *((const f32x4*)g_ffn + lane + 64 * (j & 3)); const f32x4 y = {v[j].x * rstd * g.x, v[j].y * rstd * g.y, v[j].z * rstd * g.z, v[j].w * rstd * g.w};
                const unsigned h0 = f2bf(y.x), h1 = f2bf(y.y), h2 = f2bf(y.z), h3 = f2bf(y.w);
                *oh = (unsigned long long)(h0 | (h1 << 16)) | ((unsigned long long)(h2 | (h3 << 16)) << 32);
                *ol = (unsigned long long)pk2(y.x - bf2f((unsigned short)h0), y.y - bf2f((unsigned short)h1)) | ((unsigned long long)pk2(y.z - bf2f((unsigned short)h2), y.w - bf2f((unsigned short)h3)) << 32); }
        }
    }
    SEAM(7);
    if (IN(8)) for (int rep_ = 0; rep_ < ((MK_REPEAT == 8) ? 2 : 1); ++rep_) {
        pg8::Gemm g{HN, WR, 2 * M, 256, 1024}; pg8::StaticOrder S; S.init(2 * M, 256, G, bx); EpiLg E{LG}; pg8::gemm_phase<EpiLg, pg8::StaticOrder, true, true>(L + RING_OFF, g, S, E);
    }
    SEAM(8);
    if (IN(9)) for (int rep_ = 0; rep_ < ((MK_REPEAT == 9) ? 2 : 1); ++rep_) {
        LAS unsigned* lc = (LAS unsigned*)(L + TP_OFF + 256);
        const int per = (M + G - 1) / G;
        for (int t0 = vcu * per; t0 < min(M, (vcu + 1) * per); t0 += NWAVES * 64) {
        if (tid < 64) lc[tid] = 0u;
        __syncthreads();
        const int t = t0 + tid; const bool act = (t < min(M, (vcu + 1) * per));
        int x0 = 0, x1 = 0; unsigned s0 = 0, s1 = 0; float w0 = 0.f, w1 = 0.f;
        if (act) {
            float lg[36];
            const float* a = LG + (size_t)t * 128; const float* b2 = LG + (size_t)(M + t) * 128;
#pragma unroll
            for (int q = 0; q < 9; ++q) { const f32x4 p0 = *(const f32x4*)(a + 4 * q), p1 = *(const f32x4*)(a + 64 + 4 * q), p2 = *(const f32x4*)(b2 + 4 * q), p3 = *(const f32x4*)(b2 + 64 + 4 * q);
#pragma unroll
                for (int e = 0; e < 4; ++e) lg[4 * q + e] = (p0[e] + p1[e]) + (p2[e] + p3[e]); }
#pragma unroll
            for (int j = 0; j < 4; ++j) lg[j] += b_group[j];
#pragma unroll
            for (int j = 0; j < 32; ++j) lg[4 + j] += b_router[j];
            int gi = 0; float gm = lg[0];
#pragma unroll
            for (int j = 1; j < 4; ++j) if (lg[j] > gm) { gm = lg[j]; gi = j; }
            float gs = 0.f;
#pragma unroll
            for (int j = 0; j < 4; ++j) gs += __expf(lg[j] - gm);
            const float gp = 1.f / gs;
            float sel[8];
#pragma unroll
            for (int e = 0; e < 8; ++e) sel[e] = gi == 0 ? lg[4 + e] : gi == 1 ? lg[12 + e] : gi == 2 ? lg[20 + e] : lg[28 + e];
            int e0 = 0; float m0 = sel[0];
#pragma unroll
            for (int e = 1; e < 8; ++e) if (sel[e] > m0) { m0 = sel[e]; e0 = e; }
            int e1 = -1; float m1 = -INFINITY;
#pragma unroll
            for (int e = 0; e < 8; ++e) if (e != e0 && sel[e] > m1) { m1 = sel[e]; e1 = e; }
            const float r = __expf(m1 - m0); w0 = gp / (1.f + r); w1 = gp * r / (1.f + r);
            x0 = gi * 8 + e0; x1 = gi * 8 + e1;
            s0 = __hip_atomic_fetch_add(lc + x0, 1u, __ATOMIC_RELAXED, __HIP_MEMORY_SCOPE_WORKGROUP); s1 = __hip_atomic_fetch_add(lc + x1, 1u, __ATOMIC_RELAXED, __HIP_MEMORY_SCOPE_WORKGROUP);
        }
        __syncthreads();
        if (tid < NEXP) { const unsigned c = lc[tid]; lc[32 + tid] = c ? __hip_atomic_fetch_add(ctl + CW_CNT + 64 * tid, c, RLX_AGENT) : 0u; }
        __syncthreads();
        if (act) { EID[2 * t] = x0; EID[2 * t + 1] = x1; SLOT[2 * t] = (int)(lc[32 + x0] + s0); SLOT[2 * t + 1] = (int)(lc[32 + x1] + s1); WGT[2 * t] = w0; WGT[2 * t + 1] = w1; }
        __syncthreads();
        }
    }
    SEAM(9);
    if (IN(10)) for (int rep_ = 0; rep_ < ((MK_REPEAT == 10) ? 2 : 1); ++rep_) {
        LAS unsigned* tp = (LAS unsigned*)(L + TP_OFF);
        if (tid == 0) { unsigned acc = 0; for (int e = 0; e < NEXP; ++e) { tp[e] = acc; acc += (__hip_atomic_load(ctl + CW_CNT + 64 * e, RLX_AGENT) + 255u) >> 8; } tp[NEXP] = acc;
            if (bx == 0) for (int e = 0; e <= NEXP; ++e) __hip_atomic_store(ctl + CW_TPRE + e, tp[e], RLX_AGENT); }
        __syncthreads();
        int* const IDX = (int*)(ws + WS_WROW + 512 * 1024);
        for (int m = vcu * NWAVES * 64 + tid; m < M; m += G * NWAVES * 64) {
            const int x0 = EID[2 * m], x1 = EID[2 * m + 1]; const int p0 = (int)tp[x0] * 256 + SLOT[2 * m], p1 = (int)tp[x1] * 256 + SLOT[2 * m + 1];
            POS[2 * m] = p0; POS[2 * m + 1] = p1; WROW[p0] = WGT[2 * m]; WROW[p1] = WGT[2 * m + 1]; IDX[p0] = m; IDX[p1] = m;
        }
        for (int e = vcu; e < NEXP; e += G) { const int r0 = (int)tp[e] * 256 + (int)__hip_atomic_load(ctl + CW_CNT + 64 * e, RLX_AGENT), r1 = (int)tp[e + 1] * 256;
            for (int r = r0 + tid; r < r1; r += NWAVES * 64) IDX[r] = 0; }
        __syncthreads();
    }
    SEAM(10);
    if (IN(11)) for (int rep_ = 0; rep_ < ((MK_REPEAT == 11) ? 2 : 1); ++rep_) {
        LAS unsigned* tp = (LAS unsigned*)(L + TP_OFF); if (tid <= NEXP) tp[tid] = __hip_atomic_load(ctl + CW_TPRE + tid, RLX_AGENT); __syncthreads();
        pg8::Gemm g{HN, WGU, XG_ROWS, NEXP * 512, 1024, (const int*)(ws + WS_WROW + 512 * 1024)}; ExpertOrder S{tp, 2, G, bx}; EpiGU E{ACT};
        pg8::gemm_phase<EpiGU, ExpertOrder, true, true, true>(L + RING_OFF, g, S, E);
    }
    SEAM(11);
    if (IN(12)) for (int rep_ = 0; rep_ < ((MK_REPEAT == 12) ? 2 : 1); ++rep_) {
        LAS unsigned* tp = (LAS unsigned*)(L + TP_OFF); if (tid <= NEXP) tp[tid] = __hip_atomic_load(ctl + CW_TPRE + tid, RLX_AGENT); __syncthreads();
        pg8::Gemm g{ACT, WDN, XG_ROWS, NEXP * 1024, 256}; ExpertOrder S{tp, 4, G, bx}; EpiDown E{YB, WROW};
        pg8::gemm_phase<EpiDown, ExpertOrder, true, true>(L + RING_OFF, g, S, E);
    }
    SEAM(12);
    if (IN(13)) for (int rep_ = 0; rep_ < ((MK_REPEAT == 13) ? 2 : 1); ++rep_) {
        for (int m = gw; m < M; m += NGW) {
            const int p0 = POS[2 * m], p1 = POS[2 * m + 1];
            const GAS f32x4* xr = (const GAS f32x4*)(x + (size_t)m * DM) + lane; const v2u* yr = (const v2u*)(YM + (size_t)m * DM) + lane;
            const v2u* y0 = (const v2u*)(YB + (size_t)p0 * DM) + lane; const v2u* y1 = (const v2u*)(YB + (size_t)p1 * DM) + lane;
            f32x4 v[4]; v2u ya[4], yb[4], yc[4]; float s2 = 0.f;
#pragma unroll
            for (int j = 0; j < 4; ++j) { v[j] = xr[64 * j]; ya[j] = yr[64 * j]; yb[j] = y0[64 * j]; yc[j] = y1[64 * j]; }
#pragma unroll
            for (int j = 0; j < 4; ++j) {
                v[j].x += bflo(ya[j].x) + (bflo(yb[j].x) + bflo(yc[j].x)); v[j].y += bfhi(ya[j].x) + (bfhi(yb[j].x) + bfhi(yc[j].x)); v[j].z += bflo(ya[j].y) + (bflo(yb[j].y) + bflo(yc[j].y)); v[j].w += bfhi(ya[j].y) + (bfhi(yb[j].y) + bfhi(yc[j].y));
                s2 += (v[j].x * v[j].x + v[j].y * v[j].y) + (v[j].z * v[j].z + v[j].w * v[j].w); }
            const float rstd = 1.f / sqrtf(wave_sum(s2) * (1.f / DM) + EPS);
            GAS f32x4* orow = (GAS f32x4*)(out + (size_t)m * DM) + lane;
#pragma unroll
            for (int j = 0; j < 4; ++j) { const f32x4 g = *((const f32x4*)g_final + lane + 64 * j); orow[64 * j] = (f32x4){v[j].x * rstd * g.x, v[j].y * rstd * g.y, v[j].z * rstd * g.z, v[j].w * rstd * g.w}; }
        }
    }
#undef IN
#undef SEAM
}

extern "C" void kernel_launch(void* const* d_in, const int* in_sizes, int n_in, void* d_out, int out_size, void* d_ws, size_t ws_size, hipStream_t stream) {
    static int grid = 0;
    if (grid == 0) {
        if (n_in != 22 || in_sizes[0] != M * DM || out_size != M * DM || ws_size < WS_END) { fprintf(stderr, "kernel_launch: unexpected shapes (n_in %d, in0 %d, out %d, ws %zu); nothing launched\n", n_in, n_in > 0 ? in_sizes[0] : -1, out_size, ws_size); grid = -1; return; }
        int dev = 0, cus = 0, per_cu = 0;
        if (hipGetDevice(&dev) != hipSuccess || hipDeviceGetAttribute(&cus, hipDeviceAttributeMultiprocessorCount, dev) != hipSuccess) { grid = -1; return; }
        if (hipFuncSetAttribute((const void*)mk_fwd, hipFuncAttributeMaxDynamicSharedMemorySize, LDS_BYTES) != hipSuccess) { fprintf(stderr, "kernel_launch: hipFuncSetAttribute failed\n"); grid = -1; return; }
        if (hipOccupancyMaxActiveBlocksPerMultiprocessor(&per_cu, (const void*)mk_fwd, NWAVES * 64, LDS_BYTES) != hipSuccess || per_cu < 1) { fprintf(stderr, "kernel_launch: occupancy query says %d blocks/CU\n", per_cu); per_cu = 1; }
        (void)hipGetLastError();
        grid = cus;
    }
    if (grid < 0) return;
    if (hipMemsetAsync((char*)d_ws + WS_CTL, 0, CTL_ZERO_BYTES, stream) != hipSuccess) { fprintf(stderr, "kernel_launch: memset failed\n"); return; }
    Args a{};
    for (int i = 0; i < 22; ++i) a.in[i] = (const float*)d_in[i];
    a.out = (float*)d_out; a.ws = (unsigned char*)d_ws;
#if MK_PER_PHASE
#ifndef MK_REPEAT_L
#define MK_REPEAT_L -1
#endif
    for (int p = 0; p < N_PHASES; ++p) { a.ph_lo = p; a.ph_hi = p + 1; hipLaunchKernelGGL(mk_fwd, dim3(grid), dim3(NWAVES * 64), LDS_BYTES, stream, a);
        if (p == MK_REPEAT_L) hipLaunchKernelGGL(mk_fwd, dim3(grid), dim3(NWAVES * 64), LDS_BYTES, stream, a); }
#else
#ifndef MK_PREFIX
#define MK_PREFIX -1
#endif
    void* kargs[] = {&a};
    if (MK_PREFIX >= 0) {
        a.ph_lo = 0; a.ph_hi = MK_PREFIX + 1;
        (void)hipLaunchCooperativeKernel((const void*)mk_fwd, dim3(grid), dim3(NWAVES * 64), kargs, LDS_BYTES, stream);
        (void)hipMemsetAsync((char*)d_ws + WS_CTL, 0, CTL_ZERO_BYTES, stream);
    }
    a.ph_lo = 0; a.ph_hi = N_PHASES;
    hipError_t e = hipLaunchCooperativeKernel((const void*)mk_fwd, dim3(grid), dim3(NWAVES * 64), kargs, LDS_BYTES, stream);
    if (e != hipSuccess) fprintf(stderr, "kernel_launch: cooperative launch failed: %s (grid %d)\n", hipGetErrorString(e), grid);
#endif
}
```
